# Optimizing an MI355X kernel written in HIP

```python
import math
import jax, jax.numpy as jnp
from jax import lax
import numpy as np

D_MODEL = 1024
BATCH = 8
SEQ = 4096
DEPTH = 4

GRID_W = 64
CTX_LEN = 256
D_MIX = D_MODEL
CONV_W = D_MIX // 4
CONV_GROUPS = 4
CONV_K = 31
GLA_W = D_MIX // 4
GLA_HEADS = 4
GLA_DV = GLA_W // GLA_HEADS
GLA_DK = GLA_DV // 2
GLA_RANK = 16
GLA_GATE_NORM = 16.0
GLA_CHUNK = 64
ATT_W = D_MIX - CONV_W - GLA_W
HEAD_DIM = 64
N_HEADS = ATT_W // HEAD_DIM
N_KV_HEADS = 2
Q_BLOCK = 128
ROPE_BASE = 10000.0
ROT_FREQS = HEAD_DIM // 4
D_FF = 2816
N_MOD = 9
EPS = 1e-6
IN_SIZES = (CONV_W, CONV_W, GLA_HEADS * GLA_DK, GLA_HEADS * GLA_DK, GLA_W, GLA_W,
            GLA_RANK, GLA_RANK, ATT_W, N_KV_HEADS * HEAD_DIM, N_KV_HEADS * HEAD_DIM)
IN_WIDTH = sum(IN_SIZES)

kernel_name = "hymba_style_conv_gla_gqa_macaron_dit"


def rms_norm(x, g):
    xf = x.astype(jnp.float32)
    y = xf * lax.rsqrt(jnp.mean(xf * xf, axis=-1, keepdims=True) + EPS)
    return (y * g.astype(jnp.float32)).astype(x.dtype)


def pre(x, mod, j, g):
    return rms_norm(x, g) * (1 + mod[:, :, 3 * j + 1]) + mod[:, :, 3 * j]


def half_ffn(x, mod, j, g, w1, w2):
    gu = pre(x, mod, j, g) @ w1
    a, u = jnp.split(gu, 2, axis=-1)
    return x + 0.5 * mod[:, :, 3 * j + 2] * ((jax.nn.silu(a) * u) @ w2)


def split_proj(p):
    idx = np.cumsum(np.array(IN_SIZES))[:-1].tolist()
    return jnp.split(p, idx, axis=-1)


def conv_module(a, gate, w_dw, b_dw, g, b):
    h = a * jax.nn.sigmoid(gate)
    h = lax.conv_general_dilated(h, w_dw[:, None, :].astype(h.dtype), window_strides=(1,),
                                 padding=[(CONV_K // 2, CONV_K // 2)],
                                 dimension_numbers=('NWC', 'WIO', 'NWC'),
                                 feature_group_count=CONV_W) + b_dw
    B, T, C = h.shape
    hf = h.astype(jnp.float32).reshape(B, T, CONV_GROUPS, C // CONV_GROUPS)
    mu = jnp.mean(hf, axis=-1, keepdims=True)
    var = jnp.mean(jnp.square(hf - mu), axis=-1, keepdims=True)
    hf = ((hf - mu) * lax.rsqrt(var + EPS)).reshape(B, T, C) * g + b
    return jax.nn.silu(hf).astype(a.dtype)


def gla_inputs(p, w_gate, b_gate):
    B, T, _ = p[2].shape
    f = lambda t, d: t.astype(jnp.float32).reshape(B, T, GLA_HEADS, d)
    q = f(p[2], GLA_DK) * (GLA_DK ** -0.5)
    k = f(p[3], GLA_DK)
    v = f(p[4], GLA_DV)
    la_f = f(jax.nn.log_sigmoid(p[6].astype(jnp.float32) @ w_gate[0].astype(jnp.float32)
                                 + b_gate[0].astype(jnp.float32)) / GLA_GATE_NORM, GLA_DK)
    la_b = f(jax.nn.log_sigmoid(p[7].astype(jnp.float32) @ w_gate[1].astype(jnp.float32)
                                 + b_gate[1].astype(jnp.float32)) / GLA_GATE_NORM, GLA_DK)
    return q, k, v, la_f, la_b


def gla_chunked(q, k, v, log_a, s0):
    B, T, H, DK = q.shape
    DV = v.shape[-1]
    C = GLA_CHUNK
    N = T // C
    q = q.reshape(B, N, C, H, DK)
    k = k.reshape(B, N, C, H, DK)
    v = v.reshape(B, N, C, H, DV)
    bcum = jnp.cumsum(log_a.reshape(B, N, C, H, DK), axis=2)
    b_last = bcum[:, :, -1]
    q_e = q * jnp.exp(bcum)
    k_e = k * jnp.exp(-bcum)
    k_end = k * jnp.exp(b_last[:, :, None] - bcum)
    mask = jnp.tril(jnp.ones((C, C), dtype=bool))
    att = jnp.where(mask, jnp.einsum('bnihd,bnjhd->bnhij', q_e, k_e), 0.0)
    o = jnp.einsum('bnhij,bnjhv->bnihv', att, v)
    ds = jnp.einsum('bnjhd,bnjhv->bnhdv', k_end, v)
    decay = jnp.exp(b_last)

    def step(s, inp):
        dec, d = inp
        return dec[..., None] * s + d, s

    s_fin, s_start = lax.scan(step, s0, (jnp.moveaxis(decay, 1, 0), jnp.moveaxis(ds, 1, 0)))
    s_start = jnp.moveaxis(s_start, 0, 1)
    o = o + jnp.einsum('bnihd,bnhdv->bnihv', q_e, s_start)
    return o.reshape(B, T, H, DV), s_fin


def gla_bidir(q, k, v, la_f, la_b, s0_f, s0_b):
    flip = lambda t: jnp.flip(t, axis=1)
    o_f, s_f = gla_chunked(q, k, v, la_f, s0_f)
    o_b, s_b = gla_chunked(flip(q), flip(k), flip(v), flip(la_b), s0_b)
    return o_f + flip(o_b), s_f, s_b


def gla_output(o, r, g):
    B, T = r.shape[:2]
    on = rms_norm(o, g).reshape(B, T, GLA_W)
    return (on * jax.nn.silu(r.astype(jnp.float32))).astype(r.dtype)


def rope2d(x, cos, sin):
    B, T, H, HD = x.shape
    xr = x.reshape(B, T, H, 2, 2, HD // 4)
    x1, x2 = xr[..., 0, :], xr[..., 1, :]
    c, s = cos[:, None], sin[:, None]
    out = jnp.stack([x1 * c - x2 * s, x2 * c + x1 * s], axis=-2)
    return out.reshape(B, T, H, HD).astype(x.dtype)


def group_q(q):
    B, T, H, HD = q.shape
    return (q * (HD ** -0.5)).reshape(B, T, N_KV_HEADS, H // N_KV_HEADS, HD)


def attend(qi, k, v):
    s = jnp.einsum('bqkgd,bskd->bkgqs', qi, k).astype(jnp.float32)
    p = jax.nn.softmax(s, axis=-1).astype(v.dtype)
    return jnp.einsum('bkgqs,bskd->bqkgd', p, v)


def attention_latent(q, k_all, v_all):
    B, S = q.shape[:2]
    nb = S // Q_BLOCK
    qg = group_q(q)
    qb = jnp.moveaxis(qg.reshape(B, nb, Q_BLOCK, *qg.shape[2:]), 1, 0)
    o = lax.map(lambda qi: attend(qi, k_all, v_all), qb)
    return jnp.moveaxis(o, 0, 1).reshape(B, S, ATT_W)


def token_mix(hx, hc, cos, sin, w_in, w_out, w_dw, b_dw, cn_g, cn_b, w_gate, b_gate,
              gla_g, qn_g, kn_g, last):
    B, S, _ = hx.shape
    L = hc.shape[1]
    px = split_proj(hx @ w_in)
    pc = split_proj(hc @ w_in)
    conv_x = conv_module(px[0], px[1], w_dw, b_dw, cn_g, cn_b)
    qx, kx, vx, lfx, lbx = gla_inputs(px, w_gate, b_gate)
    qc, kc, vc, lfc, lbc = gla_inputs(pc, w_gate, b_gate)
    zeros = jnp.zeros((B, GLA_HEADS, GLA_DK, GLA_DV), jnp.float32)
    o_c, s_f, s_b = gla_bidir(qc, kc, vc, lfc, lbc, zeros, zeros)
    o_x, _, _ = gla_bidir(qx, kx, vx, lfx, lbx, s_f, s_b)
    gla_x = gla_output(o_x, px[5], gla_g)
    aqx = rope2d(rms_norm(px[8].reshape(B, S, N_HEADS, HEAD_DIM), qn_g), cos, sin)
    akx = rope2d(rms_norm(px[9].reshape(B, S, N_KV_HEADS, HEAD_DIM), kn_g), cos, sin)
    avx = px[10].reshape(B, S, N_KV_HEADS, HEAD_DIM)
    akc = rms_norm(pc[9].reshape(B, L, N_KV_HEADS, HEAD_DIM), kn_g)
    avc = pc[10].reshape(B, L, N_KV_HEADS, HEAD_DIM)
    k_all = jnp.concatenate([akc, akx], axis=1)
    v_all = jnp.concatenate([avc, avx], axis=1)
    att_x = attention_latent(aqx, k_all, v_all)
    y_x = jnp.concatenate([conv_x, gla_x, att_x], axis=-1) @ w_out
    if last:
        return y_x, None
    conv_c = conv_module(pc[0], pc[1], w_dw, b_dw, cn_g, cn_b)
    gla_c = gla_output(o_c, pc[5], gla_g)
    aqc = rms_norm(pc[8].reshape(B, L, N_HEADS, HEAD_DIM), qn_g)
    att_c = attend(group_q(aqc), akc, avc).reshape(B, L, ATT_W)
    y_c = jnp.concatenate([conv_c, gla_c, att_c], axis=-1) @ w_out
    return y_x, y_c


def layer(x, ctx, mod_x, mod_c, cos, sin, g_norm, w_ffn_in, w_ffn_out, w_in, w_out, w_dw, b_dw,
          cn_g, cn_b, w_gate, b_gate, gla_g, qn_g, kn_g, last):
    x = half_ffn(x, mod_x, 0, g_norm[0], w_ffn_in[0], w_ffn_out[0])
    ctx = half_ffn(ctx, mod_c, 0, g_norm[0], w_ffn_in[0], w_ffn_out[0])
    hx = pre(x, mod_x, 1, g_norm[1])
    hc = pre(ctx, mod_c, 1, g_norm[1])
    y_x, y_c = token_mix(hx, hc, cos, sin, w_in, w_out, w_dw, b_dw, cn_g, cn_b, w_gate, b_gate,
                         gla_g, qn_g, kn_g, last)
    x = x + mod_x[:, :, 5] * y_x
    x = half_ffn(x, mod_x, 2, g_norm[2], w_ffn_in[1], w_ffn_out[1])
    if not last:
        ctx = ctx + mod_c[:, :, 5] * y_c
        ctx = half_ffn(ctx, mod_c, 2, g_norm[2], w_ffn_in[1], w_ffn_out[1])
    return x, ctx


def setup_inputs(seed: int = 0) -> dict:
    key = jax.random.key(seed)
    ks = jax.random.split(key, 20)
    nrm = lambda k, shape, s: jax.random.normal(k, shape, jnp.float32) * s
    D = D_MODEL
    return {
        "x": nrm(ks[0], (BATCH, SEQ, D), 1.0),
        "c": nrm(ks[1], (BATCH, D), 1.0),
        "ctx": nrm(ks[2], (BATCH, CTX_LEN, D), 1.0),
        "c_ctx": nrm(ks[3], (D,), 1.0),
        "w_ada": nrm(ks[4], (DEPTH, D, N_MOD * D), 0.5 * D ** -0.5),
        "b_ada": nrm(ks[5], (DEPTH, N_MOD * D), 0.02),
        "g_norm": 1.0 + nrm(ks[6], (DEPTH, 3, D), 0.02),
        "w_ffn_in": nrm(ks[7], (DEPTH, 2, D, 2 * D_FF), D ** -0.5),
        "w_ffn_out": nrm(ks[8], (DEPTH, 2, D_FF, D), D_FF ** -0.5),
        "w_in": nrm(ks[9], (DEPTH, D, IN_WIDTH), D ** -0.5),
        "w_out": nrm(ks[10], (DEPTH, D_MIX, D), D_MIX ** -0.5),
        "w_dw": nrm(ks[11], (DEPTH, CONV_K, CONV_W), CONV_K ** -0.5),
        "b_dw": nrm(ks[12], (DEPTH, CONV_W), 0.02),
        "conv_norm_g": 1.0 + nrm(ks[13], (DEPTH, CONV_W), 0.02),
        "conv_norm_b": nrm(ks[14], (DEPTH, CONV_W), 0.02),
        "w_gla_gate": nrm(ks[15], (DEPTH, 2, GLA_RANK, GLA_HEADS * GLA_DK), GLA_RANK ** -0.5),
        "b_gla_gate": nrm(ks[16], (DEPTH, 2, GLA_HEADS * GLA_DK), 0.1),
        "gla_norm_g": 1.0 + nrm(ks[17], (DEPTH, GLA_HEADS, GLA_DV), 0.02),
        "q_norm_g": 1.0 + nrm(ks[18], (DEPTH, HEAD_DIM), 0.02),
        "k_norm_g": 1.0 + nrm(ks[19], (DEPTH, HEAD_DIM), 0.02),
    }


def reference(x, c, ctx, c_ctx, w_ada, b_ada, g_norm, w_ffn_in, w_ffn_out, w_in, w_out, w_dw, b_dw,
              conv_norm_g, conv_norm_b, w_gla_gate, b_gla_gate, gla_norm_g, q_norm_g, k_norm_g):
    B, S, D = x.shape
    rows_n = S // GRID_W
    row = jnp.repeat(jnp.arange(rows_n), GRID_W).astype(jnp.float32)
    col = jnp.tile(jnp.arange(GRID_W), rows_n).astype(jnp.float32)
    freqs = ROPE_BASE ** (-jnp.arange(ROT_FREQS, dtype=jnp.float32) / ROT_FREQS)
    ang = jnp.stack([row[:, None] * freqs, col[:, None] * freqs], axis=1)
    cos, sin = jnp.cos(ang), jnp.sin(ang)
    sc = jax.nn.silu(c)
    scc = jax.nn.silu(c_ctx)
    for i in range(DEPTH):
        last = i == DEPTH - 1
        mod_x = (sc @ w_ada[i] + b_ada[i]).reshape(B, 1, N_MOD, D)
        mod_c = (scc @ w_ada[i] + b_ada[i]).reshape(1, 1, N_MOD, D)
        x, ctx = layer(x, ctx, mod_x, mod_c, cos, sin, g_norm[i], w_ffn_in[i], w_ffn_out[i],
                       w_in[i], w_out[i], w_dw[i], b_dw[i], conv_norm_g[i], conv_norm_b[i],
                       w_gla_gate[i], b_gla_gate[i], gla_norm_g[i], q_norm_g[i], k_norm_g[i], last)
    return x
```

```cpp
#include <hip/hip_runtime.h>
#include <hip/hip_cooperative_groups.h>
#include <cstdio>
#include <cstdint>
namespace cg = cooperative_groups;
__device__ __forceinline__ int opaque_tid() { int t = threadIdx.x; asm volatile("" : "+v"(t)); return t; }
namespace pg8 {
#define PG8_LAS __attribute__((address_space(3)))
typedef unsigned short bf16_t;
typedef short bf16x8 __attribute__((ext_vector_type(8)));
typedef float f32x4 __attribute__((ext_vector_type(4)));
typedef unsigned u32x4 __attribute__((ext_vector_type(4)));
constexpr int BM = 256, BK = 64, HALF = 128, HTB = HALF * BK * 2  , STAGE_BYTES = 8 * HTB, NXCD = 8, WGM = 8;

__host__ __device__ __forceinline__ int lds_byte(int r, int c) { const int st = (r >> 4) * 2 + (c >> 5), rr = r & 15, cc = c & 31, ob = rr * 64 + cc * 2; return st * 1024 + (ob ^ (((ob >> 9) & 1) << 5)); }
__host__ __device__ __forceinline__ void stage_rc(int b, int& R, int& C) { const int st = b / 1024, sb = b % 1024, swz = sb ^ (((sb >> 9) & 1) << 5); R = (st >> 1) * 16 + swz / 64; C = (st & 1) * 32 + (swz % 64) / 2; }
__host__ __device__ __forceinline__ int perm32(int rho) { const int n = rho >> 4, i = rho & 15; return 8 * (i >> 2) + 4 * n + (i & 3); }

struct Unit { int pm, pn; };
struct Gemm { const bf16_t* A; const bf16_t* Bt; int M, N, K; };

struct StaticOrder {
    int nM, nN, nwg, G, c;
    __host__ __device__ void init(int M, int N, int G_, int c_) { nM = M / BM; nN = N / BM; nwg = nM * nN; G = G_; c = c_; }
    __host__ __device__ bool next(int i, Unit& u) const {
        const long L = (long)i * G + c; if (L >= nwg) return false;
        int wgid = (int)L; { const int q = nwg / NXCD, r = nwg % NXCD, xcd = wgid % NXCD, off = wgid / NXCD; wgid = (xcd < r ? xcd * (q + 1) : r * (q + 1) + (xcd - r) * q) + off; }
        const int nig = WGM * nN, gid = wgid / nig, fm = gid * WGM, gsz = (nM - fm) < WGM ? (nM - fm) : WGM;
        u.pm = fm + ((wgid % nig) % gsz); u.pn = (wgid % nig) / gsz; return true;
    }
    __device__ __forceinline__ void a_ready(const Unit&) const {}
    __device__ __forceinline__ void done(const Unit&) const {}
};

constexpr int PF_OFF = 132096, PF_SLOT = 2048;
struct PrefOrder : StaticOrder {
    PG8_LAS unsigned char* pf; const float* ssq; const float* sw; int MXr; mutable int cnt;
    __device__ __forceinline__ void a_ready(const Unit& u) const {
        const int t = threadIdx.x, w = __builtin_amdgcn_readfirstlane(t >> 6), lane = t & 63; const int slot = cnt & 1; ++cnt;
        const int rowt = u.pm * BM, bidx = rowt >= MXr ? 8 : (rowt >> 12);
        const float* src = (w < 4) ? ssq + rowt + w * 64 + lane : sw + (size_t)bidx * 5632 + u.pn * BM + (w - 4) * 64 + lane;
        __builtin_amdgcn_global_load_lds((const unsigned*)src, (PG8_LAS unsigned*)(pf + slot * PF_SLOT + w * 256), 4, 0, 0);
    }
};
__device__ __forceinline__ unsigned cvt_pk_bf16(float lo, float hi) { unsigned r; asm volatile("v_cvt_pk_bf16_f32 %0, %1, %2" : "=v"(r) : "v"(lo), "v"(hi)); return r; }
typedef float f32x2 __attribute__((ext_vector_type(2)));
__device__ __forceinline__ float silu_f(float v) { return v * __builtin_amdgcn_rcpf(1.0f + __expf(-v)); }
struct EpiStore {
    static constexpr bool PERM = true, AFTER_DRAIN = false;
    bf16_t* O; int ldc; PG8_LAS unsigned char* pf; mutable int cnt;
    __device__ __forceinline__ void operator()(const f32x4 (&acc)[2][2][4][2], const Unit& u, int wr, int wc, int fr, int fq) const {
        const int rowt = u.pm * BM; PG8_LAS const float* sl = (PG8_LAS const float*)(pf + (cnt & 1) * PF_SLOT); ++cnt;
        const int row0 = rowt + wr * 64 + fr, col0 = u.pn * BM + wc * 32 + 8 * fq;
        f32x4 sv[2][2];
#pragma unroll
        for (int bj = 0; bj < 2; ++bj)
#pragma unroll
            for (int n = 0; n < 2; ++n) sv[bj][n] = *(PG8_LAS const f32x4*)(sl + 256 + wc * 32 + 8 * fq + bj * HALF + 4 * n);
#pragma unroll
        for (int ai = 0; ai < 2; ++ai)
#pragma unroll
            for (int m = 0; m < 4; ++m) { const int row = row0 + ai * HALF + m * 16; bf16_t* rowp = O + (size_t)row * ldc + col0;
                const float rs = __builtin_amdgcn_rsqf(sl[row - rowt] * (1.0f / 1024.0f) + 1e-6f);
#pragma unroll
                for (int bj = 0; bj < 2; ++bj) { const f32x4 v0 = acc[ai][bj][m][0] * rs + sv[bj][0], v1 = acc[ai][bj][m][1] * rs + sv[bj][1];
                    u32x4 w; w.x = cvt_pk_bf16(v0[0], v0[1]); w.y = cvt_pk_bf16(v0[2], v0[3]); w.z = cvt_pk_bf16(v1[0], v1[1]); w.w = cvt_pk_bf16(v1[2], v1[3]);
                    *(u32x4*)(rowp + bj * HALF) = w; } }
    }
};
struct EpiSwiGLU {
    static constexpr bool PERM = true, AFTER_DRAIN = false;
    bf16_t* O; int ldc; PG8_LAS unsigned char* pf; mutable int cnt;
    __device__ __forceinline__ void operator()(const f32x4 (&acc)[2][2][4][2], const Unit& u, int wr, int wc, int fr, int fq) const {
        const int rowt = u.pm * BM; PG8_LAS const float* sl = (PG8_LAS const float*)(pf + (cnt & 1) * PF_SLOT); ++cnt;
        const int row0 = rowt + wr * 64 + fr, col0 = u.pn * HALF + wc * 32 + 8 * fq;
        f32x4 sv[2][2];
#pragma unroll
        for (int bj = 0; bj < 2; ++bj)
#pragma unroll
            for (int n = 0; n < 2; ++n) sv[bj][n] = *(PG8_LAS const f32x4*)(sl + 256 + wc * 32 + 8 * fq + bj * HALF + 4 * n);
#pragma unroll
        for (int ai = 0; ai < 2; ++ai)
#pragma unroll
            for (int m = 0; m < 4; ++m) { const int row = row0 + ai * HALF + m * 16; bf16_t* rowp = O + (size_t)row * ldc + col0;
                const float rs = __builtin_amdgcn_rsqf(sl[row - rowt] * (1.0f / 1024.0f) + 1e-6f);
                const f32x4 a0 = acc[ai][0][m][0] * rs + sv[0][0], a1 = acc[ai][0][m][1] * rs + sv[0][1], u0 = acc[ai][1][m][0] * rs + sv[1][0], u1 = acc[ai][1][m][1] * rs + sv[1][1];
                u32x4 w; w.x = cvt_pk_bf16(silu_f(a0[0]) * u0[0], silu_f(a0[1]) * u0[1]); w.y = cvt_pk_bf16(silu_f(a0[2]) * u0[2], silu_f(a0[3]) * u0[3]);
                w.z = cvt_pk_bf16(silu_f(a1[0]) * u1[0], silu_f(a1[1]) * u1[1]); w.w = cvt_pk_bf16(silu_f(a1[2]) * u1[2], silu_f(a1[3]) * u1[3]);
                *(u32x4*)rowp = w; }
    }
};
typedef _Float16 h16x8 __attribute__((ext_vector_type(8)));
typedef float f32x8 __attribute__((ext_vector_type(8)));
struct EpiRes {
    static constexpr bool PERM = true, AFTER_DRAIN = false;
    const float* srcX; const float* srcC; float* outF; _Float16* XR; int srcf32, dstf32; const float* gate; float coef; int MXr;
    bf16_t* XSp; float* ssq; const float* gn; const float* scn; int doxs;
    __device__ __forceinline__ void operator()(const f32x4 (&acc)[2][2][4][2], const Unit& u, int wr, int wc, int fr, int fq) const {
        const int rowt = u.pm * BM; const bool isc = rowt >= MXr; const bool XS = doxs != 0;
        const int bidx = isc ? 8 : (rowt >> 12);
        const char* src = (const char*)(isc ? srcC + (size_t)(rowt - MXr) * 1024 : srcX + (size_t)rowt * 1024);
        char* outb = (char*)(outF + (size_t)rowt * 1024);
        char* xrb = (char*)(XR + (size_t)rowt * 1024);
        char* xsb = (char*)(XSp + (size_t)rowt * 1024); float* sqb = ssq + rowt;
        const int col0 = u.pn * BM + wc * 32 + 8 * fq;
        const float* g = gate + (size_t)bidx * 9216 + col0;
        const unsigned lo = (unsigned)((wr * 64 + fr) * 1024 + col0);
        float ss[2][4];
#pragma unroll
        for (int ai = 0; ai < 2; ++ai)
#pragma unroll
            for (int m = 0; m < 4; ++m) ss[ai][m] = 0.f;
#pragma unroll
        for (int bj = 0; bj < 2; ++bj) {
            f32x4 gv[2], gs[2];
#pragma unroll
            for (int n = 0; n < 2; ++n) { gv[n] = *(const f32x4*)(g + bj * HALF + 4 * n) * coef;
                if (XS) gs[n] = *(const f32x4*)(gn + col0 + bj * HALF + 4 * n) * (*(const f32x4*)(scn + (size_t)bidx * 9216 + col0 + bj * HALF + 4 * n) + 1.0f); }
#pragma unroll
            for (int ai = 0; ai < 2; ++ai)
#pragma unroll
                for (int m = 0; m < 4; ++m) { const unsigned eo = lo + (unsigned)((ai * HALF + m * 16) * 1024 + bj * HALF); f32x4 xv[2];
                    if (srcf32) { xv[0] = *(const f32x4*)(src + eo * 4u); xv[1] = *(const f32x4*)(src + eo * 4u + 16u); }
                    else { const f32x8 t = __builtin_convertvector(*(const h16x8*)(xrb + eo * 2u), f32x8); xv[0] = (f32x4){t[0], t[1], t[2], t[3]}; xv[1] = (f32x4){t[4], t[5], t[6], t[7]}; }
                    xv[0] += gv[0] * acc[ai][bj][m][0]; xv[1] += gv[1] * acc[ai][bj][m][1];
                    if (dstf32) { *(f32x4*)(outb + eo * 4u) = xv[0]; *(f32x4*)(outb + eo * 4u + 16u) = xv[1]; }
                    else { const f32x8 t = {xv[0][0], xv[0][1], xv[0][2], xv[0][3], xv[1][0], xv[1][1], xv[1][2], xv[1][3]}; *(h16x8*)(xrb + eo * 2u) = __builtin_convertvector(t, h16x8); }
                    if (XS) { ss[ai][m] += (xv[0][0] * xv[0][0] + xv[0][1] * xv[0][1]) + (xv[0][2] * xv[0][2] + xv[0][3] * xv[0][3]) + (xv[1][0] * xv[1][0] + xv[1][1] * xv[1][1]) + (xv[1][2] * xv[1][2] + xv[1][3] * xv[1][3]);
                        const f32x4 y0 = xv[0] * gs[0], y1 = xv[1] * gs[1];
                        u32x4 w; w.x = cvt_pk_bf16(y0[0], y0[1]); w.y = cvt_pk_bf16(y0[2], y0[3]); w.z = cvt_pk_bf16(y1[0], y1[1]); w.w = cvt_pk_bf16(y1[2], y1[3]);
                        *(u32x4*)(xsb + eo * 2u) = w; } }
        }
        if (XS) {
#pragma unroll
            for (int ai = 0; ai < 2; ++ai)
#pragma unroll
                for (int m = 0; m < 4; ++m) { float t = ss[ai][m];
                    t += __int_as_float(__builtin_amdgcn_ds_swizzle(__float_as_int(t), 0x1f | (16 << 10)));
                    auto rr = __builtin_amdgcn_permlane32_swap(__float_as_uint(t), __float_as_uint(t), false, false);
                    t = __uint_as_float(rr[0]) + __uint_as_float(rr[1]);
                    if (fq == 0) atomicAdd(sqb + (unsigned)(wr * 64 + fr + ai * HALF + m * 16), t); } }
    }
};
template <class Epi, class Sched, bool ALIGN_EPI = false, bool SP2 = false>
__device__ __forceinline__ void gemm_phase(PG8_LAS unsigned char* lds, const Gemm g, const Sched& S, const Epi& E) {
    const int tid = opaque_tid(), wid = __builtin_amdgcn_readfirstlane(tid >> 6), lane = tid & 63, wr = wid >> 2, wc = wid & 3, fr = lane & 15, fq = lane >> 4;
    const int K = g.K, nt = K / BK;
    unsigned voffA[2], voffB[2];
#pragma unroll
    for (int i = 0; i < 2; ++i) { int R, C; stage_rc(tid * 16 + i * 8192, R, C); const int Rb = Epi::PERM ? ((R & ~31) + perm32(R & 31)) : R;
        voffA[i] = (unsigned)(R * K + C) * 2u; voffB[i] = (unsigned)(Rb * K + C) * 2u; }
    const size_t kstep = (size_t)(BK * 2);
    const size_t hstep = (size_t)HALF * K * 2;
    const size_t tstep = 2 * hstep;
    const unsigned ldsw = (unsigned)wid * 1024u;
    const int aoff = lds_byte(wr * 64 + fr, fq * 8), boff = lds_byte(wc * 32 + fr, fq * 8);
#define PG8_SA(b, h) (((b) * 2 + (h)) * HTB)
#define PG8_SB(b, h) ((4 + (b) * 2 + (h)) * HTB)
#define PG8_STAGE(bufoff, gbase, voff) do { _Pragma("unroll") for (int _i = 0; _i < 2; ++_i) \
        __builtin_amdgcn_global_load_lds((const unsigned*)((const char*)(gbase) + (voff)[_i]), (PG8_LAS unsigned*)(lds + (bufoff) + ldsw + _i * 8192), 16, 0, 0); } while (0)
#define PG8_LDA(dst, b, h) do { _Pragma("unroll") for (int m = 0; m < 4; ++m) _Pragma("unroll") for (int k = 0; k < 2; ++k) dst[m][k] = *(const PG8_LAS bf16x8*)(lds + PG8_SA(b, h) + aoff + m * 2048 + k * 1024); } while (0)
#define PG8_LDB(dst, b, h) do { _Pragma("unroll") for (int n = 0; n < 2; ++n) _Pragma("unroll") for (int k = 0; k < 2; ++k) dst[n][k] = *(const PG8_LAS bf16x8*)(lds + PG8_SB(b, h) + boff + n * 2048 + k * 1024); } while (0)
#define PG8_MMA(ai, bj, At, Bt) do { __builtin_amdgcn_s_setprio(1); _Pragma("unroll") for (int m = 0; m < 4; ++m) _Pragma("unroll") for (int n = 0; n < 2; ++n) _Pragma("unroll") for (int k = 0; k < 2; ++k) \
        acc[ai][bj][m][n] = __builtin_amdgcn_mfma_f32_16x16x32_bf16(Bt[n][k], At[m][k], acc[ai][bj][m][n], 0, 0, 0); __builtin_amdgcn_s_setprio(0); } while (0)
#define PG8_WAIT_V(n) asm volatile("s_waitcnt vmcnt(" #n ")" ::: "memory")
#define PG8_WAIT_L(n) asm volatile("s_waitcnt lgkmcnt(" #n ")" ::: "memory")
#define PG8_BAR __builtin_amdgcn_s_barrier()
#define PG8_SCHED __builtin_amdgcn_sched_barrier(0)
    Unit cur, nxt; int ui = 0;
    if (!S.next(0, cur)) return;
    f32x4 acc[2][2][4][2];
#pragma unroll
    for (int a = 0; a < 2; ++a)
#pragma unroll
        for (int b = 0; b < 2; ++b)
#pragma unroll
            for (int m = 0; m < 4; ++m)
#pragma unroll
                for (int n = 0; n < 2; ++n) acc[a][b][m][n] = (f32x4){0.f, 0.f, 0.f, 0.f};
    bf16x8 At[4][2], B0[2][2], B1[2][2];
    const char* cA = (const char*)g.A + (size_t)cur.pm * tstep; const char* cB = (const char*)g.Bt + (size_t)cur.pn * tstep;
    S.a_ready(cur);
    if constexpr (SP2) {
        PG8_STAGE(PG8_SB(0, 0), cB, voffB); PG8_STAGE(PG8_SB(0, 1), cB + hstep, voffB); PG8_STAGE(PG8_SA(0, 0), cA, voffA); PG8_STAGE(PG8_SA(0, 1), cA + hstep, voffA);
        if (wr == 1) PG8_BAR;
        PG8_WAIT_V(2); PG8_BAR;
        PG8_STAGE(PG8_SB(1, 0), cB + kstep, voffB); PG8_STAGE(PG8_SA(1, 0), cA + kstep, voffA); PG8_STAGE(PG8_SB(1, 1), cB + hstep + kstep, voffB);
        PG8_WAIT_V(6); PG8_BAR;
    } else {
        PG8_STAGE(PG8_SB(0, 0), cB, voffB); PG8_STAGE(PG8_SA(0, 0), cA, voffA); PG8_STAGE(PG8_SB(0, 1), cB + hstep, voffB); PG8_STAGE(PG8_SA(0, 1), cA + hstep, voffA);
        if (wr == 1) PG8_BAR;
        PG8_WAIT_V(4); PG8_BAR;
        PG8_STAGE(PG8_SB(1, 0), cB + kstep, voffB); PG8_STAGE(PG8_SA(1, 0), cA + kstep, voffA); PG8_STAGE(PG8_SB(1, 1), cB + hstep + kstep, voffB);
        PG8_WAIT_V(6); PG8_BAR;
    }
    for (;;) {
        const bool has_next = S.next(ui + 1, nxt);
        const char* nA = has_next ? (const char*)g.A + (size_t)nxt.pm * tstep : cA; const char* nB = has_next ? (const char*)g.Bt + (size_t)nxt.pn * tstep : cB;
        for (int t = 0; t < nt; t += 2) {
            const bool last = (t == nt - 2);
            const char* a1 = cA + (size_t)(t + 1) * kstep;
            const char* a2 = last ? nA : cA + (size_t)(t + 2) * kstep; const char* b2 = last ? nB : cB + (size_t)(t + 2) * kstep;
            const char* a3 = a2 + kstep; const char* b3 = b2 + kstep;
            if (last && has_next) S.a_ready(nxt);
            if constexpr (SP2) {
            PG8_LDB(B0, 0, 0); PG8_LDB(B1, 0, 1); PG8_SCHED; PG8_LDA(At, 0, 0); PG8_STAGE(PG8_SA(1, 1), a1 + hstep, voffA);
            PG8_WAIT_V(8); PG8_WAIT_L(0); PG8_BAR; PG8_MMA(0, 0, At, B0); PG8_MMA(0, 1, At, B1); PG8_BAR; PG8_SCHED;
            PG8_LDA(At, 0, 1); PG8_STAGE(PG8_SB(0, 0), b2, voffB); PG8_STAGE(PG8_SB(0, 1), b2 + hstep, voffB); PG8_STAGE(PG8_SA(0, 0), a2, voffA);
            PG8_WAIT_V(8); PG8_WAIT_L(0); PG8_BAR; PG8_MMA(1, 0, At, B0); PG8_MMA(1, 1, At, B1); PG8_BAR; PG8_SCHED;
            PG8_LDB(B0, 1, 0); PG8_LDB(B1, 1, 1); PG8_SCHED; PG8_LDA(At, 1, 0); PG8_STAGE(PG8_SA(0, 1), a2 + hstep, voffA);
            PG8_WAIT_V(8); PG8_WAIT_L(0); PG8_BAR; PG8_MMA(0, 0, At, B0); PG8_MMA(0, 1, At, B1); PG8_BAR; PG8_SCHED;
            PG8_LDA(At, 1, 1); PG8_STAGE(PG8_SB(1, 0), b3, voffB); PG8_STAGE(PG8_SB(1, 1), b3 + hstep, voffB); PG8_STAGE(PG8_SA(1, 0), a3, voffA);
            PG8_WAIT_V(8); PG8_WAIT_L(0); PG8_BAR; PG8_MMA(1, 0, At, B0); PG8_MMA(1, 1, At, B1); PG8_BAR; PG8_SCHED;
            } else {
            PG8_LDB(B0, 0, 0); PG8_SCHED; PG8_LDA(At, 0, 0); PG8_STAGE(PG8_SA(1, 1), a1 + hstep, voffA);
            PG8_WAIT_L(8); PG8_BAR; PG8_WAIT_L(0); PG8_MMA(0, 0, At, B0); PG8_BAR; PG8_SCHED;
            PG8_LDB(B1, 0, 1); PG8_STAGE(PG8_SB(0, 0), b2, voffB);
            PG8_BAR; PG8_WAIT_L(0); PG8_MMA(0, 1, At, B1); PG8_BAR;
            PG8_LDA(At, 0, 1); PG8_STAGE(PG8_SA(0, 0), a2, voffA);
            PG8_BAR; PG8_WAIT_L(0); PG8_MMA(1, 0, At, B0); PG8_BAR; PG8_SCHED;
            PG8_STAGE(PG8_SB(0, 1), b2 + hstep, voffB);
            PG8_WAIT_V(6); PG8_BAR; PG8_MMA(1, 1, At, B1); PG8_BAR;
            PG8_LDB(B0, 1, 0); PG8_SCHED; PG8_LDA(At, 1, 0); PG8_STAGE(PG8_SA(0, 1), a2 + hstep, voffA);
            PG8_WAIT_L(8); PG8_BAR; PG8_WAIT_L(0); PG8_MMA(0, 0, At, B0); PG8_BAR; PG8_SCHED;
            PG8_LDB(B1, 1, 1); PG8_STAGE(PG8_SB(1, 0), b3, voffB);
            PG8_BAR; PG8_WAIT_L(0); PG8_MMA(0, 1, At, B1); PG8_BAR;
            PG8_LDA(At, 1, 1); PG8_STAGE(PG8_SA(1, 0), a3, voffA);
            PG8_BAR; PG8_WAIT_L(0); PG8_MMA(1, 0, At, B0); PG8_BAR; PG8_SCHED;
            PG8_STAGE(PG8_SB(1, 1), b3 + hstep, voffB);
            PG8_WAIT_V(6); PG8_BAR; PG8_MMA(1, 1, At, B1); PG8_BAR;
            }
        }
        if constexpr (ALIGN_EPI) { if (wr == 0) PG8_BAR; }
        if constexpr (!Epi::AFTER_DRAIN) { E(acc, cur, wr, wc, fr, fq); S.done(cur); }
        if (!has_next) break;
#pragma unroll
        for (int a = 0; a < 2; ++a)
#pragma unroll
            for (int b = 0; b < 2; ++b)
#pragma unroll
                for (int m = 0; m < 4; ++m)
#pragma unroll
                    for (int n = 0; n < 2; ++n) acc[a][b][m][n] = (f32x4){0.f, 0.f, 0.f, 0.f};
        cur = nxt; cA = nA; cB = nB; ++ui;
        if constexpr (ALIGN_EPI) { if (wr == 1) PG8_BAR; }
    }
    PG8_WAIT_V(0);
    if constexpr (!ALIGN_EPI) { if (wr == 0) PG8_BAR; }
    PG8_BAR;
    if constexpr (Epi::AFTER_DRAIN) { E.fused(acc, cur, wr, wc, fr, fq, lds, wid, lane); S.done(cur); }
#undef PG8_SA
#undef PG8_SB
#undef PG8_STAGE
#undef PG8_LDA
#undef PG8_LDB
#undef PG8_MMA
#undef PG8_WAIT_V
#undef PG8_WAIT_L
#undef PG8_BAR
#undef PG8_SCHED
}
}
#include <hip/hip_bf16.h>
#include <cmath>
namespace attn_body {
using bf16=__hip_bfloat16;
using bf16x8=__attribute__((ext_vector_type(8)))short;
using s16x4=__attribute__((ext_vector_type(4)))short;
using f32x16=__attribute__((ext_vector_type(16)))float;
using u32x4=__attribute__((ext_vector_type(4)))unsigned;
constexpr int D=64,QP=512,KP=128,OP=1024;
constexpr int NW=8,QBLK=32,QB=QBLK*NW,KVBLK=64;
constexpr int ATTN_UNIT_ROWS=QB;
__device__ __forceinline__ int crow(int r,int hi){return (r&3)+8*(r>>2)+4*hi;}
#define SBAR() __builtin_amdgcn_sched_barrier(0)
__device__ __forceinline__ void cmask(f32x16&p0,f32x16&p1,int jb,int qrel,int hi){
  const float NEG=-INFINITY; int kb=64*jb+4*hi;
  #pragma unroll
  for(int r=0;r<16;++r){int kv=kb+(r&3)+8*(r>>2); if(kv>qrel)p0[r]=NEG; if(kv+32>qrel)p1[r]=NEG;}
}

constexpr int NSLOT=3, SLOTB=8192;
constexpr int LDS_K=0, LDS_V=NSLOT*SLOTB, LDS_WS=2*NSLOT*SLOTB, LDS_OST=LDS_WS+NW*64*4, LDS_BYTES=LDS_OST+NW*4096;
constexpr float C2=0.125f*1.4426950408889634f;
__device__ __forceinline__ void glds16(const void*gsrc,unsigned lds_dst){unsigned keep;
  asm volatile("s_mov_b32 %0, m0\n\ts_mov_b32 m0, %2\n\ts_nop 0\n\tglobal_load_lds_dwordx4 %1, off\n\ts_mov_b32 m0, %0":"=&s"(keep):"v"(gsrc),"s"(lds_dst):"memory");}
__device__ __forceinline__ float max3f(float a,float b,float c){float r;asm("v_max3_f32 %0, %1, %2, %3":"=v"(r):"v"(a),"v"(b),"v"(c));return r;}
__device__ __forceinline__ float max2f(float a,float b){float r;asm("v_max_f32_e32 %0, %1, %2":"=v"(r):"v"(a),"v"(b));return r;}
__device__ __forceinline__ float fadd_s(float a,float b){float r;asm("v_add_f32_e32 %0, %1, %2":"=v"(r):"v"(a),"v"(b));return r;}
__device__ __forceinline__ float fsub_s(float a,float b){float r;asm("v_sub_f32_e32 %0, %1, %2":"=v"(r):"v"(a),"v"(b));return r;}
typedef float f32x2_t __attribute__((ext_vector_type(2))); typedef __bf16 bf16x2_t __attribute__((ext_vector_type(2)));
__device__ __forceinline__ unsigned cvtpk_s(float lo,float hi){f32x2_t v={lo,hi};bf16x2_t b=__builtin_convertvector(v,bf16x2_t);return __builtin_bit_cast(unsigned,b);}
#define WAIT_BAR(N) asm volatile("s_waitcnt vmcnt(" #N ") lgkmcnt(0)\n\ts_barrier":::"memory")

__device__ __forceinline__ void qkt(f32x16&p0,f32x16&p1,const char*Kslot,const bf16x8*qr,const f32x16&negm,int r32,int hi){
  const char*kb=Kslot+hi*1024+r32*16;
  #pragma unroll
  for(int d0=0;d0<4;++d0){
    const bf16x8 b0=*reinterpret_cast<const bf16x8*>(kb+d0*2048);
    const bf16x8 b1=*reinterpret_cast<const bf16x8*>(kb+d0*2048+512);
    if(d0==0){p0=__builtin_amdgcn_mfma_f32_32x32x16_bf16(b0,qr[0],negm,0,0,0);p1=__builtin_amdgcn_mfma_f32_32x32x16_bf16(b1,qr[0],negm,0,0,0);}
    else{p0=__builtin_amdgcn_mfma_f32_32x32x16_bf16(b0,qr[d0],p0,0,0,0);p1=__builtin_amdgcn_mfma_f32_32x32x16_bf16(b1,qr[d0],p1,0,0,0);}}
}
typedef __attribute__((address_space(3))) const char* lds_cptr;
typedef short v4i16_t __attribute__((ext_vector_type(4)));
__device__ __forceinline__ void kload8(bf16x8*kf,lds_cptr kp){
  kf[0]=*(const __attribute__((address_space(3))) bf16x8*)(kp);      kf[1]=*(const __attribute__((address_space(3))) bf16x8*)(kp+512);
  kf[2]=*(const __attribute__((address_space(3))) bf16x8*)(kp+2048); kf[3]=*(const __attribute__((address_space(3))) bf16x8*)(kp+2560);
  kf[4]=*(const __attribute__((address_space(3))) bf16x8*)(kp+4096); kf[5]=*(const __attribute__((address_space(3))) bf16x8*)(kp+4608);
  kf[6]=*(const __attribute__((address_space(3))) bf16x8*)(kp+6144); kf[7]=*(const __attribute__((address_space(3))) bf16x8*)(kp+6656);
}
__device__ __forceinline__ void kload2(bf16x8*kf,lds_cptr kp,int j){ kf[2*j]=*(const __attribute__((address_space(3))) bf16x8*)(kp+j*2048); kf[2*j+1]=*(const __attribute__((address_space(3))) bf16x8*)(kp+j*2048+512); }
__device__ __forceinline__ s16x4 vtr(lds_cptr p){ return __builtin_bit_cast(s16x4,__builtin_amdgcn_ds_read_tr16_b64_v4i16((__attribute__((address_space(3))) v4i16_t*)p)); }
__device__ __forceinline__ float rowmax(const f32x16&p0,const f32x16&p1){
  float a=max3f(p0[0],p0[1],p1[0]),b=max3f(p0[2],p0[3],p1[1]);a=max3f(a,p1[2],p1[3]);
  #pragma unroll
  for(int r=4;r<16;r+=4){a=max3f(a,p0[r],p0[r+1]);b=max3f(b,p0[r+2],p0[r+3]);a=max3f(a,p1[r],p1[r+1]);b=max3f(b,p1[r+2],p1[r+3]);}
  const float m=max2f(a,b);
  auto rr=__builtin_amdgcn_permlane32_swap(__float_as_uint(m),__float_as_uint(m),false,false);
  return max2f(__uint_as_float(rr[0]),__uint_as_float(rr[1]));
}
__device__ __forceinline__ void pv(f32x16*o,int vb,bf16x8 pa0,bf16x8 pa1,bf16x8 pa2,bf16x8 pa3){
  #pragma unroll
  for(int d0=0;d0<2;++d0){s16x4 lo[4],hi[4];
    #pragma unroll
    for(int ks=0;ks<4;++ks){
      asm volatile("ds_read_b64_tr_b16 %0,%1 offset:%c2":"=&v"(lo[ks]):"v"(vb),"i"(d0*4096+ks*1024):"memory");
      asm volatile("ds_read_b64_tr_b16 %0,%1 offset:%c2":"=&v"(hi[ks]):"v"(vb),"i"(d0*4096+ks*1024+512):"memory");}
    asm volatile("s_waitcnt lgkmcnt(0)":::"memory");SBAR();
    #define PK(k) (bf16x8){lo[k][0],lo[k][1],lo[k][2],lo[k][3],hi[k][0],hi[k][1],hi[k][2],hi[k][3]}
    o[d0]=__builtin_amdgcn_mfma_f32_32x32x16_bf16(pa0,PK(0),o[d0],0,0,0);
    o[d0]=__builtin_amdgcn_mfma_f32_32x32x16_bf16(pa1,PK(1),o[d0],0,0,0);
    o[d0]=__builtin_amdgcn_mfma_f32_32x32x16_bf16(pa2,PK(2),o[d0],0,0,0);
    o[d0]=__builtin_amdgcn_mfma_f32_32x32x16_bf16(pa3,PK(3),o[d0],0,0,0);
    #undef PK
  }
}

#ifndef ATTN_STORE16
#define ATTN_STORE16(p,v) (*(u32x4*)(p)=(v))
#endif
template<int THRL> __device__ __forceinline__ void attn_unit(const bf16*Q0,const bf16*__restrict__ Kh,const bf16*__restrict__ Vh,bf16*O0,const int NT,char*shm){
  const int tid=opaque_tid(),lane=tid&63,r32=lane&31,hi=lane>>5; const int wid=__builtin_amdgcn_readfirstlane(tid>>6);
  const bf16*Qw=Q0+(long)(wid*QBLK)*QP;
  const unsigned lds0=(unsigned)(uintptr_t)shm;
  float*wsf=(float*)(shm+LDS_WS)+wid*64;
  const bf16*ksrc=Kh+(long)lane*KP+wid*8;
  const bf16*vsrc=Vh+(long)(16*(wid&3)+(lane>>2))*KP+(wid>>2)*32+(lane&3)*8;
  const unsigned kdst=lds0+LDS_K+wid*1024, vdst=lds0+LDS_V+wid*1024;
  #define DMA_K(t,slot) glds16(ksrc+(long)(t)*KVBLK*KP,(unsigned)__builtin_amdgcn_readfirstlane(kdst+(slot)))
  #define DMA_V(t,slot) glds16(vsrc+(long)(t)*KVBLK*KP,(unsigned)__builtin_amdgcn_readfirstlane(vdst+(slot)))
  const int vb0=(int)(lds0+LDS_V)+((lane>>4)&1)*32+(lane&3)*8+(4*hi+((lane&15)>>2))*64;
  const char*Kbase=shm+LDS_K; bf16x8 kf[8];
  const lds_cptr shm3=(lds_cptr)shm; const lds_cptr kp0=shm3+LDS_K+hi*1024+r32*16; const lds_cptr vp0=shm3+LDS_V+((lane>>4)&1)*32+(lane&3)*8+(4*hi+((lane&15)>>2))*64;
  DMA_K(0,0);DMA_V(0,0);DMA_K(1,SLOTB);
  bf16x8 qr[4];
  #pragma unroll
  for(int d0=0;d0<4;++d0)qr[d0]=*reinterpret_cast<const bf16x8*>(&Qw[(long)r32*QP+d0*16+hi*8]);
  float mhat=0.f,l_reg=0.f;f32x16 o[2];o[0]=f32x16{};o[1]=f32x16{};f32x16 negm=f32x16{};asm volatile("":"+v"(negm));
  #define CMASK(P0,P1,t) do{}while(0)
  bool resc=false;
  #define START(P0,P1) do{ const float rm=rowmax(P0,P1); resc=false; \
    { const float dl=rm; mhat=fadd_s(mhat,dl); \
      _Pragma("unroll") for(int r=0;r<16;++r){P0[r]=fsub_s(P0[r],dl);P1[r]=fsub_s(P1[r],dl);} \
      _Pragma("unroll") for(int r=0;r<16;++r)negm[r]=-mhat; asm volatile("":"+v"(negm)); } \
    _Pragma("unroll") for(int r=0;r<16;++r)P0[r]=__builtin_amdgcn_exp2f(P0[r]); }while(0)
  #define RESC() do{ if(resc){ asm volatile("s_waitcnt lgkmcnt(0)":::"memory"); \
      _Pragma("unroll") for(int d_=0;d_<2;++d_) _Pragma("unroll") for(int r=0;r<16;++r)o[d_][r]*=wsf[crow(r,hi)]; } }while(0)
  f32x16 pA0,pA1,pB0,pB1;
  int sl_prev=0,sl_cur=0,sl_next=SLOTB;
  #define ROT() do{sl_prev=sl_cur;sl_cur=sl_next;sl_next=(sl_next==(NSLOT-1)*SLOTB)?0:sl_next+SLOTB;}while(0)
  DMA_K(2,2*SLOTB);
  WAIT_BAR(3);
  qkt(pA0,pA1,Kbase,qr,negm,r32,hi);asm volatile("s_nop 15\n\ts_nop 7":"+v"(pA0),"+v"(pA1));CMASK(pA0,pA1,0);
  START(pA0,pA1);
  _Pragma("unroll") for(int r=0;r<16;++r)pA1[r]=__builtin_amdgcn_exp2f(pA1[r]);
  WAIT_BAR(0);
  DMA_K(3,0);DMA_V(1,SLOTB);
  ROT();
  kload8(kf,kp0+sl_cur);
  WAIT_BAR(2);
  s16x4 vlo[8],vhi[8]; u32x4 pw0,pw1,pw2,pw3;
  #define PKW(P,B) cvtpk_s(P[B],P[B+1])
  #define PAF(k) __builtin_bit_cast(bf16x8,pw##k)
  #define VFR(i) (bf16x8){vlo[i][0],vlo[i][1],vlo[i][2],vlo[i][3],vhi[i][0],vhi[i][1],vhi[i][2],vhi[i][3]}
  #define PIN(x) asm volatile("":"+v"(x))
  #define MX3(a,b,c) __builtin_fmaxf(__builtin_fmaxf((a),(b)),(c))
  #define GAPA(MF,A0,A1,A2,A3,W0,W1,PW) do{ MF; sacc+=A0; sacc+=A1; sacc+=A2; sacc+=A3; PIN(sacc); W0; W1; PIN(PW); SBAR(); }while(0)
  #define EX(v) __builtin_amdgcn_exp2f(v)
  #define GAPB(MF,X,B) do{ MF; X[B]=EX(X[B]); X[B+1]=EX(X[B+1]); X[B+2]=EX(X[B+2]); X[B+3]=EX(X[B+3]); PIN(X); SBAR(); }while(0)
  #define VRD(i) do{ vlo[i]=vtr(vp_+(((i)>>2)*4096+((i)&3)*1024)); vhi[i]=vtr(vp_+(((i)>>2)*4096+((i)&3)*1024+512)); }while(0)
  #define KRD(G,j) do{ if(G){ kload2(kf,kp0+sl_next,j); SBAR(); } }while(0)
  #define STEP(C0,C1,P0,P1,t,GK,GV,GL) do{ SBAR(); \
    const lds_cptr vp_=vp0+sl_prev; \
    VRD(0); SBAR(); float sacc=(P0[0]+P0[1]); \
    GAPA(C0=__builtin_amdgcn_mfma_f32_32x32x16_bf16(kf[0],qr[0],negm,0,0,0), P0[2],P0[3],P0[4],P0[5],     pw0[0]=PKW(P0,0), pw0[1]=PKW(P0,2), pw0); \
    VRD(4); SBAR(); GAPA(C1=__builtin_amdgcn_mfma_f32_32x32x16_bf16(kf[1],qr[0],negm,0,0,0), P0[6],P0[7],P0[8],P0[9],     pw0[2]=PKW(P0,4), pw0[3]=PKW(P0,6), pw0); \
    VRD(1); SBAR(); GAPA(C0=__builtin_amdgcn_mfma_f32_32x32x16_bf16(kf[2],qr[1],C0,0,0,0),   P0[10],P0[11],P0[12],P0[13], pw1[0]=PKW(P0,8), pw1[1]=PKW(P0,10), pw1); \
    VRD(5); SBAR(); GAPA(C1=__builtin_amdgcn_mfma_f32_32x32x16_bf16(kf[3],qr[1],C1,0,0,0),   P0[14],P0[15],P1[0],P1[1],   pw1[2]=PKW(P0,12),pw1[3]=PKW(P0,14), pw1); \
    VRD(2); SBAR(); GAPA(C0=__builtin_amdgcn_mfma_f32_32x32x16_bf16(kf[4],qr[2],C0,0,0,0),   P1[2],P1[3],P1[4],P1[5],     pw2[0]=PKW(P1,0), pw2[1]=PKW(P1,2), pw2); \
    VRD(6); SBAR(); GAPA(C1=__builtin_amdgcn_mfma_f32_32x32x16_bf16(kf[5],qr[2],C1,0,0,0),   P1[6],P1[7],P1[8],P1[9],     pw2[2]=PKW(P1,4), pw2[3]=PKW(P1,6), pw2); \
    VRD(3); SBAR(); GAPA(C0=__builtin_amdgcn_mfma_f32_32x32x16_bf16(kf[6],qr[3],C0,0,0,0),   P1[10],P1[11],P1[12],P1[13], pw3[0]=PKW(P1,8), pw3[1]=PKW(P1,10), pw3); \
    VRD(7); SBAR(); GAPA(C1=__builtin_amdgcn_mfma_f32_32x32x16_bf16(kf[7],qr[3],C1,0,0,0),   P1[14],P1[15],0.f,0.f,       pw3[2]=PKW(P1,12),pw3[3]=PKW(P1,14), pw3); \
    l_reg+=sacc; \
    if(GK){DMA_K((t)+3,sl_cur);} if(GV){DMA_V((t)+1,sl_next);} \
    CMASK(C0,C1,t); \
    { float a=MX3(C0[0],C0[1],C1[0]),b=MX3(C0[2],C0[3],C1[1]); a=MX3(a,C1[2],C1[3]); \
      _Pragma("unroll") for(int r=4;r<16;r+=4){a=MX3(a,C0[r],C0[r+1]);b=MX3(b,C0[r+2],C0[r+3]);a=MX3(a,C1[r],C1[r+1]);b=MX3(b,C1[r+2],C1[r+3]);} \
      float rm=__builtin_fmaxf(a,b); { auto rr=__builtin_amdgcn_permlane32_swap(__float_as_uint(rm),__float_as_uint(rm),false,false); rm=__builtin_fmaxf(__uint_as_float(rr[0]),__uint_as_float(rr[1])); } \
      resc=false; \
      if(__builtin_expect(__any(rm>(float)THRL),0)){ const float dl=__builtin_fmaxf(rm,0.f); mhat+=dl; \
        _Pragma("unroll") for(int r=0;r<16;++r){C0[r]-=dl;C1[r]-=dl;} \
        _Pragma("unroll") for(int r=0;r<16;++r)negm[r]=-mhat; asm volatile("":"+v"(negm)); \
        const float f=__builtin_amdgcn_exp2f(-dl); l_reg*=f; if(hi==0)wsf[r32]=f; resc=true; } } \
    SBAR(); \
    GAPB(o[0]=__builtin_amdgcn_mfma_f32_32x32x16_bf16(PAF(0),VFR(0),o[0],0,0,0), C0,0); \
    GAPB(o[1]=__builtin_amdgcn_mfma_f32_32x32x16_bf16(PAF(0),VFR(4),o[1],0,0,0), C0,4); \
    KRD(GL,0); GAPB(o[0]=__builtin_amdgcn_mfma_f32_32x32x16_bf16(PAF(1),VFR(1),o[0],0,0,0), C0,8); \
    KRD(GL,1); GAPB(o[1]=__builtin_amdgcn_mfma_f32_32x32x16_bf16(PAF(1),VFR(5),o[1],0,0,0), C0,12); \
    KRD(GL,2); GAPB(o[0]=__builtin_amdgcn_mfma_f32_32x32x16_bf16(PAF(2),VFR(2),o[0],0,0,0), C1,0); \
    KRD(GL,3); GAPB(o[1]=__builtin_amdgcn_mfma_f32_32x32x16_bf16(PAF(2),VFR(6),o[1],0,0,0), C1,4); \
    GAPB(o[0]=__builtin_amdgcn_mfma_f32_32x32x16_bf16(PAF(3),VFR(3),o[0],0,0,0), C1,8); \
    GAPB(o[1]=__builtin_amdgcn_mfma_f32_32x32x16_bf16(PAF(3),VFR(7),o[1],0,0,0), C1,12); \
    }while(0)
  int t=1;
  for(;t+5<NT;t+=2){
    STEP(pB0,pB1,pA0,pA1,t,true,true,true);     WAIT_BAR(2); RESC(); ROT();
    STEP(pA0,pA1,pB0,pB1,t+1,true,true,true);   WAIT_BAR(2); RESC(); ROT();
  }
  #define ENDW(tt) do{ if((tt)+3<NT){WAIT_BAR(2);} else if((tt)+2<NT){WAIT_BAR(1);} else {WAIT_BAR(0);} }while(0)
  for(;t+1<NT;t+=2){
    STEP(pB0,pB1,pA0,pA1,t,(t+3<NT),(t+1<NT),(t+1<NT));       ENDW(t);   RESC(); ROT();
    STEP(pA0,pA1,pB0,pB1,t+1,(t+4<NT),(t+2<NT),(t+2<NT));     ENDW(t+1); RESC(); ROT();
  }
  STEP(pB0,pB1,pA0,pA1,NT-1,false,false,false); RESC();
  { float sacc=pB0[0]+pB0[1]; _Pragma("unroll") for(int r=2;r<16;++r)sacc+=pB0[r]; _Pragma("unroll") for(int r=0;r<16;++r)sacc+=pB1[r]; l_reg+=sacc;
    pw0=(u32x4){PKW(pB0,0),PKW(pB0,2),PKW(pB0,4),PKW(pB0,6)};pw1=(u32x4){PKW(pB0,8),PKW(pB0,10),PKW(pB0,12),PKW(pB0,14)};pw2=(u32x4){PKW(pB1,0),PKW(pB1,2),PKW(pB1,4),PKW(pB1,6)};pw3=(u32x4){PKW(pB1,8),PKW(pB1,10),PKW(pB1,12),PKW(pB1,14)};
    SBAR(); pv(o,vb0+sl_cur,PAF(0),PAF(1),PAF(2),PAF(3)); }
  #undef PKW
  #undef PAF
  #undef VFR
  #undef PIN
  #undef MX3
  #undef GAPA
  #undef GAPB
  #undef EX
  #undef VRD
  #undef KRD
  #undef STEP
  #undef ENDW
  {auto rr=__builtin_amdgcn_permlane32_swap(__float_as_uint(l_reg),__float_as_uint(l_reg),false,false);l_reg=__uint_as_float(rr[0])+__uint_as_float(rr[1]);}
  if(hi==0)wsf[32+r32]=l_reg;asm volatile("s_waitcnt lgkmcnt(0)":::"memory");
  float rli[16];
  #pragma unroll
  for(int r=0;r<16;++r)rli[r]=__builtin_amdgcn_rcpf(wsf[32+crow(r,hi)]);
  bf16*Ow=O0+(long)(wid*QBLK)*OP;
  { bf16*stg=(bf16*)(shm+LDS_OST)+wid*2048;
    #pragma unroll
    for(int r=0;r<16;++r){const int orow=crow(r,hi);
      #pragma unroll
      for(int d0=0;d0<2;++d0)stg[orow*64+d0*32+r32]=__float2bfloat16(o[d0][r]*rli[r]);}
    asm volatile("s_waitcnt lgkmcnt(0)":::"memory");
    #pragma unroll
    for(int i=0;i<4;++i){const int row=i*8+(lane>>3),ch=lane&7; const u32x4 v=*(const u32x4*)(stg+row*64+ch*8); ATTN_STORE16(Ow+(long)row*OP+ch*8,v);} }
  asm volatile("s_waitcnt lgkmcnt(0)\n\ts_barrier":::"memory");
  #undef DMA_K
  #undef DMA_V
  #undef CMASK
  #undef START
  #undef RESC
  #undef ROT
}
constexpr int ATTN_LDS_BYTES=LDS_BYTES;
#undef SBAR
#undef WAIT_BAR
}

constexpr int DM = 1024, BATCH = 8, SEQ = 4096, DEPTH = 4, CTXL = 256, DFF = 2816;
constexpr int MX = BATCH * SEQ, MC = BATCH * CTXL, MALL = MX + MC;
constexpr int INW = 2080, INWP = 2304, KVLEN = CTXL + SEQ, NCH = KVLEN / 64;
constexpr float EPS = 1e-6f;
constexpr float QSCALE = 0.125f * 1.4426950408889634f;
constexpr int PC_CA = 0, PC_CG = 256, PC_GQ = 512, PC_GK = 640, PC_GV = 768, PC_GR = 1024, PC_GF = 1280, PC_AQ = 1312, PC_AK = 1824;
constexpr size_t MiB = 1u << 20;
constexpr size_t WS_W1T = 0, WS_W2T = 88 * MiB, WS_WINT = 132 * MiB, WS_WOT = 150 * MiB, WS_MOD = 158 * MiB, WS_XN = 160 * MiB, WS_CAT = 228 * MiB,
                 WS_HP = 296 * MiB, WS_Q = 483 * MiB, WS_K = 517 * MiB, WS_V = 526 * MiB, WS_CTXR = 535 * MiB, WS_GDS = 543 * MiB, WS_GDEC = 577 * MiB, WS_CTL = 578 * MiB, WS_SSQ = 579 * MiB, WS_SW = 581 * MiB, WS_END = 584 * MiB;
constexpr size_t W1T_SZ = (size_t)2 * DFF * DM, W2T_SZ = (size_t)DM * DFF, WINT_SZ = (size_t)INWP * DM, WOT_SZ = (size_t)DM * DM;
static_assert(8 * W1T_SZ * 2 <= WS_W2T - WS_W1T && 8 * W2T_SZ * 2 <= WS_WINT - WS_W2T && 4 * WINT_SZ * 2 <= WS_WOT - WS_WINT && 4 * WOT_SZ * 2 <= WS_MOD - WS_WOT, "ws map W");
static_assert((size_t)MALL * DM * 2 <= WS_CAT - WS_XN && (size_t)MALL * DM * 2 <= WS_HP - WS_CAT && (size_t)MALL * DFF * 2 <= WS_Q - WS_HP && (size_t)MALL * 512 * 2 <= WS_K - WS_Q, "ws map act");
static_assert((size_t)BATCH * KVLEN * 128 * 2 <= WS_V - WS_K && (size_t)MC * DM * 4 <= WS_GDS - WS_CTXR && (size_t)BATCH * 2 * NCH * 4 * 2048 * 4 <= WS_GDEC - WS_GDS, "ws map 2");
constexpr int LDS_BYTES = 147456;
constexpr int NPH_LAYER = 9, NPHASES = 2 + DEPTH * NPH_LAYER;
constexpr int SWN = 2 * DFF;
static_assert((size_t)DEPTH * 3 * MALL * 4 <= WS_SW - WS_SSQ && (size_t)DEPTH * 3 * 9 * SWN * 4 <= WS_END - WS_SW, "ws map 3");

typedef unsigned short bf16_t;
typedef float f32x4 __attribute__((ext_vector_type(4)));
typedef unsigned u32x4 __attribute__((ext_vector_type(4)));
typedef unsigned u32x2 __attribute__((ext_vector_type(2)));
typedef float f32x2v __attribute__((ext_vector_type(2)));
#define LDSP __attribute__((address_space(3)))
#define LDS_WAIT() asm volatile("s_waitcnt lgkmcnt(0)" ::: "memory")
__device__ __forceinline__ unsigned pk2(float lo, float hi) { return pg8::cvt_pk_bf16(lo, hi); }
__device__ __forceinline__ float bflo(unsigned w) { return __uint_as_float(w << 16); }
__device__ __forceinline__ float bfhi(unsigned w) { return __uint_as_float(w & 0xffff0000u); }
__device__ __forceinline__ void unpack8(const u32x4 r, float (&x)[8]) { x[0] = bflo(r.x); x[1] = bfhi(r.x); x[2] = bflo(r.y); x[3] = bfhi(r.y); x[4] = bflo(r.z); x[5] = bfhi(r.z); x[6] = bflo(r.w); x[7] = bfhi(r.w); }
__device__ __forceinline__ u32x4 pack8(const float (&x)[8]) { u32x4 w; w.x = pk2(x[0], x[1]); w.y = pk2(x[2], x[3]); w.z = pk2(x[4], x[5]); w.w = pk2(x[6], x[7]); return w; }
template <int X> __device__ __forceinline__ float swz_xor(float v) { return __int_as_float(__builtin_amdgcn_ds_swizzle(__float_as_int(v), 0x1f | (X << 10))); }
__device__ __forceinline__ float wave_sum(float v) {
    v += swz_xor<1>(v); v += swz_xor<2>(v); v += swz_xor<4>(v); v += swz_xor<8>(v); v += swz_xor<16>(v);
    auto rr = __builtin_amdgcn_permlane32_swap(__float_as_uint(v), __float_as_uint(v), false, false);
    return __uint_as_float(rr[0]) + __uint_as_float(rr[1]);
}
__device__ __forceinline__ float sigm(float v) { return __builtin_amdgcn_rcpf(1.0f + __expf(-v)); }

struct Args { const float* in[20]; float* out; unsigned char* ws; int ph_lo, ph_hi; };
typedef const __attribute__((address_space(4))) Args* KA;
enum { I_X = 0, I_C, I_CTX, I_CCTX, I_WADA, I_BADA, I_GNORM, I_WFI, I_WFO, I_WIN, I_WOUT, I_WDW, I_BDW, I_CNG, I_CNB, I_WGG, I_BGG, I_GLAG, I_QNG, I_KNG };

__device__ __forceinline__ void transpose_item(const float* W, int K, int N, bf16_t* WT, int kb, int nsrc, int ndst, LDSP float* scr, int lane) {
    const int k0 = 64 * kb;
#pragma unroll 8
    for (int i = 0; i < 32; ++i) { const int kk = 2 * i + (lane >> 5); scr[kk * 33 + (lane & 31)] = W[(size_t)(k0 + kk) * N + nsrc + (lane & 31)]; }
    LDS_WAIT();
    const int c = lane & 7;
#pragma unroll
    for (int j = 0; j < 4; ++j) { const int n = (lane >> 3) + 8 * j; const LDSP float* s = scr + (8 * c) * 33 + n;
        u32x4 o; o.x = pk2(s[0 * 33], s[1 * 33]); o.y = pk2(s[2 * 33], s[3 * 33]); o.z = pk2(s[4 * 33], s[5 * 33]); o.w = pk2(s[6 * 33], s[7 * 33]);
        *(u32x4*)(WT + (size_t)(ndst + n) * K + k0 + 8 * c) = o; }
    LDS_WAIT();
}
__device__ __forceinline__ void phase0(KA a, LDSP unsigned char* lds, int tid, int lane, int wave, int bid, int G) {
    unsigned char* ws = a->ws;
    LDSP float* scr = (LDSP float*)(lds + wave * 8704);
    const int gw = bid * 8 + wave, NGW = G * 8;
    constexpr int I1 = 16 * 176, I2 = 44 * 32, I3 = 16 * 65, I4 = 16 * 32, LI = 2 * I1 + 2 * I2 + I3 + I4;
    for (int it = gw; it < DEPTH * LI; it += NGW) {
        const int l = it / LI; int r = it % LI;
        if (r < 2 * I1) { const int f = r / I1, rr = r % I1, kb = rr / 176, nb = rr % 176, nsrc = nb * 32; const bool isu = nsrc >= DFF; const int j = isu ? nsrc - DFF : nsrc;
            transpose_item(a->in[I_WFI] + (size_t)(l * 2 + f) * DM * 2 * DFF, DM, 2 * DFF, (bf16_t*)(ws + WS_W1T) + (size_t)(l * 2 + f) * W1T_SZ, kb, nsrc, 256 * (j >> 7) + (isu ? 128 : 0) + (j & 127), scr, lane); continue; }
        r -= 2 * I1;
        if (r < 2 * I2) { const int f = r / I2, rr = r % I2, kb = rr / 32, nb = rr % 32;
            transpose_item(a->in[I_WFO] + (size_t)(l * 2 + f) * DFF * DM, DFF, DM, (bf16_t*)(ws + WS_W2T) + (size_t)(l * 2 + f) * W2T_SZ, kb, nb * 32, nb * 32, scr, lane); continue; }
        r -= 2 * I2;
        if (r < I3) { const int kb = r / 65, nb = r % 65;
            transpose_item(a->in[I_WIN] + (size_t)l * DM * INW, DM, INW, (bf16_t*)(ws + WS_WINT) + (size_t)l * WINT_SZ, kb, nb * 32, nb * 32, scr, lane); continue; }
        r -= I3;
        { const int kb = r / 32, nb = r % 32;
            transpose_item(a->in[I_WOUT] + (size_t)l * DM * DM, DM, DM, (bf16_t*)(ws + WS_WOT) + (size_t)l * WOT_SZ, kb, nb * 32, nb * 32, scr, lane); }
    }
    { constexpr int PV = (INWP - INW) * DM * 2 / 16;
        for (int i = bid * 512 + tid; i < DEPTH * PV; i += G * 512) { const int l = i / PV, r = i % PV;
            ((u32x4*)((bf16_t*)(ws + WS_WINT) + (size_t)l * WINT_SZ + (size_t)INW * DM))[r] = (u32x4){0u, 0u, 0u, 0u}; } }
    { float* SSQ = (float*)(ws + WS_SSQ); for (int i = bid * 512 + tid; i < DEPTH * 3 * MALL; i += G * 512) SSQ[i] = 0.f; }
    __syncthreads();
    LDSP float* S = (LDSP float*)(lds + 69632);
    LDSP float* red = (LDSP float*)(lds + 106496);
    for (int i = tid; i < 9 * 1024; i += 512) { const int r = i >> 10, k = i & 1023; const float cv = r < 8 ? a->in[I_C][r * 1024 + k] : a->in[I_CCTX][k]; S[i] = cv * sigm(cv); }
    __syncthreads();
    float* MOD = (float*)(ws + WS_MOD);
    for (int it = bid; it < DEPTH * 144; it += G) {
        const int l = it / 144, n0 = (it % 144) * 64;
        const float* Wp = a->in[I_WADA] + (size_t)l * DM * 9216 + n0 + lane;
        float acc[9];
#pragma unroll
        for (int r = 0; r < 9; ++r) acc[r] = 0.f;
#pragma unroll 8
        for (int kk = 0; kk < 128; ++kk) { const int k = wave * 128 + kk; const float w = Wp[(size_t)k * 9216];
#pragma unroll
            for (int r = 0; r < 9; ++r) acc[r] += S[r * 1024 + k] * w; }
#pragma unroll
        for (int r = 0; r < 9; ++r) red[(wave * 9 + r) * 64 + lane] = acc[r];
        __syncthreads();
        for (int o = tid; o < 576; o += 512) { const int r = o >> 6, ln = o & 63; float s = 0.f;
#pragma unroll
            for (int w = 0; w < 8; ++w) s += red[(w * 9 + r) * 64 + ln];
            MOD[(size_t)(l * 9 + r) * 9216 + n0 + ln] = s + a->in[I_BADA][l * 9216 + n0 + ln]; }
        __syncthreads();
    }
}
__device__ __forceinline__ void phase1(KA a, LDSP unsigned char* lds, int tid, int lane, int wave, int bid, int G) {
    const float* MOD = (const float*)(a->ws + WS_MOD); bf16_t* XN = (bf16_t*)(a->ws + WS_XN); float* SSQ = (float*)(a->ws + WS_SSQ); float* SW = (float*)(a->ws + WS_SW);
    const float* g = a->in[I_GNORM];
    for (int m = bid * 8 + wave; m < MALL; m += G * 8) {
        const bool isc = m >= MX;
        const float* xr = isc ? a->in[I_CTX] + (size_t)(m - MX) * DM : a->in[I_X] + (size_t)m * DM;
        const float* md = MOD + (size_t)(isc ? 8 : (m >> 12)) * 9216;
        f32x4 v[4]; float ss = 0.f;
#pragma unroll
        for (int q = 0; q < 4; ++q) { v[q] = ((const f32x4*)xr)[lane + 64 * q]; ss += (v[q].x * v[q].x + v[q].y * v[q].y) + (v[q].z * v[q].z + v[q].w * v[q].w); }
        ss = wave_sum(ss);
        if (lane == 0) SSQ[m] = ss;
#pragma unroll
        for (int q = 0; q < 4; ++q) { const int col = 4 * lane + 256 * q;
            const f32x4 y = v[q] * *(const f32x4*)(g + col) * (*(const f32x4*)(md + 1024 + col) + 1.0f);
            u32x2 o; o.x = pk2(y.x, y.y); o.y = pk2(y.z, y.w);
            *(u32x2*)(XN + (size_t)m * DM + col) = o; }
    }
    LDSP float* SH = (LDSP float*)lds;
    constexpr int RPL = 2 * DFF + INWP + 2 * DFF;
#pragma unroll 1
    for (int l = 0; l < DEPTH; ++l) {
        __syncthreads();
        for (int i = tid; i < 27 * 256; i += 512) { const int v = i >> 8, j = v / 9, bi = v % 9, c4 = (i & 255) * 4; *(LDSP f32x4*)(SH + v * 1024 + c4) = *(const f32x4*)(MOD + (size_t)(l * 9 + bi) * 9216 + (3 * j) * 1024 + c4); }
        __syncthreads();
        const bf16_t* w0b = (const bf16_t*)(a->ws + WS_W1T) + (size_t)(l * 2) * W1T_SZ; const bf16_t* w1b = (const bf16_t*)(a->ws + WS_WINT) + (size_t)l * WINT_SZ; const bf16_t* w2b = (const bf16_t*)(a->ws + WS_W1T) + (size_t)(l * 2 + 1) * W1T_SZ;
#define SW_ROWPTR(rr) ((rr) < 2 * DFF ? w0b + (size_t)(rr) * DM : ((rr) < 2 * DFF + INWP ? w1b + (size_t)((rr) - 2 * DFF) * DM : w2b + (size_t)((rr) - 2 * DFF - INWP) * DM))
        u32x4 nx0 = {0u, 0u, 0u, 0u}, nx1 = {0u, 0u, 0u, 0u};
        { const int r0 = bid * 8 + wave; if (r0 < RPL) { const bf16_t* p = SW_ROWPTR(r0); nx0 = *(const u32x4*)(p + lane * 8); nx1 = *(const u32x4*)(p + 512 + lane * 8); } }
#pragma unroll 1
        for (int r = bid * 8 + wave; r < RPL; r += G * 8) {
            float w0[8], w1[8]; unpack8(nx0, w0); unpack8(nx1, w1);
            { const int rn = r + G * 8; if (rn < RPL) { const bf16_t* p = SW_ROWPTR(rn); nx0 = *(const u32x4*)(p + lane * 8); nx1 = *(const u32x4*)(p + 512 + lane * 8); } }
            const int j = r < 2 * DFF ? 0 : (r < 2 * DFF + INWP ? 1 : 2), rj = r - (j == 0 ? 0 : (j == 1 ? 2 * DFF : 2 * DFF + INWP));
#pragma unroll
            for (int bi = 0; bi < 9; ++bi) { LDSP const float* sh = SH + (j * 9 + bi) * 1024 + lane * 8;
                const f32x4 s0 = *(LDSP const f32x4*)(sh), s1 = *(LDSP const f32x4*)(sh + 4), s2 = *(LDSP const f32x4*)(sh + 512), s3 = *(LDSP const f32x4*)(sh + 516);
                float d = (w0[0] * s0.x + w0[1] * s0.y) + (w0[2] * s0.z + w0[3] * s0.w) + (w0[4] * s1.x + w0[5] * s1.y) + (w0[6] * s1.z + w0[7] * s1.w)
                        + (w1[0] * s2.x + w1[1] * s2.y) + (w1[2] * s2.z + w1[3] * s2.w) + (w1[4] * s3.x + w1[5] * s3.y) + (w1[6] * s3.z + w1[7] * s3.w);
                d = wave_sum(d);
                if (lane == 0) SW[((size_t)(l * 3 + j) * 9 + bi) * SWN + rj] = d; } }
#undef SW_ROWPTR
    }
    __syncthreads();
}
__device__ __forceinline__ void prep_phase(KA a, LDSP unsigned char* lds, int l, int tid, int lane, int wave, int bid, int G) {
    LDSP f32x2v* CS = (LDSP f32x2v*)(lds);
    for (int i = tid; i < 1024; i += 512) { const int pos = i >> 4, f = i & 15;
        const float freq = exp2f(-(float)f * (13.287712379549449f / 16.0f)); const float ang = (float)pos * freq;
        float rev = ang * 0.15915494309189535f; rev -= floorf(rev);
        CS[i] = (f32x2v){__builtin_amdgcn_cosf(rev), __builtin_amdgcn_sinf(rev)}; }
    __syncthreads();
    const bf16_t* P = (const bf16_t*)(a->ws + WS_HP); bf16_t* Q = (bf16_t*)(a->ws + WS_Q); bf16_t* Kb = (bf16_t*)(a->ws + WS_K); bf16_t* Vb = (bf16_t*)(a->ws + WS_V);
    const int sub = lane & 7, axis = sub >> 2, half = (sub >> 1) & 1, f0 = (sub & 1) * 8;
    float qg[8], kg[8];
#pragma unroll
    for (int e = 0; e < 8; ++e) { qg[e] = a->in[I_QNG][l * 64 + sub * 8 + e]; kg[e] = a->in[I_KNG][l * 64 + sub * 8 + e]; }
    u32x4 nq = {0u, 0u, 0u, 0u}, nk_ = {0u, 0u, 0u, 0u};
    { const int m0 = bid * 8 + wave; if (m0 < MALL) { nq = *(const u32x4*)(P + (size_t)m0 * INWP + PC_AQ + lane * 8); nk_ = *(const u32x4*)(P + (size_t)m0 * INWP + PC_AK + (lane & 31) * 8); } }
    for (int m = bid * 8 + wave; m < MALL; m += G * 8) {
        const u32x4 rawq = nq, rawk = nk_;
        { const int mn = m + G * 8; if (mn < MALL) { nq = *(const u32x4*)(P + (size_t)mn * INWP + PC_AQ + lane * 8); nk_ = *(const u32x4*)(P + (size_t)mn * INWP + PC_AK + (lane & 31) * 8); } }
        const bool lat = m < MX;
        const int b = lat ? (m >> 12) : ((m - MX) >> 8), t = lat ? (m & 4095) : 0, pos = lat ? (CTXL + t) : ((m - MX) & 255);
        const int p = axis ? (t & 63) : (t >> 6);
        const bf16_t* pr = P + (size_t)m * INWP;
        float x[8], y[8];
        { const u32x4 raw = rawq; unpack8(raw, x);
            float ss = 0.f;
#pragma unroll
            for (int e = 0; e < 8; ++e) ss += x[e] * x[e];
            ss += swz_xor<1>(ss); ss += swz_xor<2>(ss); ss += swz_xor<4>(ss);
            const float rstd = 1.0f / sqrtf(ss * (1.0f / 64.0f) + EPS);
#pragma unroll
            for (int e = 0; e < 8; ++e) y[e] = x[e] * rstd * qg[e];
            if (lat) {
#pragma unroll
                for (int e = 0; e < 8; ++e) { const float o = swz_xor<2>(y[e]); const f32x2v cs = CS[p * 16 + f0 + e]; x[e] = half ? (y[e] * cs.x + o * cs.y) : (y[e] * cs.x - o * cs.y); }
            } else {
#pragma unroll
                for (int e = 0; e < 8; ++e) x[e] = y[e];
            }
#pragma unroll
            for (int e = 0; e < 8; ++e) x[e] *= QSCALE;
            *(u32x4*)(Q + (size_t)m * 512 + lane * 8) = pack8(x); }
        { const u32x4 raw = rawk; unpack8(raw, x);
            float ss = 0.f;
#pragma unroll
            for (int e = 0; e < 8; ++e) ss += x[e] * x[e];
            ss += swz_xor<1>(ss); ss += swz_xor<2>(ss); ss += swz_xor<4>(ss);
            const float rstd = 1.0f / sqrtf(ss * (1.0f / 64.0f) + EPS);
#pragma unroll
            for (int e = 0; e < 8; ++e) y[e] = x[e] * rstd * kg[e];
            if (lat) {
#pragma unroll
                for (int e = 0; e < 8; ++e) { const float o = swz_xor<2>(y[e]); const f32x2v cs = CS[p * 16 + f0 + e]; x[e] = half ? (y[e] * cs.x + o * cs.y) : (y[e] * cs.x - o * cs.y); }
            } else {
#pragma unroll
                for (int e = 0; e < 8; ++e) x[e] = y[e];
            }
            const size_t kvrow = ((size_t)b * KVLEN + pos) * 128;
            if (lane < 16) *(u32x4*)(Kb + kvrow + lane * 8) = pack8(x);
            else if (lane < 32) *(u32x4*)(Vb + kvrow + (lane - 16) * 8) = raw; }
    }
    __syncthreads();
}
__device__ __forceinline__ void conv_phase(KA a, LDSP unsigned char* lds, int l, bool last, int tid, int lane, int bid, int G) {
    LDSP float* hs = (LDSP float*)lds;
    LDSP bf16_t* os = (LDSP bf16_t*)(lds + 94 * 256 * 4);
    const bf16_t* P = (const bf16_t*)(a->ws + WS_HP); bf16_t* CAT = (bf16_t*)a->out;
    const int c = tid & 255, hf = tid >> 8;
    float w[31];
#pragma unroll
    for (int k = 0; k < 31; ++k) w[k] = a->in[I_WDW][(size_t)(l * 31 + k) * 256 + c];
    const float bias = a->in[I_BDW][l * 256 + c], gg = a->in[I_CNG][l * 256 + c], bb = a->in[I_CNB][l * 256 + c];
    const int nitems = last ? 512 : 544;
    for (int it = bid; it < nitems; it += G) {
        int base, len, t0;
        if (it < 512) { base = (it >> 6) * SEQ; len = SEQ; t0 = (it & 63) * 64; } else { const int i2 = it - 512; base = MX + (i2 >> 2) * CTXL; len = CTXL; t0 = (i2 & 3) * 64; }
        for (int rr = tid >> 5; rr < 94; rr += 16) { const int t = t0 - 15 + rr, c8 = (tid & 31) * 8;
            float h[8];
            if (t >= 0 && t < len) { const bf16_t* pr = P + (size_t)(base + t) * INWP + c8; float av[8], gv[8];
                unpack8(*(const u32x4*)(pr + PC_CA), av); unpack8(*(const u32x4*)(pr + PC_CG), gv);
#pragma unroll
                for (int e = 0; e < 8; ++e) h[e] = av[e] * sigm(gv[e]);
            } else {
#pragma unroll
                for (int e = 0; e < 8; ++e) h[e] = 0.f;
            }
            *(LDSP f32x4*)(hs + rr * 256 + c8) = (f32x4){h[0], h[1], h[2], h[3]}; *(LDSP f32x4*)(hs + rr * 256 + c8 + 4) = (f32x4){h[4], h[5], h[6], h[7]}; }
        __syncthreads();
#pragma unroll 1
        for (int i0 = 0; i0 < 32; i0 += 4) { const int ib = hf * 32 + i0;
            float xw[34];
#pragma unroll
            for (int k = 0; k < 34; ++k) xw[k] = hs[(ib + k) * 256 + c];
            float acc[4], mean[4], var[4];
#pragma unroll
            for (int t = 0; t < 4; ++t) { float s_ = bias;
#pragma unroll
                for (int k = 0; k < 31; ++k) s_ += w[k] * xw[t + k];
                acc[t] = s_; mean[t] = s_; }
#pragma unroll
            for (int t = 0; t < 4; ++t) mean[t] += swz_xor<1>(mean[t]);
#pragma unroll
            for (int t = 0; t < 4; ++t) mean[t] += swz_xor<2>(mean[t]);
#pragma unroll
            for (int t = 0; t < 4; ++t) mean[t] += swz_xor<4>(mean[t]);
#pragma unroll
            for (int t = 0; t < 4; ++t) mean[t] += swz_xor<8>(mean[t]);
#pragma unroll
            for (int t = 0; t < 4; ++t) mean[t] += swz_xor<16>(mean[t]);
#pragma unroll
            for (int t = 0; t < 4; ++t) { auto rr = __builtin_amdgcn_permlane32_swap(__float_as_uint(mean[t]), __float_as_uint(mean[t]), false, false);
                mean[t] = (__uint_as_float(rr[0]) + __uint_as_float(rr[1])) * (1.0f / 64.0f); acc[t] -= mean[t]; var[t] = acc[t] * acc[t]; }
#pragma unroll
            for (int t = 0; t < 4; ++t) var[t] += swz_xor<1>(var[t]);
#pragma unroll
            for (int t = 0; t < 4; ++t) var[t] += swz_xor<2>(var[t]);
#pragma unroll
            for (int t = 0; t < 4; ++t) var[t] += swz_xor<4>(var[t]);
#pragma unroll
            for (int t = 0; t < 4; ++t) var[t] += swz_xor<8>(var[t]);
#pragma unroll
            for (int t = 0; t < 4; ++t) var[t] += swz_xor<16>(var[t]);
#pragma unroll
            for (int t = 0; t < 4; ++t) { auto rr = __builtin_amdgcn_permlane32_swap(__float_as_uint(var[t]), __float_as_uint(var[t]), false, false);
                const float vv = (__uint_as_float(rr[0]) + __uint_as_float(rr[1])) * (1.0f / 64.0f);
                const float y = acc[t] * __builtin_amdgcn_rsqf(vv + EPS) * gg + bb;
                const float o = y * sigm(y);
                os[(ib + t) * 256 + c] = (bf16_t)(pk2(o, 0.f) & 0xffffu); } }
        __syncthreads();
        for (int q = tid; q < 2048; q += 512) { const int row = q >> 5, c8 = (q & 31) * 8;
            *(u32x4*)(CAT + (size_t)(base + t0 + row) * DM + c8) = *(const LDSP u32x4*)(os + row * 256 + c8); }
        __syncthreads();
    }
}
typedef short gbf16x8 __attribute__((ext_vector_type(8)));
constexpr int GB_WG = 106496, GB_BG = 106496 + 16384;
constexpr int GB_Q = 0, GB_K = 8448, GB_GF = 16896, GB_GB = 20992, GB_VT = 25088, GB_S0T = 34304, GB_QE = 42496, GB_KE = 50688, GB_KENDT = 58880, GB_ATT = 68096, GB_TOT = 86528, GB_O = 88576, GB_END = 105984;
constexpr int VTP = 72, ATP = 72, KTP = 72, OP_ = 68;
static_assert(GB_END <= 131072 && GB_VT + 64 * VTP * 2 == GB_S0T && GB_ATT + 2 * 64 * ATP * 2 == GB_TOT && GB_O + 64 * OP_ * 4 == GB_END, "gla lds");
__device__ __forceinline__ int gla_row(int b, int c, int i) { return c < 4 ? MX + b * CTXL + c * 64 + i : b * SEQ + (c - 4) * 64 + i; }
__device__ __forceinline__ void st_bf16(LDSP unsigned char* base, int byteoff, float v) { *(LDSP bf16_t*)(base + byteoff) = (bf16_t)(pk2(v, 0.f) & 0xffffu); }
struct GlaRegs { u32x4 qk, gt, vv, rg; f32x4 s0[2]; };
template <bool G3> __device__ __forceinline__ void gla_issue(KA a, GlaRegs& R, int b, int c, int h, int tid) {
    const bf16_t* P = (const bf16_t*)(a->ws + WS_HP);
    { const int i = (tid & 255) >> 2, part = tid & 3; const bf16_t* pr = P + (size_t)gla_row(b, c, i) * INWP;
        R.qk = *(const u32x4*)(pr + (tid < 256 ? PC_GQ : PC_GK) + h * 32 + part * 8);
        R.gt = *(const u32x4*)(pr + PC_GF + part * 8); }
    { const int j = tid >> 3, part = tid & 7; R.vv = *(const u32x4*)(P + (size_t)gla_row(b, c, j) * INWP + PC_GV + h * 64 + part * 8); }
    if (G3) { const float* DS = (const float*)(a->ws + WS_GDS);
#pragma unroll
        for (int dir = 0; dir < 2; ++dir) { const size_t ci = ((size_t)(b * 2 + dir) * NCH + c) * 4 + h; R.s0[dir] = *(const f32x4*)(DS + ci * 2048 + (tid >> 4) * 64 + (tid & 15) * 4); }
        R.rg = *(const u32x4*)(P + (size_t)gla_row(b, c, tid >> 3) * INWP + PC_GR + h * 64 + (tid & 7) * 8); }
}
template <bool G3> __device__ __forceinline__ void gla_stage(KA a, LDSP unsigned char* B, const GlaRegs& R, int l, int b, int c, int h, int tid) {
    LDSP float* Qf = (LDSP float*)(B + GB_Q); LDSP float* Kf = (LDSP float*)(B + GB_K); LDSP float* GF = (LDSP float*)(B + GB_GF); LDSP float* GBk = (LDSP float*)(B + GB_GB);
    { const int i = (tid & 255) >> 2, part = tid & 3;
        float x[8]; unpack8(R.qk, x);
        if (tid < 256) {
#pragma unroll
            for (int e = 0; e < 8; ++e) Qf[i * 33 + part * 8 + e] = x[e];
            unpack8(R.gt, x);
#pragma unroll
            for (int e = 0; e < 8; ++e) (part < 2 ? GF : GBk)[i * 16 + (part & 1) * 8 + e] = x[e];
        } else {
#pragma unroll
            for (int e = 0; e < 8; ++e) Kf[i * 33 + part * 8 + e] = x[e]; } }
    { const int j = tid >> 3, part = tid & 7; const u32x4 r = R.vv;
        const unsigned w[4] = {r.x, r.y, r.z, r.w};
#pragma unroll
        for (int e = 0; e < 8; ++e) *(LDSP bf16_t*)(B + GB_VT + ((part * 8 + e) * VTP + j) * 2) = (bf16_t)((e & 1) ? (w[e >> 1] >> 16) : (w[e >> 1] & 0xffffu)); }
    if (G3) {
#pragma unroll
        for (int dir = 0; dir < 2; ++dir) { const int d = tid >> 4, v4 = (tid & 15) * 4; const f32x4 sv = R.s0[dir];
            st_bf16(B, GB_S0T + dir * 4096 + ((v4 + 0) * 32 + d) * 2, sv.x); st_bf16(B, GB_S0T + dir * 4096 + ((v4 + 1) * 32 + d) * 2, sv.y);
            st_bf16(B, GB_S0T + dir * 4096 + ((v4 + 2) * 32 + d) * 2, sv.z); st_bf16(B, GB_S0T + dir * 4096 + ((v4 + 3) * 32 + d) * 2, sv.w); } }
    __syncthreads();
    const int dir = tid >> 8, seg = (tid >> 5) & 7, d = tid & 31;
    float p[8];
    { LDSP const float* Wg = (LDSP const float*)(B + GB_WG) + (dir * 16) * 128 + h * 32 + d; const float bg = ((LDSP const float*)(B + GB_BG))[dir * 128 + h * 32 + d];
        float wc[16];
#pragma unroll
        for (int r = 0; r < 16; ++r) wc[r] = Wg[r * 128];
        LDSP const float* gs = dir ? GBk : GF; float run = 0.f;
#pragma unroll
        for (int r = 0; r < 8; ++r) { const int i = dir ? 63 - (seg * 8 + r) : seg * 8 + r; float z = bg;
#pragma unroll
            for (int q = 0; q < 16; ++q) z += gs[i * 16 + q] * wc[q];
            const float ls = fminf(z, 0.f) - __logf(1.0f + __expf(-fabsf(z)));
            run += ls * (1.0f / 16.0f); p[r] = run; }
        ((LDSP float*)(B + GB_TOT))[(dir * 8 + seg) * 32 + d] = run; }
    __syncthreads();
    float off = 0.f, bl = 0.f;
#pragma unroll
    for (int sg = 0; sg < 8; ++sg) { const float t = ((LDSP const float*)(B + GB_TOT))[(dir * 8 + sg) * 32 + d]; bl += t; off += (sg < seg) ? t : 0.f; }
#pragma unroll
    for (int r = 0; r < 8; ++r) { const int i = dir ? 63 - (seg * 8 + r) : seg * 8 + r; const float bc = p[r] + off;
        if (G3) { st_bf16(B, GB_QE + dir * 4096 + (i * 32 + d) * 2, Qf[i * 33 + d] * 0.17677669529663687f * __expf(bc)); st_bf16(B, GB_KE + dir * 4096 + (i * 32 + d) * 2, Kf[i * 33 + d] * __expf(-bc)); }
        else st_bf16(B, GB_KENDT + dir * (32 * KTP * 2) + (d * KTP + i) * 2, Kf[i * 33 + d] * __expf(bl - bc)); }
    if (!G3 && seg == 0) ((float*)(a->ws + WS_GDEC))[(((size_t)(b * 2 + dir) * NCH + c) * 4 + h) * 32 + d] = __expf(bl);
    __syncthreads();
}
__device__ __forceinline__ void gla_g1_phase(KA a, LDSP unsigned char* lds, int l, int tid, int bid, int G) {
    float* DS = (float*)(a->ws + WS_GDS);
    const int lane = tid & 63, w = tid >> 6, fr = lane & 15, fq = lane >> 4;
    for (int i = tid; i < 2 * 16 * 128; i += 512) ((LDSP float*)(lds + GB_WG))[i] = a->in[I_WGG][(size_t)l * 2 * 16 * 128 + i];
    if (tid < 256) ((LDSP float*)(lds + GB_BG))[tid] = a->in[I_BGG][l * 256 + tid];
    __syncthreads();
    GlaRegs R, Rn;
    if (bid < BATCH * NCH * 4) gla_issue<false>(a, Rn, (bid >> 2) / NCH, (bid >> 2) % NCH, bid & 3, tid);
    for (int it = bid; it < BATCH * NCH * 4; it += G) {
        const int h = it & 3, c = (it >> 2) % NCH, b = (it >> 2) / NCH;
        R = Rn;
        { const int itn = it + G; if (itn < BATCH * NCH * 4) gla_issue<false>(a, Rn, (itn >> 2) / NCH, (itn >> 2) % NCH, itn & 3, tid); }
        gla_stage<false>(a, lds, R, l, b, c, h, tid);
        const int dir = w >> 2, dt = (w >> 1) & 1;
        const size_t ci = ((size_t)(b * 2 + dir) * NCH + c) * 4 + h;
        gbf16x8 af[2];
#pragma unroll
        for (int sx = 0; sx < 2; ++sx) af[sx] = *(LDSP const gbf16x8*)(lds + GB_KENDT + dir * (32 * KTP * 2) + ((dt * 16 + fr) * KTP + sx * 32 + fq * 8) * 2);
#pragma unroll
        for (int t = 0; t < 2; ++t) { const int vt = (w & 1) * 2 + t; f32x4 acc = {0.f, 0.f, 0.f, 0.f};
#pragma unroll
            for (int sx = 0; sx < 2; ++sx) { const gbf16x8 bf = *(LDSP const gbf16x8*)(lds + GB_VT + ((vt * 16 + fr) * VTP + sx * 32 + fq * 8) * 2);
                acc = __builtin_amdgcn_mfma_f32_16x16x32_bf16(af[sx], bf, acc, 0, 0, 0); }
#pragma unroll
            for (int r = 0; r < 4; ++r) DS[ci * 2048 + (size_t)(dt * 16 + fq * 4 + r) * 64 + vt * 16 + fr] = acc[r]; }
        __syncthreads();
    }
}
__device__ __forceinline__ void gla_g2_phase(KA a, int tid, int bid, int G) {
    float* DS = (float*)(a->ws + WS_GDS); const float* DEC = (const float*)(a->ws + WS_GDEC);
    for (int e = bid * 512 + tid; e < BATCH * 2 * 4 * 2048; e += G * 512) {
        const int dv = e & 2047, h = (e >> 11) & 3, dir = (e >> 13) & 1, b = e >> 14, d = dv >> 6;
        float S = 0.f;
#pragma unroll 4
        for (int st = 0; st < NCH; ++st) { const int c = dir ? (st < 4 ? 3 - st : 71 - st) : st;
            const size_t ci = ((size_t)(b * 2 + dir) * NCH + c) * 4 + h;
            const float dsv = DS[ci * 2048 + dv], dec = DEC[ci * 32 + d];
            DS[ci * 2048 + dv] = S; S = dec * S + dsv; }
    }
}
__device__ __forceinline__ void gla_g3_phase(KA a, LDSP unsigned char* lds, int l, bool last, int tid, int bid, int G) {
    const bf16_t* P = (const bf16_t*)(a->ws + WS_HP); bf16_t* CAT = (bf16_t*)a->out;
    const int lane = tid & 63, w = tid >> 6, fr = lane & 15, fq = lane >> 4, it_ = w >> 1;
    for (int i = tid; i < 2 * 16 * 128; i += 512) ((LDSP float*)(lds + GB_WG))[i] = a->in[I_WGG][(size_t)l * 2 * 16 * 128 + i];
    if (tid < 256) ((LDSP float*)(lds + GB_BG))[tid] = a->in[I_BGG][l * 256 + tid];
    __syncthreads();
    const int c_lo = last ? 4 : 0, ncs = NCH - c_lo, nit = BATCH * ncs * 4;
    GlaRegs R, Rn;
    if (bid < nit) gla_issue<true>(a, Rn, (bid >> 2) / ncs, c_lo + (bid >> 2) % ncs, bid & 3, tid);
    for (int it = bid; it < nit; it += G) {
        const int h = it & 3, c = c_lo + (it >> 2) % ncs, b = (it >> 2) / ncs;
        R = Rn;
        { const int itn = it + G; if (itn < nit) gla_issue<true>(a, Rn, (itn >> 2) / ncs, c_lo + (itn >> 2) % ncs, itn & 3, tid); }
        gla_stage<true>(a, lds, R, l, b, c, h, tid);
        gbf16x8 qf[2];
#pragma unroll
        for (int dir = 0; dir < 2; ++dir) { qf[dir] = *(LDSP const gbf16x8*)(lds + GB_QE + dir * 4096 + ((it_ * 16 + fr) * 32 + fq * 8) * 2);
#pragma unroll
            for (int t = 0; t < 2; ++t) { const int jt = (w & 1) * 2 + t;
                const gbf16x8 kf = *(LDSP const gbf16x8*)(lds + GB_KE + dir * 4096 + ((jt * 16 + fr) * 32 + fq * 8) * 2);
                const f32x4 z = {0.f, 0.f, 0.f, 0.f};
                const f32x4 s4 = __builtin_amdgcn_mfma_f32_16x16x32_bf16(qf[dir], kf, z, 0, 0, 0);
#pragma unroll
                for (int r = 0; r < 4; ++r) { const int i = it_ * 16 + fq * 4 + r, j = jt * 16 + fr; const bool keep = dir ? (j >= i) : (j <= i);
                    st_bf16(lds, GB_ATT + dir * (64 * ATP * 2) + (i * ATP + j) * 2, keep ? s4[r] : 0.f); } } }
        __syncthreads();
#pragma unroll
        for (int t = 0; t < 2; ++t) { const int vt = (w & 1) * 2 + t; f32x4 acc = {0.f, 0.f, 0.f, 0.f};
#pragma unroll
            for (int dir = 0; dir < 2; ++dir) {
#pragma unroll
                for (int sx = 0; sx < 2; ++sx) { const gbf16x8 af = *(LDSP const gbf16x8*)(lds + GB_ATT + dir * (64 * ATP * 2) + ((it_ * 16 + fr) * ATP + sx * 32 + fq * 8) * 2);
                    const gbf16x8 bf = *(LDSP const gbf16x8*)(lds + GB_VT + ((vt * 16 + fr) * VTP + sx * 32 + fq * 8) * 2);
                    acc = __builtin_amdgcn_mfma_f32_16x16x32_bf16(af, bf, acc, 0, 0, 0); }
                const gbf16x8 sf = *(LDSP const gbf16x8*)(lds + GB_S0T + dir * 4096 + ((vt * 16 + fr) * 32 + fq * 8) * 2);
                acc = __builtin_amdgcn_mfma_f32_16x16x32_bf16(qf[dir], sf, acc, 0, 0, 0); }
#pragma unroll
            for (int r = 0; r < 4; ++r) ((LDSP float*)(lds + GB_O))[(it_ * 16 + fq * 4 + r) * OP_ + vt * 16 + fr] = acc[r]; }
        __syncthreads();
        { const int i = tid >> 3, vg = tid & 7;
            const f32x4 o0 = *(LDSP const f32x4*)(lds + GB_O + (i * OP_ + vg * 8) * 4), o1 = *(LDSP const f32x4*)(lds + GB_O + (i * OP_ + vg * 8 + 4) * 4);
            float ss = (o0.x * o0.x + o0.y * o0.y) + (o0.z * o0.z + o0.w * o0.w) + (o1.x * o1.x + o1.y * o1.y) + (o1.z * o1.z + o1.w * o1.w);
            ss += swz_xor<1>(ss); ss += swz_xor<2>(ss); ss += swz_xor<4>(ss);
            const float rstd = 1.0f / sqrtf(ss * (1.0f / 64.0f) + EPS);
            const int row = gla_row(b, c, i);
            const float* gg = a->in[I_GLAG] + (size_t)(l * 4 + h) * 64 + vg * 8;
            float r[8]; unpack8(R.rg, r);
            float y[8] = {o0.x, o0.y, o0.z, o0.w, o1.x, o1.y, o1.z, o1.w};
#pragma unroll
            for (int e = 0; e < 8; ++e) y[e] = y[e] * rstd * gg[e] * (r[e] * sigm(r[e]));
            *(u32x4*)(CAT + (size_t)row * DM + 256 + h * 64 + vg * 8) = pack8(y); }
    }
}
__device__ __forceinline__ void ctx_gemm_res(KA a, LDSP unsigned char* lds, const bf16_t* A, const bf16_t* Bt, int K, bool srcf32, const float* gate, float coef,
                                             _Float16* XR, bf16_t* XS, float* ssq, const float* gn, const float* scn, int tid, int bid, int G) {
    const int lane = tid & 63, w = tid >> 6, wm = w >> 1, wn = w & 1, fr = lane & 15, fq = lane >> 4;
    LDSP unsigned char* As = lds; LDSP unsigned char* Bs = lds + 18432; LDSP float* Cs = (LDSP float*)(lds + 32768);
    const int nk = K / 64, lr = tid >> 3, lc = (tid & 7) * 8;
    for (int u = bid; u < 256; u += G) {
        int tm = u >> 4, tn = u & 15;
        if (G == 256) { const int x = u & 7, sl = u >> 3; tm = (x & 3) * 4 + (sl >> 3); tn = (x >> 2) * 8 + (sl & 7); }
        const size_t row0 = (size_t)MX + tm * 128; const int col0 = tn * 64;
        const bf16_t* ap0 = A + (row0 + lr) * K + lc; const bf16_t* ap1 = ap0 + (size_t)64 * K; const bf16_t* bp = Bt + (size_t)(col0 + lr) * K + lc;
        u32x4 ra0[4], ra1[4], rb[4];
#pragma unroll
        for (int q = 0; q < 4; ++q) { ra0[q] = *(const u32x4*)(ap0 + q * 64); ra1[q] = *(const u32x4*)(ap1 + q * 64); rb[q] = *(const u32x4*)(bp + q * 64); }
        f32x4 acc[2][2];
#pragma unroll
        for (int mt = 0; mt < 2; ++mt)
#pragma unroll
            for (int nt = 0; nt < 2; ++nt) acc[mt][nt] = (f32x4){0.f, 0.f, 0.f, 0.f};
#pragma unroll 1
        for (int kt = 0; kt < nk; kt += 4) {
#pragma unroll
            for (int q = 0; q < 4; ++q) {
                *(LDSP u32x4*)(As + (lr * 72 + lc) * 2) = ra0[q]; *(LDSP u32x4*)(As + ((64 + lr) * 72 + lc) * 2) = ra1[q]; *(LDSP u32x4*)(Bs + (lr * 72 + lc) * 2) = rb[q];
                __syncthreads();
                if (kt + q + 4 < nk) { ra0[q] = *(const u32x4*)(ap0 + (kt + q + 4) * 64); ra1[q] = *(const u32x4*)(ap1 + (kt + q + 4) * 64); rb[q] = *(const u32x4*)(bp + (kt + q + 4) * 64); }
#pragma unroll
                for (int ks = 0; ks < 2; ++ks) { gbf16x8 af[2], bf[2];
#pragma unroll
                    for (int mt = 0; mt < 2; ++mt) af[mt] = *(LDSP const gbf16x8*)(As + ((wm * 32 + mt * 16 + fr) * 72 + ks * 32 + fq * 8) * 2);
#pragma unroll
                    for (int nt = 0; nt < 2; ++nt) bf[nt] = *(LDSP const gbf16x8*)(Bs + ((wn * 32 + nt * 16 + fr) * 72 + ks * 32 + fq * 8) * 2);
#pragma unroll
                    for (int mt = 0; mt < 2; ++mt)
#pragma unroll
                        for (int nt = 0; nt < 2; ++nt) acc[mt][nt] = __builtin_amdgcn_mfma_f32_16x16x32_bf16(af[mt], bf[nt], acc[mt][nt], 0, 0, 0); }
                __syncthreads();
            }
        }
#pragma unroll
        for (int mt = 0; mt < 2; ++mt)
#pragma unroll
            for (int nt = 0; nt < 2; ++nt)
#pragma unroll
                for (int r = 0; r < 4; ++r) Cs[(wm * 32 + mt * 16 + fq * 4 + r) * 68 + wn * 32 + nt * 16 + fr] = acc[mt][nt][r];
        __syncthreads();
        { const int rl = tid >> 2, cs = (tid & 3) * 16; const size_t grow = row0 + rl; const int gc = col0 + cs;
            float x[16];
            if (srcf32) { const float* sp_ = a->in[I_CTX] + (grow - MX) * 1024 + gc;
#pragma unroll
                for (int q = 0; q < 4; ++q) { const f32x4 t = *(const f32x4*)(sp_ + 4 * q); x[4 * q] = t.x; x[4 * q + 1] = t.y; x[4 * q + 2] = t.z; x[4 * q + 3] = t.w; } }
            else {
#pragma unroll
                for (int q = 0; q < 2; ++q) { const pg8::f32x8 t = __builtin_convertvector(*(const pg8::h16x8*)(XR + grow * 1024 + gc + 8 * q), pg8::f32x8);
#pragma unroll
                    for (int e = 0; e < 8; ++e) x[8 * q + e] = t[e]; } }
            const float* g = gate + (size_t)8 * 9216 + gc; const float* gnp = gn + gc; const float* scp = scn + (size_t)8 * 9216 + gc;
            float ss = 0.f, y[16];
#pragma unroll
            for (int q = 0; q < 4; ++q) { const f32x4 gv = *(const f32x4*)(g + 4 * q), cv = *(LDSP const f32x4*)(Cs + rl * 68 + cs + 4 * q), gg = *(const f32x4*)(gnp + 4 * q), sc = *(const f32x4*)(scp + 4 * q);
#pragma unroll
                for (int e = 0; e < 4; ++e) { const float xv = x[4 * q + e] + coef * gv[e] * cv[e]; x[4 * q + e] = xv; ss += xv * xv; y[4 * q + e] = xv * gg[e] * (sc[e] + 1.0f); } }
#pragma unroll
            for (int q = 0; q < 2; ++q) { const pg8::f32x8 t = {x[8 * q], x[8 * q + 1], x[8 * q + 2], x[8 * q + 3], x[8 * q + 4], x[8 * q + 5], x[8 * q + 6], x[8 * q + 7]};
                *(pg8::h16x8*)(XR + grow * 1024 + gc + 8 * q) = __builtin_convertvector(t, pg8::h16x8);
                u32x4 wv; wv.x = pk2(y[8 * q], y[8 * q + 1]); wv.y = pk2(y[8 * q + 2], y[8 * q + 3]); wv.z = pk2(y[8 * q + 4], y[8 * q + 5]); wv.w = pk2(y[8 * q + 6], y[8 * q + 7]);
                *(u32x4*)(XS + grow * 1024 + gc + 8 * q) = wv; }
            ss += swz_xor<1>(ss); ss += swz_xor<2>(ss);
            if ((tid & 3) == 0) atomicAdd(ssq + grow, ss); }
        __syncthreads();
    }
}
__device__ __forceinline__ void attn_phase(KA a, unsigned char* lds, bool last, int bid, int G) {
    using abf = attn_body::bf16;
    const abf* Q = (const abf*)(a->ws + WS_Q); const abf* Kb = (const abf*)(a->ws + WS_K); const abf* Vb = (const abf*)(a->ws + WS_V); abf* CAT = (abf*)a->out;
    const int nunits = last ? 1024 : 1088;
    for (int u = bid; u < nunits; u += G) {
        int b, h, NT; size_t qrow;
        if (u < 1024) { b = u >> 7; h = (u >> 4) & 7; qrow = (size_t)b * SEQ + (size_t)(u & 15) * 256; NT = NCH; }
        else { const int uc = u - 1024; b = uc >> 3; h = uc & 7; qrow = (size_t)MX + (size_t)b * CTXL; NT = 4; }
        const size_t kvo = (size_t)b * KVLEN * 128 + (h >> 2) * 64;
        attn_body::attn_unit<8>(Q + qrow * 512 + h * 64, Kb + kvo, Vb + kvo, CAT + qrow * DM + 512 + h * 64, NT, (char*)lds);
    }
}
#define XB_TMO      128
#define XB_XCNT(j)  (256  + 64 * (j))
#define XB_XSUB(j)  (1280 + 64 * (j))
#define XB_XGEN(j)  (2304 + 64 * (j))
#define XB_TOP      3328
#define XB_TOPGEN   3392
#define XCD_BAR_WORDS 3456
#define XB_SPIN_CAP (1u << 18)

__device__ __forceinline__ unsigned xb_ld(unsigned* p)              { return __hip_atomic_load(p, __ATOMIC_RELAXED, __HIP_MEMORY_SCOPE_AGENT); }
__device__ __forceinline__ unsigned xb_add(unsigned* p, unsigned v) { return __hip_atomic_fetch_add(p, v, __ATOMIC_RELAXED, __HIP_MEMORY_SCOPE_AGENT); }
__device__ __forceinline__ unsigned xb_xcc_id() { return (unsigned)__builtin_amdgcn_s_getreg((3 << 11) | 20) & 0xFu; }
#define XB_SPIN(cond, bar) do { unsigned _sp = 0; while (cond) { __builtin_amdgcn_s_sleep(1); \
    if ((++_sp & 255u) == 0u) { if (xb_ld(&(bar)[XB_TMO])) break; if (_sp > XB_SPIN_CAP) { atomicAdd(&(bar)[XB_TMO], 1u); break; } } } } while (0)

struct XcdBarrier {
    unsigned* bar; unsigned x;
    volatile LDSP unsigned* st;
};

__device__ __forceinline__ XcdBarrier xcd_barrier_post(unsigned* bar, volatile LDSP unsigned* st) {
    XcdBarrier b; b.bar = bar; b.x = xb_xcc_id(); b.st = st;
    if (threadIdx.x == 0) (void)xb_add(&bar[XB_XCNT(b.x)], 1u);
    return b;
}
__device__ __forceinline__ void xcd_barrier_complete(unsigned* bar, unsigned x, unsigned& nloc, unsigned& nx) {
    const unsigned G = gridDim.x * gridDim.y * gridDim.z;
    unsigned sum, cnt, mine, sp = 0u;
    for (;;) {
        sum = 0u; cnt = 0u; mine = 0u;
#pragma unroll
        for (unsigned j = 0; j < 16; ++j) { const unsigned c = xb_ld(&bar[XB_XCNT(j)]); sum += c; cnt += (c > 0u) ? 1u : 0u; mine = (j == x) ? c : mine; }
        if (sum == G) break;
        __builtin_amdgcn_s_sleep(1);
        if ((++sp & 255u) == 0u) { if (xb_ld(&bar[XB_TMO])) break; if (sp > XB_SPIN_CAP) { atomicAdd(&bar[XB_TMO], 1u); break; } }
    }
    nloc = mine > 0u ? mine : 1u; nx = cnt > 0u ? cnt : 1u;
}

__device__ __forceinline__ void xcd_barrier(const XcdBarrier& b) {
    asm volatile("s_waitcnt vmcnt(0)" ::: "memory");
    __syncthreads();
    if (threadIdx.x == 0) {
        unsigned* bar = b.bar;
        __builtin_amdgcn_s_waitcnt(0);
        unsigned nloc = b.st[0], nx = b.st[1];
        if (nloc == 0u) { xcd_barrier_complete(bar, b.x, nloc, nx); b.st[0] = nloc; b.st[1] = nx; }
        const unsigned old = xb_add(&bar[XB_XSUB(b.x)], 1u);
        const unsigned gen = old / nloc;
        if (old + 1u == (gen + 1u) * nloc) {
            __builtin_amdgcn_fence(__ATOMIC_RELEASE, "agent");
            asm volatile("s_waitcnt vmcnt(0)" ::: "memory");
            const unsigned og = xb_add(&bar[XB_TOP], 1u);
            const unsigned tg = og / nx;
            if (og + 1u == (tg + 1u) * nx) xb_add(&bar[XB_TOPGEN], 1u);
            else XB_SPIN(xb_ld(&bar[XB_TOPGEN]) == tg, bar);
            __builtin_amdgcn_fence(__ATOMIC_ACQUIRE, "agent");
            xb_add(&bar[XB_XGEN(b.x)], 1u);
            asm volatile("s_waitcnt vmcnt(0)" ::: "memory");
        } else {
            XB_SPIN(xb_ld(&bar[XB_XGEN(b.x)]) == gen, bar);
            __builtin_amdgcn_fence(__ATOMIC_ACQUIRE, "agent");
            asm volatile("s_waitcnt vmcnt(0)" ::: "memory");
        }
    }
    __syncthreads();
}
__global__ void __launch_bounds__(512, 2) mega_fwd(Args a_unused) {
    KA a = (KA)__builtin_amdgcn_kernarg_segment_ptr();
    const int ph_lo = a->ph_lo, ph_hi = a->ph_hi;
    extern __shared__ __attribute__((aligned(16))) unsigned char lds_raw[];
    LDSP unsigned char* lds0 = (LDSP unsigned char*)lds_raw;
    { LDSP unsigned char* lds = lds0;
    volatile LDSP unsigned* xst = (volatile LDSP unsigned*)(lds + 131072 + 64);
    if (threadIdx.x == 0) { xst[0] = 0u; xst[1] = 0u; }
    __syncthreads(); }
#pragma unroll 1
    for (int ph = ph_lo; ph < ph_hi; ++ph) {
        asm volatile("" : "+s"(a));
        LDSP unsigned char* lds = lds0; asm volatile("" : "+s"(lds));
        volatile LDSP unsigned* xst = (volatile LDSP unsigned*)(lds + 131072 + 64);
        unsigned char* ws = a->ws;
        float* CTXR = (float*)(ws + WS_CTXR);
        const float* MOD = (const float*)(ws + WS_MOD);
        bf16_t* XN = (bf16_t*)(ws + WS_XN); bf16_t* CAT = (bf16_t*)a->out; bf16_t* HP = (bf16_t*)(ws + WS_HP); _Float16* XR = (_Float16*)(ws + WS_CAT);
        const int tid = opaque_tid(), lane = tid & 63, wave = __builtin_amdgcn_readfirstlane(tid >> 6);
        int G = gridDim.x, bid = blockIdx.x; asm volatile("" : "+s"(G), "+s"(bid));
        if (ph == 0) { phase0(a, lds, tid, lane, wave, bid, G); }
        else if (ph == 1) { phase1(a, lds, tid, lane, wave, bid, G); }
        else {
            const int l = (ph - 2) / NPH_LAYER, sp = (ph - 2) % NPH_LAYER; const bool last = (l == DEPTH - 1);
            const bool first = (l == 0 && sp <= 1);
            const float* srcX = first ? a->in[I_X] : a->out; const float* srcC = first ? a->in[I_CTX] : CTXR;
            const int Mtail = last ? MX : MALL;
            const float* SSQ = (const float*)(ws + WS_SSQ); const float* SW = (const float*)(ws + WS_SW);
            switch (sp) {
            case 0: case 7: { const int f = (sp == 0) ? 0 : 1, j = (sp == 0) ? 0 : 2; const int M = (sp == 0) ? MALL : Mtail;
                pg8::Gemm g{XN, (const bf16_t*)(ws + WS_W1T) + (size_t)(l * 2 + f) * W1T_SZ, M, 2 * DFF, DM}; pg8::PrefOrder S; S.init(M, 2 * DFF, G, bid);
                S.pf = lds + pg8::PF_OFF; S.ssq = SSQ + (size_t)(l * 3 + j) * MALL; S.sw = SW + (size_t)(l * 3 + j) * 9 * SWN; S.MXr = MX; S.cnt = 0;
                pg8::EpiSwiGLU E{HP, DFF, lds + pg8::PF_OFF, 0};
                pg8::gemm_phase<pg8::EpiSwiGLU, pg8::PrefOrder, true, true>(lds, g, S, E); } break;
            case 1: case 6: case 8: {
                const bf16_t* A; const bf16_t* Bt; int K, M, j; float coef;
                if (sp == 1) { A = HP; Bt = (const bf16_t*)(ws + WS_W2T) + (size_t)(l * 2 + 0) * W2T_SZ; K = DFF; M = MALL; j = 0; coef = 0.5f; }
                else if (sp == 6) { A = CAT; Bt = (const bf16_t*)(ws + WS_WOT) + (size_t)l * WOT_SZ; K = DM; M = Mtail; j = 1; coef = 1.0f; }
                else { A = HP; Bt = (const bf16_t*)(ws + WS_W2T) + (size_t)(l * 2 + 1) * W2T_SZ; K = DFF; M = Mtail; j = 2; coef = 0.5f; }
                const int ln = (j == 2) ? l + 1 : l, jn = (j == 2) ? 0 : j + 1;
                const bool has_next = ln < DEPTH; const int nidx = has_next ? (ln * 3 + jn) : 0;
                pg8::Gemm g{A, Bt, MX, DM, K}; pg8::StaticOrder S; S.init(MX, DM, G, bid);
                pg8::EpiRes E{a->in[I_X], a->in[I_CTX], a->out, XR, first ? 1 : 0, (last && sp == 8) ? 1 : 0, MOD + (size_t)l * 9 * 9216 + (3 * j + 2) * 1024, coef, MX,
                              XN, (float*)(ws + WS_SSQ) + (size_t)nidx * MALL, a->in[I_GNORM] + (size_t)nidx * DM, MOD + (size_t)(nidx / 3) * 9 * 9216 + (3 * jn + 1) * 1024, has_next ? 1 : 0};
                pg8::gemm_phase<pg8::EpiRes, pg8::StaticOrder, true, true>(lds, g, S, E);
                if (M == MALL) ctx_gemm_res(a, lds, A, Bt, K, first, MOD + (size_t)l * 9 * 9216 + (3 * j + 2) * 1024, coef, XR, XN, (float*)(ws + WS_SSQ) + (size_t)nidx * MALL,
                                            a->in[I_GNORM] + (size_t)nidx * DM, MOD + (size_t)(nidx / 3) * 9 * 9216 + (3 * jn + 1) * 1024, tid, bid, G); } break;
            case 2: { pg8::Gemm g{XN, (const bf16_t*)(ws + WS_WINT) + (size_t)l * WINT_SZ, MALL, INWP, DM}; pg8::PrefOrder S; S.init(MALL, INWP, G, bid);
                S.pf = lds + pg8::PF_OFF; S.ssq = SSQ + (size_t)(l * 3 + 1) * MALL; S.sw = SW + (size_t)(l * 3 + 1) * 9 * SWN; S.MXr = MX; S.cnt = 0;
                pg8::EpiStore E{HP, INWP, lds + pg8::PF_OFF, 0};
                pg8::gemm_phase<pg8::EpiStore, pg8::PrefOrder, true, true>(lds, g, S, E); } break;
            case 3: prep_phase(a, lds, l, tid, lane, wave, bid, G); gla_g1_phase(a, lds, l, tid, bid, G); break;
            case 4: gla_g2_phase(a, tid, bid, G); conv_phase(a, lds, l, last, tid, lane, bid, G); break;
            case 5: attn_phase(a, (unsigned char*)lds, last, bid, G); gla_g3_phase(a, lds, l, last, tid, bid, G); break;
            default: break;
            }
        }
        if (ph + 1 < ph_hi) {
            unsigned* barw = (unsigned*)(ws + WS_CTL);
            if (ph == ph_lo) {
                if (bid == 0) for (int i = tid; i < XCD_BAR_WORDS; i += 512) __hip_atomic_store(barw + i, 0u, __ATOMIC_RELAXED, __HIP_MEMORY_SCOPE_AGENT);
                cg::this_grid().sync();
                (void)xcd_barrier_post(barw, xst);
            } else { XcdBarrier xb; xb.bar = barw; xb.x = xb_xcc_id(); xb.st = xst; xcd_barrier(xb); }
        }
    }
}

#ifndef MK_MULTI
#define MK_MULTI 0
#endif
extern "C" void kernel_launch(void* const* d_in, const int* in_sizes, int n_in, void* d_out, int out_size, void* d_ws, size_t ws_size, hipStream_t stream) {
    static int grid = 0;
    if (grid == 0) {
        if (n_in != 20 || out_size != MX * DM || ws_size < WS_END) { fprintf(stderr, "kernel_launch: unexpected shapes (n_in %d, out %d, ws %zu); nothing launched\n", n_in, out_size, ws_size); grid = -1; return; }
        int dev = 0, cus = 0, per_cu = 0;
        if (hipGetDevice(&dev) != hipSuccess || hipDeviceGetAttribute(&cus, hipDeviceAttributeMultiprocessorCount, dev) != hipSuccess) { grid = -1; return; }
        if (hipFuncSetAttribute((const void*)mega_fwd, hipFuncAttributeMaxDynamicSharedMemorySize, LDS_BYTES) != hipSuccess) { fprintf(stderr, "kernel_launch: hipFuncSetAttribute failed\n"); grid = -1; return; }
        if (hipOccupancyMaxActiveBlocksPerMultiprocessor(&per_cu, (const void*)mega_fwd, 512, LDS_BYTES) != hipSuccess || per_cu < 1) { fprintf(stderr, "kernel_launch: occupancy query gave %d\n", per_cu); per_cu = 1; }
        (void)hipGetLastError();
        grid = cus * per_cu;
    }
    if (grid < 0) return;
    Args a{};
    for (int i = 0; i < 20; ++i) a.in[i] = (const float*)d_in[i];
    a.out = (float*)d_out; a.ws = (unsigned char*)d_ws;
#if MK_MULTI
    for (int ph = 0; ph < NPHASES; ++ph) { a.ph_lo = ph; a.ph_hi = ph + 1; hipLaunchKernelGGL(mega_fwd, dim3(grid), dim3(512), LDS_BYTES, stream, a); }
#else
    a.ph_lo = 0; a.ph_hi = NPHASES;
    void* args[] = {&a};
    hipError_t e = hipLaunchCooperativeKernel((const void*)mega_fwd, dim3(grid), dim3(512), args, LDS_BYTES, stream);
    if (e != hipSuccess) fprintf(stderr, "kernel_launch: cooperative launch failed: %s (grid %d)\n", hipGetErrorString(e), grid);
#endif
}
```

```cpp
#include <hip/hip_runtime.h>
#include <hip/hip_cooperative_groups.h>
#include <cstdio>
#include <cstdint>
namespace cg = cooperative_groups;
__device__ __forceinline__ int opaque_tid() { int t = threadIdx.x; asm volatile("" : "+v"(t)); return t; }
namespace pg8 {
#define PG8_LAS __attribute__((address_space(3)))
typedef unsigned short bf16_t;
typedef short bf16x8 __attribute__((ext_vector_type(8)));
typedef float f32x4 __attribute__((ext_vector_type(4)));
typedef unsigned u32x4 __attribute__((ext_vector_type(4)));
constexpr int BM = 256, BK = 64, HALF = 128, HTB = HALF * BK * 2  , STAGE_BYTES = 8 * HTB, NXCD = 8, WGM = 8;

__host__ __device__ __forceinline__ int lds_byte(int r, int c) { const int st = (r >> 4) * 2 + (c >> 5), rr = r & 15, cc = c & 31, ob = rr * 64 + cc * 2; return st * 1024 + (ob ^ (((ob >> 9) & 1) << 5)); }
__host__ __device__ __forceinline__ void stage_rc(int b, int& R, int& C) { const int st = b / 1024, sb = b % 1024, swz = sb ^ (((sb >> 9) & 1) << 5); R = (st >> 1) * 16 + swz / 64; C = (st & 1) * 32 + (swz % 64) / 2; }
__host__ __device__ __forceinline__ int perm32(int rho) { const int n = rho >> 4, i = rho & 15; return 8 * (i >> 2) + 4 * n + (i & 3); }

struct Unit { int pm, pn; };
struct Gemm { const bf16_t* A; const bf16_t* Bt; int M, N, K; };

struct StaticOrder {
    int nM, nN, nwg, G, c;
    __host__ __device__ void init(int M, int N, int G_, int c_) { nM = M / BM; nN = N / BM; nwg = nM * nN; G = G_; c = c_; }
    __host__ __device__ bool next(int i, Unit& u) const {
        const long L = (long)i * G + c; if (L >= nwg) return false;
        int wgid = (int)L; { const int q = nwg / NXCD, r = nwg % NXCD, xcd = wgid % NXCD, off = wgid / NXCD; wgid = (xcd < r ? xcd * (q + 1) : r * (q + 1) + (xcd - r) * q) + off; }
        const int nig = WGM * nN, gid = wgid / nig, fm = gid * WGM, gsz = (nM - fm) < WGM ? (nM - fm) : WGM;
        u.pm = fm + ((wgid % nig) % gsz); u.pn = (wgid % nig) / gsz; return true;
    }
    __device__ __forceinline__ void a_ready(const Unit&) const {}
    __device__ __forceinline__ void done(const Unit&) const {}
};

constexpr int PF_OFF = 132096, PF_SLOT = 2048;
struct PrefOrder : StaticOrder {
    PG8_LAS unsigned char* pf; const float* ssq; const float* sw; int MXr; mutable int cnt;
    __device__ __forceinline__ void a_ready(const Unit& u) const {
        const int t = threadIdx.x, w = __builtin_amdgcn_readfirstlane(t >> 6), lane = t & 63; const int slot = cnt & 1; ++cnt;
        const int rowt = u.pm * BM, bidx = rowt >= MXr ? 8 : (rowt >> 12);
        const float* src = (w < 4) ? ssq + rowt + w * 64 + lane : sw + (size_t)bidx * 5632 + u.pn * BM + (w - 4) * 64 + lane;
        __builtin_amdgcn_global_load_lds((const unsigned*)src, (PG8_LAS unsigned*)(pf + slot * PF_SLOT + w * 256), 4, 0, 0);
    }
};
__device__ __forceinline__ unsigned cvt_pk_bf16(float lo, float hi) { unsigned r; asm volatile("v_cvt_pk_bf16_f32 %0, %1, %2" : "=v"(r) : "v"(lo), "v"(hi)); return r; }
typedef float f32x2 __attribute__((ext_vector_type(2)));
__device__ __forceinline__ float silu_f(float v) { return v * __builtin_amdgcn_rcpf(1.0f + __expf(-v)); }
struct EpiStore {
    static constexpr bool PERM = true, AFTER_DRAIN = false;
    bf16_t* O; int ldc; PG8_LAS unsigned char* pf; mutable int cnt;
    __device__ __forceinline__ void operator()(const f32x4 (&acc)[2][2][4][2], const Unit& u, int wr, int wc, int fr, int fq) const {
        const int rowt = u.pm * BM; PG8_LAS const float* sl = (PG8_LAS const float*)(pf + (cnt & 1) * PF_SLOT); ++cnt;
        const int row0 = rowt + wr * 64 + fr, col0 = u.pn * BM + wc * 32 + 8 * fq;
        f32x4 sv[2][2];
#pragma unroll
        for (int bj = 0; bj < 2; ++bj)
#pragma unroll
            for (int n = 0; n < 2; ++n) sv[bj][n] = *(PG8_LAS const f32x4*)(sl + 256 + wc * 32 + 8 * fq + bj * HALF + 4 * n);
#pragma unroll
        for (int ai = 0; ai < 2; ++ai)
#pragma unroll
            for (int m = 0; m < 4; ++m) { const int row = row0 + ai * HALF + m * 16; bf16_t* rowp = O + (size_t)row * ldc + col0;
                const float rs = __builtin_amdgcn_rsqf(sl[row - rowt] * (1.0f / 1024.0f) + 1e-6f);
#pragma unroll
                for (int bj = 0; bj < 2; ++bj) { const f32x4 v0 = acc[ai][bj][m][0] * rs + sv[bj][0], v1 = acc[ai][bj][m][1] * rs + sv[bj][1];
                    u32x4 w; w.x = cvt_pk_bf16(v0[0], v0[1]); w.y = cvt_pk_bf16(v0[2], v0[3]); w.z = cvt_pk_bf16(v1[0], v1[1]); w.w = cvt_pk_bf16(v1[2], v1[3]);
                    *(u32x4*)(rowp + bj * HALF) = w; } }
    }
};
struct EpiSwiGLU {
    static constexpr bool PERM = true, AFTER_DRAIN = false;
    bf16_t* O; int ldc; PG8_LAS unsigned char* pf; mutable int cnt;
    __device__ __forceinline__ void operator()(const f32x4 (&acc)[2][2][4][2], const Unit& u, int wr, int wc, int fr, int fq) const {
        const int rowt = u.pm * BM; PG8_LAS const float* sl = (PG8_LAS const float*)(pf + (cnt & 1) * PF_SLOT); ++cnt;
        const int row0 = rowt + wr * 64 + fr, col0 = u.pn * HALF + wc * 32 + 8 * fq;
        f32x4 sv[2][2];
#pragma unroll
        for (int bj = 0; bj < 2; ++bj)
#pragma unroll
            for (int n = 0; n < 2; ++n) sv[bj][n] = *(PG8_LAS const f32x4*)(sl + 256 + wc * 32 + 8 * fq + bj * HALF + 4 * n);
#pragma unroll
        for (int ai = 0; ai < 2; ++ai)
#pragma unroll
            for (int m = 0; m < 4; ++m) { const int row = row0 + ai * HALF + m * 16; bf16_t* rowp = O + (size_t)row * ldc + col0;
                const float rs = __builtin_amdgcn_rsqf(sl[row - rowt] * (1.0f / 1024.0f) + 1e-6f);
                const f32x4 a0 = acc[ai][0][m][0] * rs + sv[0][0], a1 = acc[ai][0][m][1] * rs + sv[0][1], u0 = acc[ai][1][m][0] * rs + sv[1][0], u1 = acc[ai][1][m][1] * rs + sv[1][1];
                u32x4 w; w.x = cvt_pk_bf16(silu_f(a0[0]) * u0[0], silu_f(a0[1]) * u0[1]); w.y = cvt_pk_bf16(silu_f(a0[2]) * u0[2], silu_f(a0[3]) * u0[3]);
                w.z = cvt_pk_bf16(silu_f(a1[0]) * u1[0], silu_f(a1[1]) * u1[1]); w.w = cvt_pk_bf16(silu_f(a1[2]) * u1[2], silu_f(a1[3]) * u1[3]);
                *(u32x4*)rowp = w; }
    }
};
typedef _Float16 h16x8 __attribute__((ext_vector_type(8)));
typedef float f32x8 __attribute__((ext_vector_type(8)));
struct EpiRes {
    static constexpr bool PERM = true, AFTER_DRAIN = false;
    const float* srcX; const float* srcC; float* outF; _Float16* XR; int srcf32, dstf32; const float* gate; float coef; int MXr;
    bf16_t* XSp; float* ssq; const float* gn; const float* scn; int doxs;
    __device__ __forceinline__ void operator()(const f32x4 (&acc)[2][2][4][2], const Unit& u, int wr, int wc, int fr, int fq) const {
        const int rowt = u.pm * BM; const bool isc = rowt >= MXr; const bool XS = doxs != 0;
        const int bidx = isc ? 8 : (rowt >> 12);
        const char* src = (const char*)(isc ? srcC + (size_t)(rowt - MXr) * 1024 : srcX + (size_t)rowt * 1024);
        char* outb = (char*)(outF + (size_t)rowt * 1024);
        char* xrb = (char*)(XR + (size_t)rowt * 1024);
        char* xsb = (char*)(XSp + (size_t)rowt * 1024); float* sqb = ssq + rowt;
        const int col0 = u.pn * BM + wc * 32 + 8 * fq;
        const float* g = gate + (size_t)bidx * 9216 + col0;
        const unsigned lo = (unsigned)((wr * 64 + fr) * 1024 + col0);
        float ss[2][4];
#pragma unroll
        for (int ai = 0; ai < 2; ++ai)
#pragma unroll
            for (int m = 0; m < 4; ++m) ss[ai][m] = 0.f;
#pragma unroll
        for (int bj = 0; bj < 2; ++bj) {
            f32x4 gv[2], gs[2];
#pragma unroll
            for (int n = 0; n < 2; ++n) { gv[n] = *(const f32x4*)(g + bj * HALF + 4 * n) * coef;
                if (XS) gs[n] = *(const f32x4*)(gn + col0 + bj * HALF + 4 * n) * (*(const f32x4*)(scn + (size_t)bidx * 9216 + col0 + bj * HALF + 4 * n) + 1.0f); }
#pragma unroll
            for (int ai = 0; ai < 2; ++ai)
#pragma unroll
                for (int m = 0; m < 4; ++m) { const unsigned eo = lo + (unsigned)((ai * HALF + m * 16) * 1024 + bj * HALF); f32x4 xv[2];
                    if (srcf32) { xv[0] = *(const f32x4*)(src + eo * 4u); xv[1] = *(const f32x4*)(src + eo * 4u + 16u); }
                    else { const f32x8 t = __builtin_convertvector(*(const h16x8*)(xrb + eo * 2u), f32x8); xv[0] = (f32x4){t[0], t[1], t[2], t[3]}; xv[1] = (f32x4){t[4], t[5], t[6], t[7]}; }
                    xv[0] += gv[0] * acc[ai][bj][m][0]; xv[1] += gv[1] * acc[ai][bj][m][1];
                    if (dstf32) { *(f32x4*)(outb + eo * 4u) = xv[0]; *(f32x4*)(outb + eo * 4u + 16u) = xv[1]; }
                    else { const f32x8 t = {xv[0][0], xv[0][1], xv[0][2], xv[0][3], xv[1][0], xv[1][1], xv[1][2], xv[1][3]}; *(h16x8*)(xrb + eo * 2u) = __builtin_convertvector(t, h16x8); }
                    if (XS) { ss[ai][m] += (xv[0][0] * xv[0][0] + xv[0][1] * xv[0][1]) + (xv[0][2] * xv[0][2] + xv[0][3] * xv[0][3]) + (xv[1][0] * xv[1][0] + xv[1][1] * xv[1][1]) + (xv[1][2] * xv[1][2] + xv[1][3] * xv[1][3]);
                        const f32x4 y0 = xv[0] * gs[0], y1 = xv[1] * gs[1];
                        u32x4 w; w.x = cvt_pk_bf16(y0[0], y0[1]); w.y = cvt_pk_bf16(y0[2], y0[3]); w.z = cvt_pk_bf16(y1[0], y1[1]); w.w = cvt_pk_bf16(y1[2], y1[3]);
                        *(u32x4*)(xsb + eo * 2u) = w; } }
        }
        if (XS) {
#pragma unroll
            for (int ai = 0; ai < 2; ++ai)
#pragma unroll
                for (int m = 0; m < 4; ++m) { float t = ss[ai][m];
                    t += __int_as_float(__builtin_amdgcn_ds_swizzle(__float_as_int(t), 0x1f | (16 << 10)));
                    auto rr = __builtin_amdgcn_permlane32_swap(__float_as_uint(t), __float_as_uint(t), false, false);
                    t = __uint_as_float(rr[0]) + __uint_as_float(rr[1]);
                    if (fq == 0) atomicAdd(sqb + (unsigned)(wr * 64 + fr + ai * HALF + m * 16), t); } }
    }
};
template <class Epi, class Sched, bool ALIGN_EPI = false, bool SP2 = false>
__device__ __forceinline__ void gemm_phase(PG8_LAS unsigned char* lds, const Gemm g, const Sched& S, const Epi& E) {
    const int tid = opaque_tid(), wid = __builtin_amdgcn_readfirstlane(tid >> 6), lane = tid & 63, wr = wid >> 2, wc = wid & 3, fr = lane & 15, fq = lane >> 4;
    const int K = g.K, nt = K / BK;
    unsigned voffA[2], voffB[2];
#pragma unroll
    for (int i = 0; i < 2; ++i) { int R, C; stage_rc(tid * 16 + i * 8192, R, C); const int Rb = Epi::PERM ? ((R & ~31) + perm32(R & 31)) : R;
        voffA[i] = (unsigned)(R * K + C) * 2u; voffB[i] = (unsigned)(Rb * K + C) * 2u; }
    const size_t kstep = (size_t)(BK * 2);
    const size_t hstep = (size_t)HALF * K * 2;
    const size_t tstep = 2 * hstep;
    const unsigned ldsw = (unsigned)wid * 1024u;
    const int aoff = lds_byte(wr * 64 + fr, fq * 8), boff = lds_byte(wc * 32 + fr, fq * 8);
#define PG8_SA(b, h) (((b) * 2 + (h)) * HTB)
#define PG8_SB(b, h) ((4 + (b) * 2 + (h)) * HTB)
#define PG8_STAGE(bufoff, gbase, voff) do { _Pragma("unroll") for (int _i = 0; _i < 2; ++_i) \
        __builtin_amdgcn_global_load_lds((const unsigned*)((const char*)(gbase) + (voff)[_i]), (PG8_LAS unsigned*)(lds + (bufoff) + ldsw + _i * 8192), 16, 0, 0); } while (0)
#define PG8_LDA(dst, b, h) do { _Pragma("unroll") for (int m = 0; m < 4; ++m) _Pragma("unroll") for (int k = 0; k < 2; ++k) dst[m][k] = *(const PG8_LAS bf16x8*)(lds + PG8_SA(b, h) + aoff + m * 2048 + k * 1024); } while (0)
#define PG8_LDB(dst, b, h) do { _Pragma("unroll") for (int n = 0; n < 2; ++n) _Pragma("unroll") for (int k = 0; k < 2; ++k) dst[n][k] = *(const PG8_LAS bf16x8*)(lds + PG8_SB(b, h) + boff + n * 2048 + k * 1024); } while (0)
#define PG8_MMA(ai, bj, At, Bt) do { __builtin_amdgcn_s_setprio(1); _Pragma("unroll") for (int m = 0; m < 4; ++m) _Pragma("unroll") for (int n = 0; n < 2; ++n) _Pragma("unroll") for (int k = 0; k < 2; ++k) \
        acc[ai][bj][m][n] = __builtin_amdgcn_mfma_f32_16x16x32_bf16(Bt[n][k], At[m][k], acc[ai][bj][m][n], 0, 0, 0); __builtin_amdgcn_s_setprio(0); } while (0)
#define PG8_WAIT_V(n) asm volatile("s_waitcnt vmcnt(" #n ")" ::: "memory")
#define PG8_WAIT_L(n) asm volatile("s_waitcnt lgkmcnt(" #n ")" ::: "memory")
#define PG8_BAR __builtin_amdgcn_s_barrier()
#define PG8_SCHED __builtin_amdgcn_sched_barrier(0)
    Unit cur, nxt; int ui = 0;
    if (!S.next(0, cur)) return;
    f32x4 acc[2][2][4][2];
#pragma unroll
    for (int a = 0; a < 2; ++a)
#pragma unroll
        for (int b = 0; b < 2; ++b)
#pragma unroll
            for (int m = 0; m < 4; ++m)
#pragma unroll
                for (int n = 0; n < 2; ++n) acc[a][b][m][n] = (f32x4){0.f, 0.f, 0.f, 0.f};
    bf16x8 At[4][2], B0[2][2], B1[2][2];
    const char* cA = (const char*)g.A + (size_t)cur.pm * tstep; const char* cB = (const char*)g.Bt + (size_t)cur.pn * tstep;
    S.a_ready(cur);
    if constexpr (SP2) {
        PG8_STAGE(PG8_SB(0, 0), cB, voffB); PG8_STAGE(PG8_SB(0, 1), cB + hstep, voffB); PG8_STAGE(PG8_SA(0, 0), cA, voffA); PG8_STAGE(PG8_SA(0, 1), cA + hstep, voffA);
        if (wr == 1) PG8_BAR;
        PG8_WAIT_V(2); PG8_BAR;
        PG8_STAGE(PG8_SB(1, 0), cB + kstep, voffB); PG8_STAGE(PG8_SA(1, 0), cA + kstep, voffA); PG8_STAGE(PG8_SB(1, 1), cB + hstep + kstep, voffB);
        PG8_WAIT_V(6); PG8_BAR;
    } else {
        PG8_STAGE(PG8_SB(0, 0), cB, voffB); PG8_STAGE(PG8_SA(0, 0), cA, voffA); PG8_STAGE(PG8_SB(0, 1), cB + hstep, voffB); PG8_STAGE(PG8_SA(0, 1), cA + hstep, voffA);
        if (wr == 1) PG8_BAR;
        PG8_WAIT_V(4); PG8_BAR;
        PG8_STAGE(PG8_SB(1, 0), cB + kstep, voffB); PG8_STAGE(PG8_SA(1, 0), cA + kstep, voffA); PG8_STAGE(PG8_SB(1, 1), cB + hstep + kstep, voffB);
        PG8_WAIT_V(6); PG8_BAR;
    }
    for (;;) {
        const bool has_next = S.next(ui + 1, nxt);
        const char* nA = has_next ? (const char*)g.A + (size_t)nxt.pm * tstep : cA; const char* nB = has_next ? (const char*)g.Bt + (size_t)nxt.pn * tstep : cB;
        for (int t = 0; t < nt; t += 2) {
            const bool last = (t == nt - 2);
            const char* a1 = cA + (size_t)(t + 1) * kstep;
            const char* a2 = last ? nA : cA + (size_t)(t + 2) * kstep; const char* b2 = last ? nB : cB + (size_t)(t + 2) * kstep;
            const char* a3 = a2 + kstep; const char* b3 = b2 + kstep;
            if (last && has_next) S.a_ready(nxt);
            if constexpr (SP2) {
            PG8_LDB(B0, 0, 0); PG8_LDB(B1, 0, 1); PG8_SCHED; PG8_LDA(At, 0, 0); PG8_STAGE(PG8_SA(1, 1), a1 + hstep, voffA);
            PG8_WAIT_V(8); PG8_WAIT_L(0); PG8_BAR; PG8_MMA(0, 0, At, B0); PG8_MMA(0, 1, At, B1); PG8_BAR; PG8_SCHED;
            PG8_LDA(At, 0, 1); PG8_STAGE(PG8_SB(0, 0), b2, voffB); PG8_STAGE(PG8_SB(0, 1), b2 + hstep, voffB); PG8_STAGE(PG8_SA(0, 0), a2, voffA);
            PG8_WAIT_V(8); PG8_WAIT_L(0); PG8_BAR; PG8_MMA(1, 0, At, B0); PG8_MMA(1, 1, At, B1); PG8_BAR; PG8_SCHED;
            PG8_LDB(B0, 1, 0); PG8_LDB(B1, 1, 1); PG8_SCHED; PG8_LDA(At, 1, 0); PG8_STAGE(PG8_SA(0, 1), a2 + hstep, voffA);
            PG8_WAIT_V(8); PG8_WAIT_L(0); PG8_BAR; PG8_MMA(0, 0, At, B0); PG8_MMA(0, 1, At, B1); PG8_BAR; PG8_SCHED;
            PG8_LDA(At, 1, 1); PG8_STAGE(PG8_SB(1, 0), b3, voffB); PG8_STAGE(PG8_SB(1, 1), b3 + hstep, voffB); PG8_STAGE(PG8_SA(1, 0), a3, voffA);
            PG8_WAIT_V(8); PG8_WAIT_L(0); PG8_BAR; PG8_MMA(1, 0, At, B0); PG8_MMA(1, 1, At, B1); PG8_BAR; PG8_SCHED;
            } else {
            PG8_LDB(B0, 0, 0); PG8_SCHED; PG8_LDA(At, 0, 0); PG8_STAGE(PG8_SA(1, 1), a1 + hstep, voffA);
            PG8_WAIT_L(8); PG8_BAR; PG8_WAIT_L(0); PG8_MMA(0, 0, At, B0); PG8_BAR; PG8_SCHED;
            PG8_LDB(B1, 0, 1); PG8_STAGE(PG8_SB(0, 0), b2, voffB);
            PG8_BAR; PG8_WAIT_L(0); PG8_MMA(0, 1, At, B1); PG8_BAR;
            PG8_LDA(At, 0, 1); PG8_STAGE(PG8_SA(0, 0), a2, voffA);
            PG8_BAR; PG8_WAIT_L(0); PG8_MMA(1, 0, At, B0); PG8_BAR; PG8_SCHED;
            PG8_STAGE(PG8_SB(0, 1), b2 + hstep, voffB);
            PG8_WAIT_V(6); PG8_BAR; PG8_MMA(1, 1, At, B1); PG8_BAR;
            PG8_LDB(B0, 1, 0); PG8_SCHED; PG8_LDA(At, 1, 0); PG8_STAGE(PG8_SA(0, 1), a2 + hstep, voffA);
            PG8_WAIT_L(8); PG8_BAR; PG8_WAIT_L(0); PG8_MMA(0, 0, At, B0); PG8_BAR; PG8_SCHED;
            PG8_LDB(B1, 1, 1); PG8_STAGE(PG8_SB(1, 0), b3, voffB);
            PG8_BAR; PG8_WAIT_L(0); PG8_MMA(0, 1, At, B1); PG8_BAR;
            PG8_LDA(At, 1, 1); PG8_STAGE(PG8_SA(1, 0), a3, voffA);
            PG8_BAR; PG8_WAIT_L(0); PG8_MMA(1, 0, At, B0); PG8_BAR; PG8_SCHED;
            PG8_STAGE(PG8_SB(1, 1), b3 + hstep, voffB);
            PG8_WAIT_V(6); PG8_BAR; PG8_MMA(1, 1, At, B1); PG8_BAR;
            }
        }
        if constexpr (ALIGN_EPI) { if (wr == 0) PG8_BAR; }
        if constexpr (!Epi::AFTER_DRAIN) { E(acc, cur, wr, wc, fr, fq); S.done(cur); }
        if (!has_next) break;
#pragma unroll
        for (int a = 0; a < 2; ++a)
#pragma unroll
            for (int b = 0; b < 2; ++b)
#pragma unroll
                for (int m = 0; m < 4; ++m)
#pragma unroll
                    for (int n = 0; n < 2; ++n) acc[a][b][m][n] = (f32x4){0.f, 0.f, 0.f, 0.f};
        cur = nxt; cA = nA; cB = nB; ++ui;
        if constexpr (ALIGN_EPI) { if (wr == 1) PG8_BAR; }
    }
    PG8_WAIT_V(0);
    if constexpr (!ALIGN_EPI) { if (wr == 0) PG8_BAR; }
    PG8_BAR;
    if constexpr (Epi::AFTER_DRAIN) { E.fused(acc, cur, wr, wc, fr, fq, lds, wid, lane); S.done(cur); }
#undef PG8_SA
#undef PG8_SB
#undef PG8_STAGE
#undef PG8_LDA
#undef PG8_LDB
#undef PG8_MMA
#undef PG8_WAIT_V
#undef PG8_WAIT_L
#undef PG8_BAR
#undef PG8_SCHED
}
}
#include <hip/hip_bf16.h>
#include <cmath>
namespace attn_body {
using bf16=__hip_bfloat16;
using bf16x8=__attribute__((ext_vector_type(8)))short;
using s16x4=__attribute__((ext_vector_type(4)))short;
using f32x16=__attribute__((ext_vector_type(16)))float;
using u32x4=__attribute__((ext_vector_type(4)))unsigned;
constexpr int D=64,QP=512,KP=128,OP=1024;
constexpr int NW=8,QBLK=32,QB=QBLK*NW,KVBLK=64;
constexpr int ATTN_UNIT_ROWS=QB;
__device__ __forceinline__ int crow(int r,int hi){return (r&3)+8*(r>>2)+4*hi;}
#define SBAR() __builtin_amdgcn_sched_barrier(0)
__device__ __forceinline__ void cmask(f32x16&p0,f32x16&p1,int jb,int qrel,int hi){
  const float NEG=-INFINITY; int kb=64*jb+4*hi;
  #pragma unroll
  for(int r=0;r<16;++r){int kv=kb+(r&3)+8*(r>>2); if(kv>qrel)p0[r]=NEG; if(kv+32>qrel)p1[r]=NEG;}
}

constexpr int NSLOT=3, SLOTB=8192;
constexpr int LDS_K=0, LDS_V=NSLOT*SLOTB, LDS_WS=2*NSLOT*SLOTB, LDS_OST=LDS_WS+NW*64*4, LDS_BYTES=LDS_OST+NW*4096;
constexpr float C2=0.125f*1.4426950408889634f;
__device__ __forceinline__ void glds16(const void*gsrc,unsigned lds_dst){unsigned keep;
  asm volatile("s_mov_b32 %0, m0\n\ts_mov_b32 m0, %2\n\ts_nop 0\n\tglobal_load_lds_dwordx4 %1, off\n\ts_mov_b32 m0, %0":"=&s"(keep):"v"(gsrc),"s"(lds_dst):"memory");}
__device__ __forceinline__ float max3f(float a,float b,float c){float r;asm("v_max3_f32 %0, %1, %2, %3":"=v"(r):"v"(a),"v"(b),"v"(c));return r;}
__device__ __forceinline__ float max2f(float a,float b){float r;asm("v_max_f32_e32 %0, %1, %2":"=v"(r):"v"(a),"v"(b));return r;}
__device__ __forceinline__ float fadd_s(float a,float b){float r;asm("v_add_f32_e32 %0, %1, %2":"=v"(r):"v"(a),"v"(b));return r;}
__device__ __forceinline__ float fsub_s(float a,float b){float r;asm("v_sub_f32_e32 %0, %1, %2":"=v"(r):"v"(a),"v"(b));return r;}
typedef float f32x2_t __attribute__((ext_vector_type(2))); typedef __bf16 bf16x2_t __attribute__((ext_vector_type(2)));
__device__ __forceinline__ unsigned cvtpk_s(float lo,float hi){f32x2_t v={lo,hi};bf16x2_t b=__builtin_convertvector(v,bf16x2_t);return __builtin_bit_cast(unsigned,b);}
#define WAIT_BAR(N) asm volatile("s_waitcnt vmcnt(" #N ") lgkmcnt(0)\n\ts_barrier":::"memory")

__device__ __forceinline__ void qkt(f32x16&p0,f32x16&p1,const char*Kslot,const bf16x8*qr,const f32x16&negm,int r32,int hi){
  const char*kb=Kslot+hi*1024+r32*16;
  #pragma unroll
  for(int d0=0;d0<4;++d0){
    const bf16x8 b0=*reinterpret_cast<const bf16x8*>(kb+d0*2048);
    const bf16x8 b1=*reinterpret_cast<const bf16x8*>(kb+d0*2048+512);
    if(d0==0){p0=__builtin_amdgcn_mfma_f32_32x32x16_bf16(b0,qr[0],negm,0,0,0);p1=__builtin_amdgcn_mfma_f32_32x32x16_bf16(b1,qr[0],negm,0,0,0);}
    else{p0=__builtin_amdgcn_mfma_f32_32x32x16_bf16(b0,qr[d0],p0,0,0,0);p1=__builtin_amdgcn_mfma_f32_32x32x16_bf16(b1,qr[d0],p1,0,0,0);}}
}
typedef __attribute__((address_space(3))) const char* lds_cptr;
typedef short v4i16_t __attribute__((ext_vector_type(4)));
__device__ __forceinline__ void kload8(bf16x8*kf,lds_cptr kp){
  kf[0]=*(const __attribute__((address_space(3))) bf16x8*)(kp);      kf[1]=*(const __attribute__((address_space(3))) bf16x8*)(kp+512);
  kf[2]=*(const __attribute__((address_space(3))) bf16x8*)(kp+2048); kf[3]=*(const __attribute__((address_space(3))) bf16x8*)(kp+2560);
  kf[4]=*(const __attribute__((address_space(3))) bf16x8*)(kp+4096); kf[5]=*(const __attribute__((address_space(3))) bf16x8*)(kp+4608);
  kf[6]=*(const __attribute__((address_space(3))) bf16x8*)(kp+6144); kf[7]=*(const __attribute__((address_space(3))) bf16x8*)(kp+6656);
}
__device__ __forceinline__ void kload2(bf16x8*kf,lds_cptr kp,int j){ kf[2*j]=*(const __attribute__((address_space(3))) bf16x8*)(kp+j*2048); kf[2*j+1]=*(const __attribute__((address_space(3))) bf16x8*)(kp+j*2048+512); }
__device__ __forceinline__ s16x4 vtr(lds_cptr p){ return __builtin_bit_cast(s16x4,__builtin_amdgcn_ds_read_tr16_b64_v4i16((__attribute__((address_space(3))) v4i16_t*)p)); }
__device__ __forceinline__ float rowmax(const f32x16&p0,const f32x16&p1){
  float a=max3f(p0[0],p0[1],p1[0]),b=max3f(p0[2],p0[3],p1[1]);a=max3f(a,p1[2],p1[3]);
  #pragma unroll
  for(int r=4;r<16;r+=4){a=max3f(a,p0[r],p0[r+1]);b=max3f(b,p0[r+2],p0[r+3]);a=max3f(a,p1[r],p1[r+1]);b=max3f(b,p1[r+2],p1[r+3]);}
  const float m=max2f(a,b);
  auto rr=__builtin_amdgcn_permlane32_swap(__float_as_uint(m),__float_as_uint(m),false,false);
  return max2f(__uint_as_float(rr[0]),__uint_as_float(rr[1]));
}
__device__ __forceinline__ void pv(f32x16*o,int vb,bf16x8 pa0,bf16x8 pa1,bf16x8 pa2,bf16x8 pa3){
  #pragma unroll
  for(int d0=0;d0<2;++d0){s16x4 lo[4],hi[4];
    #pragma unroll
    for(int ks=0;ks<4;++ks){
      asm volatile("ds_read_b64_tr_b16 %0,%1 offset:%c2":"=&v"(lo[ks]):"v"(vb),"i"(d0*4096+ks*1024):"memory");
      asm volatile("ds_read_b64_tr_b16 %0,%1 offset:%c2":"=&v"(hi[ks]):"v"(vb),"i"(d0*4096+ks*1024+512):"memory");}
    asm volatile("s_waitcnt lgkmcnt(0)":::"memory");SBAR();
    #define PK(k) (bf16x8){lo[k][0],lo[k][1],lo[k][2],lo[k][3],hi[k][0],hi[k][1],hi[k][2],hi[k][3]}
    o[d0]=__builtin_amdgcn_mfma_f32_32x32x16_bf16(pa0,PK(0),o[d0],0,0,0);
    o[d0]=__builtin_amdgcn_mfma_f32_32x32x16_bf16(pa1,PK(1),o[d0],0,0,0);
    o[d0]=__builtin_amdgcn_mfma_f32_32x32x16_bf16(pa2,PK(2),o[d0],0,0,0);
    o[d0]=__builtin_amdgcn_mfma_f32_32x32x16_bf16(pa3,PK(3),o[d0],0,0,0);
    #undef PK
  }
}

#ifndef ATTN_STORE16
#define ATTN_STORE16(p,v) (*(u32x4*)(p)=(v))
#endif
template<int THRL> __device__ __forceinline__ void attn_unit(const bf16*Q0,const bf16*__restrict__ Kh,const bf16*__restrict__ Vh,bf16*O0,const int NT,char*shm){
  const int tid=opaque_tid(),lane=tid&63,r32=lane&31,hi=lane>>5; const int wid=__builtin_amdgcn_readfirstlane(tid>>6);
  const bf16*Qw=Q0+(long)(wid*QBLK)*QP;
  const unsigned lds0=(unsigned)(uintptr_t)shm;
  float*wsf=(float*)(shm+LDS_WS)+wid*64;
  const bf16*ksrc=Kh+(long)lane*KP+wid*8;
  const bf16*vsrc=Vh+(long)(16*(wid&3)+(lane>>2))*KP+(wid>>2)*32+(lane&3)*8;
  const unsigned kdst=lds0+LDS_K+wid*1024, vdst=lds0+LDS_V+wid*1024;
  #define DMA_K(t,slot) glds16(ksrc+(long)(t)*KVBLK*KP,(unsigned)__builtin_amdgcn_readfirstlane(kdst+(slot)))
  #define DMA_V(t,slot) glds16(vsrc+(long)(t)*KVBLK*KP,(unsigned)__builtin_amdgcn_readfirstlane(vdst+(slot)))
  const int vb0=(int)(lds0+LDS_V)+((lane>>4)&1)*32+(lane&3)*8+(4*hi+((lane&15)>>2))*64;
  const char*Kbase=shm+LDS_K; bf16x8 kf[8];
  const lds_cptr shm3=(lds_cptr)shm; const lds_cptr kp0=shm3+LDS_K+hi*1024+r32*16; const lds_cptr vp0=shm3+LDS_V+((lane>>4)&1)*32+(lane&3)*8+(4*hi+((lane&15)>>2))*64;
  DMA_K(0,0);DMA_V(0,0);DMA_K(1,SLOTB);
  bf16x8 qr[4];
  #pragma unroll
  for(int d0=0;d0<4;++d0)qr[d0]=*reinterpret_cast<const bf16x8*>(&Qw[(long)r32*QP+d0*16+hi*8]);
  float mhat=0.f,l_reg=0.f;f32x16 o[2];o[0]=f32x16{};o[1]=f32x16{};f32x16 negm=f32x16{};asm volatile("":"+v"(negm));
  #define CMASK(P0,P1,t) do{}while(0)
  bool resc=false;
  #define START(P0,P1) do{ const float rm=rowmax(P0,P1); resc=false; \
    { const float dl=rm; mhat=fadd_s(mhat,dl); \
      _Pragma("unroll") for(int r=0;r<16;++r){P0[r]=fsub_s(P0[r],dl);P1[r]=fsub_s(P1[r],dl);} \
      _Pragma("unroll") for(int r=0;r<16;++r)negm[r]=-mhat; asm volatile("":"+v"(negm)); } \
    _Pragma("unroll") for(int r=0;r<16;++r)P0[r]=__builtin_amdgcn_exp2f(P0[r]); }while(0)
  #define RESC() do{ if(resc){ asm volatile("s_waitcnt lgkmcnt(0)":::"memory"); \
      _Pragma("unroll") for(int d_=0;d_<2;++d_) _Pragma("unroll") for(int r=0;r<16;++r)o[d_][r]*=wsf[crow(r,hi)]; } }while(0)
  f32x16 pA0,pA1,pB0,pB1;
  int sl_prev=0,sl_cur=0,sl_next=SLOTB;
  #define ROT() do{sl_prev=sl_cur;sl_cur=sl_next;sl_next=(sl_next==(NSLOT-1)*SLOTB)?0:sl_next+SLOTB;}while(0)
  DMA_K(2,2*SLOTB);
  WAIT_BAR(3);
  qkt(pA0,pA1,Kbase,qr,negm,r32,hi);asm volatile("s_nop 15\n\ts_nop 7":"+v"(pA0),"+v"(pA1));CMASK(pA0,pA1,0);
  START(pA0,pA1);
  _Pragma("unroll") for(int r=0;r<16;++r)pA1[r]=__builtin_amdgcn_exp2f(pA1[r]);
  WAIT_BAR(0);
  DMA_K(3,0);DMA_V(1,SLOTB);
  ROT();
  kload8(kf,kp0+sl_cur);
  WAIT_BAR(2);
  s16x4 vlo[8],vhi[8]; u32x4 pw0,pw1,pw2,pw3;
  #define PKW(P,B) cvtpk_s(P[B],P[B+1])
  #define PAF(k) __builtin_bit_cast(bf16x8,pw##k)
  #define VFR(i) (bf16x8){vlo[i][0],vlo[i][1],vlo[i][2],vlo[i][3],vhi[i][0],vhi[i][1],vhi[i][2],vhi[i][3]}
  #define PIN(x) asm volatile("":"+v"(x))
  #define MX3(a,b,c) __builtin_fmaxf(__builtin_fmaxf((a),(b)),(c))
  #define GAPA(MF,A0,A1,A2,A3,W0,W1,PW) do{ MF; sacc+=A0; sacc+=A1; sacc+=A2; sacc+=A3; PIN(sacc); W0; W1; PIN(PW); SBAR(); }while(0)
  #define EX(v) __builtin_amdgcn_exp2f(v)
  #define GAPB(MF,X,B) do{ MF; X[B]=EX(X[B]); X[B+1]=EX(X[B+1]); X[B+2]=EX(X[B+2]); X[B+3]=EX(X[B+3]); PIN(X); SBAR(); }while(0)
  #define VRD(i) do{ vlo[i]=vtr(vp_+(((i)>>2)*4096+((i)&3)*1024)); vhi[i]=vtr(vp_+(((i)>>2)*4096+((i)&3)*1024+512)); }while(0)
  #define KRD(G,j) do{ if(G){ kload2(kf,kp0+sl_next,j); SBAR(); } }while(0)
  #define STEP(C0,C1,P0,P1,t,GK,GV,GL) do{ SBAR(); \
    const lds_cptr vp_=vp0+sl_prev; \
    VRD(0); SBAR(); float sacc=(P0[0]+P0[1]); \
    GAPA(C0=__builtin_amdgcn_mfma_f32_32x32x16_bf16(kf[0],qr[0],negm,0,0,0), P0[2],P0[3],P0[4],P0[5],     pw0[0]=PKW(P0,0), pw0[1]=PKW(P0,2), pw0); \
    VRD(4); SBAR(); GAPA(C1=__builtin_amdgcn_mfma_f32_32x32x16_bf16(kf[1],qr[0],negm,0,0,0), P0[6],P0[7],P0[8],P0[9],     pw0[2]=PKW(P0,4), pw0[3]=PKW(P0,6), pw0); \
    VRD(1); SBAR(); GAPA(C0=__builtin_amdgcn_mfma_f32_32x32x16_bf16(kf[2],qr[1],C0,0,0,0),   P0[10],P0[11],P0[12],P0[13], pw1[0]=PKW(P0,8), pw1[1]=PKW(P0,10), pw1); \
    VRD(5); SBAR(); GAPA(C1=__builtin_amdgcn_mfma_f32_32x32x16_bf16(kf[3],qr[1],C1,0,0,0),   P0[14],P0[15],P1[0],P1[1],   pw1[2]=PKW(P0,12),pw1[3]=PKW(P0,14), pw1); \
    VRD(2); SBAR(); GAPA(C0=__builtin_amdgcn_mfma_f32_32x32x16_bf16(kf[4],qr[2],C0,0,0,0),   P1[2],P1[3],P1[4],P1[5],     pw2[0]=PKW(P1,0), pw2[1]=PKW(P1,2), pw2); \
    VRD(6); SBAR(); GAPA(C1=__builtin_amdgcn_mfma_f32_32x32x16_bf16(kf[5],qr[2],C1,0,0,0),   P1[6],P1[7],P1[8],P1[9],     pw2[2]=PKW(P1,4), pw2[3]=PKW(P1,6), pw2); \
    VRD(3); SBAR(); GAPA(C0=__builtin_amdgcn_mfma_f32_32x32x16_bf16(kf[6],qr[3],C0,0,0,0),   P1[10],P1[11],P1[12],P1[13], pw3[0]=PKW(P1,8), pw3[1]=PKW(P1,10), pw3); \
    VRD(7); SBAR(); GAPA(C1=__builtin_amdgcn_mfma_f32_32x32x16_bf16(kf[7],qr[3],C1,0,0,0),   P1[14],P1[15],0.f,0.f,       pw3[2]=PKW(P1,12),pw3[3]=PKW(P1,14), pw3); \
    l_reg+=sacc; \
    if(GK){DMA_K((t)+3,sl_cur);} if(GV){DMA_V((t)+1,sl_next);} \
    CMASK(C0,C1,t); \
    { float a=MX3(C0[0],C0[1],C1[0]),b=MX3(C0[2],C0[3],C1[1]); a=MX3(a,C1[2],C1[3]); \
      _Pragma("unroll") for(int r=4;r<16;r+=4){a=MX3(a,C0[r],C0[r+1]);b=MX3(b,C0[r+2],C0[r+3]);a=MX3(a,C1[r],C1[r+1]);b=MX3(b,C1[r+2],C1[r+3]);} \
      float rm=__builtin_fmaxf(a,b); { auto rr=__builtin_amdgcn_permlane32_swap(__float_as_uint(rm),__float_as_uint(rm),false,false); rm=__builtin_fmaxf(__uint_as_float(rr[0]),__uint_as_float(rr[1])); } \
      resc=false; \
      if(__builtin_expect(__any(rm>(float)THRL),0)){ const float dl=__builtin_fmaxf(rm,0.f); mhat+=dl; \
        _Pragma("unroll") for(int r=0;r<16;++r){C0[r]-=dl;C1[r]-=dl;} \
        _Pragma("unroll") for(int r=0;r<16;++r)negm[r]=-mhat; asm volatile("":"+v"(negm)); \
        const float f=__builtin_amdgcn_exp2f(-dl); l_reg*=f; if(hi==0)wsf[r32]=f; resc=true; } } \
    SBAR(); \
    GAPB(o[0]=__builtin_amdgcn_mfma_f32_32x32x16_bf16(PAF(0),VFR(0),o[0],0,0,0), C0,0); \
    GAPB(o[1]=__builtin_amdgcn_mfma_f32_32x32x16_bf16(PAF(0),VFR(4),o[1],0,0,0), C0,4); \
    KRD(GL,0); GAPB(o[0]=__builtin_amdgcn_mfma_f32_32x32x16_bf16(PAF(1),VFR(1),o[0],0,0,0), C0,8); \
    KRD(GL,1); GAPB(o[1]=__builtin_amdgcn_mfma_f32_32x32x16_bf16(PAF(1),VFR(5),o[1],0,0,0), C0,12); \
    KRD(GL,2); GAPB(o[0]=__builtin_amdgcn_mfma_f32_32x32x16_bf16(PAF(2),VFR(2),o[0],0,0,0), C1,0); \
    KRD(GL,3); GAPB(o[1]=__builtin_amdgcn_mfma_f32_32x32x16_bf16(PAF(2),VFR(6),o[1],0,0,0), C1,4); \
    GAPB(o[0]=__builtin_amdgcn_mfma_f32_32x32x16_bf16(PAF(3),VFR(3),o[0],0,0,0), C1,8); \
    GAPB(o[1]=__builtin_amdgcn_mfma_f32_32x32x16_bf16(PAF(3),VFR(7),o[1],0,0,0), C1,12); \
    }while(0)
  int t=1;
  for(;t+5<NT;t+=2){
    STEP(pB0,pB1,pA0,pA1,t,true,true,true);     WAIT_BAR(2); RESC(); ROT();
    STEP(pA0,pA1,pB0,pB1,t+1,true,true,true);   WAIT_BAR(2); RESC(); ROT();
  }
  #define ENDW(tt) do{ if((tt)+3<NT){WAIT_BAR(2);} else if((tt)+2<NT){WAIT_BAR(1);} else {WAIT_BAR(0);} }while(0)
  for(;t+1<NT;t+=2){
    STEP(pB0,pB1,pA0,pA1,t,(t+3<NT),(t+1<NT),(t+1<NT));       ENDW(t);   RESC(); ROT();
    STEP(pA0,pA1,pB0,pB1,t+1,(t+4<NT),(t+2<NT),(t+2<NT));     ENDW(t+1); RESC(); ROT();
  }
  STEP(pB0,pB1,pA0,pA1,NT-1,false,false,false); RESC();
  { float sacc=pB0[0]+pB0[1]; _Pragma("unroll") for(int r=2;r<16;++r)sacc+=pB0[r]; _Pragma("unroll") for(int r=0;r<16;++r)sacc+=pB1[r]; l_reg+=sacc;
    pw0=(u32x4){PKW(pB0,0),PKW(pB0,2),PKW(pB0,4),PKW(pB0,6)};pw1=(u32x4){PKW(pB0,8),PKW(pB0,10),PKW(pB0,12),PKW(pB0,14)};pw2=(u32x4){PKW(pB1,0),PKW(pB1,2),PKW(pB1,4),PKW(pB1,6)};pw3=(u32x4){PKW(pB1,8),PKW(pB1,10),PKW(pB1,12),PKW(pB1,14)};
    SBAR(); pv(o,vb0+sl_cur,PAF(0),PAF(1),PAF(2),PAF(3)); }
  #undef PKW
  #undef PAF
  #undef VFR
  #undef PIN
  #undef MX3
  #undef GAPA
  #undef GAPB
  #undef EX
  #undef VRD
  #undef KRD
  #undef STEP
  #undef ENDW
  {auto rr=__builtin_amdgcn_permlane32_swap(__float_as_uint(l_reg),__float_as_uint(l_reg),false,false);l_reg=__uint_as_float(rr[0])+__uint_as_float(rr[1]);}
  if(hi==0)wsf[32+r32]=l_reg;asm volatile("s_waitcnt lgkmcnt(0)":::"memory");
  float rli[16];
  #pragma unroll
  for(int r=0;r<16;++r)rli[r]=__builtin_amdgcn_rcpf(wsf[32+crow(r,hi)]);
  bf16*Ow=O0+(long)(wid*QBLK)*OP;
  { bf16*stg=(bf16*)(shm+LDS_OST)+wid*2048;
    #pragma unroll
    for(int r=0;r<16;++r){const int orow=crow(r,hi);
      #pragma unroll
      for(int d0=0;d0<2;++d0)stg[orow*64+d0*32+r32]=__float2bfloat16(o[d0][r]*rli[r]);}
    asm volatile("s_waitcnt lgkmcnt(0)":::"memory");
    #pragma unroll
    for(int i=0;i<4;++i){const int row=i*8+(lane>>3),ch=lane&7; const u32x4 v=*(const u32x4*)(stg+row*64+ch*8); ATTN_STORE16(Ow+(long)row*OP+ch*8,v);} }
  asm volatile("s_waitcnt lgkmcnt(0)\n\ts_barrier":::"memory");
  #undef DMA_K
  #undef DMA_V
  #undef CMASK
  #undef START
  #undef RESC
  #undef ROT
}
constexpr int ATTN_LDS_BYTES=LDS_BYTES;
#undef SBAR
#undef WAIT_BAR
}

constexpr int DM = 1024, BATCH = 8, SEQ = 4096, DEPTH = 4, CTXL = 256, DFF = 2816;
constexpr int MX = BATCH * SEQ, MC = BATCH * CTXL, MALL = MX + MC;
constexpr int INW = 2080, INWP = 2304, KVLEN = CTXL + SEQ, NCH = KVLEN / 64;
constexpr float EPS = 1e-6f;
constexpr float QSCALE = 0.125f * 1.4426950408889634f;
constexpr int PC_CA = 0, PC_CG = 256, PC_GQ = 512, PC_GK = 640, PC_GV = 768, PC_GR = 1024, PC_GF = 1280, PC_AQ = 1312, PC_AK = 1824;
constexpr size_t MiB = 1u << 20;
constexpr size_t WS_W1T = 0, WS_W2T = 88 * MiB, WS_WINT = 132 * MiB, WS_WOT = 150 * MiB, WS_MOD = 158 * MiB, WS_XN = 160 * MiB, WS_CAT = 228 * MiB,
                 WS_HP = 296 * MiB, WS_Q = 483 * MiB, WS_K = 517 * MiB, WS_V = 526 * MiB, WS_CTXR = 535 * MiB, WS_GDS = 543 * MiB, WS_GDEC = 577 * MiB, WS_CTL = 578 * MiB, WS_SSQ = 579 * MiB, WS_SW = 581 * MiB, WS_END = 584 * MiB;
constexpr size_t W1T_SZ = (size_t)2 * DFF * DM, W2T_SZ = (size_t)DM * DFF, WINT_SZ = (size_t)INWP * DM, WOT_SZ = (size_t)DM * DM;
static_assert(8 * W1T_SZ * 2 <= WS_W2T - WS_W1T && 8 * W2T_SZ * 2 <= WS_WINT - WS_W2T && 4 * WINT_SZ * 2 <= WS_WOT - WS_WINT && 4 * WOT_SZ * 2 <= WS_MOD - WS_WOT, "ws map W");
static_assert((size_t)MALL * DM * 2 <= WS_CAT - WS_XN && (size_t)MALL * DM * 2 <= WS_HP - WS_CAT && (size_t)MALL * DFF * 2 <= WS_Q - WS_HP && (size_t)MALL * 512 * 2 <= WS_K - WS_Q, "ws map act");
static_assert((size_t)BATCH * KVLEN * 128 * 2 <= WS_V - WS_K && (size_t)MC * DM * 4 <= WS_GDS - WS_CTXR && (size_t)BATCH * 2 * NCH * 4 * 2048 * 4 <= WS_GDEC - WS_GDS, "ws map 2");
constexpr int LDS_BYTES = 147456;
constexpr int NPH_LAYER = 9, NPHASES = 2 + DEPTH * NPH_LAYER;
constexpr int SWN = 2 * DFF;
static_assert((size_t)DEPTH * 3 * MALL * 4 <= WS_SW - WS_SSQ && (size_t)DEPTH * 3 * 9 * SWN * 4 <= WS_END - WS_SW, "ws map 3");

typedef unsigned short bf16_t;
typedef float f32x4 __attribute__((ext_vector_type(4)));
typedef unsigned u32x4 __attribute__((ext_vector_type(4)));
typedef unsigned u32x2 __attribute__((ext_vector_type(2)));
typedef float f32x2v __attribute__((ext_vector_type(2)));
#define LDSP __attribute__((address_space(3)))
#define LDS_WAIT() asm volatile("s_waitcnt lgkmcnt(0)" ::: "memory")
__device__ __forceinline__ unsigned pk2(float lo, float hi) { return pg8::cvt_pk_bf16(lo, hi); }
__device__ __forceinline__ float bflo(unsigned w) { return __uint_as_float(w << 16); }
__device__ __forceinline__ float bfhi(unsigned w) { return __uint_as_float(w & 0xffff0000u); }
__device__ __forceinline__ void unpack8(const u32x4 r, float (&x)[8]) { x[0] = bflo(r.x); x[1] = bfhi(r.x); x[2] = bflo(r.y); x[3] = bfhi(r.y); x[4] = bflo(r.z); x[5] = bfhi(r.z); x[6] = bflo(r.w); x[7] = bfhi(r.w); }
__device__ __forceinline__ u32x4 pack8(const float (&x)[8]) { u32x4 w; w.x = pk2(x[0], x[1]); w.y = pk2(x[2], x[3]); w.z = pk2(x[4], x[5]); w.w = pk2(x[6], x[7]); return w; }
template <int X> __device__ __forceinline__ float swz_xor(float v) { return __int_as_float(__builtin_amdgcn_ds_swizzle(__float_as_int(v), 0x1f | (X << 10))); }
__device__ __forceinline__ float wave_sum(float v) {
    v += swz_xor<1>(v); v += swz_xor<2>(v); v += swz_xor<4>(v); v += swz_xor<8>(v); v += swz_xor<16>(v);
    auto rr = __builtin_amdgcn_permlane32_swap(__float_as_uint(v), __float_as_uint(v), false, false);
    return __uint_as_float(rr[0]) + __uint_as_float(rr[1]);
}
__device__ __forceinline__ float sigm(float v) { return __builtin_amdgcn_rcpf(1.0f + __expf(-v)); }

struct Args { const float* in[20]; float* out; unsigned char* ws; int ph_lo, ph_hi; };
typedef const __attribute__((address_space(4))) Args* KA;
enum { I_X = 0, I_C, I_CTX, I_CCTX, I_WADA, I_BADA, I_GNORM, I_WFI, I_WFO, I_WIN, I_WOUT, I_WDW, I_BDW, I_CNG, I_CNB, I_WGG, I_BGG, I_GLAG, I_QNG, I_KNG };

__device__ __forceinline__ void transpose_item(const float* W, int K, int N, bf16_t* WT, int kb, int nsrc, int ndst, LDSP float* scr, int lane) {
    const int k0 = 64 * kb;
#pragma unroll 8
    for (int i = 0; i < 32; ++i) { const int kk = 2 * i + (lane >> 5); scr[kk * 33 + (lane & 31)] = W[(size_t)(k0 + kk) * N + nsrc + (lane & 31)]; }
    LDS_WAIT();
    const int c = lane & 7;
#pragma unroll
    for (int j = 0; j < 4; ++j) { const int n = (lane >> 3) + 8 * j; const LDSP float* s = scr + (8 * c) * 33 + n;
        u32x4 o; o.x = pk2(s[0 * 33], s[1 * 33]); o.y = pk2(s[2 * 33], s[3 * 33]); o.z = pk2(s[4 * 33], s[5 * 33]); o.w = pk2(s[6 * 33], s[7 * 33]);
        *(u32x4*)(WT + (size_t)(ndst + n) * K + k0 + 8 * c) = o; }
    LDS_WAIT();
}
__device__ __forceinline__ void phase0(KA a, LDSP unsigned char* lds, int tid, int lane, int wave, int bid, int G) {
    unsigned char* ws = a->ws;
    LDSP float* scr = (LDSP float*)(lds + wave * 8704);
    const int gw = bid * 8 + wave, NGW = G * 8;
    constexpr int I1 = 16 * 176, I2 = 44 * 32, I3 = 16 * 65, I4 = 16 * 32, LI = 2 * I1 + 2 * I2 + I3 + I4;
    for (int it = gw; it < DEPTH * LI; it += NGW) {
        const int l = it / LI; int r = it % LI;
        if (r < 2 * I1) { const int f = r / I1, rr = r % I1, kb = rr / 176, nb = rr % 176, nsrc = nb * 32; const bool isu = nsrc >= DFF; const int j = isu ? nsrc - DFF : nsrc;
            transpose_item(a->in[I_WFI] + (size_t)(l * 2 + f) * DM * 2 * DFF, DM, 2 * DFF, (bf16_t*)(ws + WS_W1T) + (size_t)(l * 2 + f) * W1T_SZ, kb, nsrc, 256 * (j >> 7) + (isu ? 128 : 0) + (j & 127), scr, lane); continue; }
        r -= 2 * I1;
        if (r < 2 * I2) { const int f = r / I2, rr = r % I2, kb = rr / 32, nb = rr % 32;
            transpose_item(a->in[I_WFO] + (size_t)(l * 2 + f) * DFF * DM, DFF, DM, (bf16_t*)(ws + WS_W2T) + (size_t)(l * 2 + f) * W2T_SZ, kb, nb * 32, nb * 32, scr, lane); continue; }
        r -= 2 * I2;
        if (r < I3) { const int kb = r / 65, nb = r % 65;
            transpose_item(a->in[I_WIN] + (size_t)l * DM * INW, DM, INW, (bf16_t*)(ws + WS_WINT) + (size_t)l * WINT_SZ, kb, nb * 32, nb * 32, scr, lane); continue; }
        r -= I3;
        { const int kb = r / 32, nb = r % 32;
            transpose_item(a->in[I_WOUT] + (size_t)l * DM * DM, DM, DM, (bf16_t*)(ws + WS_WOT) + (size_t)l * WOT_SZ, kb, nb * 32, nb * 32, scr, lane); }
    }
    { constexpr int PV = (INWP - INW) * DM * 2 / 16;
        for (int i = bid * 512 + tid; i < DEPTH * PV; i += G * 512) { const int l = i / PV, r = i % PV;
            ((u32x4*)((bf16_t*)(ws + WS_WINT) + (size_t)l * WINT_SZ + (size_t)INW * DM))[r] = (u32x4){0u, 0u, 0u, 0u}; } }
    { float* SSQ = (float*)(ws + WS_SSQ); for (int i = bid * 512 + tid; i < DEPTH * 3 * MALL; i += G * 512) SSQ[i] = 0.f; }
    __syncthreads();
    LDSP float* S = (LDSP float*)(lds + 69632);
    LDSP float* red = (LDSP float*)(lds + 106496);
    for (int i = tid; i < 9 * 1024; i += 512) { const int r = i >> 10, k = i & 1023; const float cv = r < 8 ? a->in[I_C][r * 1024 + k] : a->in[I_CCTX][k]; S[i] = cv * sigm(cv); }
    __syncthreads();
    float* MOD = (float*)(ws + WS_MOD);
    for (int it = bid; it < DEPTH * 144; it += G) {
        const int l = it / 144, n0 = (it % 144) * 64;
        const float* Wp = a->in[I_WADA] + (size_t)l * DM * 9216 + n0 + lane;
        float acc[9];
#pragma unroll
        for (int r = 0; r < 9; ++r) acc[r] = 0.f;
#pragma unroll 8
        for (int kk = 0; kk < 128; ++kk) { const int k = wave * 128 + kk; const float w = Wp[(size_t)k * 9216];
#pragma unroll
            for (int r = 0; r < 9; ++r) acc[r] += S[r * 1024 + k] * w; }
#pragma unroll
        for (int r = 0; r < 9; ++r) red[(wave * 9 + r) * 64 + lane] = acc[r];
        __syncthreads();
        for (int o = tid; o < 576; o += 512) { const int r = o >> 6, ln = o & 63; float s = 0.f;
#pragma unroll
            for (int w = 0; w < 8; ++w) s += red[(w * 9 + r) * 64 + ln];
            MOD[(size_t)(l * 9 + r) * 9216 + n0 + ln] = s + a->in[I_BADA][l * 9216 + n0 + ln]; }
        __syncthreads();
    }
}
__device__ __forceinline__ void phase1(KA a, LDSP unsigned char* lds, int tid, int lane, int wave, int bid, int G) {
    const float* MOD = (const float*)(a->ws + WS_MOD); bf16_t* XN = (bf16_t*)(a->ws + WS_XN); float* SSQ = (float*)(a->ws + WS_SSQ); float* SW = (float*)(a->ws + WS_SW);
    const float* g = a->in[I_GNORM];
    for (int m = bid * 8 + wave; m < MALL; m += G * 8) {
        const bool isc = m >= MX;
        const float* xr = isc ? a->in[I_CTX] + (size_t)(m - MX) * DM : a->in[I_X] + (size_t)m * DM;
        const float* md = MOD + (size_t)(isc ? 8 : (m >> 12)) * 9216;
        f32x4 v[4]; float ss = 0.f;
#pragma unroll
        for (int q = 0; q < 4; ++q) { v[q] = ((const f32x4*)xr)[lane + 64 * q]; ss += (v[q].x * v[q].x + v[q].y * v[q].y) + (v[q].z * v[q].z + v[q].w * v[q].w); }
        ss = wave_sum(ss);
        if (lane == 0) SSQ[m] = ss;
#pragma unroll
        for (int q = 0; q < 4; ++q) { const int col = 4 * lane + 256 * q;
            const f32x4 y = v[q] * *(const f32x4*)(g + col) * (*(const f32x4*)(md + 1024 + col) + 1.0f);
            u32x2 o; o.x = pk2(y.x, y.y); o.y = pk2(y.z, y.w);
            *(u32x2*)(XN + (size_t)m * DM + col) = o; }
    }
    LDSP float* SH = (LDSP float*)lds;
    constexpr int RPL = 2 * DFF + INWP + 2 * DFF;
#pragma unroll 1
    for (int l = 0; l < DEPTH; ++l) {
        __syncthreads();
        for (int i = tid; i < 27 * 256; i += 512) { const int v = i >> 8, j = v / 9, bi = v % 9, c4 = (i & 255) * 4; *(LDSP f32x4*)(SH + v * 1024 + c4) = *(const f32x4*)(MOD + (size_t)(l * 9 + bi) * 9216 + (3 * j) * 1024 + c4); }
        __syncthreads();
        const bf16_t* w0b = (const bf16_t*)(a->ws + WS_W1T) + (size_t)(l * 2) * W1T_SZ; const bf16_t* w1b = (const bf16_t*)(a->ws + WS_WINT) + (size_t)l * WINT_SZ; const bf16_t* w2b = (const bf16_t*)(a->ws + WS_W1T) + (size_t)(l * 2 + 1) * W1T_SZ;
#define SW_ROWPTR(rr) ((rr) < 2 * DFF ? w0b + (size_t)(rr) * DM : ((rr) < 2 * DFF + INWP ? w1b + (size_t)((rr) - 2 * DFF) * DM : w2b + (size_t)((rr) - 2 * DFF - INWP) * DM))
        u32x4 nx0 = {0u, 0u, 0u, 0u}, nx1 = {0u, 0u, 0u, 0u};
        { const int r0 = bid * 8 + wave; if (r0 < RPL) { const bf16_t* p = SW_ROWPTR(r0); nx0 = *(const u32x4*)(p + lane * 8); nx1 = *(const u32x4*)(p + 512 + lane * 8); } }
#pragma unroll 1
        for (int r = bid * 8 + wave; r < RPL; r += G * 8) {
            float w0[8], w1[8]; unpack8(nx0, w0); unpack8(nx1, w1);
            { const int rn = r + G * 8; if (rn < RPL) { const bf16_t* p = SW_ROWPTR(rn); nx0 = *(const u32x4*)(p + lane * 8); nx1 = *(const u32x4*)(p + 512 + lane * 8); } }
            const int j = r < 2 * DFF ? 0 : (r < 2 * DFF + INWP ? 1 : 2), rj = r - (j == 0 ? 0 : (j == 1 ? 2 * DFF : 2 * DFF + INWP));
#pragma unroll
            for (int bi = 0; bi < 9; ++bi) { LDSP const float* sh = SH + (j * 9 + bi) * 1024 + lane * 8;
                const f32x4 s0 = *(LDSP const f32x4*)(sh), s1 = *(LDSP const f32x4*)(sh + 4), s2 = *(LDSP const f32x4*)(sh + 512), s3 = *(LDSP const f32x4*)(sh + 516);
                float d = (w0[0] * s0.x + w0[1] * s0.y) + (w0[2] * s0.z + w0[3] * s0.w) + (w0[4] * s1.x + w0[5] * s1.y) + (w0[6] * s1.z + w0[7] * s1.w)
                        + (w1[0] * s2.x + w1[1] * s2.y) + (w1[2] * s2.z + w1[3] * s2.w) + (w1[4] * s3.x + w1[5] * s3.y) + (w1[6] * s3.z + w1[7] * s3.w);
                d = wave_sum(d);
                if (lane == 0) SW[((size_t)(l * 3 + j) * 9 + bi) * SWN + rj] = d; } }
#undef SW_ROWPTR
    }
    __syncthreads();
}
__device__ __forceinline__ void prep_phase(KA a, LDSP unsigned char* lds, int l, int tid, int lane, int wave, int bid, int G) {
    LDSP f32x2v* CS = (LDSP f32x2v*)(lds);
    for (int i = tid; i < 1024; i += 512) { const int pos = i >> 4, f = i & 15;
        const float freq = exp2f(-(float)f * (13.287712379549449f / 16.0f)); const float ang = (float)pos * freq;
        float rev = ang * 0.15915494309189535f; rev -= floorf(rev);
        CS[i] = (f32x2v){__builtin_amdgcn_cosf(rev), __builtin_amdgcn_sinf(rev)}; }
    __syncthreads();
    const bf16_t* P = (const bf16_t*)(a->ws + WS_HP); bf16_t* Q = (bf16_t*)(a->ws + WS_Q); bf16_t* Kb = (bf16_t*)(a->ws + WS_K); bf16_t* Vb = (bf16_t*)(a->ws + WS_V);
    const int sub = lane & 7, axis = sub >> 2, half = (sub >> 1) & 1, f0 = (sub & 1) * 8;
    float qg[8], kg[8];
#pragma unroll
    for (int e = 0; e < 8; ++e) { qg[e] = a->in[I_QNG][l * 64 + sub * 8 + e]; kg[e] = a->in[I_KNG][l * 64 + sub * 8 + e]; }
    u32x4 nq = {0u, 0u, 0u, 0u}, nk_ = {0u, 0u, 0u, 0u};
    { const int m0 = bid * 8 + wave; if (m0 < MALL) { nq = *(const u32x4*)(P + (size_t)m0 * INWP + PC_AQ + lane * 8); nk_ = *(const u32x4*)(P + (size_t)m0 * INWP + PC_AK + (lane & 31) * 8); } }
    for (int m = bid * 8 + wave; m < MALL; m += G * 8) {
        const u32x4 rawq = nq, rawk = nk_;
        { const int mn = m + G * 8; if (mn < MALL) { nq = *(const u32x4*)(P + (size_t)mn * INWP + PC_AQ + lane * 8); nk_ = *(const u32x4*)(P + (size_t)mn * INWP + PC_AK + (lane & 31) * 8); } }
        const bool lat = m < MX;
        const int b = lat ? (m >> 12) : ((m - MX) >> 8), t = lat ? (m & 4095) : 0, pos = lat ? (CTXL + t) : ((m - MX) & 255);
        const int p = axis ? (t & 63) : (t >> 6);
        const bf16_t* pr = P + (size_t)m * INWP;
        float x[8], y[8];
        { const u32x4 raw = rawq; unpack8(raw, x);
            float ss = 0.f;
#pragma unroll
            for (int e = 0; e < 8; ++e) ss += x[e] * x[e];
            ss += swz_xor<1>(ss); ss += swz_xor<2>(ss); ss += swz_xor<4>(ss);
            const float rstd = 1.0f / sqrtf(ss * (1.0f / 64.0f) + EPS);
#pragma unroll
            for (int e = 0; e < 8; ++e) y[e] = x[e] * rstd * qg[e];
            if (lat) {
#pragma unroll
                for (int e = 0; e < 8; ++e) { const float o = swz_xor<2>(y[e]); const f32x2v cs = CS[p * 16 + f0 + e]; x[e] = half ? (y[e] * cs.x + o * cs.y) : (y[e] * cs.x - o * cs.y); }
            } else {
#pragma unroll
                for (int e = 0; e < 8; ++e) x[e] = y[e];
            }
#pragma unroll
            for (int e = 0; e < 8; ++e) x[e] *= QSCALE;
            *(u32x4*)(Q + (size_t)m * 512 + lane * 8) = pack8(x); }
        { const u32x4 raw = rawk; unpack8(raw, x);
            float ss = 0.f;
#pragma unroll
            for (int e = 0; e < 8; ++e) ss += x[e] * x[e];
            ss += swz_xor<1>(ss); ss += swz_xor<2>(ss); ss += swz_xor<4>(ss);
            const float rstd = 1.0f / sqrtf(ss * (1.0f / 64.0f) + EPS);
#pragma unroll
            for (int e = 0; e < 8; ++e) y[e] = x[e] * rstd * kg[e];
            if (lat) {
#pragma unroll
                for (int e = 0; e < 8; ++e) { const float o = swz_xor<2>(y[e]); const f32x2v cs = CS[p * 16 + f0 + e]; x[e] = half ? (y[e] * cs.x + o * cs.y) : (y[e] * cs.x - o * cs.y); }
            } else {
#pragma unroll
                for (int e = 0; e < 8; ++e) x[e] = y[e];
            }
            const size_t kvrow = ((size_t)b * KVLEN + pos) * 128;
            if (lane < 16) *(u32x4*)(Kb + kvrow + lane * 8) = pack8(x);
            else if (lane < 32) *(u32x4*)(Vb + kvrow + (lane - 16) * 8) = raw; }
    }
    __syncthreads();
}
__device__ __forceinline__ void conv_phase(KA a, LDSP unsigned char* lds, int l, bool last, int tid, int lane, int bid, int G) {
    LDSP float* hs = (LDSP float*)lds;
    LDSP bf16_t* os = (LDSP bf16_t*)(lds + 94 * 256 * 4);
    const bf16_t* P = (const bf16_t*)(a->ws + WS_HP); bf16_t* CAT = (bf16_t*)a->out;
    const int c = tid & 255, hf = tid >> 8;
    float w[31];
#pragma unroll
    for (int k = 0; k < 31; ++k) w[k] = a->in[I_WDW][(size_t)(l * 31 + k) * 256 + c];
    const float bias = a->in[I_BDW][l * 256 + c], gg = a->in[I_CNG][l * 256 + c], bb = a->in[I_CNB][l * 256 + c];
    const int nitems = last ? 512 : 544;
    for (int it = bid; it < nitems; it += G) {
        int base, len, t0;
        if (it < 512) { base = (it >> 6) * SEQ; len = SEQ; t0 = (it & 63) * 64; } else { const int i2 = it - 512; base = MX + (i2 >> 2) * CTXL; len = CTXL; t0 = (i2 & 3) * 64; }
        for (int rr = tid >> 5; rr < 94; rr += 16) { const int t = t0 - 15 + rr, c8 = (tid & 31) * 8;
            float h[8];
            if (t >= 0 && t < len) { const bf16_t* pr = P + (size_t)(base + t) * INWP + c8; float av[8], gv[8];
                unpack8(*(const u32x4*)(pr + PC_CA), av); unpack8(*(const u32x4*)(pr + PC_CG), gv);
#pragma unroll
                for (int e = 0; e < 8; ++e) h[e] = av[e] * sigm(gv[e]);
            } else {
#pragma unroll
                for (int e = 0; e < 8; ++e) h[e] = 0.f;
            }
            *(LDSP f32x4*)(hs + rr * 256 + c8) = (f32x4){h[0], h[1], h[2], h[3]}; *(LDSP f32x4*)(hs + rr * 256 + c8 + 4) = (f32x4){h[4], h[5], h[6], h[7]}; }
        __syncthreads();
#pragma unroll 1
        for (int i0 = 0; i0 < 32; i0 += 4) { const int ib = hf * 32 + i0;
            float xw[34];
#pragma unroll
            for (int k = 0; k < 34; ++k) xw[k] = hs[(ib + k) * 256 + c];
            float acc[4], mean[4], var[4];
#pragma unroll
            for (int t = 0; t < 4; ++t) { float s_ = bias;
#pragma unroll
                for (int k = 0; k < 31; ++k) s_ += w[k] * xw[t + k];
                acc[t] = s_; mean[t] = s_; }
#pragma unroll
            for (int t = 0; t < 4; ++t) mean[t] += swz_xor<1>(mean[t]);
#pragma unroll
            for (int t = 0; t < 4; ++t) mean[t] += swz_xor<2>(mean[t]);
#pragma unroll
            for (int t = 0; t < 4; ++t) mean[t] += swz_xor<4>(mean[t]);
#pragma unroll
            for (int t = 0; t < 4; ++t) mean[t] += swz_xor<8>(mean[t]);
#pragma unroll
            for (int t = 0; t < 4; ++t) mean[t] += swz_xor<16>(mean[t]);
#pragma unroll
            for (int t = 0; t < 4; ++t) { auto rr = __builtin_amdgcn_permlane32_swap(__float_as_uint(mean[t]), __float_as_uint(mean[t]), false, false);
                mean[t] = (__uint_as_float(rr[0]) + __uint_as_float(rr[1])) * (1.0f / 64.0f); acc[t] -= mean[t]; var[t] = acc[t] * acc[t]; }
#pragma unroll
            for (int t = 0; t < 4; ++t) var[t] += swz_xor<1>(var[t]);
#pragma unroll
            for (int t = 0; t < 4; ++t) var[t] += swz_xor<2>(var[t]);
#pragma unroll
            for (int t = 0; t < 4; ++t) var[t] += swz_xor<4>(var[t]);
#pragma unroll
            for (int t = 0; t < 4; ++t) var[t] += swz_xor<8>(var[t]);
#pragma unroll
            for (int t = 0; t < 4; ++t) var[t] += swz_xor<16>(var[t]);
#pragma unroll
            for (int t = 0; t < 4; ++t) { auto rr = __builtin_amdgcn_permlane32_swap(__float_as_uint(var[t]), __float_as_uint(var[t]), false, false);
                const float vv = (__uint_as_float(rr[0]) + __uint_as_float(rr[1])) * (1.0f / 64.0f);
                const float y = acc[t] * __builtin_amdgcn_rsqf(vv + EPS) * gg + bb;
                const float o = y * sigm(y);
                os[(ib + t) * 256 + c] = (bf16_t)(pk2(o, 0.f) & 0xffffu); } }
        __syncthreads();
        for (int q = tid; q < 2048; q += 512) { const int row = q >> 5, c8 = (q & 31) * 8;
            *(u32x4*)(CAT + (size_t)(base + t0 + row) * DM + c8) = *(const LDSP u32x4*)(os + row * 256 + c8); }
        __syncthreads();
    }
}
typedef short gbf16x8 __attribute__((ext_vector_type(8)));
constexpr int GB_WG = 106496, GB_BG = 106496 + 16384;
constexpr int GB_Q = 0, GB_K = 8448, GB_GF = 16896, GB_GB = 20992, GB_VT = 25088, GB_S0T = 34304, GB_QE = 42496, GB_KE = 50688, GB_KENDT = 58880, GB_ATT = 68096, GB_TOT = 86528, GB_O = 88576, GB_END = 105984;
constexpr int VTP = 72, ATP = 72, KTP = 72, OP_ = 68;
static_assert(GB_END <= 131072 && GB_VT + 64 * VTP * 2 == GB_S0T && GB_ATT + 2 * 64 * ATP * 2 == GB_TOT && GB_O + 64 * OP_ * 4 == GB_END, "gla lds");
__device__ __forceinline__ int gla_row(int b, int c, int i) { return c < 4 ? MX + b * CTXL + c * 64 + i : b * SEQ + (c - 4) * 64 + i; }
__device__ __forceinline__ void st_bf16(LDSP unsigned char* base, int byteoff, float v) { *(LDSP bf16_t*)(base + byteoff) = (bf16_t)(pk2(v, 0.f) & 0xffffu); }
struct GlaRegs { u32x4 qk, gt, vv, rg; f32x4 s0[2], gg[2]; };
template <bool G3> __device__ __forceinline__ void gla_issue(KA a, GlaRegs& R, const float* ggb, int b, int c, int h, int tid) {
    const bf16_t* P = (const bf16_t*)(a->ws + WS_HP);
    { const int i = (tid & 255) >> 2, part = tid & 3; const bf16_t* pr = P + (size_t)gla_row(b, c, i) * INWP;
        R.qk = (u32x4){0u, 0u, 0u, 0u};
        if (G3 || tid >= 256) R.qk = *(const u32x4*)(pr + (tid < 256 ? PC_GQ : PC_GK) + h * 32 + part * 8);
        R.gt = *(const u32x4*)(pr + PC_GF + part * 8); }
    { const int j = tid >> 3, part = tid & 7; R.vv = *(const u32x4*)(P + (size_t)gla_row(b, c, j) * INWP + PC_GV + h * 64 + part * 8); }
    if (G3) { const float* DS = (const float*)(a->ws + WS_GDS);
#pragma unroll
        for (int dir = 0; dir < 2; ++dir) { const size_t ci = ((size_t)(b * 2 + dir) * NCH + c) * 4 + h; R.s0[dir] = *(const f32x4*)(DS + ci * 2048 + (tid >> 4) * 64 + (tid & 15) * 4); }
        R.rg = *(const u32x4*)(P + (size_t)gla_row(b, c, tid >> 3) * INWP + PC_GR + h * 64 + (tid & 7) * 8);
        R.gg[0] = *(const f32x4*)(ggb + h * 64 + (tid & 7) * 8); R.gg[1] = *(const f32x4*)(ggb + h * 64 + (tid & 7) * 8 + 4); }
}
template <bool G3> __device__ __forceinline__ void gla_stage(KA a, LDSP unsigned char* B, const GlaRegs& R, int l, int b, int c, int h, int tid) {
    LDSP float* Qf = (LDSP float*)(B + GB_Q); LDSP float* Kf = (LDSP float*)(B + GB_K); LDSP float* GF = (LDSP float*)(B + GB_GF); LDSP float* GBk = (LDSP float*)(B + GB_GB);
    { const int i = (tid & 255) >> 2, part = tid & 3;
        float x[8]; unpack8(R.qk, x);
        if (tid < 256) {
            if (G3) {
#pragma unroll
                for (int e = 0; e < 8; ++e) Qf[i * 33 + part * 8 + e] = x[e]; }
            unpack8(R.gt, x);
#pragma unroll
            for (int e = 0; e < 8; ++e) (part < 2 ? GF : GBk)[i * 16 + (part & 1) * 8 + e] = x[e];
        } else {
#pragma unroll
            for (int e = 0; e < 8; ++e) Kf[i * 33 + part * 8 + e] = x[e]; } }
    { const int j = tid >> 3, part = tid & 7; const u32x4 r = R.vv;
        const unsigned w[4] = {r.x, r.y, r.z, r.w};
#pragma unroll
        for (int e = 0; e < 8; ++e) *(LDSP bf16_t*)(B + GB_VT + ((part * 8 + e) * VTP + j) * 2) = (bf16_t)((e & 1) ? (w[e >> 1] >> 16) : (w[e >> 1] & 0xffffu)); }
    if (G3) {
#pragma unroll
        for (int dir = 0; dir < 2; ++dir) { const int d = tid >> 4, v4 = (tid & 15) * 4; const f32x4 sv = R.s0[dir];
            st_bf16(B, GB_S0T + dir * 4096 + ((v4 + 0) * 32 + d) * 2, sv.x); st_bf16(B, GB_S0T + dir * 4096 + ((v4 + 1) * 32 + d) * 2, sv.y);
            st_bf16(B, GB_S0T + dir * 4096 + ((v4 + 2) * 32 + d) * 2, sv.z); st_bf16(B, GB_S0T + dir * 4096 + ((v4 + 3) * 32 + d) * 2, sv.w); } }
    __syncthreads();
    const int dir = tid >> 8, seg = (tid >> 5) & 7, d = tid & 31;
    float p[8];
    { LDSP const float* Wg = (LDSP const float*)(B + GB_WG) + (dir * 16) * 128 + h * 32 + d; const float bg = ((LDSP const float*)(B + GB_BG))[dir * 128 + h * 32 + d];
        float wc[16];
#pragma unroll
        for (int r = 0; r < 16; ++r) wc[r] = Wg[r * 128];
        LDSP const float* gs = dir ? GBk : GF; float run = 0.f;
#pragma unroll
        for (int r = 0; r < 8; ++r) { const int i = dir ? 63 - (seg * 8 + r) : seg * 8 + r; float z = bg;
#pragma unroll
            for (int q = 0; q < 16; ++q) z += gs[i * 16 + q] * wc[q];
            const float ls = fminf(z, 0.f) - __logf(1.0f + __expf(-fabsf(z)));
            run += ls * (1.0f / 16.0f); p[r] = run; }
        ((LDSP float*)(B + GB_TOT))[(dir * 8 + seg) * 32 + d] = run; }
    __syncthreads();
    float off = 0.f, bl = 0.f;
#pragma unroll
    for (int sg = 0; sg < 8; ++sg) { const float t = ((LDSP const float*)(B + GB_TOT))[(dir * 8 + sg) * 32 + d]; bl += t; off += (sg < seg) ? t : 0.f; }
#pragma unroll
    for (int r = 0; r < 8; ++r) { const int i = dir ? 63 - (seg * 8 + r) : seg * 8 + r; const float bc = p[r] + off;
        if (G3) { st_bf16(B, GB_QE + dir * 4096 + (i * 32 + d) * 2, Qf[i * 33 + d] * 0.17677669529663687f * __expf(bc)); st_bf16(B, GB_KE + dir * 4096 + (i * 32 + d) * 2, Kf[i * 33 + d] * __expf(-bc)); }
        else st_bf16(B, GB_KENDT + dir * (32 * KTP * 2) + (d * KTP + i) * 2, Kf[i * 33 + d] * __expf(bl - bc)); }
    if (!G3 && seg == 0) ((float*)(a->ws + WS_GDEC))[(((size_t)(b * 2 + dir) * NCH + c) * 4 + h) * 32 + d] = __expf(bl);
    __syncthreads();
}
__device__ __forceinline__ void gla_g1_phase(KA a, LDSP unsigned char* lds, int l, int tid, int bid, int G) {
    float* DS = (float*)(a->ws + WS_GDS);
    const int lane = tid & 63, w = tid >> 6, fr = lane & 15, fq = lane >> 4;
    for (int i = tid; i < 2 * 16 * 128; i += 512) ((LDSP float*)(lds + GB_WG))[i] = a->in[I_WGG][(size_t)l * 2 * 16 * 128 + i];
    if (tid < 256) ((LDSP float*)(lds + GB_BG))[tid] = a->in[I_BGG][l * 256 + tid];
    __syncthreads();
    GlaRegs R, Rn;
    if (bid < BATCH * NCH * 4) gla_issue<false>(a, Rn, nullptr, (bid >> 2) / NCH, (bid >> 2) % NCH, bid & 3, tid);
    for (int it = bid; it < BATCH * NCH * 4; it += G) {
        const int h = it & 3, c = (it >> 2) % NCH, b = (it >> 2) / NCH;
        R = Rn;
        { const int itn = it + G; if (itn < BATCH * NCH * 4) gla_issue<false>(a, Rn, nullptr, (itn >> 2) / NCH, (itn >> 2) % NCH, itn & 3, tid); }
        gla_stage<false>(a, lds, R, l, b, c, h, tid);
        const int dir = w >> 2, dt = (w >> 1) & 1;
        const size_t ci = ((size_t)(b * 2 + dir) * NCH + c) * 4 + h;
        gbf16x8 af[2];
#pragma unroll
        for (int sx = 0; sx < 2; ++sx) af[sx] = *(LDSP const gbf16x8*)(lds + GB_KENDT + dir * (32 * KTP * 2) + ((dt * 16 + fr) * KTP + sx * 32 + fq * 8) * 2);
#pragma unroll
        for (int t = 0; t < 2; ++t) { const int vt = (w & 1) * 2 + t; f32x4 acc = {0.f, 0.f, 0.f, 0.f};
#pragma unroll
            for (int sx = 0; sx < 2; ++sx) { const gbf16x8 bf = *(LDSP const gbf16x8*)(lds + GB_VT + ((vt * 16 + fr) * VTP + sx * 32 + fq * 8) * 2);
                acc = __builtin_amdgcn_mfma_f32_16x16x32_bf16(af[sx], bf, acc, 0, 0, 0); }
#pragma unroll
            for (int r = 0; r < 4; ++r) DS[ci * 2048 + (size_t)(dt * 16 + fq * 4 + r) * 64 + vt * 16 + fr] = acc[r]; }
        __syncthreads();
    }
}
__device__ __forceinline__ void gla_g2_phase(KA a, int tid, int bid, int G) {
    float* DS = (float*)(a->ws + WS_GDS); const float* DEC = (const float*)(a->ws + WS_GDEC);
    for (int e = bid * 512 + tid; e < BATCH * 2 * 4 * 2048; e += G * 512) {
        const int dv = e & 2047, h = (e >> 11) & 3, dir = (e >> 13) & 1, b = e >> 14, d = dv >> 6;
        float S = 0.f;
#pragma unroll 4
        for (int st = 0; st < NCH; ++st) { const int c = dir ? (st < 4 ? 3 - st : 71 - st) : st;
            const size_t ci = ((size_t)(b * 2 + dir) * NCH + c) * 4 + h;
            const float dsv = DS[ci * 2048 + dv], dec = DEC[ci * 32 + d];
            DS[ci * 2048 + dv] = S; S = dec * S + dsv; }
    }
}
__device__ __forceinline__ void gla_g3_phase(KA a, LDSP unsigned char* lds, int l, bool last, int tid, int bid, int G) {
    const bf16_t* P = (const bf16_t*)(a->ws + WS_HP); bf16_t* CAT = (bf16_t*)a->out;
    const int lane = tid & 63, w = tid >> 6, fr = lane & 15, fq = lane >> 4, it_ = w >> 1;
    for (int i = tid; i < 2 * 16 * 128; i += 512) ((LDSP float*)(lds + GB_WG))[i] = a->in[I_WGG][(size_t)l * 2 * 16 * 128 + i];
    if (tid < 256) ((LDSP float*)(lds + GB_BG))[tid] = a->in[I_BGG][l * 256 + tid];
    __syncthreads();
    const int c_lo = last ? 4 : 0, ncs = NCH - c_lo, nit = BATCH * ncs * 4;
    GlaRegs R, Rn;
    if (bid < nit) gla_issue<true>(a, Rn, a->in[I_GLAG] + (size_t)l * 256, (bid >> 2) / ncs, c_lo + (bid >> 2) % ncs, bid & 3, tid);
    for (int it = bid; it < nit; it += G) {
        const int h = it & 3, c = c_lo + (it >> 2) % ncs, b = (it >> 2) / ncs;
        R = Rn;
        { const int itn = it + G; if (itn < nit) gla_issue<true>(a, Rn, a->in[I_GLAG] + (size_t)l * 256, (itn >> 2) / ncs, c_lo + (itn >> 2) % ncs, itn & 3, tid); }
        gla_stage<true>(a, lds, R, l, b, c, h, tid);
        gbf16x8 qf[2];
#pragma unroll
        for (int dir = 0; dir < 2; ++dir) { qf[dir] = *(LDSP const gbf16x8*)(lds + GB_QE + dir * 4096 + ((it_ * 16 + fr) * 32 + fq * 8) * 2);
#pragma unroll
            for (int t = 0; t < 2; ++t) { const int jt = (w & 1) * 2 + t;
                const gbf16x8 kf = *(LDSP const gbf16x8*)(lds + GB_KE + dir * 4096 + ((jt * 16 + fr) * 32 + fq * 8) * 2);
                const f32x4 z = {0.f, 0.f, 0.f, 0.f};
                const f32x4 s4 = __builtin_amdgcn_mfma_f32_16x16x32_bf16(qf[dir], kf, z, 0, 0, 0);
#pragma unroll
                for (int r = 0; r < 4; ++r) { const int i = it_ * 16 + fq * 4 + r, j = jt * 16 + fr; const bool keep = dir ? (j >= i) : (j <= i);
                    st_bf16(lds, GB_ATT + dir * (64 * ATP * 2) + (i * ATP + j) * 2, keep ? s4[r] : 0.f); } } }
        __syncthreads();
#pragma unroll
        for (int t = 0; t < 2; ++t) { const int vt = (w & 1) * 2 + t; f32x4 acc = {0.f, 0.f, 0.f, 0.f};
#pragma unroll
            for (int dir = 0; dir < 2; ++dir) {
#pragma unroll
                for (int sx = 0; sx < 2; ++sx) { const gbf16x8 af = *(LDSP const gbf16x8*)(lds + GB_ATT + dir * (64 * ATP * 2) + ((it_ * 16 + fr) * ATP + sx * 32 + fq * 8) * 2);
                    const gbf16x8 bf = *(LDSP const gbf16x8*)(lds + GB_VT + ((vt * 16 + fr) * VTP + sx * 32 + fq * 8) * 2);
                    acc = __builtin_amdgcn_mfma_f32_16x16x32_bf16(af, bf, acc, 0, 0, 0); }
                const gbf16x8 sf = *(LDSP const gbf16x8*)(lds + GB_S0T + dir * 4096 + ((vt * 16 + fr) * 32 + fq * 8) * 2);
                acc = __builtin_amdgcn_mfma_f32_16x16x32_bf16(qf[dir], sf, acc, 0, 0, 0); }
#pragma unroll
            for (int r = 0; r < 4; ++r) ((LDSP float*)(lds + GB_O))[(it_ * 16 + fq * 4 + r) * OP_ + vt * 16 + fr] = acc[r]; }
        __syncthreads();
        { const int i = tid >> 3, vg = tid & 7;
            const f32x4 o0 = *(LDSP const f32x4*)(lds + GB_O + (i * OP_ + vg * 8) * 4), o1 = *(LDSP const f32x4*)(lds + GB_O + (i * OP_ + vg * 8 + 4) * 4);
            float ss = (o0.x * o0.x + o0.y * o0.y) + (o0.z * o0.z + o0.w * o0.w) + (o1.x * o1.x + o1.y * o1.y) + (o1.z * o1.z + o1.w * o1.w);
            ss += swz_xor<1>(ss); ss += swz_xor<2>(ss); ss += swz_xor<4>(ss);
            const float rstd = 1.0f / sqrtf(ss * (1.0f / 64.0f) + EPS);
            const int row = gla_row(b, c, i);
            const float gg[8] = {R.gg[0].x, R.gg[0].y, R.gg[0].z, R.gg[0].w, R.gg[1].x, R.gg[1].y, R.gg[1].z, R.gg[1].w};
            float r[8]; unpack8(R.rg, r);
            float y[8] = {o0.x, o0.y, o0.z, o0.w, o1.x, o1.y, o1.z, o1.w};
#pragma unroll
            for (int e = 0; e < 8; ++e) y[e] = y[e] * rstd * gg[e] * (r[e] * sigm(r[e]));
            *(u32x4*)(CAT + (size_t)row * DM + 256 + h * 64 + vg * 8) = pack8(y); }
    }
}
__device__ __forceinline__ void ctx_gemm_res(KA a, LDSP unsigned char* lds, const bf16_t* A, const bf16_t* Bt, int K, bool srcf32, const float* gate, float coef,
                                             _Float16* XR, bf16_t* XS, float* ssq, const float* gn, const float* scn, int tid, int bid, int G) {
    const int lane = tid & 63, w = tid >> 6, wm = w >> 1, wn = w & 1, fr = lane & 15, fq = lane >> 4;
    LDSP unsigned char* As = lds; LDSP unsigned char* Bs = lds + 18432; LDSP float* Cs = (LDSP float*)(lds + 32768);
    const int nk = K / 64, lr = tid >> 3, lc = (tid & 7) * 8;
    for (int u = bid; u < 256; u += G) {
        int tm = u >> 4, tn = u & 15;
        if (G == 256) { const int x = u & 7, sl = u >> 3; tm = (x & 3) * 4 + (sl >> 3); tn = (x >> 2) * 8 + (sl & 7); }
        const size_t row0 = (size_t)MX + tm * 128; const int col0 = tn * 64;
        const bf16_t* ap0 = A + (row0 + lr) * K + lc; const bf16_t* ap1 = ap0 + (size_t)64 * K; const bf16_t* bp = Bt + (size_t)(col0 + lr) * K + lc;
        u32x4 ra0[4], ra1[4], rb[4];
#pragma unroll
        for (int q = 0; q < 4; ++q) { ra0[q] = *(const u32x4*)(ap0 + q * 64); ra1[q] = *(const u32x4*)(ap1 + q * 64); rb[q] = *(const u32x4*)(bp + q * 64); }
        f32x4 acc[2][2];
#pragma unroll
        for (int mt = 0; mt < 2; ++mt)
#pragma unroll
            for (int nt = 0; nt < 2; ++nt) acc[mt][nt] = (f32x4){0.f, 0.f, 0.f, 0.f};
#pragma unroll 1
        for (int kt = 0; kt < nk; kt += 4) {
#pragma unroll
            for (int q = 0; q < 4; ++q) {
                *(LDSP u32x4*)(As + (lr * 72 + lc) * 2) = ra0[q]; *(LDSP u32x4*)(As + ((64 + lr) * 72 + lc) * 2) = ra1[q]; *(LDSP u32x4*)(Bs + (lr * 72 + lc) * 2) = rb[q];
                __syncthreads();
                if (kt + q + 4 < nk) { ra0[q] = *(const u32x4*)(ap0 + (kt + q + 4) * 64); ra1[q] = *(const u32x4*)(ap1 + (kt + q + 4) * 64); rb[q] = *(const u32x4*)(bp + (kt + q + 4) * 64); }
#pragma unroll
                for (int ks = 0; ks < 2; ++ks) { gbf16x8 af[2], bf[2];
#pragma unroll
                    for (int mt = 0; mt < 2; ++mt) af[mt] = *(LDSP const gbf16x8*)(As + ((wm * 32 + mt * 16 + fr) * 72 + ks * 32 + fq * 8) * 2);
#pragma unroll
                    for (int nt = 0; nt < 2; ++nt) bf[nt] = *(LDSP const gbf16x8*)(Bs + ((wn * 32 + nt * 16 + fr) * 72 + ks * 32 + fq * 8) * 2);
#pragma unroll
                    for (int mt = 0; mt < 2; ++mt)
#pragma unroll
                        for (int nt = 0; nt < 2; ++nt) acc[mt][nt] = __builtin_amdgcn_mfma_f32_16x16x32_bf16(af[mt], bf[nt], acc[mt][nt], 0, 0, 0); }
                __syncthreads();
            }
        }
#pragma unroll
        for (int mt = 0; mt < 2; ++mt)
#pragma unroll
            for (int nt = 0; nt < 2; ++nt)
#pragma unroll
                for (int r = 0; r < 4; ++r) Cs[(wm * 32 + mt * 16 + fq * 4 + r) * 68 + wn * 32 + nt * 16 + fr] = acc[mt][nt][r];
        __syncthreads();
        { const int rl = tid >> 2, cs = (tid & 3) * 16; const size_t grow = row0 + rl; const int gc = col0 + cs;
            float x[16];
            if (srcf32) { const float* sp_ = a->in[I_CTX] + (grow - MX) * 1024 + gc;
#pragma unroll
                for (int q = 0; q < 4; ++q) { const f32x4 t = *(const f32x4*)(sp_ + 4 * q); x[4 * q] = t.x; x[4 * q + 1] = t.y; x[4 * q + 2] = t.z; x[4 * q + 3] = t.w; } }
            else {
#pragma unroll
                for (int q = 0; q < 2; ++q) { const pg8::f32x8 t = __builtin_convertvector(*(const pg8::h16x8*)(XR + grow * 1024 + gc + 8 * q), pg8::f32x8);
#pragma unroll
                    for (int e = 0; e < 8; ++e) x[8 * q + e] = t[e]; } }
            const float* g = gate + (size_t)8 * 9216 + gc; const float* gnp = gn + gc; const float* scp = scn + (size_t)8 * 9216 + gc;
            float ss = 0.f, y[16];
#pragma unroll
            for (int q = 0; q < 4; ++q) { const f32x4 gv = *(const f32x4*)(g + 4 * q), cv = *(LDSP const f32x4*)(Cs + rl * 68 + cs + 4 * q), gg = *(const f32x4*)(gnp + 4 * q), sc = *(const f32x4*)(scp + 4 * q);
#pragma unroll
                for (int e = 0; e < 4; ++e) { const float xv = x[4 * q + e] + coef * gv[e] * cv[e]; x[4 * q + e] = xv; ss += xv * xv; y[4 * q + e] = xv * gg[e] * (sc[e] + 1.0f); } }
#pragma unroll
            for (int q = 0; q < 2; ++q) { const pg8::f32x8 t = {x[8 * q], x[8 * q + 1], x[8 * q + 2], x[8 * q + 3], x[8 * q + 4], x[8 * q + 5], x[8 * q + 6], x[8 * q + 7]};
                *(pg8::h16x8*)(XR + grow * 1024 + gc + 8 * q) = __builtin_convertvector(t, pg8::h16x8);
                u32x4 wv; wv.x = pk2(y[8 * q], y[8 * q + 1]); wv.y = pk2(y[8 * q + 2], y[8 * q + 3]); wv.z = pk2(y[8 * q + 4], y[8 * q + 5]); wv.w = pk2(y[8 * q + 6], y[8 * q + 7]);
                *(u32x4*)(XS + grow * 1024 + gc + 8 * q) = wv; }
            ss += swz_xor<1>(ss); ss += swz_xor<2>(ss);
            if ((tid & 3) == 0) atomicAdd(ssq + grow, ss); }
        __syncthreads();
    }
}
__device__ __forceinline__ void attn_phase(KA a, unsigned char* lds, bool last, int bid, int G) {
    using abf = attn_body::bf16;
    const abf* Q = (const abf*)(a->ws + WS_Q); const abf* Kb = (const abf*)(a->ws + WS_K); const abf* Vb = (const abf*)(a->ws + WS_V); abf* CAT = (abf*)a->out;
    const int nunits = last ? 1024 : 1088;
    const int nlat = bid < 1024 ? (1024 - bid + G - 1) / G : 0, c0 = G - 1 - bid, nctx = (nunits > 1024 && c0 < 64) ? (64 - c0 + G - 1) / G : 0;
    for (int i = 0; i < nlat + nctx; ++i) {
        const int u = (i < nlat) ? bid + i * G : 1024 + c0 + (i - nlat) * G;
        int b, h, NT; size_t qrow;
        if (u < 1024) { b = u >> 7; h = (u >> 4) & 7; qrow = (size_t)b * SEQ + (size_t)(u & 15) * 256; NT = NCH; }
        else { const int uc = u - 1024; b = uc >> 3; h = uc & 7; qrow = (size_t)MX + (size_t)b * CTXL; NT = 4; }
        const size_t kvo = (size_t)b * KVLEN * 128 + (h >> 2) * 64;
        attn_body::attn_unit<8>(Q + qrow * 512 + h * 64, Kb + kvo, Vb + kvo, CAT + qrow * DM + 512 + h * 64, NT, (char*)lds);
    }
}
#define XB_TMO      128
#define XB_XCNT(j)  (256  + 64 * (j))
#define XB_XSUB(j)  (1280 + 64 * (j))
#define XB_XGEN(j)  (2304 + 64 * (j))
#define XB_TOP      3328
#define XB_TOPGEN   3392
#define XCD_BAR_WORDS 3456
#define XB_SPIN_CAP (1u << 18)

__device__ __forceinline__ unsigned xb_ld(unsigned* p)              { return __hip_atomic_load(p, __ATOMIC_RELAXED, __HIP_MEMORY_SCOPE_AGENT); }
__device__ __forceinline__ unsigned xb_add(unsigned* p, unsigned v) { return __hip_atomic_fetch_add(p, v, __ATOMIC_RELAXED, __HIP_MEMORY_SCOPE_AGENT); }
__device__ __forceinline__ unsigned xb_xcc_id() { return (unsigned)__builtin_amdgcn_s_getreg((3 << 11) | 20) & 0xFu; }
#define XB_SPIN(cond, bar) do { unsigned _sp = 0; while (cond) { __builtin_amdgcn_s_sleep(1); \
    if ((++_sp & 255u) == 0u) { if (xb_ld(&(bar)[XB_TMO])) break; if (_sp > XB_SPIN_CAP) { atomicAdd(&(bar)[XB_TMO], 1u); break; } } } } while (0)

struct XcdBarrier {
    unsigned* bar; unsigned x;
    volatile LDSP unsigned* st;
};

__device__ __forceinline__ XcdBarrier xcd_barrier_post(unsigned* bar, volatile LDSP unsigned* st) {
    XcdBarrier b; b.bar = bar; b.x = xb_xcc_id(); b.st = st;
    if (threadIdx.x == 0) (void)xb_add(&bar[XB_XCNT(b.x)], 1u);
    return b;
}
__device__ __forceinline__ void xcd_barrier_complete(unsigned* bar, unsigned x, unsigned& nloc, unsigned& nx) {
    const unsigned G = gridDim.x * gridDim.y * gridDim.z;
    unsigned sum, cnt, mine, sp = 0u;
    for (;;) {
        sum = 0u; cnt = 0u; mine = 0u;
#pragma unroll
        for (unsigned j = 0; j < 16; ++j) { const unsigned c = xb_ld(&bar[XB_XCNT(j)]); sum += c; cnt += (c > 0u) ? 1u : 0u; mine = (j == x) ? c : mine; }
        if (sum == G) break;
        __builtin_amdgcn_s_sleep(1);
        if ((++sp & 255u) == 0u) { if (xb_ld(&bar[XB_TMO])) break; if (sp > XB_SPIN_CAP) { atomicAdd(&bar[XB_TMO], 1u); break; } }
    }
    nloc = mine > 0u ? mine : 1u; nx = cnt > 0u ? cnt : 1u;
}

__device__ __forceinline__ void xcd_barrier(const XcdBarrier& b) {
    asm volatile("s_waitcnt vmcnt(0)" ::: "memory");
    __syncthreads();
    if (threadIdx.x == 0) {
        unsigned* bar = b.bar;
        __builtin_amdgcn_s_waitcnt(0);
        unsigned nloc = b.st[0], nx = b.st[1];
        if (nloc == 0u) { xcd_barrier_complete(bar, b.x, nloc, nx); b.st[0] = nloc; b.st[1] = nx; }
        const unsigned old = xb_add(&bar[XB_XSUB(b.x)], 1u);
        const unsigned gen = old / nloc;
        if (old + 1u == (gen + 1u) * nloc) {
            __builtin_amdgcn_fence(__ATOMIC_RELEASE, "agent");
            asm volatile("s_waitcnt vmcnt(0)" ::: "memory");
            const unsigned og = xb_add(&bar[XB_TOP], 1u);
            const unsigned tg = og / nx;
            if (og + 1u == (tg + 1u) * nx) xb_add(&bar[XB_TOPGEN], 1u);
            else XB_SPIN(xb_ld(&bar[XB_TOPGEN]) == tg, bar);
            __builtin_amdgcn_fence(__ATOMIC_ACQUIRE, "agent");
            xb_add(&bar[XB_XGEN(b.x)], 1u);
            asm volatile("s_waitcnt vmcnt(0)" ::: "memory");
        } else {
            XB_SPIN(xb_ld(&bar[XB_XGEN(b.x)]) == gen, bar);
            __builtin_amdgcn_fence(__ATOMIC_ACQUIRE, "agent");
            asm volatile("s_waitcnt vmcnt(0)" ::: "memory");
        }
    }
    __syncthreads();
}
__global__ void __launch_bounds__(512, 2) mega_fwd(Args a_unused) {
    KA a = (KA)__builtin_amdgcn_kernarg_segment_ptr();
    const int ph_lo = a->ph_lo, ph_hi = a->ph_hi;
    extern __shared__ __attribute__((aligned(16))) unsigned char lds_raw[];
    LDSP unsigned char* lds0 = (LDSP unsigned char*)lds_raw;
    { LDSP unsigned char* lds = lds0;
    volatile LDSP unsigned* xst = (volatile LDSP unsigned*)(lds + 131072 + 64);
    if (threadIdx.x == 0) { xst[0] = 0u; xst[1] = 0u; }
    __syncthreads(); }
#pragma unroll 1
    for (int ph = ph_lo; ph < ph_hi; ++ph) {
        asm volatile("" : "+s"(a));
        LDSP unsigned char* lds = lds0; asm volatile("" : "+s"(lds));
        volatile LDSP unsigned* xst = (volatile LDSP unsigned*)(lds + 131072 + 64);
        unsigned char* ws = a->ws;
        float* CTXR = (float*)(ws + WS_CTXR);
        const float* MOD = (const float*)(ws + WS_MOD);
        bf16_t* XN = (bf16_t*)(ws + WS_XN); bf16_t* CAT = (bf16_t*)a->out; bf16_t* HP = (bf16_t*)(ws + WS_HP); _Float16* XR = (_Float16*)(ws + WS_CAT);
        const int tid = opaque_tid(), lane = tid & 63, wave = __builtin_amdgcn_readfirstlane(tid >> 6);
        int G = gridDim.x, bid = blockIdx.x; asm volatile("" : "+s"(G), "+s"(bid));
        if (ph == 0) { phase0(a, lds, tid, lane, wave, bid, G); }
        else if (ph == 1) { phase1(a, lds, tid, lane, wave, bid, G); }
        else {
            const int l = (ph - 2) / NPH_LAYER, sp = (ph - 2) % NPH_LAYER; const bool last = (l == DEPTH - 1);
            const bool first = (l == 0 && sp <= 1);
            const float* srcX = first ? a->in[I_X] : a->out; const float* srcC = first ? a->in[I_CTX] : CTXR;
            const int Mtail = last ? MX : MALL;
            const float* SSQ = (const float*)(ws + WS_SSQ); const float* SW = (const float*)(ws + WS_SW);
            switch (sp) {
            case 0: case 7: { const int f = (sp == 0) ? 0 : 1, j = (sp == 0) ? 0 : 2; const int M = (sp == 0) ? MALL : Mtail;
                pg8::Gemm g{XN, (const bf16_t*)(ws + WS_W1T) + (size_t)(l * 2 + f) * W1T_SZ, M, 2 * DFF, DM}; pg8::PrefOrder S; S.init(M, 2 * DFF, G, bid);
                S.pf = lds + pg8::PF_OFF; S.ssq = SSQ + (size_t)(l * 3 + j) * MALL; S.sw = SW + (size_t)(l * 3 + j) * 9 * SWN; S.MXr = MX; S.cnt = 0;
                pg8::EpiSwiGLU E{HP, DFF, lds + pg8::PF_OFF, 0};
                pg8::gemm_phase<pg8::EpiSwiGLU, pg8::PrefOrder, true, true>(lds, g, S, E); } break;
            case 1: case 6: case 8: {
                const bf16_t* A; const bf16_t* Bt; int K, M, j; float coef;
                if (sp == 1) { A = HP; Bt = (const bf16_t*)(ws + WS_W2T) + (size_t)(l * 2 + 0) * W2T_SZ; K = DFF; M = MALL; j = 0; coef = 0.5f; }
                else if (sp == 6) { A = CAT; Bt = (const bf16_t*)(ws + WS_WOT) + (size_t)l * WOT_SZ; K = DM; M = Mtail; j = 1; coef = 1.0f; }
                else { A = HP; Bt = (const bf16_t*)(ws + WS_W2T) + (size_t)(l * 2 + 1) * W2T_SZ; K = DFF; M = Mtail; j = 2; coef = 0.5f; }
                const int ln = (j == 2) ? l + 1 : l, jn = (j == 2) ? 0 : j + 1;
                const bool has_next = ln < DEPTH; const int nidx = has_next ? (ln * 3 + jn) : 0;
                pg8::Gemm g{A, Bt, MX, DM, K}; pg8::StaticOrder S; S.init(MX, DM, G, bid);
                pg8::EpiRes E{a->in[I_X], a->in[I_CTX], a->out, XR, first ? 1 : 0, (last && sp == 8) ? 1 : 0, MOD + (size_t)l * 9 * 9216 + (3 * j + 2) * 1024, coef, MX,
                              XN, (float*)(ws + WS_SSQ) + (size_t)nidx * MALL, a->in[I_GNORM] + (size_t)nidx * DM, MOD + (size_t)(nidx / 3) * 9 * 9216 + (3 * jn + 1) * 1024, has_next ? 1 : 0};
                pg8::gemm_phase<pg8::EpiRes, pg8::StaticOrder, true, true>(lds, g, S, E);
                if (M == MALL) ctx_gemm_res(a, lds, A, Bt, K, first, MOD + (size_t)l * 9 * 9216 + (3 * j + 2) * 1024, coef, XR, XN, (float*)(ws + WS_SSQ) + (size_t)nidx * MALL,
                                            a->in[I_GNORM] + (size_t)nidx * DM, MOD + (size_t)(nidx / 3) * 9 * 9216 + (3 * jn + 1) * 1024, tid, bid, G); } break;
            case 2: { pg8::Gemm g{XN, (const bf16_t*)(ws + WS_WINT) + (size_t)l * WINT_SZ, MALL, INWP, DM}; pg8::PrefOrder S; S.init(MALL, INWP, G, bid);
                S.pf = lds + pg8::PF_OFF; S.ssq = SSQ + (size_t)(l * 3 + 1) * MALL; S.sw = SW + (size_t)(l * 3 + 1) * 9 * SWN; S.MXr = MX; S.cnt = 0;
                pg8::EpiStore E{HP, INWP, lds + pg8::PF_OFF, 0};
                pg8::gemm_phase<pg8::EpiStore, pg8::PrefOrder, true, true>(lds, g, S, E); } break;
            case 3: prep_phase(a, lds, l, tid, lane, wave, bid, G); gla_g1_phase(a, lds, l, tid, bid, G); break;
            case 4: gla_g2_phase(a, tid, bid, G); conv_phase(a, lds, l, last, tid, lane, bid, G); break;
            case 5: attn_phase(a, (unsigned char*)lds, last, bid, G); gla_g3_phase(a, lds, l, last, tid, bid, G); break;
            default: break;
            }
        }
        if (ph + 1 < ph_hi) {
            unsigned* barw = (unsigned*)(ws + WS_CTL);
            if (ph == ph_lo) {
                if (bid == 0) for (int i = tid; i < XCD_BAR_WORDS; i += 512) __hip_atomic_store(barw + i, 0u, __ATOMIC_RELAXED, __HIP_MEMORY_SCOPE_AGENT);
                cg::this_grid().sync();
                (void)xcd_barrier_post(barw, xst);
            } else { XcdBarrier xb; xb.bar = barw; xb.x = xb_xcc_id(); xb.st = xst; xcd_barrier(xb); }
        }
    }
}

#ifndef MK_MULTI
#define MK_MULTI 0
#endif
extern "C" void kernel_launch(void* const* d_in, const int* in_sizes, int n_in, void* d_out, int out_size, void* d_ws, size_t ws_size, hipStream_t stream) {
    static int grid = 0;
    if (grid == 0) {
        if (n_in != 20 || out_size != MX * DM || ws_size < WS_END) { fprintf(stderr, "kernel_launch: unexpected shapes (n_in %d, out %d, ws %zu); nothing launched\n", n_in, out_size, ws_size); grid = -1; return; }
        int dev = 0, cus = 0, per_cu = 0;
        if (hipGetDevice(&dev) != hipSuccess || hipDeviceGetAttribute(&cus, hipDeviceAttributeMultiprocessorCount, dev) != hipSuccess) { grid = -1; return; }
        if (hipFuncSetAttribute((const void*)mega_fwd, hipFuncAttributeMaxDynamicSharedMemorySize, LDS_BYTES) != hipSuccess) { fprintf(stderr, "kernel_launch: hipFuncSetAttribute failed\n"); grid = -1; return; }
        if (hipOccupancyMaxActiveBlocksPerMultiprocessor(&per_cu, (const void*)mega_fwd, 512, LDS_BYTES) != hipSuccess || per_cu < 1) { fprintf(stderr, "kernel_launch: occupancy query gave %d\n", per_cu); per_cu = 1; }
        (void)hipGetLastError();
        grid = cus * per_cu;
    }
    if (grid < 0) return;
    Args a{};
    for (int i = 0; i < 20; ++i) a.in[i] = (const float*)d_in[i];
    a.out = (float*)d_out; a.ws = (unsigned char*)d_ws;
#if MK_MULTI
    for (int ph = 0; ph < NPHASES; ++ph) { a.ph_lo = ph; a.ph_hi = ph + 1; hipLaunchKernelGGL(mega_fwd, dim3(grid), dim3(512), LDS_BYTES, stream, a); }
#else
    a.ph_lo = 0; a.ph_hi = NPHASES;
    void* args[] = {&a};
    hipError_t e = hipLaunchCooperativeKernel((const void*)mega_fwd, dim3(grid), dim3(512), args, LDS_BYTES, stream);
    if (e != hipSuccess) fprintf(stderr, "kernel_launch: cooperative launch failed: %s (grid %d)\n", hipGetErrorString(e), grid);
#endif
}
```

```cpp
#include <hip/hip_runtime.h>
#include <hip/hip_cooperative_groups.h>
#include <cstdio>
#include <cstdint>
namespace cg = cooperative_groups;
__device__ __forceinline__ int opaque_tid() { int t = threadIdx.x; asm volatile("" : "+v"(t)); return t; }
namespace pg8 {
#define PG8_LAS __attribute__((address_space(3)))
typedef unsigned short bf16_t;
typedef short bf16x8 __attribute__((ext_vector_type(8)));
typedef float f32x4 __attribute__((ext_vector_type(4)));
typedef unsigned u32x4 __attribute__((ext_vector_type(4)));
constexpr int BM = 256, BK = 64, HALF = 128, HTB = HALF * BK * 2  , STAGE_BYTES = 8 * HTB, NXCD = 8, WGM = 8;

__host__ __device__ __forceinline__ int lds_byte(int r, int c) { const int st = (r >> 4) * 2 + (c >> 5), rr = r & 15, cc = c & 31, ob = rr * 64 + cc * 2; return st * 1024 + (ob ^ (((ob >> 9) & 1) << 5)); }
__host__ __device__ __forceinline__ void stage_rc(int b, int& R, int& C) { const int st = b / 1024, sb = b % 1024, swz = sb ^ (((sb >> 9) & 1) << 5); R = (st >> 1) * 16 + swz / 64; C = (st & 1) * 32 + (swz % 64) / 2; }
__host__ __device__ __forceinline__ int perm32(int rho) { const int n = rho >> 4, i = rho & 15; return 8 * (i >> 2) + 4 * n + (i & 3); }

struct Unit { int pm, pn; };
struct Gemm { const bf16_t* A; const bf16_t* Bt; int M, N, K; };

struct StaticOrder {
    int nM, nN, nwg, G, c;
    __host__ __device__ void init(int M, int N, int G_, int c_) { nM = M / BM; nN = N / BM; nwg = nM * nN; G = G_; c = c_; }
    __host__ __device__ bool next(int i, Unit& u) const {
        const long L = (long)i * G + c; if (L >= nwg) return false;
        int wgid = (int)L; { const int q = nwg / NXCD, r = nwg % NXCD, xcd = wgid % NXCD, off = wgid / NXCD; wgid = (xcd < r ? xcd * (q + 1) : r * (q + 1) + (xcd - r) * q) + off; }
        const int nig = WGM * nN, gid = wgid / nig, fm = gid * WGM, gsz = (nM - fm) < WGM ? (nM - fm) : WGM;
        u.pm = fm + ((wgid % nig) % gsz); u.pn = (wgid % nig) / gsz; return true;
    }
    __device__ __forceinline__ void a_ready(const Unit&) const {}
    __device__ __forceinline__ void done(const Unit&) const {}
};

constexpr int PF_OFF = 132096, PF_SLOT = 2048;
struct PrefOrder : StaticOrder {
    PG8_LAS unsigned char* pf; const float* ssq; const float* sw; int MXr; mutable int cnt;
    __device__ __forceinline__ void a_ready(const Unit& u) const {
        const int t = threadIdx.x, w = __builtin_amdgcn_readfirstlane(t >> 6), lane = t & 63; const int slot = cnt & 1; ++cnt;
        const int rowt = u.pm * BM, bidx = rowt >= MXr ? 8 : (rowt >> 12);
        const float* src = (w < 4) ? ssq + rowt + w * 64 + lane : sw + (size_t)bidx * 5632 + u.pn * BM + (w - 4) * 64 + lane;
        __builtin_amdgcn_global_load_lds((const unsigned*)src, (PG8_LAS unsigned*)(pf + slot * PF_SLOT + w * 256), 4, 0, 0);
    }
};
typedef float cvt_f32x2_t __attribute__((ext_vector_type(2))); typedef __bf16 cvt_bf16x2_t __attribute__((ext_vector_type(2)));
__device__ __forceinline__ unsigned cvt_pk_bf16(float lo, float hi) { const cvt_f32x2_t v = {lo, hi}; const cvt_bf16x2_t b = __builtin_convertvector(v, cvt_bf16x2_t); return __builtin_bit_cast(unsigned, b); }
typedef float f32x2 __attribute__((ext_vector_type(2)));
__device__ __forceinline__ float silu_f(float v) { return v * __builtin_amdgcn_rcpf(1.0f + __expf(-v)); }
struct EpiStore {
    static constexpr bool PERM = true, AFTER_DRAIN = false;
    bf16_t* O; int ldc; PG8_LAS unsigned char* pf; mutable int cnt;
    __device__ __forceinline__ void operator()(const f32x4 (&acc)[2][2][4][2], const Unit& u, int wr, int wc, int fr, int fq) const {
        const int rowt = u.pm * BM; PG8_LAS const float* sl = (PG8_LAS const float*)(pf + (cnt & 1) * PF_SLOT); ++cnt;
        const int row0 = rowt + wr * 64 + fr, col0 = u.pn * BM + wc * 32 + 8 * fq;
        f32x4 sv[2][2];
#pragma unroll
        for (int bj = 0; bj < 2; ++bj)
#pragma unroll
            for (int n = 0; n < 2; ++n) sv[bj][n] = *(PG8_LAS const f32x4*)(sl + 256 + wc * 32 + 8 * fq + bj * HALF + 4 * n);
#pragma unroll
        for (int ai = 0; ai < 2; ++ai)
#pragma unroll
            for (int m = 0; m < 4; ++m) { const int row = row0 + ai * HALF + m * 16; bf16_t* rowp = O + (size_t)row * ldc + col0;
                const float rs = __builtin_amdgcn_rsqf(sl[row - rowt] * (1.0f / 1024.0f) + 1e-6f);
#pragma unroll
                for (int bj = 0; bj < 2; ++bj) { const f32x4 v0 = acc[ai][bj][m][0] * rs + sv[bj][0], v1 = acc[ai][bj][m][1] * rs + sv[bj][1];
                    u32x4 w; w.x = cvt_pk_bf16(v0[0], v0[1]); w.y = cvt_pk_bf16(v0[2], v0[3]); w.z = cvt_pk_bf16(v1[0], v1[1]); w.w = cvt_pk_bf16(v1[2], v1[3]);
                    *(u32x4*)(rowp + bj * HALF) = w; } }
    }
};
struct EpiSwiGLU {
    static constexpr bool PERM = true, AFTER_DRAIN = false;
    bf16_t* O; int ldc; PG8_LAS unsigned char* pf; mutable int cnt;
    __device__ __forceinline__ void operator()(const f32x4 (&acc)[2][2][4][2], const Unit& u, int wr, int wc, int fr, int fq) const {
        const int rowt = u.pm * BM; PG8_LAS const float* sl = (PG8_LAS const float*)(pf + (cnt & 1) * PF_SLOT); ++cnt;
        const int row0 = rowt + wr * 64 + fr, col0 = u.pn * HALF + wc * 32 + 8 * fq;
        f32x4 sv[2][2];
#pragma unroll
        for (int bj = 0; bj < 2; ++bj)
#pragma unroll
            for (int n = 0; n < 2; ++n) sv[bj][n] = *(PG8_LAS const f32x4*)(sl + 256 + wc * 32 + 8 * fq + bj * HALF + 4 * n);
#pragma unroll
        for (int ai = 0; ai < 2; ++ai)
#pragma unroll
            for (int m = 0; m < 4; ++m) { const int row = row0 + ai * HALF + m * 16; bf16_t* rowp = O + (size_t)row * ldc + col0;
                const float rs = __builtin_amdgcn_rsqf(sl[row - rowt] * (1.0f / 1024.0f) + 1e-6f);
                const f32x4 a0 = acc[ai][0][m][0] * rs + sv[0][0], a1 = acc[ai][0][m][1] * rs + sv[0][1], u0 = acc[ai][1][m][0] * rs + sv[1][0], u1 = acc[ai][1][m][1] * rs + sv[1][1];
                u32x4 w; w.x = cvt_pk_bf16(silu_f(a0[0]) * u0[0], silu_f(a0[1]) * u0[1]); w.y = cvt_pk_bf16(silu_f(a0[2]) * u0[2], silu_f(a0[3]) * u0[3]);
                w.z = cvt_pk_bf16(silu_f(a1[0]) * u1[0], silu_f(a1[1]) * u1[1]); w.w = cvt_pk_bf16(silu_f(a1[2]) * u1[2], silu_f(a1[3]) * u1[3]);
                *(u32x4*)rowp = w; }
    }
};
typedef _Float16 h16x8 __attribute__((ext_vector_type(8)));
typedef float f32x8 __attribute__((ext_vector_type(8)));
struct EpiRes {
    static constexpr bool PERM = true, AFTER_DRAIN = false;
    float* outF; _Float16* XR; int dstf32; const float* gate; float coef; int MXr;
    bf16_t* XSp; float* ssq; const float* gn; const float* scn; int doxs;
    __device__ __forceinline__ void operator()(const f32x4 (&acc)[2][2][4][2], const Unit& u, int wr, int wc, int fr, int fq) const {
        const int rowt = u.pm * BM; const bool isc = rowt >= MXr; const bool XS = doxs != 0;
        const int bidx = isc ? 8 : (rowt >> 12);
        char* outb = (char*)(outF + (size_t)rowt * 1024);
        char* xrb = (char*)(XR + (size_t)rowt * 1024);
        char* xsb = (char*)(XSp + (size_t)rowt * 1024); float* sqb = ssq + rowt;
        const int col0 = u.pn * BM + wc * 32 + 8 * fq;
        const float* g = gate + (size_t)bidx * 9216 + col0;
        const unsigned lo = (unsigned)((wr * 64 + fr) * 1024 + col0);
        float ss[2][4];
#pragma unroll
        for (int ai = 0; ai < 2; ++ai)
#pragma unroll
            for (int m = 0; m < 4; ++m) ss[ai][m] = 0.f;
#pragma unroll
        for (int bj = 0; bj < 2; ++bj) {
            u32x4 xin[2][4];
#pragma unroll
            for (int ai = 0; ai < 2; ++ai)
#pragma unroll
                for (int m = 0; m < 4; ++m) xin[ai][m] = *(const u32x4*)(xrb + (lo + (unsigned)((ai * HALF + m * 16) * 1024 + bj * HALF)) * 2u);
            f32x4 gv[2], gs[2];
#pragma unroll
            for (int n = 0; n < 2; ++n) { gv[n] = *(const f32x4*)(g + bj * HALF + 4 * n) * coef;
                if (XS) gs[n] = *(const f32x4*)(gn + col0 + bj * HALF + 4 * n) * (*(const f32x4*)(scn + (size_t)bidx * 9216 + col0 + bj * HALF + 4 * n) + 1.0f); }
#pragma unroll
            for (int ai = 0; ai < 2; ++ai)
#pragma unroll
                for (int m = 0; m < 4; ++m) { const unsigned eo = lo + (unsigned)((ai * HALF + m * 16) * 1024 + bj * HALF); f32x4 xv[2];
                    { const f32x8 t = __builtin_convertvector(__builtin_bit_cast(h16x8, xin[ai][m]), f32x8); xv[0] = (f32x4){t[0], t[1], t[2], t[3]}; xv[1] = (f32x4){t[4], t[5], t[6], t[7]}; }
                    xv[0] += gv[0] * acc[ai][bj][m][0]; xv[1] += gv[1] * acc[ai][bj][m][1];
                    if (dstf32) { *(f32x4*)(outb + eo * 4u) = xv[0]; *(f32x4*)(outb + eo * 4u + 16u) = xv[1]; }
                    else { const f32x8 t = {xv[0][0], xv[0][1], xv[0][2], xv[0][3], xv[1][0], xv[1][1], xv[1][2], xv[1][3]}; *(h16x8*)(xrb + eo * 2u) = __builtin_convertvector(t, h16x8); }
                    if (XS) { ss[ai][m] += (xv[0][0] * xv[0][0] + xv[0][1] * xv[0][1]) + (xv[0][2] * xv[0][2] + xv[0][3] * xv[0][3]) + (xv[1][0] * xv[1][0] + xv[1][1] * xv[1][1]) + (xv[1][2] * xv[1][2] + xv[1][3] * xv[1][3]);
                        const f32x4 y0 = xv[0] * gs[0], y1 = xv[1] * gs[1];
                        u32x4 w; w.x = cvt_pk_bf16(y0[0], y0[1]); w.y = cvt_pk_bf16(y0[2], y0[3]); w.z = cvt_pk_bf16(y1[0], y1[1]); w.w = cvt_pk_bf16(y1[2], y1[3]);
                        *(u32x4*)(xsb + eo * 2u) = w; } }
        }
        if (XS) {
#pragma unroll
            for (int ai = 0; ai < 2; ++ai)
#pragma unroll
                for (int m = 0; m < 4; ++m) { float t = ss[ai][m];
                    t += __int_as_float(__builtin_amdgcn_ds_swizzle(__float_as_int(t), 0x1f | (16 << 10)));
                    auto rr = __builtin_amdgcn_permlane32_swap(__float_as_uint(t), __float_as_uint(t), false, false);
                    t = __uint_as_float(rr[0]) + __uint_as_float(rr[1]);
                    if (fq == 0) atomicAdd(sqb + (unsigned)(wr * 64 + fr + ai * HALF + m * 16), t); } }
    }
};
template <class Epi, class Sched, bool ALIGN_EPI = false, bool SP2 = false>
__device__ __forceinline__ void gemm_phase(PG8_LAS unsigned char* lds, const Gemm g, const Sched& S, const Epi& E) {
    const int tid = opaque_tid(), wid = __builtin_amdgcn_readfirstlane(tid >> 6), lane = tid & 63, wr = wid >> 2, wc = wid & 3, fr = lane & 15, fq = lane >> 4;
    const int K = g.K, nt = K / BK;
    unsigned voffA[2], voffB[2];
#pragma unroll
    for (int i = 0; i < 2; ++i) { int R, C; stage_rc(tid * 16 + i * 8192, R, C); const int Rb = Epi::PERM ? ((R & ~31) + perm32(R & 31)) : R;
        voffA[i] = (unsigned)(R * K + C) * 2u; voffB[i] = (unsigned)(Rb * K + C) * 2u; }
    const size_t kstep = (size_t)(BK * 2);
    const size_t hstep = (size_t)HALF * K * 2;
    const size_t tstep = 2 * hstep;
    const unsigned ldsw = (unsigned)wid * 1024u;
    const int aoff = lds_byte(wr * 64 + fr, fq * 8), boff = lds_byte(wc * 32 + fr, fq * 8);
#define PG8_SA(b, h) (((b) * 2 + (h)) * HTB)
#define PG8_SB(b, h) ((4 + (b) * 2 + (h)) * HTB)
#define PG8_STAGE(bufoff, gbase, voff) do { _Pragma("unroll") for (int _i = 0; _i < 2; ++_i) \
        __builtin_amdgcn_global_load_lds((const unsigned*)((const char*)(gbase) + (voff)[_i]), (PG8_LAS unsigned*)(lds + (bufoff) + ldsw + _i * 8192), 16, 0, 0); } while (0)
#define PG8_LDA(dst, b, h) do { _Pragma("unroll") for (int m = 0; m < 4; ++m) _Pragma("unroll") for (int k = 0; k < 2; ++k) dst[m][k] = *(const PG8_LAS bf16x8*)(lds + PG8_SA(b, h) + aoff + m * 2048 + k * 1024); } while (0)
#define PG8_LDB(dst, b, h) do { _Pragma("unroll") for (int n = 0; n < 2; ++n) _Pragma("unroll") for (int k = 0; k < 2; ++k) dst[n][k] = *(const PG8_LAS bf16x8*)(lds + PG8_SB(b, h) + boff + n * 2048 + k * 1024); } while (0)
#define PG8_MMA(ai, bj, At, Bt) do { __builtin_amdgcn_s_setprio(1); _Pragma("unroll") for (int m = 0; m < 4; ++m) _Pragma("unroll") for (int n = 0; n < 2; ++n) _Pragma("unroll") for (int k = 0; k < 2; ++k) \
        acc[ai][bj][m][n] = __builtin_amdgcn_mfma_f32_16x16x32_bf16(Bt[n][k], At[m][k], acc[ai][bj][m][n], 0, 0, 0); __builtin_amdgcn_s_setprio(0); } while (0)
#define PG8_WAIT_V(n) asm volatile("s_waitcnt vmcnt(" #n ")" ::: "memory")
#define PG8_WAIT_L(n) asm volatile("s_waitcnt lgkmcnt(" #n ")" ::: "memory")
#define PG8_BAR __builtin_amdgcn_s_barrier()
#define PG8_SCHED __builtin_amdgcn_sched_barrier(0)
    Unit cur, nxt; int ui = 0;
    if (!S.next(0, cur)) return;
    f32x4 acc[2][2][4][2];
#pragma unroll
    for (int a = 0; a < 2; ++a)
#pragma unroll
        for (int b = 0; b < 2; ++b)
#pragma unroll
            for (int m = 0; m < 4; ++m)
#pragma unroll
                for (int n = 0; n < 2; ++n) acc[a][b][m][n] = (f32x4){0.f, 0.f, 0.f, 0.f};
    bf16x8 At[4][2], B0[2][2], B1[2][2];
    const char* cA = (const char*)g.A + (size_t)cur.pm * tstep; const char* cB = (const char*)g.Bt + (size_t)cur.pn * tstep;
    S.a_ready(cur);
    if constexpr (SP2) {
        PG8_STAGE(PG8_SB(0, 0), cB, voffB); PG8_STAGE(PG8_SB(0, 1), cB + hstep, voffB); PG8_STAGE(PG8_SA(0, 0), cA, voffA); PG8_STAGE(PG8_SA(0, 1), cA + hstep, voffA);
        if (wr == 1) PG8_BAR;
        PG8_WAIT_V(2); PG8_BAR;
        PG8_STAGE(PG8_SB(1, 0), cB + kstep, voffB); PG8_STAGE(PG8_SA(1, 0), cA + kstep, voffA); PG8_STAGE(PG8_SB(1, 1), cB + hstep + kstep, voffB);
        PG8_WAIT_V(6); PG8_BAR;
    } else {
        PG8_STAGE(PG8_SB(0, 0), cB, voffB); PG8_STAGE(PG8_SA(0, 0), cA, voffA); PG8_STAGE(PG8_SB(0, 1), cB + hstep, voffB); PG8_STAGE(PG8_SA(0, 1), cA + hstep, voffA);
        if (wr == 1) PG8_BAR;
        PG8_WAIT_V(4); PG8_BAR;
        PG8_STAGE(PG8_SB(1, 0), cB + kstep, voffB); PG8_STAGE(PG8_SA(1, 0), cA + kstep, voffA); PG8_STAGE(PG8_SB(1, 1), cB + hstep + kstep, voffB);
        PG8_WAIT_V(6); PG8_BAR;
    }
    for (;;) {
        const bool has_next = S.next(ui + 1, nxt);
        const char* nA = has_next ? (const char*)g.A + (size_t)nxt.pm * tstep : cA; const char* nB = has_next ? (const char*)g.Bt + (size_t)nxt.pn * tstep : cB;
        for (int t = 0; t < nt; t += 2) {
            const bool last = (t == nt - 2);
            const char* a1 = cA + (size_t)(t + 1) * kstep;
            const char* a2 = last ? nA : cA + (size_t)(t + 2) * kstep; const char* b2 = last ? nB : cB + (size_t)(t + 2) * kstep;
            const char* a3 = a2 + kstep; const char* b3 = b2 + kstep;
            if (last && has_next) S.a_ready(nxt);
            if constexpr (SP2) {
            PG8_LDB(B0, 0, 0); PG8_LDB(B1, 0, 1); PG8_SCHED; PG8_LDA(At, 0, 0); PG8_STAGE(PG8_SA(1, 1), a1 + hstep, voffA);
            PG8_WAIT_V(8); PG8_WAIT_L(0); PG8_BAR; PG8_MMA(0, 0, At, B0); PG8_MMA(0, 1, At, B1); PG8_BAR; PG8_SCHED;
            PG8_LDA(At, 0, 1); PG8_STAGE(PG8_SB(0, 0), b2, voffB); PG8_STAGE(PG8_SB(0, 1), b2 + hstep, voffB); PG8_STAGE(PG8_SA(0, 0), a2, voffA);
            PG8_WAIT_V(8); PG8_WAIT_L(0); PG8_BAR; PG8_MMA(1, 0, At, B0); PG8_MMA(1, 1, At, B1); PG8_BAR; PG8_SCHED;
            PG8_LDB(B0, 1, 0); PG8_LDB(B1, 1, 1); PG8_SCHED; PG8_LDA(At, 1, 0); PG8_STAGE(PG8_SA(0, 1), a2 + hstep, voffA);
            PG8_WAIT_V(8); PG8_WAIT_L(0); PG8_BAR; PG8_MMA(0, 0, At, B0); PG8_MMA(0, 1, At, B1); PG8_BAR; PG8_SCHED;
            PG8_LDA(At, 1, 1); PG8_STAGE(PG8_SB(1, 0), b3, voffB); PG8_STAGE(PG8_SB(1, 1), b3 + hstep, voffB); PG8_STAGE(PG8_SA(1, 0), a3, voffA);
            PG8_WAIT_V(8); PG8_WAIT_L(0); PG8_BAR; PG8_MMA(1, 0, At, B0); PG8_MMA(1, 1, At, B1); PG8_BAR; PG8_SCHED;
            } else {
            PG8_LDB(B0, 0, 0); PG8_SCHED; PG8_LDA(At, 0, 0); PG8_STAGE(PG8_SA(1, 1), a1 + hstep, voffA);
            PG8_WAIT_L(8); PG8_BAR; PG8_WAIT_L(0); PG8_MMA(0, 0, At, B0); PG8_BAR; PG8_SCHED;
            PG8_LDB(B1, 0, 1); PG8_STAGE(PG8_SB(0, 0), b2, voffB);
            PG8_BAR; PG8_WAIT_L(0); PG8_MMA(0, 1, At, B1); PG8_BAR;
            PG8_LDA(At, 0, 1); PG8_STAGE(PG8_SA(0, 0), a2, voffA);
            PG8_BAR; PG8_WAIT_L(0); PG8_MMA(1, 0, At, B0); PG8_BAR; PG8_SCHED;
            PG8_STAGE(PG8_SB(0, 1), b2 + hstep, voffB);
            PG8_WAIT_V(6); PG8_BAR; PG8_MMA(1, 1, At, B1); PG8_BAR;
            PG8_LDB(B0, 1, 0); PG8_SCHED; PG8_LDA(At, 1, 0); PG8_STAGE(PG8_SA(0, 1), a2 + hstep, voffA);
            PG8_WAIT_L(8); PG8_BAR; PG8_WAIT_L(0); PG8_MMA(0, 0, At, B0); PG8_BAR; PG8_SCHED;
            PG8_LDB(B1, 1, 1); PG8_STAGE(PG8_SB(1, 0), b3, voffB);
            PG8_BAR; PG8_WAIT_L(0); PG8_MMA(0, 1, At, B1); PG8_BAR;
            PG8_LDA(At, 1, 1); PG8_STAGE(PG8_SA(1, 0), a3, voffA);
            PG8_BAR; PG8_WAIT_L(0); PG8_MMA(1, 0, At, B0); PG8_BAR; PG8_SCHED;
            PG8_STAGE(PG8_SB(1, 1), b3 + hstep, voffB);
            PG8_WAIT_V(6); PG8_BAR; PG8_MMA(1, 1, At, B1); PG8_BAR;
            }
        }
        if constexpr (ALIGN_EPI) { if (wr == 0) PG8_BAR; }
        if constexpr (!Epi::AFTER_DRAIN) { E(acc, cur, wr, wc, fr, fq); S.done(cur); }
        if (!has_next) break;
#pragma unroll
        for (int a = 0; a < 2; ++a)
#pragma unroll
            for (int b = 0; b < 2; ++b)
#pragma unroll
                for (int m = 0; m < 4; ++m)
#pragma unroll
                    for (int n = 0; n < 2; ++n) acc[a][b][m][n] = (f32x4){0.f, 0.f, 0.f, 0.f};
        cur = nxt; cA = nA; cB = nB; ++ui;
        if constexpr (ALIGN_EPI) { if (wr == 1) PG8_BAR; }
    }
    PG8_WAIT_V(0);
    if constexpr (!ALIGN_EPI) { if (wr == 0) PG8_BAR; }
    PG8_BAR;
    if constexpr (Epi::AFTER_DRAIN) { E.fused(acc, cur, wr, wc, fr, fq, lds, wid, lane); S.done(cur); }
#undef PG8_SA
#undef PG8_SB
#undef PG8_STAGE
#undef PG8_LDA
#undef PG8_LDB
#undef PG8_MMA
#undef PG8_WAIT_V
#undef PG8_WAIT_L
#undef PG8_BAR
#undef PG8_SCHED
}
}
#include <hip/hip_bf16.h>
#include <cmath>
namespace attn_body {
using bf16=__hip_bfloat16;
using bf16x8=__attribute__((ext_vector_type(8)))short;
using s16x4=__attribute__((ext_vector_type(4)))short;
using f32x16=__attribute__((ext_vector_type(16)))float;
using u32x4=__attribute__((ext_vector_type(4)))unsigned;
constexpr int D=64,QP=512,KP=128,OP=1024;
constexpr int NW=8,QBLK=32,QB=QBLK*NW,KVBLK=64;
constexpr int ATTN_UNIT_ROWS=QB;
__device__ __forceinline__ int crow(int r,int hi){return (r&3)+8*(r>>2)+4*hi;}
#define SBAR() __builtin_amdgcn_sched_barrier(0)
__device__ __forceinline__ void cmask(f32x16&p0,f32x16&p1,int jb,int qrel,int hi){
  const float NEG=-INFINITY; int kb=64*jb+4*hi;
  #pragma unroll
  for(int r=0;r<16;++r){int kv=kb+(r&3)+8*(r>>2); if(kv>qrel)p0[r]=NEG; if(kv+32>qrel)p1[r]=NEG;}
}

constexpr int NSLOT=3, SLOTB=8192;
constexpr int LDS_K=0, LDS_V=NSLOT*SLOTB, LDS_WS=2*NSLOT*SLOTB, LDS_OST=LDS_WS+NW*64*4, LDS_BYTES=LDS_OST+NW*4096;
constexpr float C2=0.125f*1.4426950408889634f;
__device__ __forceinline__ void glds16(const void*gsrc,unsigned lds_dst){unsigned keep;
  asm volatile("s_mov_b32 %0, m0\n\ts_mov_b32 m0, %2\n\ts_nop 0\n\tglobal_load_lds_dwordx4 %1, off\n\ts_mov_b32 m0, %0":"=&s"(keep):"v"(gsrc),"s"(lds_dst):"memory");}
__device__ __forceinline__ float max3f(float a,float b,float c){float r;asm("v_max3_f32 %0, %1, %2, %3":"=v"(r):"v"(a),"v"(b),"v"(c));return r;}
__device__ __forceinline__ float max2f(float a,float b){float r;asm("v_max_f32_e32 %0, %1, %2":"=v"(r):"v"(a),"v"(b));return r;}
__device__ __forceinline__ float fadd_s(float a,float b){float r;asm("v_add_f32_e32 %0, %1, %2":"=v"(r):"v"(a),"v"(b));return r;}
__device__ __forceinline__ float fsub_s(float a,float b){float r;asm("v_sub_f32_e32 %0, %1, %2":"=v"(r):"v"(a),"v"(b));return r;}
typedef float f32x2_t __attribute__((ext_vector_type(2))); typedef __bf16 bf16x2_t __attribute__((ext_vector_type(2)));
__device__ __forceinline__ unsigned cvtpk_s(float lo,float hi){f32x2_t v={lo,hi};bf16x2_t b=__builtin_convertvector(v,bf16x2_t);return __builtin_bit_cast(unsigned,b);}
#define WAIT_BAR(N) asm volatile("s_waitcnt vmcnt(" #N ") lgkmcnt(0)\n\ts_barrier":::"memory")

__device__ __forceinline__ void qkt(f32x16&p0,f32x16&p1,const char*Kslot,const bf16x8*qr,const f32x16&negm,int r32,int hi){
  const char*kb=Kslot+hi*1024+r32*16;
  #pragma unroll
  for(int d0=0;d0<4;++d0){
    const bf16x8 b0=*reinterpret_cast<const bf16x8*>(kb+d0*2048);
    const bf16x8 b1=*reinterpret_cast<const bf16x8*>(kb+d0*2048+512);
    if(d0==0){p0=__builtin_amdgcn_mfma_f32_32x32x16_bf16(b0,qr[0],negm,0,0,0);p1=__builtin_amdgcn_mfma_f32_32x32x16_bf16(b1,qr[0],negm,0,0,0);}
    else{p0=__builtin_amdgcn_mfma_f32_32x32x16_bf16(b0,qr[d0],p0,0,0,0);p1=__builtin_amdgcn_mfma_f32_32x32x16_bf16(b1,qr[d0],p1,0,0,0);}}
}
typedef __attribute__((address_space(3))) const char* lds_cptr;
typedef short v4i16_t __attribute__((ext_vector_type(4)));
__device__ __forceinline__ void kload8(bf16x8*kf,lds_cptr kp){
  kf[0]=*(const __attribute__((address_space(3))) bf16x8*)(kp);      kf[1]=*(const __attribute__((address_space(3))) bf16x8*)(kp+512);
  kf[2]=*(const __attribute__((address_space(3))) bf16x8*)(kp+2048); kf[3]=*(const __attribute__((address_space(3))) bf16x8*)(kp+2560);
  kf[4]=*(const __attribute__((address_space(3))) bf16x8*)(kp+4096); kf[5]=*(const __attribute__((address_space(3))) bf16x8*)(kp+4608);
  kf[6]=*(const __attribute__((address_space(3))) bf16x8*)(kp+6144); kf[7]=*(const __attribute__((address_space(3))) bf16x8*)(kp+6656);
}
__device__ __forceinline__ void kload2(bf16x8*kf,lds_cptr kp,int j){ kf[2*j]=*(const __attribute__((address_space(3))) bf16x8*)(kp+j*2048); kf[2*j+1]=*(const __attribute__((address_space(3))) bf16x8*)(kp+j*2048+512); }
__device__ __forceinline__ s16x4 vtr(lds_cptr p){ return __builtin_bit_cast(s16x4,__builtin_amdgcn_ds_read_tr16_b64_v4i16((__attribute__((address_space(3))) v4i16_t*)p)); }
__device__ __forceinline__ float rowmax(const f32x16&p0,const f32x16&p1){
  float a=max3f(p0[0],p0[1],p1[0]),b=max3f(p0[2],p0[3],p1[1]);a=max3f(a,p1[2],p1[3]);
  #pragma unroll
  for(int r=4;r<16;r+=4){a=max3f(a,p0[r],p0[r+1]);b=max3f(b,p0[r+2],p0[r+3]);a=max3f(a,p1[r],p1[r+1]);b=max3f(b,p1[r+2],p1[r+3]);}
  const float m=max2f(a,b);
  auto rr=__builtin_amdgcn_permlane32_swap(__float_as_uint(m),__float_as_uint(m),false,false);
  return max2f(__uint_as_float(rr[0]),__uint_as_float(rr[1]));
}
__device__ __forceinline__ void pv(f32x16*o,int vb,bf16x8 pa0,bf16x8 pa1,bf16x8 pa2,bf16x8 pa3){
  #pragma unroll
  for(int d0=0;d0<2;++d0){s16x4 lo[4],hi[4];
    #pragma unroll
    for(int ks=0;ks<4;++ks){
      asm volatile("ds_read_b64_tr_b16 %0,%1 offset:%c2":"=&v"(lo[ks]):"v"(vb),"i"(d0*4096+ks*1024):"memory");
      asm volatile("ds_read_b64_tr_b16 %0,%1 offset:%c2":"=&v"(hi[ks]):"v"(vb),"i"(d0*4096+ks*1024+512):"memory");}
    asm volatile("s_waitcnt lgkmcnt(0)":::"memory");SBAR();
    #define PK(k) (bf16x8){lo[k][0],lo[k][1],lo[k][2],lo[k][3],hi[k][0],hi[k][1],hi[k][2],hi[k][3]}
    o[d0]=__builtin_amdgcn_mfma_f32_32x32x16_bf16(pa0,PK(0),o[d0],0,0,0);
    o[d0]=__builtin_amdgcn_mfma_f32_32x32x16_bf16(pa1,PK(1),o[d0],0,0,0);
    o[d0]=__builtin_amdgcn_mfma_f32_32x32x16_bf16(pa2,PK(2),o[d0],0,0,0);
    o[d0]=__builtin_amdgcn_mfma_f32_32x32x16_bf16(pa3,PK(3),o[d0],0,0,0);
    #undef PK
  }
}

#ifndef ATTN_STORE16
#define ATTN_STORE16(p,v) (*(u32x4*)(p)=(v))
#endif
template<int THRL> __device__ __forceinline__ void attn_unit(const bf16*Q0,const bf16*__restrict__ Kh,const bf16*__restrict__ Vh,bf16*O0,const int NT,char*shm){
  const int tid=opaque_tid(),lane=tid&63,r32=lane&31,hi=lane>>5; const int wid=__builtin_amdgcn_readfirstlane(tid>>6);
  const bf16*Qw=Q0+(long)(wid*QBLK)*QP;
  const unsigned lds0=(unsigned)(uintptr_t)shm;
  float*wsf=(float*)(shm+LDS_WS)+wid*64;
  const bf16*ksrc=Kh+(long)lane*KP+wid*8;
  const bf16*vsrc=Vh+(long)(16*(wid&3)+(lane>>2))*KP+(wid>>2)*32+(lane&3)*8;
  const unsigned kdst=lds0+LDS_K+wid*1024, vdst=lds0+LDS_V+wid*1024;
  #define DMA_K(t,slot) glds16(ksrc+(long)(t)*KVBLK*KP,(unsigned)__builtin_amdgcn_readfirstlane(kdst+(slot)))
  #define DMA_V(t,slot) glds16(vsrc+(long)(t)*KVBLK*KP,(unsigned)__builtin_amdgcn_readfirstlane(vdst+(slot)))
  const int vb0=(int)(lds0+LDS_V)+((lane>>4)&1)*32+(lane&3)*8+(4*hi+((lane&15)>>2))*64;
  const char*Kbase=shm+LDS_K; bf16x8 kf[8];
  const lds_cptr shm3=(lds_cptr)shm; const lds_cptr kp0=shm3+LDS_K+hi*1024+r32*16; const lds_cptr vp0=shm3+LDS_V+((lane>>4)&1)*32+(lane&3)*8+(4*hi+((lane&15)>>2))*64;
  DMA_K(0,0);DMA_V(0,0);DMA_K(1,SLOTB);
  bf16x8 qr[4];
  #pragma unroll
  for(int d0=0;d0<4;++d0)qr[d0]=*reinterpret_cast<const bf16x8*>(&Qw[(long)r32*QP+d0*16+hi*8]);
  float mhat=0.f,l_reg=0.f;f32x16 o[2];o[0]=f32x16{};o[1]=f32x16{};f32x16 negm=f32x16{};asm volatile("":"+v"(negm));
  #define CMASK(P0,P1,t) do{}while(0)
  bool resc=false;
  #define START(P0,P1) do{ const float rm=rowmax(P0,P1); resc=false; \
    { const float dl=rm; mhat=fadd_s(mhat,dl); \
      _Pragma("unroll") for(int r=0;r<16;++r){P0[r]=fsub_s(P0[r],dl);P1[r]=fsub_s(P1[r],dl);} \
      _Pragma("unroll") for(int r=0;r<16;++r)negm[r]=-mhat; asm volatile("":"+v"(negm)); } \
    _Pragma("unroll") for(int r=0;r<16;++r)P0[r]=__builtin_amdgcn_exp2f(P0[r]); }while(0)
  #define RESC() do{ if(resc){ asm volatile("s_waitcnt lgkmcnt(0)":::"memory"); \
      _Pragma("unroll") for(int d_=0;d_<2;++d_) _Pragma("unroll") for(int r=0;r<16;++r)o[d_][r]*=wsf[crow(r,hi)]; } }while(0)
  f32x16 pA0,pA1,pB0,pB1;
  int sl_prev=0,sl_cur=0,sl_next=SLOTB;
  #define ROT() do{sl_prev=sl_cur;sl_cur=sl_next;sl_next=(sl_next==(NSLOT-1)*SLOTB)?0:sl_next+SLOTB;}while(0)
  DMA_K(2,2*SLOTB);
  WAIT_BAR(3);
  qkt(pA0,pA1,Kbase,qr,negm,r32,hi);asm volatile("s_nop 15\n\ts_nop 7":"+v"(pA0),"+v"(pA1));CMASK(pA0,pA1,0);
  START(pA0,pA1);
  _Pragma("unroll") for(int r=0;r<16;++r)pA1[r]=__builtin_amdgcn_exp2f(pA1[r]);
  WAIT_BAR(0);
  DMA_K(3,0);DMA_V(1,SLOTB);
  ROT();
  kload8(kf,kp0+sl_cur);
  WAIT_BAR(2);
  s16x4 vlo[8],vhi[8]; u32x4 pw0,pw1,pw2,pw3;
  #define PKW(P,B) cvtpk_s(P[B],P[B+1])
  #define PAF(k) __builtin_bit_cast(bf16x8,pw##k)
  #define VFR(i) (bf16x8){vlo[i][0],vlo[i][1],vlo[i][2],vlo[i][3],vhi[i][0],vhi[i][1],vhi[i][2],vhi[i][3]}
  #define PIN(x) asm volatile("":"+v"(x))
  #define MX3(a,b,c) __builtin_fmaxf(__builtin_fmaxf((a),(b)),(c))
  #define GAPA(MF,A0,A1,A2,A3,W0,W1,PW) do{ MF; sacc+=A0; sacc+=A1; sacc+=A2; sacc+=A3; PIN(sacc); W0; W1; PIN(PW); SBAR(); }while(0)
  #define EX(v) __builtin_amdgcn_exp2f(v)
  #define GAPB(MF,X,B) do{ MF; X[B]=EX(X[B]); X[B+1]=EX(X[B+1]); X[B+2]=EX(X[B+2]); X[B+3]=EX(X[B+3]); PIN(X); SBAR(); }while(0)
  #define VRD(i) do{ vlo[i]=vtr(vp_+(((i)>>2)*4096+((i)&3)*1024)); vhi[i]=vtr(vp_+(((i)>>2)*4096+((i)&3)*1024+512)); }while(0)
  #define KRD(G,j) do{ if(G){ kload2(kf,kp0+sl_next,j); SBAR(); } }while(0)
  #define STEP(C0,C1,P0,P1,t,GK,GV,GL) do{ SBAR(); \
    const lds_cptr vp_=vp0+sl_prev; \
    VRD(0); SBAR(); float sacc=(P0[0]+P0[1]); \
    GAPA(C0=__builtin_amdgcn_mfma_f32_32x32x16_bf16(kf[0],qr[0],negm,0,0,0), P0[2],P0[3],P0[4],P0[5],     pw0[0]=PKW(P0,0), pw0[1]=PKW(P0,2), pw0); \
    VRD(4); SBAR(); GAPA(C1=__builtin_amdgcn_mfma_f32_32x32x16_bf16(kf[1],qr[0],negm,0,0,0), P0[6],P0[7],P0[8],P0[9],     pw0[2]=PKW(P0,4), pw0[3]=PKW(P0,6), pw0); \
    VRD(1); SBAR(); GAPA(C0=__builtin_amdgcn_mfma_f32_32x32x16_bf16(kf[2],qr[1],C0,0,0,0),   P0[10],P0[11],P0[12],P0[13], pw1[0]=PKW(P0,8), pw1[1]=PKW(P0,10), pw1); \
    VRD(5); SBAR(); GAPA(C1=__builtin_amdgcn_mfma_f32_32x32x16_bf16(kf[3],qr[1],C1,0,0,0),   P0[14],P0[15],P1[0],P1[1],   pw1[2]=PKW(P0,12),pw1[3]=PKW(P0,14), pw1); \
    VRD(2); SBAR(); GAPA(C0=__builtin_amdgcn_mfma_f32_32x32x16_bf16(kf[4],qr[2],C0,0,0,0),   P1[2],P1[3],P1[4],P1[5],     pw2[0]=PKW(P1,0), pw2[1]=PKW(P1,2), pw2); \
    VRD(6); SBAR(); GAPA(C1=__builtin_amdgcn_mfma_f32_32x32x16_bf16(kf[5],qr[2],C1,0,0,0),   P1[6],P1[7],P1[8],P1[9],     pw2[2]=PKW(P1,4), pw2[3]=PKW(P1,6), pw2); \
    VRD(3); SBAR(); GAPA(C0=__builtin_amdgcn_mfma_f32_32x32x16_bf16(kf[6],qr[3],C0,0,0,0),   P1[10],P1[11],P1[12],P1[13], pw3[0]=PKW(P1,8), pw3[1]=PKW(P1,10), pw3); \
    VRD(7); SBAR(); GAPA(C1=__builtin_amdgcn_mfma_f32_32x32x16_bf16(kf[7],qr[3],C1,0,0,0),   P1[14],P1[15],0.f,0.f,       pw3[2]=PKW(P1,12),pw3[3]=PKW(P1,14), pw3); \
    l_reg+=sacc; \
    if(GK){DMA_K((t)+3,sl_cur);} if(GV){DMA_V((t)+1,sl_next);} \
    CMASK(C0,C1,t); \
    { float a=MX3(C0[0],C0[1],C1[0]),b=MX3(C0[2],C0[3],C1[1]); a=MX3(a,C1[2],C1[3]); \
      _Pragma("unroll") for(int r=4;r<16;r+=4){a=MX3(a,C0[r],C0[r+1]);b=MX3(b,C0[r+2],C0[r+3]);a=MX3(a,C1[r],C1[r+1]);b=MX3(b,C1[r+2],C1[r+3]);} \
      float rm=__builtin_fmaxf(a,b); { auto rr=__builtin_amdgcn_permlane32_swap(__float_as_uint(rm),__float_as_uint(rm),false,false); rm=__builtin_fmaxf(__uint_as_float(rr[0]),__uint_as_float(rr[1])); } \
      resc=false; \
      if(__builtin_expect(__any(rm>(float)THRL),0)){ const float dl=__builtin_fmaxf(rm,0.f); mhat+=dl; \
        _Pragma("unroll") for(int r=0;r<16;++r){C0[r]-=dl;C1[r]-=dl;} \
        _Pragma("unroll") for(int r=0;r<16;++r)negm[r]=-mhat; asm volatile("":"+v"(negm)); \
        const float f=__builtin_amdgcn_exp2f(-dl); l_reg*=f; if(hi==0)wsf[r32]=f; resc=true; } } \
    SBAR(); \
    GAPB(o[0]=__builtin_amdgcn_mfma_f32_32x32x16_bf16(PAF(0),VFR(0),o[0],0,0,0), C0,0); \
    GAPB(o[1]=__builtin_amdgcn_mfma_f32_32x32x16_bf16(PAF(0),VFR(4),o[1],0,0,0), C0,4); \
    KRD(GL,0); GAPB(o[0]=__builtin_amdgcn_mfma_f32_32x32x16_bf16(PAF(1),VFR(1),o[0],0,0,0), C0,8); \
    KRD(GL,1); GAPB(o[1]=__builtin_amdgcn_mfma_f32_32x32x16_bf16(PAF(1),VFR(5),o[1],0,0,0), C0,12); \
    KRD(GL,2); GAPB(o[0]=__builtin_amdgcn_mfma_f32_32x32x16_bf16(PAF(2),VFR(2),o[0],0,0,0), C1,0); \
    KRD(GL,3); GAPB(o[1]=__builtin_amdgcn_mfma_f32_32x32x16_bf16(PAF(2),VFR(6),o[1],0,0,0), C1,4); \
    GAPB(o[0]=__builtin_amdgcn_mfma_f32_32x32x16_bf16(PAF(3),VFR(3),o[0],0,0,0), C1,8); \
    GAPB(o[1]=__builtin_amdgcn_mfma_f32_32x32x16_bf16(PAF(3),VFR(7),o[1],0,0,0), C1,12); \
    }while(0)
  int t=1;
  for(;t+5<NT;t+=2){
    STEP(pB0,pB1,pA0,pA1,t,true,true,true);     WAIT_BAR(2); RESC(); ROT();
    STEP(pA0,pA1,pB0,pB1,t+1,true,true,true);   WAIT_BAR(2); RESC(); ROT();
  }
  #define ENDW(tt) do{ if((tt)+3<NT){WAIT_BAR(2);} else if((tt)+2<NT){WAIT_BAR(1);} else {WAIT_BAR(0);} }while(0)
  for(;t+1<NT;t+=2){
    STEP(pB0,pB1,pA0,pA1,t,(t+3<NT),(t+1<NT),(t+1<NT));       ENDW(t);   RESC(); ROT();
    STEP(pA0,pA1,pB0,pB1,t+1,(t+4<NT),(t+2<NT),(t+2<NT));     ENDW(t+1); RESC(); ROT();
  }
  STEP(pB0,pB1,pA0,pA1,NT-1,false,false,false); RESC();
  { float sacc=pB0[0]+pB0[1]; _Pragma("unroll") for(int r=2;r<16;++r)sacc+=pB0[r]; _Pragma("unroll") for(int r=0;r<16;++r)sacc+=pB1[r]; l_reg+=sacc;
    pw0=(u32x4){PKW(pB0,0),PKW(pB0,2),PKW(pB0,4),PKW(pB0,6)};pw1=(u32x4){PKW(pB0,8),PKW(pB0,10),PKW(pB0,12),PKW(pB0,14)};pw2=(u32x4){PKW(pB1,0),PKW(pB1,2),PKW(pB1,4),PKW(pB1,6)};pw3=(u32x4){PKW(pB1,8),PKW(pB1,10),PKW(pB1,12),PKW(pB1,14)};
    SBAR(); pv(o,vb0+sl_cur,PAF(0),PAF(1),PAF(2),PAF(3)); }
  #undef PKW
  #undef PAF
  #undef VFR
  #undef PIN
  #undef MX3
  #undef GAPA
  #undef GAPB
  #undef EX
  #undef VRD
  #undef KRD
  #undef STEP
  #undef ENDW
  {auto rr=__builtin_amdgcn_permlane32_swap(__float_as_uint(l_reg),__float_as_uint(l_reg),false,false);l_reg=__uint_as_float(rr[0])+__uint_as_float(rr[1]);}
  if(hi==0)wsf[32+r32]=l_reg;asm volatile("s_waitcnt lgkmcnt(0)":::"memory");
  float rli[16];
  #pragma unroll
  for(int r=0;r<16;++r)rli[r]=__builtin_amdgcn_rcpf(wsf[32+crow(r,hi)]);
  bf16*Ow=O0+(long)(wid*QBLK)*OP;
  { bf16*stg=(bf16*)(shm+LDS_OST)+wid*2048;
    #pragma unroll
    for(int r=0;r<16;++r){const int orow=crow(r,hi);
      #pragma unroll
      for(int d0=0;d0<2;++d0)stg[orow*64+d0*32+r32]=__float2bfloat16(o[d0][r]*rli[r]);}
    asm volatile("s_waitcnt lgkmcnt(0)":::"memory");
    #pragma unroll
    for(int i=0;i<4;++i){const int row=i*8+(lane>>3),ch=lane&7; const u32x4 v=*(const u32x4*)(stg+row*64+ch*8); ATTN_STORE16(Ow+(long)row*OP+ch*8,v);} }
  asm volatile("s_waitcnt lgkmcnt(0)\n\ts_barrier":::"memory");
  #undef DMA_K
  #undef DMA_V
  #undef CMASK
  #undef START
  #undef RESC
  #undef ROT
}
constexpr int ATTN_LDS_BYTES=LDS_BYTES;
#undef SBAR
#undef WAIT_BAR
}

constexpr int DM = 1024, BATCH = 8, SEQ = 4096, DEPTH = 4, CTXL = 256, DFF = 2816;
constexpr int MX = BATCH * SEQ, MC = BATCH * CTXL, MALL = MX + MC;
constexpr int INW = 2080, INWP = 2304, KVLEN = CTXL + SEQ, NCH = KVLEN / 64;
constexpr float EPS = 1e-6f;
constexpr float QSCALE = 0.125f * 1.4426950408889634f;
constexpr int PC_CA = 0, PC_CG = 256, PC_GQ = 512, PC_GK = 640, PC_GV = 768, PC_GR = 1024, PC_GF = 1280, PC_AQ = 1312, PC_AK = 1824;
constexpr size_t MiB = 1u << 20;
constexpr size_t WS_W1T = 0, WS_W2T = 88 * MiB, WS_WINT = 132 * MiB, WS_WOT = 150 * MiB, WS_MOD = 158 * MiB, WS_XN = 160 * MiB, WS_CAT = 228 * MiB,
                 WS_HP = 296 * MiB, WS_Q = 483 * MiB, WS_K = 517 * MiB, WS_V = 526 * MiB, WS_CTXR = 535 * MiB, WS_GDS = 543 * MiB, WS_GDEC = 577 * MiB, WS_CTL = 578 * MiB, WS_SSQ = 579 * MiB, WS_SW = 581 * MiB, WS_END = 584 * MiB;
constexpr size_t W1T_SZ = (size_t)2 * DFF * DM, W2T_SZ = (size_t)DM * DFF, WINT_SZ = (size_t)INWP * DM, WOT_SZ = (size_t)DM * DM;
static_assert(8 * W1T_SZ * 2 <= WS_W2T - WS_W1T && 8 * W2T_SZ * 2 <= WS_WINT - WS_W2T && 4 * WINT_SZ * 2 <= WS_WOT - WS_WINT && 4 * WOT_SZ * 2 <= WS_MOD - WS_WOT, "ws map W");
static_assert((size_t)MALL * DM * 2 <= WS_CAT - WS_XN && (size_t)MALL * DM * 2 <= WS_HP - WS_CAT && (size_t)MALL * DFF * 2 <= WS_Q - WS_HP && (size_t)MALL * 512 * 2 <= WS_K - WS_Q, "ws map act");
static_assert((size_t)BATCH * KVLEN * 128 * 2 <= WS_V - WS_K && (size_t)MC * DM * 4 <= WS_GDS - WS_CTXR && (size_t)BATCH * 2 * NCH * 4 * 2048 * 4 <= WS_GDEC - WS_GDS, "ws map 2");
constexpr int LDS_BYTES = 147456;
constexpr int NPH_LAYER = 9, NPHASES = 2 + DEPTH * NPH_LAYER;
constexpr int SWN = 2 * DFF;
static_assert((size_t)DEPTH * 3 * MALL * 4 <= WS_SW - WS_SSQ && (size_t)DEPTH * 3 * 9 * SWN * 4 <= WS_END - WS_SW, "ws map 3");

typedef unsigned short bf16_t;
typedef float f32x4 __attribute__((ext_vector_type(4)));
typedef unsigned u32x4 __attribute__((ext_vector_type(4)));
typedef unsigned u32x2 __attribute__((ext_vector_type(2)));
typedef float f32x2v __attribute__((ext_vector_type(2)));
#define LDSP __attribute__((address_space(3)))
#define LDS_WAIT() asm volatile("s_waitcnt lgkmcnt(0)" ::: "memory")
__device__ __forceinline__ unsigned pk2(float lo, float hi) { return pg8::cvt_pk_bf16(lo, hi); }
__device__ __forceinline__ float bflo(unsigned w) { return __uint_as_float(w << 16); }
__device__ __forceinline__ float bfhi(unsigned w) { return __uint_as_float(w & 0xffff0000u); }
__device__ __forceinline__ void unpack8(const u32x4 r, float (&x)[8]) { x[0] = bflo(r.x); x[1] = bfhi(r.x); x[2] = bflo(r.y); x[3] = bfhi(r.y); x[4] = bflo(r.z); x[5] = bfhi(r.z); x[6] = bflo(r.w); x[7] = bfhi(r.w); }
__device__ __forceinline__ u32x4 pack8(const float (&x)[8]) { u32x4 w; w.x = pk2(x[0], x[1]); w.y = pk2(x[2], x[3]); w.z = pk2(x[4], x[5]); w.w = pk2(x[6], x[7]); return w; }
template <int X> __device__ __forceinline__ float swz_xor(float v) { return __int_as_float(__builtin_amdgcn_ds_swizzle(__float_as_int(v), 0x1f | (X << 10))); }
__device__ __forceinline__ float wave_sum(float v) {
    v += swz_xor<1>(v); v += swz_xor<2>(v); v += swz_xor<4>(v); v += swz_xor<8>(v); v += swz_xor<16>(v);
    auto rr = __builtin_amdgcn_permlane32_swap(__float_as_uint(v), __float_as_uint(v), false, false);
    return __uint_as_float(rr[0]) + __uint_as_float(rr[1]);
}
__device__ __forceinline__ float sigm(float v) { return __builtin_amdgcn_rcpf(1.0f + __expf(-v)); }

struct Args { const float* in[20]; float* out; unsigned char* ws; int ph_lo, ph_hi; };
typedef const __attribute__((address_space(4))) Args* KA;
enum { I_X = 0, I_C, I_CTX, I_CCTX, I_WADA, I_BADA, I_GNORM, I_WFI, I_WFO, I_WIN, I_WOUT, I_WDW, I_BDW, I_CNG, I_CNB, I_WGG, I_BGG, I_GLAG, I_QNG, I_KNG };

__device__ __forceinline__ void transpose_item(const float* W, int K, int N, bf16_t* WT, int kb, int nsrc, int ndst, LDSP float* scr, int lane) {
    const int k0 = 64 * kb;
#pragma unroll 8
    for (int i = 0; i < 32; ++i) { const int kk = 2 * i + (lane >> 5); scr[kk * 33 + (lane & 31)] = W[(size_t)(k0 + kk) * N + nsrc + (lane & 31)]; }
    LDS_WAIT();
    const int c = lane & 7;
#pragma unroll
    for (int j = 0; j < 4; ++j) { const int n = (lane >> 3) + 8 * j; const LDSP float* s = scr + (8 * c) * 33 + n;
        u32x4 o; o.x = pk2(s[0 * 33], s[1 * 33]); o.y = pk2(s[2 * 33], s[3 * 33]); o.z = pk2(s[4 * 33], s[5 * 33]); o.w = pk2(s[6 * 33], s[7 * 33]);
        *(u32x4*)(WT + (size_t)(ndst + n) * K + k0 + 8 * c) = o; }
    LDS_WAIT();
}
__device__ __forceinline__ void phase0(KA a, LDSP unsigned char* lds, int tid, int lane, int wave, int bid, int G) {
    unsigned char* ws = a->ws;
    LDSP float* scr = (LDSP float*)(lds + wave * 8704);
    const int gw = bid * 8 + wave, NGW = G * 8;
    constexpr int I1 = 16 * 176, I2 = 44 * 32, I3 = 16 * 65, I4 = 16 * 32, LI = 2 * I1 + 2 * I2 + I3 + I4;
    for (int it = gw; it < DEPTH * LI; it += NGW) {
        const int l = it / LI; int r = it % LI;
        if (r < 2 * I1) { const int f = r / I1, rr = r % I1, kb = rr / 176, nb = rr % 176, nsrc = nb * 32; const bool isu = nsrc >= DFF; const int j = isu ? nsrc - DFF : nsrc;
            transpose_item(a->in[I_WFI] + (size_t)(l * 2 + f) * DM * 2 * DFF, DM, 2 * DFF, (bf16_t*)(ws + WS_W1T) + (size_t)(l * 2 + f) * W1T_SZ, kb, nsrc, 256 * (j >> 7) + (isu ? 128 : 0) + (j & 127), scr, lane); continue; }
        r -= 2 * I1;
        if (r < 2 * I2) { const int f = r / I2, rr = r % I2, kb = rr / 32, nb = rr % 32;
            transpose_item(a->in[I_WFO] + (size_t)(l * 2 + f) * DFF * DM, DFF, DM, (bf16_t*)(ws + WS_W2T) + (size_t)(l * 2 + f) * W2T_SZ, kb, nb * 32, nb * 32, scr, lane); continue; }
        r -= 2 * I2;
        if (r < I3) { const int kb = r / 65, nb = r % 65;
            transpose_item(a->in[I_WIN] + (size_t)l * DM * INW, DM, INW, (bf16_t*)(ws + WS_WINT) + (size_t)l * WINT_SZ, kb, nb * 32, nb * 32, scr, lane); continue; }
        r -= I3;
        { const int kb = r / 32, nb = r % 32;
            transpose_item(a->in[I_WOUT] + (size_t)l * DM * DM, DM, DM, (bf16_t*)(ws + WS_WOT) + (size_t)l * WOT_SZ, kb, nb * 32, nb * 32, scr, lane); }
    }
    { constexpr int PV = (INWP - INW) * DM * 2 / 16;
        for (int i = bid * 512 + tid; i < DEPTH * PV; i += G * 512) { const int l = i / PV, r = i % PV;
            ((u32x4*)((bf16_t*)(ws + WS_WINT) + (size_t)l * WINT_SZ + (size_t)INW * DM))[r] = (u32x4){0u, 0u, 0u, 0u}; } }
    { float* SSQ = (float*)(ws + WS_SSQ); for (int i = bid * 512 + tid; i < DEPTH * 3 * MALL; i += G * 512) SSQ[i] = 0.f; }
    __syncthreads();
    LDSP float* S = (LDSP float*)(lds + 69632);
    LDSP float* red = (LDSP float*)(lds + 106496);
    for (int i = tid; i < 9 * 1024; i += 512) { const int r = i >> 10, k = i & 1023; const float cv = r < 8 ? a->in[I_C][r * 1024 + k] : a->in[I_CCTX][k]; S[i] = cv * sigm(cv); }
    __syncthreads();
    float* MOD = (float*)(ws + WS_MOD);
    for (int it = bid; it < DEPTH * 144; it += G) {
        const int l = it / 144, n0 = (it % 144) * 64;
        const float* Wp = a->in[I_WADA] + (size_t)l * DM * 9216 + n0 + lane;
        float acc[9];
#pragma unroll
        for (int r = 0; r < 9; ++r) acc[r] = 0.f;
#pragma unroll 8
        for (int kk = 0; kk < 128; ++kk) { const int k = wave * 128 + kk; const float w = Wp[(size_t)k * 9216];
#pragma unroll
            for (int r = 0; r < 9; ++r) acc[r] += S[r * 1024 + k] * w; }
#pragma unroll
        for (int r = 0; r < 9; ++r) red[(wave * 9 + r) * 64 + lane] = acc[r];
        __syncthreads();
        for (int o = tid; o < 576; o += 512) { const int r = o >> 6, ln = o & 63; float s = 0.f;
#pragma unroll
            for (int w = 0; w < 8; ++w) s += red[(w * 9 + r) * 64 + ln];
            MOD[(size_t)(l * 9 + r) * 9216 + n0 + ln] = s + a->in[I_BADA][l * 9216 + n0 + ln]; }
        __syncthreads();
    }
}
__device__ __forceinline__ void phase1(KA a, LDSP unsigned char* lds, int tid, int lane, int wave, int bid, int G) {
    const float* MOD = (const float*)(a->ws + WS_MOD); bf16_t* XN = (bf16_t*)(a->ws + WS_XN); float* SSQ = (float*)(a->ws + WS_SSQ); float* SW = (float*)(a->ws + WS_SW);
    const float* g = a->in[I_GNORM];
    for (int m = bid * 8 + wave; m < MALL; m += G * 8) {
        const bool isc = m >= MX;
        const float* xr = isc ? a->in[I_CTX] + (size_t)(m - MX) * DM : a->in[I_X] + (size_t)m * DM;
        const float* md = MOD + (size_t)(isc ? 8 : (m >> 12)) * 9216;
        f32x4 v[4]; float ss = 0.f;
#pragma unroll
        for (int q = 0; q < 4; ++q) { v[q] = ((const f32x4*)xr)[lane + 64 * q]; ss += (v[q].x * v[q].x + v[q].y * v[q].y) + (v[q].z * v[q].z + v[q].w * v[q].w); }
        ss = wave_sum(ss);
        if (lane == 0) SSQ[m] = ss;
#pragma unroll
        for (int q = 0; q < 4; ++q) { const int col = 4 * lane + 256 * q;
            const f32x4 y = v[q] * *(const f32x4*)(g + col) * (*(const f32x4*)(md + 1024 + col) + 1.0f);
            u32x2 o; o.x = pk2(y.x, y.y); o.y = pk2(y.z, y.w);
            *(u32x2*)(XN + (size_t)m * DM + col) = o;
            typedef _Float16 h16x4 __attribute__((ext_vector_type(4)));
            *(h16x4*)((_Float16*)(a->ws + WS_CAT) + (size_t)m * DM + col) = __builtin_convertvector(v[q], h16x4); }
    }
    LDSP float* SH = (LDSP float*)lds;
    constexpr int RPL = 2 * DFF + INWP + 2 * DFF;
#pragma unroll 1
    for (int l = 0; l < DEPTH; ++l) {
        __syncthreads();
        for (int i = tid; i < 27 * 256; i += 512) { const int v = i >> 8, j = v / 9, bi = v % 9, c4 = (i & 255) * 4; *(LDSP f32x4*)(SH + v * 1024 + c4) = *(const f32x4*)(MOD + (size_t)(l * 9 + bi) * 9216 + (3 * j) * 1024 + c4); }
        __syncthreads();
        const bf16_t* w0b = (const bf16_t*)(a->ws + WS_W1T) + (size_t)(l * 2) * W1T_SZ; const bf16_t* w1b = (const bf16_t*)(a->ws + WS_WINT) + (size_t)l * WINT_SZ; const bf16_t* w2b = (const bf16_t*)(a->ws + WS_W1T) + (size_t)(l * 2 + 1) * W1T_SZ;
#define SW_ROWPTR(rr) ((rr) < 2 * DFF ? w0b + (size_t)(rr) * DM : ((rr) < 2 * DFF + INWP ? w1b + (size_t)((rr) - 2 * DFF) * DM : w2b + (size_t)((rr) - 2 * DFF - INWP) * DM))
        u32x4 nx0 = {0u, 0u, 0u, 0u}, nx1 = {0u, 0u, 0u, 0u};
        { const int r0 = bid * 8 + wave; if (r0 < RPL) { const bf16_t* p = SW_ROWPTR(r0); nx0 = *(const u32x4*)(p + lane * 8); nx1 = *(const u32x4*)(p + 512 + lane * 8); } }
#pragma unroll 1
        for (int r = bid * 8 + wave; r < RPL; r += G * 8) {
            float w0[8], w1[8]; unpack8(nx0, w0); unpack8(nx1, w1);
            { const int rn = r + G * 8; if (rn < RPL) { const bf16_t* p = SW_ROWPTR(rn); nx0 = *(const u32x4*)(p + lane * 8); nx1 = *(const u32x4*)(p + 512 + lane * 8); } }
            const int j = r < 2 * DFF ? 0 : (r < 2 * DFF + INWP ? 1 : 2), rj = r - (j == 0 ? 0 : (j == 1 ? 2 * DFF : 2 * DFF + INWP));
#pragma unroll
            for (int bi = 0; bi < 9; ++bi) { LDSP const float* sh = SH + (j * 9 + bi) * 1024 + lane * 8;
                const f32x4 s0 = *(LDSP const f32x4*)(sh), s1 = *(LDSP const f32x4*)(sh + 4), s2 = *(LDSP const f32x4*)(sh + 512), s3 = *(LDSP const f32x4*)(sh + 516);
                float d = (w0[0] * s0.x + w0[1] * s0.y) + (w0[2] * s0.z + w0[3] * s0.w) + (w0[4] * s1.x + w0[5] * s1.y) + (w0[6] * s1.z + w0[7] * s1.w)
                        + (w1[0] * s2.x + w1[1] * s2.y) + (w1[2] * s2.z + w1[3] * s2.w) + (w1[4] * s3.x + w1[5] * s3.y) + (w1[6] * s3.z + w1[7] * s3.w);
                d = wave_sum(d);
                if (lane == 0) SW[((size_t)(l * 3 + j) * 9 + bi) * SWN + rj] = d; } }
#undef SW_ROWPTR
    }
    __syncthreads();
}
__device__ __forceinline__ void prep_phase(KA a, LDSP unsigned char* lds, int l, int tid, int lane, int wave, int bid, int G) {
    LDSP f32x2v* CS = (LDSP f32x2v*)(lds);
    for (int i = tid; i < 1024; i += 512) { const int pos = i >> 4, f = i & 15;
        const float freq = exp2f(-(float)f * (13.287712379549449f / 16.0f)); const float ang = (float)pos * freq;
        float rev = ang * 0.15915494309189535f; rev -= floorf(rev);
        CS[i] = (f32x2v){__builtin_amdgcn_cosf(rev), __builtin_amdgcn_sinf(rev)}; }
    __syncthreads();
    const bf16_t* P = (const bf16_t*)(a->ws + WS_HP); bf16_t* Q = (bf16_t*)(a->ws + WS_Q); bf16_t* Kb = (bf16_t*)(a->ws + WS_K); bf16_t* Vb = (bf16_t*)(a->ws + WS_V);
    const int sub = lane & 7, axis = sub >> 2, half = (sub >> 1) & 1, f0 = (sub & 1) * 8;
    float qg[8], kg[8];
#pragma unroll
    for (int e = 0; e < 8; ++e) { qg[e] = a->in[I_QNG][l * 64 + sub * 8 + e]; kg[e] = a->in[I_KNG][l * 64 + sub * 8 + e]; }
    u32x4 nq = {0u, 0u, 0u, 0u}, nk_ = {0u, 0u, 0u, 0u};
    { const int m0 = bid * 8 + wave; if (m0 < MALL) { nq = *(const u32x4*)(P + (size_t)m0 * INWP + PC_AQ + lane * 8); nk_ = *(const u32x4*)(P + (size_t)m0 * INWP + PC_AK + (lane & 31) * 8); } }
    for (int m = bid * 8 + wave; m < MALL; m += G * 8) {
        const u32x4 rawq = nq, rawk = nk_;
        { const int mn = m + G * 8; if (mn < MALL) { nq = *(const u32x4*)(P + (size_t)mn * INWP + PC_AQ + lane * 8); nk_ = *(const u32x4*)(P + (size_t)mn * INWP + PC_AK + (lane & 31) * 8); } }
        const bool lat = m < MX;
        const int b = lat ? (m >> 12) : ((m - MX) >> 8), t = lat ? (m & 4095) : 0, pos = lat ? (CTXL + t) : ((m - MX) & 255);
        const int p = axis ? (t & 63) : (t >> 6);
        const bf16_t* pr = P + (size_t)m * INWP;
        float x[8], y[8];
        { const u32x4 raw = rawq; unpack8(raw, x);
            float ss = 0.f;
#pragma unroll
            for (int e = 0; e < 8; ++e) ss += x[e] * x[e];
            ss += swz_xor<1>(ss); ss += swz_xor<2>(ss); ss += swz_xor<4>(ss);
            const float rstd = 1.0f / sqrtf(ss * (1.0f / 64.0f) + EPS);
#pragma unroll
            for (int e = 0; e < 8; ++e) y[e] = x[e] * rstd * qg[e];
            if (lat) {
#pragma unroll
                for (int e = 0; e < 8; ++e) { const float o = swz_xor<2>(y[e]); const f32x2v cs = CS[p * 16 + f0 + e]; x[e] = half ? (y[e] * cs.x + o * cs.y) : (y[e] * cs.x - o * cs.y); }
            } else {
#pragma unroll
                for (int e = 0; e < 8; ++e) x[e] = y[e];
            }
#pragma unroll
            for (int e = 0; e < 8; ++e) x[e] *= QSCALE;
            *(u32x4*)(Q + (size_t)m * 512 + lane * 8) = pack8(x); }
        { const u32x4 raw = rawk; unpack8(raw, x);
            float ss = 0.f;
#pragma unroll
            for (int e = 0; e < 8; ++e) ss += x[e] * x[e];
            ss += swz_xor<1>(ss); ss += swz_xor<2>(ss); ss += swz_xor<4>(ss);
            const float rstd = 1.0f / sqrtf(ss * (1.0f / 64.0f) + EPS);
#pragma unroll
            for (int e = 0; e < 8; ++e) y[e] = x[e] * rstd * kg[e];
            if (lat) {
#pragma unroll
                for (int e = 0; e < 8; ++e) { const float o = swz_xor<2>(y[e]); const f32x2v cs = CS[p * 16 + f0 + e]; x[e] = half ? (y[e] * cs.x + o * cs.y) : (y[e] * cs.x - o * cs.y); }
            } else {
#pragma unroll
                for (int e = 0; e < 8; ++e) x[e] = y[e];
            }
            const size_t kvrow = ((size_t)b * KVLEN + pos) * 128;
            if (lane < 16) *(u32x4*)(Kb + kvrow + lane * 8) = pack8(x);
            else if (lane < 32) *(u32x4*)(Vb + kvrow + (lane - 16) * 8) = raw; }
    }
    __syncthreads();
}
__device__ __forceinline__ void conv_phase(KA a, LDSP unsigned char* lds, int l, bool last, int tid, int lane, int bid, int G) {
    LDSP float* hs = (LDSP float*)lds;
    LDSP bf16_t* os = (LDSP bf16_t*)(lds + 94 * 256 * 4);
    const bf16_t* P = (const bf16_t*)(a->ws + WS_HP); bf16_t* CAT = (bf16_t*)a->out;
    const int c = tid & 255, hf = tid >> 8;
    float w[31];
#pragma unroll
    for (int k = 0; k < 31; ++k) w[k] = a->in[I_WDW][(size_t)(l * 31 + k) * 256 + c];
    const float bias = a->in[I_BDW][l * 256 + c], gg = a->in[I_CNG][l * 256 + c], bb = a->in[I_CNB][l * 256 + c];
    const int nitems = last ? 512 : 544;
    for (int it = bid; it < nitems; it += G) {
        int base, len, t0;
        if (it < 512) { base = (it >> 6) * SEQ; len = SEQ; t0 = (it & 63) * 64; } else { const int i2 = it - 512; base = MX + (i2 >> 2) * CTXL; len = CTXL; t0 = (i2 & 3) * 64; }
        for (int rr = tid >> 5; rr < 94; rr += 16) { const int t = t0 - 15 + rr, c8 = (tid & 31) * 8;
            float h[8];
            if (t >= 0 && t < len) { const bf16_t* pr = P + (size_t)(base + t) * INWP + c8; float av[8], gv[8];
                unpack8(*(const u32x4*)(pr + PC_CA), av); unpack8(*(const u32x4*)(pr + PC_CG), gv);
#pragma unroll
                for (int e = 0; e < 8; ++e) h[e] = av[e] * sigm(gv[e]);
            } else {
#pragma unroll
                for (int e = 0; e < 8; ++e) h[e] = 0.f;
            }
            *(LDSP f32x4*)(hs + rr * 256 + c8) = (f32x4){h[0], h[1], h[2], h[3]}; *(LDSP f32x4*)(hs + rr * 256 + c8 + 4) = (f32x4){h[4], h[5], h[6], h[7]}; }
        __syncthreads();
#pragma unroll 1
        for (int i0 = 0; i0 < 32; i0 += 4) { const int ib = hf * 32 + i0;
            float xw[34];
#pragma unroll
            for (int k = 0; k < 34; ++k) xw[k] = hs[(ib + k) * 256 + c];
            float acc[4], mean[4], var[4];
#pragma unroll
            for (int t = 0; t < 4; ++t) { float s_ = bias;
#pragma unroll
                for (int k = 0; k < 31; ++k) s_ += w[k] * xw[t + k];
                acc[t] = s_; mean[t] = s_; }
#pragma unroll
            for (int t = 0; t < 4; ++t) mean[t] += swz_xor<1>(mean[t]);
#pragma unroll
            for (int t = 0; t < 4; ++t) mean[t] += swz_xor<2>(mean[t]);
#pragma unroll
            for (int t = 0; t < 4; ++t) mean[t] += swz_xor<4>(mean[t]);
#pragma unroll
            for (int t = 0; t < 4; ++t) mean[t] += swz_xor<8>(mean[t]);
#pragma unroll
            for (int t = 0; t < 4; ++t) mean[t] += swz_xor<16>(mean[t]);
#pragma unroll
            for (int t = 0; t < 4; ++t) { auto rr = __builtin_amdgcn_permlane32_swap(__float_as_uint(mean[t]), __float_as_uint(mean[t]), false, false);
                mean[t] = (__uint_as_float(rr[0]) + __uint_as_float(rr[1])) * (1.0f / 64.0f); acc[t] -= mean[t]; var[t] = acc[t] * acc[t]; }
#pragma unroll
            for (int t = 0; t < 4; ++t) var[t] += swz_xor<1>(var[t]);
#pragma unroll
            for (int t = 0; t < 4; ++t) var[t] += swz_xor<2>(var[t]);
#pragma unroll
            for (int t = 0; t < 4; ++t) var[t] += swz_xor<4>(var[t]);
#pragma unroll
            for (int t = 0; t < 4; ++t) var[t] += swz_xor<8>(var[t]);
#pragma unroll
            for (int t = 0; t < 4; ++t) var[t] += swz_xor<16>(var[t]);
#pragma unroll
            for (int t = 0; t < 4; ++t) { auto rr = __builtin_amdgcn_permlane32_swap(__float_as_uint(var[t]), __float_as_uint(var[t]), false, false);
                const float vv = (__uint_as_float(rr[0]) + __uint_as_float(rr[1])) * (1.0f / 64.0f);
                const float y = acc[t] * __builtin_amdgcn_rsqf(vv + EPS) * gg + bb;
                const float o = y * sigm(y);
                os[(ib + t) * 256 + c] = (bf16_t)(pk2(o, 0.f) & 0xffffu); } }
        __syncthreads();
        for (int q = tid; q < 2048; q += 512) { const int row = q >> 5, c8 = (q & 31) * 8;
            *(u32x4*)(CAT + (size_t)(base + t0 + row) * DM + c8) = *(const LDSP u32x4*)(os + row * 256 + c8); }
        __syncthreads();
    }
}
typedef short gbf16x8 __attribute__((ext_vector_type(8)));
constexpr int GB_WG = 106496, GB_BG = 106496 + 16384;
constexpr int GB_Q = 0, GB_K = 8448, GB_GF = 16896, GB_GB = 20992, GB_VT = 25088, GB_S0T = 34304, GB_QE = 42496, GB_KE = 50688, GB_KENDT = 58880, GB_ATT = 68096, GB_TOT = 86528, GB_O = 88576, GB_END = 105984;
constexpr int VTP = 72, ATP = 72, KTP = 72, OP_ = 68;
static_assert(GB_END <= 131072 && GB_VT + 64 * VTP * 2 == GB_S0T && GB_ATT + 2 * 64 * ATP * 2 == GB_TOT && GB_O + 64 * OP_ * 4 == GB_END, "gla lds");
__device__ __forceinline__ int gla_row(int b, int c, int i) { return c < 4 ? MX + b * CTXL + c * 64 + i : b * SEQ + (c - 4) * 64 + i; }
__device__ __forceinline__ void st_bf16(LDSP unsigned char* base, int byteoff, float v) { *(LDSP bf16_t*)(base + byteoff) = (bf16_t)(pk2(v, 0.f) & 0xffffu); }
struct GlaRegs { u32x4 qk, gt, vv, rg; f32x4 s0[2], gg[2]; };
template <bool G3> __device__ __forceinline__ void gla_issue(KA a, GlaRegs& R, const float* ggb, int b, int c, int h, int tid) {
    const bf16_t* P = (const bf16_t*)(a->ws + WS_HP);
    { const int i = (tid & 255) >> 2, part = tid & 3; const bf16_t* pr = P + (size_t)gla_row(b, c, i) * INWP;
        R.qk = (u32x4){0u, 0u, 0u, 0u};
        if (G3 || tid >= 256) R.qk = *(const u32x4*)(pr + (tid < 256 ? PC_GQ : PC_GK) + h * 32 + part * 8);
        R.gt = *(const u32x4*)(pr + PC_GF + part * 8); }
    { const int j = tid >> 3, part = tid & 7; R.vv = *(const u32x4*)(P + (size_t)gla_row(b, c, j) * INWP + PC_GV + h * 64 + part * 8); }
    if (G3) { const float* DS = (const float*)(a->ws + WS_GDS);
#pragma unroll
        for (int dir = 0; dir < 2; ++dir) { const size_t ci = ((size_t)(b * 2 + dir) * NCH + c) * 4 + h; R.s0[dir] = *(const f32x4*)(DS + ci * 2048 + (tid >> 4) * 64 + (tid & 15) * 4); }
        R.rg = *(const u32x4*)(P + (size_t)gla_row(b, c, tid >> 3) * INWP + PC_GR + h * 64 + (tid & 7) * 8);
        R.gg[0] = *(const f32x4*)(ggb + h * 64 + (tid & 7) * 8); R.gg[1] = *(const f32x4*)(ggb + h * 64 + (tid & 7) * 8 + 4); }
}
template <bool G3> __device__ __forceinline__ void gla_stage(KA a, LDSP unsigned char* B, const GlaRegs& R, int l, int b, int c, int h, int tid) {
    LDSP float* Qf = (LDSP float*)(B + GB_Q); LDSP float* Kf = (LDSP float*)(B + GB_K); LDSP float* GF = (LDSP float*)(B + GB_GF); LDSP float* GBk = (LDSP float*)(B + GB_GB);
    { const int i = (tid & 255) >> 2, part = tid & 3;
        float x[8]; unpack8(R.qk, x);
        if (tid < 256) {
            if (G3) {
#pragma unroll
                for (int e = 0; e < 8; ++e) Qf[i * 33 + part * 8 + e] = x[e]; }
            unpack8(R.gt, x);
#pragma unroll
            for (int e = 0; e < 8; ++e) (part < 2 ? GF : GBk)[i * 16 + (part & 1) * 8 + e] = x[e];
        } else {
#pragma unroll
            for (int e = 0; e < 8; ++e) Kf[i * 33 + part * 8 + e] = x[e]; } }
    { const int j = tid >> 3, part = tid & 7; const u32x4 r = R.vv;
        const unsigned w[4] = {r.x, r.y, r.z, r.w};
#pragma unroll
        for (int e = 0; e < 8; ++e) *(LDSP bf16_t*)(B + GB_VT + ((part * 8 + e) * VTP + j) * 2) = (bf16_t)((e & 1) ? (w[e >> 1] >> 16) : (w[e >> 1] & 0xffffu)); }
    if (G3) {
#pragma unroll
        for (int dir = 0; dir < 2; ++dir) { const int d = tid >> 4, v4 = (tid & 15) * 4; const f32x4 sv = R.s0[dir];
            st_bf16(B, GB_S0T + dir * 4096 + ((v4 + 0) * 32 + d) * 2, sv.x); st_bf16(B, GB_S0T + dir * 4096 + ((v4 + 1) * 32 + d) * 2, sv.y);
            st_bf16(B, GB_S0T + dir * 4096 + ((v4 + 2) * 32 + d) * 2, sv.z); st_bf16(B, GB_S0T + dir * 4096 + ((v4 + 3) * 32 + d) * 2, sv.w); } }
    __syncthreads();
    const int dir = tid >> 8, seg = (tid >> 5) & 7, d = tid & 31;
    float p[8], qv[8], kv[8];
    { LDSP const float* Wg = (LDSP const float*)(B + GB_WG) + (dir * 16) * 128 + h * 32 + d; const float bg = ((LDSP const float*)(B + GB_BG))[dir * 128 + h * 32 + d];
        float wc[16];
#pragma unroll
        for (int r = 0; r < 16; ++r) wc[r] = Wg[r * 128];
        LDSP const float* gs = dir ? GBk : GF;
#pragma unroll
        for (int r = 0; r < 8; ++r) { const int i = dir ? 63 - (seg * 8 + r) : seg * 8 + r; kv[r] = Kf[i * 33 + d]; qv[r] = G3 ? Qf[i * 33 + d] : 0.f; }
        float run = 0.f;
#pragma unroll
        for (int hb = 0; hb < 2; ++hb) {
            f32x4 gq[4][4];
#pragma unroll
            for (int r = 0; r < 4; ++r) { const int i = dir ? 63 - (seg * 8 + hb * 4 + r) : seg * 8 + hb * 4 + r;
#pragma unroll
                for (int q = 0; q < 4; ++q) gq[r][q] = *(LDSP const f32x4*)(gs + i * 16 + 4 * q); }
#pragma unroll
            for (int r = 0; r < 4; ++r) { float z0 = bg, z1 = 0.f, z2 = 0.f, z3 = 0.f;
#pragma unroll
                for (int q = 0; q < 4; ++q) { z0 += gq[r][q].x * wc[4 * q]; z1 += gq[r][q].y * wc[4 * q + 1]; z2 += gq[r][q].z * wc[4 * q + 2]; z3 += gq[r][q].w * wc[4 * q + 3]; }
                const float z = (z0 + z1) + (z2 + z3);
                const float ls = fminf(z, 0.f) - __logf(1.0f + __expf(-fabsf(z)));
                run += ls * (1.0f / 16.0f); p[hb * 4 + r] = run; } }
        ((LDSP float*)(B + GB_TOT))[(dir * 8 + seg) * 32 + d] = run; }
    __syncthreads();
    float off = 0.f, bl = 0.f;
#pragma unroll
    for (int sg = 0; sg < 8; ++sg) { const float t = ((LDSP const float*)(B + GB_TOT))[(dir * 8 + sg) * 32 + d]; bl += t; off += (sg < seg) ? t : 0.f; }
    float o1[8], o2[8];
#pragma unroll
    for (int r = 0; r < 8; ++r) { const float bc = p[r] + off;
        if (G3) { o1[r] = qv[r] * 0.17677669529663687f * __expf(bc); o2[r] = kv[r] * __expf(-bc); }
        else { o1[r] = kv[r] * __expf(bl - bc); o2[r] = 0.f; } }
#pragma unroll
    for (int r = 0; r < 8; ++r) { const int i = dir ? 63 - (seg * 8 + r) : seg * 8 + r;
        if (G3) { st_bf16(B, GB_QE + dir * 4096 + (i * 32 + d) * 2, o1[r]); st_bf16(B, GB_KE + dir * 4096 + (i * 32 + d) * 2, o2[r]); }
        else st_bf16(B, GB_KENDT + dir * (32 * KTP * 2) + (d * KTP + i) * 2, o1[r]); }
    if (!G3 && seg == 0) ((float*)(a->ws + WS_GDEC))[(((size_t)(b * 2 + dir) * NCH + c) * 4 + h) * 32 + d] = __expf(bl);
    __syncthreads();
}
__device__ __forceinline__ void gla_g1_phase(KA a, LDSP unsigned char* lds, int l, int tid, int bid, int G) {
    float* DS = (float*)(a->ws + WS_GDS);
    const int lane = tid & 63, w = tid >> 6, fr = lane & 15, fq = lane >> 4;
    for (int i = tid; i < 2 * 16 * 128; i += 512) ((LDSP float*)(lds + GB_WG))[i] = a->in[I_WGG][(size_t)l * 2 * 16 * 128 + i];
    if (tid < 256) ((LDSP float*)(lds + GB_BG))[tid] = a->in[I_BGG][l * 256 + tid];
    __syncthreads();
    GlaRegs R, Rn;
    if (bid < BATCH * NCH * 4) gla_issue<false>(a, Rn, nullptr, (bid >> 2) / NCH, (bid >> 2) % NCH, bid & 3, tid);
    for (int it = bid; it < BATCH * NCH * 4; it += G) {
        const int h = it & 3, c = (it >> 2) % NCH, b = (it >> 2) / NCH;
        R = Rn;
        { const int itn = it + G; if (itn < BATCH * NCH * 4) gla_issue<false>(a, Rn, nullptr, (itn >> 2) / NCH, (itn >> 2) % NCH, itn & 3, tid); }
        gla_stage<false>(a, lds, R, l, b, c, h, tid);
        const int dir = w >> 2, dt = (w >> 1) & 1;
        const size_t ci = ((size_t)(b * 2 + dir) * NCH + c) * 4 + h;
        gbf16x8 af[2];
#pragma unroll
        for (int sx = 0; sx < 2; ++sx) af[sx] = *(LDSP const gbf16x8*)(lds + GB_KENDT + dir * (32 * KTP * 2) + ((dt * 16 + fr) * KTP + sx * 32 + fq * 8) * 2);
#pragma unroll
        for (int t = 0; t < 2; ++t) { const int vt = (w & 1) * 2 + t; f32x4 acc = {0.f, 0.f, 0.f, 0.f};
#pragma unroll
            for (int sx = 0; sx < 2; ++sx) { const gbf16x8 bf = *(LDSP const gbf16x8*)(lds + GB_VT + ((vt * 16 + fr) * VTP + sx * 32 + fq * 8) * 2);
                acc = __builtin_amdgcn_mfma_f32_16x16x32_bf16(af[sx], bf, acc, 0, 0, 0); }
#pragma unroll
            for (int r = 0; r < 4; ++r) DS[ci * 2048 + (size_t)(dt * 16 + fq * 4 + r) * 64 + vt * 16 + fr] = acc[r]; }
        __syncthreads();
    }
}
__device__ __forceinline__ void gla_g2_phase(KA a, int tid, int bid, int G) {
    float* DS = (float*)(a->ws + WS_GDS); const float* DEC = (const float*)(a->ws + WS_GDEC);
    for (int e = bid * 512 + tid; e < BATCH * 2 * 4 * 2048; e += G * 512) {
        const int dv = e & 2047, h = (e >> 11) & 3, dir = (e >> 13) & 1, b = e >> 14, d = dv >> 6;
        float S = 0.f;
#pragma unroll 4
        for (int st = 0; st < NCH; ++st) { const int c = dir ? (st < 4 ? 3 - st : 71 - st) : st;
            const size_t ci = ((size_t)(b * 2 + dir) * NCH + c) * 4 + h;
            const float dsv = DS[ci * 2048 + dv], dec = DEC[ci * 32 + d];
            DS[ci * 2048 + dv] = S; S = dec * S + dsv; }
    }
}
__device__ __forceinline__ void gla_g3_phase(KA a, LDSP unsigned char* lds, int l, bool last, int tid, int bid, int G) {
    const bf16_t* P = (const bf16_t*)(a->ws + WS_HP); bf16_t* CAT = (bf16_t*)a->out;
    const int lane = tid & 63, w = tid >> 6, fr = lane & 15, fq = lane >> 4, it_ = w >> 1;
    for (int i = tid; i < 2 * 16 * 128; i += 512) ((LDSP float*)(lds + GB_WG))[i] = a->in[I_WGG][(size_t)l * 2 * 16 * 128 + i];
    if (tid < 256) ((LDSP float*)(lds + GB_BG))[tid] = a->in[I_BGG][l * 256 + tid];
    __syncthreads();
    const int c_lo = last ? 4 : 0, ncs = NCH - c_lo, nit = BATCH * ncs * 4;
    GlaRegs R, Rn;
    if (bid < nit) gla_issue<true>(a, Rn, a->in[I_GLAG] + (size_t)l * 256, (bid >> 2) / ncs, c_lo + (bid >> 2) % ncs, bid & 3, tid);
    for (int it = bid; it < nit; it += G) {
        const int h = it & 3, c = c_lo + (it >> 2) % ncs, b = (it >> 2) / ncs;
        R = Rn;
        { const int itn = it + G; if (itn < nit) gla_issue<true>(a, Rn, a->in[I_GLAG] + (size_t)l * 256, (itn >> 2) / ncs, c_lo + (itn >> 2) % ncs, itn & 3, tid); }
        gla_stage<true>(a, lds, R, l, b, c, h, tid);
        gbf16x8 qf[2];
#pragma unroll
        for (int dir = 0; dir < 2; ++dir) { qf[dir] = *(LDSP const gbf16x8*)(lds + GB_QE + dir * 4096 + ((it_ * 16 + fr) * 32 + fq * 8) * 2);
#pragma unroll
            for (int t = 0; t < 2; ++t) { const int jt = (w & 1) * 2 + t;
                const gbf16x8 kf = *(LDSP const gbf16x8*)(lds + GB_KE + dir * 4096 + ((jt * 16 + fr) * 32 + fq * 8) * 2);
                const f32x4 z = {0.f, 0.f, 0.f, 0.f};
                const f32x4 s4 = __builtin_amdgcn_mfma_f32_16x16x32_bf16(qf[dir], kf, z, 0, 0, 0);
#pragma unroll
                for (int r = 0; r < 4; ++r) { const int i = it_ * 16 + fq * 4 + r, j = jt * 16 + fr; const bool keep = dir ? (j >= i) : (j <= i);
                    st_bf16(lds, GB_ATT + dir * (64 * ATP * 2) + (i * ATP + j) * 2, keep ? s4[r] : 0.f); } } }
        __syncthreads();
#pragma unroll
        for (int t = 0; t < 2; ++t) { const int vt = (w & 1) * 2 + t; f32x4 acc = {0.f, 0.f, 0.f, 0.f};
#pragma unroll
            for (int dir = 0; dir < 2; ++dir) {
#pragma unroll
                for (int sx = 0; sx < 2; ++sx) { const gbf16x8 af = *(LDSP const gbf16x8*)(lds + GB_ATT + dir * (64 * ATP * 2) + ((it_ * 16 + fr) * ATP + sx * 32 + fq * 8) * 2);
                    const gbf16x8 bf = *(LDSP const gbf16x8*)(lds + GB_VT + ((vt * 16 + fr) * VTP + sx * 32 + fq * 8) * 2);
                    acc = __builtin_amdgcn_mfma_f32_16x16x32_bf16(af, bf, acc, 0, 0, 0); }
                const gbf16x8 sf = *(LDSP const gbf16x8*)(lds + GB_S0T + dir * 4096 + ((vt * 16 + fr) * 32 + fq * 8) * 2);
                acc = __builtin_amdgcn_mfma_f32_16x16x32_bf16(qf[dir], sf, acc, 0, 0, 0); }
#pragma unroll
            for (int r = 0; r < 4; ++r) ((LDSP float*)(lds + GB_O))[(it_ * 16 + fq * 4 + r) * OP_ + vt * 16 + fr] = acc[r]; }
        __syncthreads();
        { const int i = tid >> 3, vg = tid & 7;
            const f32x4 o0 = *(LDSP const f32x4*)(lds + GB_O + (i * OP_ + vg * 8) * 4), o1 = *(LDSP const f32x4*)(lds + GB_O + (i * OP_ + vg * 8 + 4) * 4);
            float ss = (o0.x * o0.x + o0.y * o0.y) + (o0.z * o0.z + o0.w * o0.w) + (o1.x * o1.x + o1.y * o1.y) + (o1.z * o1.z + o1.w * o1.w);
            ss += swz_xor<1>(ss); ss += swz_xor<2>(ss); ss += swz_xor<4>(ss);
            const float rstd = 1.0f / sqrtf(ss * (1.0f / 64.0f) + EPS);
            const int row = gla_row(b, c, i);
            const float gg[8] = {R.gg[0].x, R.gg[0].y, R.gg[0].z, R.gg[0].w, R.gg[1].x, R.gg[1].y, R.gg[1].z, R.gg[1].w};
            float r[8]; unpack8(R.rg, r);
            float y[8] = {o0.x, o0.y, o0.z, o0.w, o1.x, o1.y, o1.z, o1.w};
#pragma unroll
            for (int e = 0; e < 8; ++e) y[e] = y[e] * rstd * gg[e] * (r[e] * sigm(r[e]));
            *(u32x4*)(CAT + (size_t)row * DM + 256 + h * 64 + vg * 8) = pack8(y); }
    }
}
__device__ __forceinline__ void ctx_gemm_res(KA a, LDSP unsigned char* lds, const bf16_t* A, const bf16_t* Bt, int K, const float* gate, float coef,
                                             _Float16* XR, bf16_t* XS, float* ssq, const float* gn, const float* scn, int tid, int bid, int G) {
    const int lane = tid & 63, w = tid >> 6, wm = w >> 1, wn = w & 1, fr = lane & 15, fq = lane >> 4;
    LDSP unsigned char* As = lds; LDSP unsigned char* Bs = lds + 18432; LDSP float* Cs = (LDSP float*)(lds + 32768);
    const int nk = K / 64, lr = tid >> 3, lc = (tid & 7) * 8;
    for (int u = bid; u < 256; u += G) {
        int tm = u >> 4, tn = u & 15;
        if (G == 256) { const int x = u & 7, sl = u >> 3; tm = (x & 3) * 4 + (sl >> 3); tn = (x >> 2) * 8 + (sl & 7); }
        const size_t row0 = (size_t)MX + tm * 128; const int col0 = tn * 64;
        const bf16_t* ap0 = A + (row0 + lr) * K + lc; const bf16_t* ap1 = ap0 + (size_t)64 * K; const bf16_t* bp = Bt + (size_t)(col0 + lr) * K + lc;
        u32x4 ra0[4], ra1[4], rb[4];
#pragma unroll
        for (int q = 0; q < 4; ++q) { ra0[q] = *(const u32x4*)(ap0 + q * 64); ra1[q] = *(const u32x4*)(ap1 + q * 64); rb[q] = *(const u32x4*)(bp + q * 64); }
        f32x4 acc[2][2];
#pragma unroll
        for (int mt = 0; mt < 2; ++mt)
#pragma unroll
            for (int nt = 0; nt < 2; ++nt) acc[mt][nt] = (f32x4){0.f, 0.f, 0.f, 0.f};
#pragma unroll 1
        for (int kt = 0; kt < nk; kt += 4) {
#pragma unroll
            for (int q = 0; q < 4; ++q) {
                *(LDSP u32x4*)(As + (lr * 72 + lc) * 2) = ra0[q]; *(LDSP u32x4*)(As + ((64 + lr) * 72 + lc) * 2) = ra1[q]; *(LDSP u32x4*)(Bs + (lr * 72 + lc) * 2) = rb[q];
                __syncthreads();
                if (kt + q + 4 < nk) { ra0[q] = *(const u32x4*)(ap0 + (kt + q + 4) * 64); ra1[q] = *(const u32x4*)(ap1 + (kt + q + 4) * 64); rb[q] = *(const u32x4*)(bp + (kt + q + 4) * 64); }
#pragma unroll
                for (int ks = 0; ks < 2; ++ks) { gbf16x8 af[2], bf[2];
#pragma unroll
                    for (int mt = 0; mt < 2; ++mt) af[mt] = *(LDSP const gbf16x8*)(As + ((wm * 32 + mt * 16 + fr) * 72 + ks * 32 + fq * 8) * 2);
#pragma unroll
                    for (int nt = 0; nt < 2; ++nt) bf[nt] = *(LDSP const gbf16x8*)(Bs + ((wn * 32 + nt * 16 + fr) * 72 + ks * 32 + fq * 8) * 2);
#pragma unroll
                    for (int mt = 0; mt < 2; ++mt)
#pragma unroll
                        for (int nt = 0; nt < 2; ++nt) acc[mt][nt] = __builtin_amdgcn_mfma_f32_16x16x32_bf16(af[mt], bf[nt], acc[mt][nt], 0, 0, 0); }
                __syncthreads();
            }
        }
#pragma unroll
        for (int mt = 0; mt < 2; ++mt)
#pragma unroll
            for (int nt = 0; nt < 2; ++nt)
#pragma unroll
                for (int r = 0; r < 4; ++r) Cs[(wm * 32 + mt * 16 + fq * 4 + r) * 68 + wn * 32 + nt * 16 + fr] = acc[mt][nt][r];
        __syncthreads();
        { const int rl = tid >> 2, cs = (tid & 3) * 16; const size_t grow = row0 + rl; const int gc = col0 + cs;
            float x[16];
            {
#pragma unroll
                for (int q = 0; q < 2; ++q) { const pg8::f32x8 t = __builtin_convertvector(*(const pg8::h16x8*)(XR + grow * 1024 + gc + 8 * q), pg8::f32x8);
#pragma unroll
                    for (int e = 0; e < 8; ++e) x[8 * q + e] = t[e]; } }
            const float* g = gate + (size_t)8 * 9216 + gc; const float* gnp = gn + gc; const float* scp = scn + (size_t)8 * 9216 + gc;
            float ss = 0.f, y[16];
#pragma unroll
            for (int q = 0; q < 4; ++q) { const f32x4 gv = *(const f32x4*)(g + 4 * q), cv = *(LDSP const f32x4*)(Cs + rl * 68 + cs + 4 * q), gg = *(const f32x4*)(gnp + 4 * q), sc = *(const f32x4*)(scp + 4 * q);
#pragma unroll
                for (int e = 0; e < 4; ++e) { const float xv = x[4 * q + e] + coef * gv[e] * cv[e]; x[4 * q + e] = xv; ss += xv * xv; y[4 * q + e] = xv * gg[e] * (sc[e] + 1.0f); } }
#pragma unroll
            for (int q = 0; q < 2; ++q) { const pg8::f32x8 t = {x[8 * q], x[8 * q + 1], x[8 * q + 2], x[8 * q + 3], x[8 * q + 4], x[8 * q + 5], x[8 * q + 6], x[8 * q + 7]};
                *(pg8::h16x8*)(XR + grow * 1024 + gc + 8 * q) = __builtin_convertvector(t, pg8::h16x8);
                u32x4 wv; wv.x = pk2(y[8 * q], y[8 * q + 1]); wv.y = pk2(y[8 * q + 2], y[8 * q + 3]); wv.z = pk2(y[8 * q + 4], y[8 * q + 5]); wv.w = pk2(y[8 * q + 6], y[8 * q + 7]);
                *(u32x4*)(XS + grow * 1024 + gc + 8 * q) = wv; }
            ss += swz_xor<1>(ss); ss += swz_xor<2>(ss);
            if ((tid & 3) == 0) atomicAdd(ssq + grow, ss); }
        __syncthreads();
    }
}
__device__ __forceinline__ void attn_phase(KA a, unsigned char* lds, bool last, int bid, int G) {
    using abf = attn_body::bf16;
    const abf* Q = (const abf*)(a->ws + WS_Q); const abf* Kb = (const abf*)(a->ws + WS_K); const abf* Vb = (const abf*)(a->ws + WS_V); abf* CAT = (abf*)a->out;
    const int nunits = last ? 1024 : 1088;
    const int nlat = bid < 1024 ? (1024 - bid + G - 1) / G : 0, c0 = G - 1 - bid, nctx = (nunits > 1024 && c0 < 64) ? (64 - c0 + G - 1) / G : 0;
    for (int i = 0; i < nlat + nctx; ++i) {
        const int u = (i < nlat) ? bid + i * G : 1024 + c0 + (i - nlat) * G;
        int b, h, NT; size_t qrow;
        if (u < 1024) { b = u >> 7; h = (u >> 4) & 7; qrow = (size_t)b * SEQ + (size_t)(u & 15) * 256; NT = NCH; }
        else { const int uc = u - 1024; b = uc >> 3; h = uc & 7; qrow = (size_t)MX + (size_t)b * CTXL; NT = 4; }
        const size_t kvo = (size_t)b * KVLEN * 128 + (h >> 2) * 64;
        attn_body::attn_unit<8>(Q + qrow * 512 + h * 64, Kb + kvo, Vb + kvo, CAT + qrow * DM + 512 + h * 64, NT, (char*)lds);
    }
}
#define XB_TMO      128
#define XB_XCNT(j)  (256  + 64 * (j))
#define XB_XSUB(j)  (1280 + 64 * (j))
#define XB_XGEN(j)  (2304 + 64 * (j))
#define XB_TOP      3328
#define XB_TOPGEN   3392
#define XCD_BAR_WORDS 3456
#define XB_SPIN_CAP (1u << 18)

__device__ __forceinline__ unsigned xb_ld(unsigned* p)              { return __hip_atomic_load(p, __ATOMIC_RELAXED, __HIP_MEMORY_SCOPE_AGENT); }
__device__ __forceinline__ unsigned xb_add(unsigned* p, unsigned v) { return __hip_atomic_fetch_add(p, v, __ATOMIC_RELAXED, __HIP_MEMORY_SCOPE_AGENT); }
__device__ __forceinline__ unsigned xb_xcc_id() { return (unsigned)__builtin_amdgcn_s_getreg((3 << 11) | 20) & 0xFu; }
#define XB_SPIN(cond, bar) do { unsigned _sp = 0; while (cond) { __builtin_amdgcn_s_sleep(1); \
    if ((++_sp & 255u) == 0u) { if (xb_ld(&(bar)[XB_TMO])) break; if (_sp > XB_SPIN_CAP) { atomicAdd(&(bar)[XB_TMO], 1u); break; } } } } while (0)

struct XcdBarrier {
    unsigned* bar; unsigned x;
    volatile LDSP unsigned* st;
};

__device__ __forceinline__ XcdBarrier xcd_barrier_post(unsigned* bar, volatile LDSP unsigned* st) {
    XcdBarrier b; b.bar = bar; b.x = xb_xcc_id(); b.st = st;
    if (threadIdx.x == 0) (void)xb_add(&bar[XB_XCNT(b.x)], 1u);
    return b;
}
__device__ __forceinline__ void xcd_barrier_complete(unsigned* bar, unsigned x, unsigned& nloc, unsigned& nx) {
    const unsigned G = gridDim.x * gridDim.y * gridDim.z;
    unsigned sum, cnt, mine, sp = 0u;
    for (;;) {
        sum = 0u; cnt = 0u; mine = 0u;
#pragma unroll
        for (unsigned j = 0; j < 16; ++j) { const unsigned c = xb_ld(&bar[XB_XCNT(j)]); sum += c; cnt += (c > 0u) ? 1u : 0u; mine = (j == x) ? c : mine; }
        if (sum == G) break;
        __builtin_amdgcn_s_sleep(1);
        if ((++sp & 255u) == 0u) { if (xb_ld(&bar[XB_TMO])) break; if (sp > XB_SPIN_CAP) { atomicAdd(&bar[XB_TMO], 1u); break; } }
    }
    nloc = mine > 0u ? mine : 1u; nx = cnt > 0u ? cnt : 1u;
}

__device__ __forceinline__ void xcd_barrier(const XcdBarrier& b) {
    asm volatile("s_waitcnt vmcnt(0)" ::: "memory");
    __syncthreads();
    if (threadIdx.x == 0) {
        unsigned* bar = b.bar;
        __builtin_amdgcn_s_waitcnt(0);
        unsigned nloc = b.st[0], nx = b.st[1];
        if (nloc == 0u) { xcd_barrier_complete(bar, b.x, nloc, nx); b.st[0] = nloc; b.st[1] = nx; }
        const unsigned old = xb_add(&bar[XB_XSUB(b.x)], 1u);
        const unsigned gen = old / nloc;
        if (old + 1u == (gen + 1u) * nloc) {
            __builtin_amdgcn_fence(__ATOMIC_RELEASE, "agent");
            asm volatile("s_waitcnt vmcnt(0)" ::: "memory");
            const unsigned og = xb_add(&bar[XB_TOP], 1u);
            const unsigned tg = og / nx;
            if (og + 1u == (tg + 1u) * nx) xb_add(&bar[XB_TOPGEN], 1u);
            else XB_SPIN(xb_ld(&bar[XB_TOPGEN]) == tg, bar);
            __builtin_amdgcn_fence(__ATOMIC_ACQUIRE, "agent");
            xb_add(&bar[XB_XGEN(b.x)], 1u);
            asm volatile("s_waitcnt vmcnt(0)" ::: "memory");
        } else {
            XB_SPIN(xb_ld(&bar[XB_XGEN(b.x)]) == gen, bar);
            __builtin_amdgcn_fence(__ATOMIC_ACQUIRE, "agent");
            asm volatile("s_waitcnt vmcnt(0)" ::: "memory");
        }
    }
    __syncthreads();
}
__global__ void __launch_bounds__(512, 2) mega_fwd(Args a_unused) {
    KA a = (KA)__builtin_amdgcn_kernarg_segment_ptr();
    const int ph_lo = a->ph_lo, ph_hi = a->ph_hi;
    extern __shared__ __attribute__((aligned(16))) unsigned char lds_raw[];
    LDSP unsigned char* lds0 = (LDSP unsigned char*)lds_raw;
    { LDSP unsigned char* lds = lds0;
    volatile LDSP unsigned* xst = (volatile LDSP unsigned*)(lds + 131072 + 64);
    if (threadIdx.x == 0) { xst[0] = 0u; xst[1] = 0u; }
    __syncthreads(); }
#pragma unroll 1
    for (int ph = ph_lo; ph < ph_hi; ++ph) {
        asm volatile("" : "+s"(a));
        LDSP unsigned char* lds = lds0; asm volatile("" : "+s"(lds));
        volatile LDSP unsigned* xst = (volatile LDSP unsigned*)(lds + 131072 + 64);
        unsigned char* ws = a->ws;
        float* CTXR = (float*)(ws + WS_CTXR);
        const float* MOD = (const float*)(ws + WS_MOD);
        bf16_t* XN = (bf16_t*)(ws + WS_XN); bf16_t* CAT = (bf16_t*)a->out; bf16_t* HP = (bf16_t*)(ws + WS_HP); _Float16* XR = (_Float16*)(ws + WS_CAT);
        const int tid = opaque_tid(), lane = tid & 63, wave = __builtin_amdgcn_readfirstlane(tid >> 6);
        int G = gridDim.x, bid = blockIdx.x; asm volatile("" : "+s"(G), "+s"(bid));
        if (ph == 0) { phase0(a, lds, tid, lane, wave, bid, G); }
        else if (ph == 1) { phase1(a, lds, tid, lane, wave, bid, G); }
        else {
            const int l = (ph - 2) / NPH_LAYER, sp = (ph - 2) % NPH_LAYER; const bool last = (l == DEPTH - 1);
            const bool first = (l == 0 && sp <= 1);
            const float* srcX = first ? a->in[I_X] : a->out; const float* srcC = first ? a->in[I_CTX] : CTXR;
            const int Mtail = last ? MX : MALL;
            const float* SSQ = (const float*)(ws + WS_SSQ); const float* SW = (const float*)(ws + WS_SW);
            switch (sp) {
            case 0: case 7: { const int f = (sp == 0) ? 0 : 1, j = (sp == 0) ? 0 : 2; const int M = (sp == 0) ? MALL : Mtail;
                pg8::Gemm g{XN, (const bf16_t*)(ws + WS_W1T) + (size_t)(l * 2 + f) * W1T_SZ, M, 2 * DFF, DM}; pg8::PrefOrder S; S.init(M, 2 * DFF, G, bid);
                S.pf = lds + pg8::PF_OFF; S.ssq = SSQ + (size_t)(l * 3 + j) * MALL; S.sw = SW + (size_t)(l * 3 + j) * 9 * SWN; S.MXr = MX; S.cnt = 0;
                pg8::EpiSwiGLU E{HP, DFF, lds + pg8::PF_OFF, 0};
                pg8::gemm_phase<pg8::EpiSwiGLU, pg8::PrefOrder, true, true>(lds, g, S, E); } break;
            case 1: case 6: case 8: {
                const bf16_t* A; const bf16_t* Bt; int K, M, j; float coef;
                if (sp == 1) { A = HP; Bt = (const bf16_t*)(ws + WS_W2T) + (size_t)(l * 2 + 0) * W2T_SZ; K = DFF; M = MALL; j = 0; coef = 0.5f; }
                else if (sp == 6) { A = CAT; Bt = (const bf16_t*)(ws + WS_WOT) + (size_t)l * WOT_SZ; K = DM; M = Mtail; j = 1; coef = 1.0f; }
                else { A = HP; Bt = (const bf16_t*)(ws + WS_W2T) + (size_t)(l * 2 + 1) * W2T_SZ; K = DFF; M = Mtail; j = 2; coef = 0.5f; }
                const int ln = (j == 2) ? l + 1 : l, jn = (j == 2) ? 0 : j + 1;
                const bool has_next = ln < DEPTH; const int nidx = has_next ? (ln * 3 + jn) : 0;
                pg8::Gemm g{A, Bt, MX, DM, K}; pg8::StaticOrder S; S.init(MX, DM, G, bid);
                pg8::EpiRes E{a->out, XR, (last && sp == 8) ? 1 : 0, MOD + (size_t)l * 9 * 9216 + (3 * j + 2) * 1024, coef, MX,
                              XN, (float*)(ws + WS_SSQ) + (size_t)nidx * MALL, a->in[I_GNORM] + (size_t)nidx * DM, MOD + (size_t)(nidx / 3) * 9 * 9216 + (3 * jn + 1) * 1024, has_next ? 1 : 0};
                pg8::gemm_phase<pg8::EpiRes, pg8::StaticOrder, true, true>(lds, g, S, E);
                if (M == MALL) ctx_gemm_res(a, lds, A, Bt, K, MOD + (size_t)l * 9 * 9216 + (3 * j + 2) * 1024, coef, XR, XN, (float*)(ws + WS_SSQ) + (size_t)nidx * MALL,
                                            a->in[I_GNORM] + (size_t)nidx * DM, MOD + (size_t)(nidx / 3) * 9 * 9216 + (3 * jn + 1) * 1024, tid, bid, G); } break;
            case 2: { pg8::Gemm g{XN, (const bf16_t*)(ws + WS_WINT) + (size_t)l * WINT_SZ, MALL, INWP, DM}; pg8::PrefOrder S; S.init(MALL, INWP, G, bid);
                S.pf = lds + pg8::PF_OFF; S.ssq = SSQ + (size_t)(l * 3 + 1) * MALL; S.sw = SW + (size_t)(l * 3 + 1) * 9 * SWN; S.MXr = MX; S.cnt = 0;
                pg8::EpiStore E{HP, INWP, lds + pg8::PF_OFF, 0};
                pg8::gemm_phase<pg8::EpiStore, pg8::PrefOrder, true, true>(lds, g, S, E); } break;
            case 3: prep_phase(a, lds, l, tid, lane, wave, bid, G); gla_g1_phase(a, lds, l, tid, bid, G); break;
            case 4: gla_g2_phase(a, tid, bid, G); conv_phase(a, lds, l, last, tid, lane, bid, G); break;
            case 5: attn_phase(a, (unsigned char*)lds, last, bid, G); gla_g3_phase(a, lds, l, last, tid, bid, G); break;
            default: break;
            }
        }
        if (ph + 1 < ph_hi) {
            unsigned* barw = (unsigned*)(ws + WS_CTL);
            if (ph == ph_lo) {
                if (bid == 0) for (int i = tid; i < XCD_BAR_WORDS; i += 512) __hip_atomic_store(barw + i, 0u, __ATOMIC_RELAXED, __HIP_MEMORY_SCOPE_AGENT);
                cg::this_grid().sync();
                (void)xcd_barrier_post(barw, xst);
            } else { XcdBarrier xb; xb.bar = barw; xb.x = xb_xcc_id(); xb.st = xst; xcd_barrier(xb); }
        }
    }
}

#ifndef MK_MULTI
#define MK_MULTI 0
#endif
extern "C" void kernel_launch(void* const* d_in, const int* in_sizes, int n_in, void* d_out, int out_size, void* d_ws, size_t ws_size, hipStream_t stream) {
    static int grid = 0;
    if (grid == 0) {
        if (n_in != 20 || out_size != MX * DM || ws_size < WS_END) { fprintf(stderr, "kernel_launch: unexpected shapes (n_in %d, out %d, ws %zu); nothing launched\n", n_in, out_size, ws_size); grid = -1; return; }
        int dev = 0, cus = 0, per_cu = 0;
        if (hipGetDevice(&dev) != hipSuccess || hipDeviceGetAttribute(&cus, hipDeviceAttributeMultiprocessorCount, dev) != hipSuccess) { grid = -1; return; }
        if (hipFuncSetAttribute((const void*)mega_fwd, hipFuncAttributeMaxDynamicSharedMemorySize, LDS_BYTES) != hipSuccess) { fprintf(stderr, "kernel_launch: hipFuncSetAttribute failed\n"); grid = -1; return; }
        if (hipOccupancyMaxActiveBlocksPerMultiprocessor(&per_cu, (const void*)mega_fwd, 512, LDS_BYTES) != hipSuccess || per_cu < 1) { fprintf(stderr, "kernel_launch: occupancy query gave %d\n", per_cu); per_cu = 1; }
        (void)hipGetLastError();
        grid = cus * per_cu;
    }
    if (grid < 0) return;
    Args a{};
    for (int i = 0; i < 20; ++i) a.in[i] = (const float*)d_in[i];
    a.out = (float*)d_out; a.ws = (unsigned char*)d_ws;
#if MK_MULTI
    for (int ph = 0; ph < NPHASES; ++ph) { a.ph_lo = ph; a.ph_hi = ph + 1; hipLaunchKernelGGL(mega_fwd, dim3(grid), dim3(512), LDS_BYTES, stream, a); }
#else
    a.ph_lo = 0; a.ph_hi = NPHASES;
    void* args[] = {&a};
    hipError_t e = hipLaunchCooperativeKernel((const void*)mega_fwd, dim3(grid), dim3(512), args, LDS_BYTES, stream);
    if (e != hipSuccess) fprintf(stderr, "kernel_launch: cooperative launch failed: %s (grid %d)\n", hipGetErrorString(e), grid);
#endif
}
```

```cpp
#include <hip/hip_runtime.h>
#include <hip/hip_cooperative_groups.h>
#include <cstdio>
#include <cstdint>
namespace cg = cooperative_groups;
__device__ __forceinline__ int opaque_tid() { int t = threadIdx.x; asm volatile("" : "+v"(t)); return t; }
namespace pg8 {
#define PG8_LAS __attribute__((address_space(3)))
typedef unsigned short bf16_t;
typedef short bf16x8 __attribute__((ext_vector_type(8)));
typedef float f32x4 __attribute__((ext_vector_type(4)));
typedef unsigned u32x4 __attribute__((ext_vector_type(4)));
constexpr int BM = 256, BK = 64, HALF = 128, HTB = HALF * BK * 2  , STAGE_BYTES = 8 * HTB, NXCD = 8, WGM = 8;

__host__ __device__ __forceinline__ int lds_byte(int r, int c) { const int st = (r >> 4) * 2 + (c >> 5), rr = r & 15, cc = c & 31, ob = rr * 64 + cc * 2; return st * 1024 + (ob ^ (((ob >> 9) & 1) << 5)); }
__host__ __device__ __forceinline__ void stage_rc(int b, int& R, int& C) { const int st = b / 1024, sb = b % 1024, swz = sb ^ (((sb >> 9) & 1) << 5); R = (st >> 1) * 16 + swz / 64; C = (st & 1) * 32 + (swz % 64) / 2; }
__host__ __device__ __forceinline__ int perm32(int rho) { const int n = rho >> 4, i = rho & 15; return 8 * (i >> 2) + 4 * n + (i & 3); }

struct Unit { int pm, pn; };
struct Gemm { const bf16_t* A; const bf16_t* Bt; int M, N, K; };

struct StaticOrder {
    int nM, nN, nwg, G, c;
    __host__ __device__ void init(int M, int N, int G_, int c_) { nM = M / BM; nN = N / BM; nwg = nM * nN; G = G_; c = c_; }
    __host__ __device__ bool next(int i, Unit& u) const {
        const long L = (long)i * G + c; if (L >= nwg) return false;
        int wgid = (int)L; { const int q = nwg / NXCD, r = nwg % NXCD, xcd = wgid % NXCD, off = wgid / NXCD; wgid = (xcd < r ? xcd * (q + 1) : r * (q + 1) + (xcd - r) * q) + off; }
        const int nig = WGM * nN, gid = wgid / nig, fm = gid * WGM, gsz = (nM - fm) < WGM ? (nM - fm) : WGM;
        u.pm = fm + ((wgid % nig) % gsz); u.pn = (wgid % nig) / gsz; return true;
    }
    __device__ __forceinline__ void a_ready(const Unit&) const {}
    __device__ __forceinline__ void done(const Unit&) const {}
};

constexpr int PF_OFF = 132096, PF_SLOT = 2048;
struct PrefOrder : StaticOrder {
    PG8_LAS unsigned char* pf; const float* ssq; const float* sw; int MXr; mutable int cnt;
    __device__ __forceinline__ void a_ready(const Unit& u) const {
        const int t = threadIdx.x, w = __builtin_amdgcn_readfirstlane(t >> 6), lane = t & 63; const int slot = cnt & 1; ++cnt;
        const int rowt = u.pm * BM, bidx = rowt >= MXr ? 8 : (rowt >> 12);
        const float* src = (w < 4) ? ssq + rowt + w * 64 + lane : sw + (size_t)bidx * 5632 + u.pn * BM + (w - 4) * 64 + lane;
        __builtin_amdgcn_global_load_lds((const unsigned*)src, (PG8_LAS unsigned*)(pf + slot * PF_SLOT + w * 256), 4, 0, 0);
    }
};
typedef float cvt_f32x2_t __attribute__((ext_vector_type(2))); typedef __bf16 cvt_bf16x2_t __attribute__((ext_vector_type(2)));
__device__ __forceinline__ unsigned cvt_pk_bf16(float lo, float hi) { const cvt_f32x2_t v = {lo, hi}; const cvt_bf16x2_t b = __builtin_convertvector(v, cvt_bf16x2_t); return __builtin_bit_cast(unsigned, b); }
typedef float f32x2 __attribute__((ext_vector_type(2)));
__device__ __forceinline__ float silu_f(float v) { return v * __builtin_amdgcn_rcpf(1.0f + __expf(-v)); }
struct EpiStore {
    static constexpr bool PERM = true, AFTER_DRAIN = false;
    bf16_t* O; int ldc; PG8_LAS unsigned char* pf; mutable int cnt;
    __device__ __forceinline__ void operator()(const f32x4 (&acc)[2][2][4][2], const Unit& u, int wr, int wc, int fr, int fq) const {
        const int rowt = u.pm * BM; PG8_LAS const float* sl = (PG8_LAS const float*)(pf + (cnt & 1) * PF_SLOT); ++cnt;
        const int row0 = rowt + wr * 64 + fr, col0 = u.pn * BM + wc * 32 + 8 * fq;
        f32x4 sv[2][2];
#pragma unroll
        for (int bj = 0; bj < 2; ++bj)
#pragma unroll
            for (int n = 0; n < 2; ++n) sv[bj][n] = *(PG8_LAS const f32x4*)(sl + 256 + wc * 32 + 8 * fq + bj * HALF + 4 * n);
        float rsv[2][4];
#pragma unroll
        for (int ai = 0; ai < 2; ++ai)
#pragma unroll
            for (int m = 0; m < 4; ++m) rsv[ai][m] = __builtin_amdgcn_rsqf(sl[wr * 64 + fr + ai * HALF + m * 16] * (1.0f / 1024.0f) + 1e-6f);
#pragma unroll
        for (int ai = 0; ai < 2; ++ai)
#pragma unroll
            for (int m = 0; m < 4; ++m) { const int row = row0 + ai * HALF + m * 16; bf16_t* rowp = O + (size_t)row * ldc + col0;
                const float rs = rsv[ai][m];
#pragma unroll
                for (int bj = 0; bj < 2; ++bj) { const f32x4 v0 = acc[ai][bj][m][0] * rs + sv[bj][0], v1 = acc[ai][bj][m][1] * rs + sv[bj][1];
                    u32x4 w; w.x = cvt_pk_bf16(v0[0], v0[1]); w.y = cvt_pk_bf16(v0[2], v0[3]); w.z = cvt_pk_bf16(v1[0], v1[1]); w.w = cvt_pk_bf16(v1[2], v1[3]);
                    *(u32x4*)(rowp + bj * HALF) = w; } }
    }
};
struct EpiSwiGLU {
    static constexpr bool PERM = true, AFTER_DRAIN = false;
    bf16_t* O; int ldc; PG8_LAS unsigned char* pf; mutable int cnt;
    __device__ __forceinline__ void operator()(const f32x4 (&acc)[2][2][4][2], const Unit& u, int wr, int wc, int fr, int fq) const {
        const int rowt = u.pm * BM; PG8_LAS const float* sl = (PG8_LAS const float*)(pf + (cnt & 1) * PF_SLOT); ++cnt;
        const int row0 = rowt + wr * 64 + fr, col0 = u.pn * HALF + wc * 32 + 8 * fq;
        f32x4 sv[2][2];
#pragma unroll
        for (int bj = 0; bj < 2; ++bj)
#pragma unroll
            for (int n = 0; n < 2; ++n) sv[bj][n] = *(PG8_LAS const f32x4*)(sl + 256 + wc * 32 + 8 * fq + bj * HALF + 4 * n);
        float rsv[2][4];
#pragma unroll
        for (int ai = 0; ai < 2; ++ai)
#pragma unroll
            for (int m = 0; m < 4; ++m) rsv[ai][m] = __builtin_amdgcn_rsqf(sl[wr * 64 + fr + ai * HALF + m * 16] * (1.0f / 1024.0f) + 1e-6f);
#pragma unroll
        for (int ai = 0; ai < 2; ++ai)
#pragma unroll
            for (int m = 0; m < 4; ++m) { const int row = row0 + ai * HALF + m * 16; bf16_t* rowp = O + (size_t)row * ldc + col0;
                const float rs = rsv[ai][m];
                const f32x4 a0 = acc[ai][0][m][0] * rs + sv[0][0], a1 = acc[ai][0][m][1] * rs + sv[0][1], u0 = acc[ai][1][m][0] * rs + sv[1][0], u1 = acc[ai][1][m][1] * rs + sv[1][1];
                u32x4 w; w.x = cvt_pk_bf16(silu_f(a0[0]) * u0[0], silu_f(a0[1]) * u0[1]); w.y = cvt_pk_bf16(silu_f(a0[2]) * u0[2], silu_f(a0[3]) * u0[3]);
                w.z = cvt_pk_bf16(silu_f(a1[0]) * u1[0], silu_f(a1[1]) * u1[1]); w.w = cvt_pk_bf16(silu_f(a1[2]) * u1[2], silu_f(a1[3]) * u1[3]);
                *(u32x4*)rowp = w; }
    }
};
typedef _Float16 h16x8 __attribute__((ext_vector_type(8)));
typedef float f32x8 __attribute__((ext_vector_type(8)));
struct EpiRes {
    static constexpr bool PERM = true, AFTER_DRAIN = false;
    float* outF; _Float16* XR; int dstf32; const float* gate; float coef; int MXr;
    bf16_t* XSp; float* ssq; const float* gn; const float* scn; int doxs;
    __device__ __forceinline__ void operator()(const f32x4 (&acc)[2][2][4][2], const Unit& u, int wr, int wc, int fr, int fq) const {
        const int rowt = u.pm * BM; const bool isc = rowt >= MXr; const bool XS = doxs != 0;
        const int bidx = isc ? 8 : (rowt >> 12);
        char* outb = (char*)(outF + (size_t)rowt * 1024);
        char* xrb = (char*)(XR + (size_t)rowt * 1024);
        char* xsb = (char*)(XSp + (size_t)rowt * 1024); float* sqb = ssq + rowt;
        const int col0 = u.pn * BM + wc * 32 + 8 * fq;
        const float* g = gate + (size_t)bidx * 9216 + col0;
        const unsigned lo = (unsigned)((wr * 64 + fr) * 1024 + col0);
        float ss[2][4];
#pragma unroll
        for (int ai = 0; ai < 2; ++ai)
#pragma unroll
            for (int m = 0; m < 4; ++m) ss[ai][m] = 0.f;
#pragma unroll
        for (int bj = 0; bj < 2; ++bj) {
            u32x4 xin[2][4];
#pragma unroll
            for (int ai = 0; ai < 2; ++ai)
#pragma unroll
                for (int m = 0; m < 4; ++m) xin[ai][m] = *(const u32x4*)(xrb + (lo + (unsigned)((ai * HALF + m * 16) * 1024 + bj * HALF)) * 2u);
            f32x4 gv[2], gs[2];
#pragma unroll
            for (int n = 0; n < 2; ++n) { gv[n] = *(const f32x4*)(g + bj * HALF + 4 * n) * coef;
                if (XS) gs[n] = *(const f32x4*)(gn + col0 + bj * HALF + 4 * n) * (*(const f32x4*)(scn + (size_t)bidx * 9216 + col0 + bj * HALF + 4 * n) + 1.0f); }
#pragma unroll
            for (int ai = 0; ai < 2; ++ai)
#pragma unroll
                for (int m = 0; m < 4; ++m) { const unsigned eo = lo + (unsigned)((ai * HALF + m * 16) * 1024 + bj * HALF); f32x4 xv[2];
                    { const f32x8 t = __builtin_convertvector(__builtin_bit_cast(h16x8, xin[ai][m]), f32x8); xv[0] = (f32x4){t[0], t[1], t[2], t[3]}; xv[1] = (f32x4){t[4], t[5], t[6], t[7]}; }
                    xv[0] += gv[0] * acc[ai][bj][m][0]; xv[1] += gv[1] * acc[ai][bj][m][1];
                    if (dstf32) { *(f32x4*)(outb + eo * 4u) = xv[0]; *(f32x4*)(outb + eo * 4u + 16u) = xv[1]; }
                    else { const f32x8 t = {xv[0][0], xv[0][1], xv[0][2], xv[0][3], xv[1][0], xv[1][1], xv[1][2], xv[1][3]}; *(h16x8*)(xrb + eo * 2u) = __builtin_convertvector(t, h16x8); }
                    if (XS) { ss[ai][m] += (xv[0][0] * xv[0][0] + xv[0][1] * xv[0][1]) + (xv[0][2] * xv[0][2] + xv[0][3] * xv[0][3]) + (xv[1][0] * xv[1][0] + xv[1][1] * xv[1][1]) + (xv[1][2] * xv[1][2] + xv[1][3] * xv[1][3]);
                        const f32x4 y0 = xv[0] * gs[0], y1 = xv[1] * gs[1];
                        u32x4 w; w.x = cvt_pk_bf16(y0[0], y0[1]); w.y = cvt_pk_bf16(y0[2], y0[3]); w.z = cvt_pk_bf16(y1[0], y1[1]); w.w = cvt_pk_bf16(y1[2], y1[3]);
                        *(u32x4*)(xsb + eo * 2u) = w; } }
        }
        if (XS) {
#pragma unroll
            for (int ai = 0; ai < 2; ++ai)
#pragma unroll
                for (int m = 0; m < 4; ++m) { float t = ss[ai][m];
                    t += __int_as_float(__builtin_amdgcn_ds_swizzle(__float_as_int(t), 0x1f | (16 << 10)));
                    auto rr = __builtin_amdgcn_permlane32_swap(__float_as_uint(t), __float_as_uint(t), false, false);
                    t = __uint_as_float(rr[0]) + __uint_as_float(rr[1]);
                    if (fq == 0) atomicAdd(sqb + (unsigned)(wr * 64 + fr + ai * HALF + m * 16), t); } }
    }
};
template <class Epi, class Sched, bool ALIGN_EPI = false, bool SP2 = false>
__device__ __forceinline__ void gemm_phase(PG8_LAS unsigned char* lds, const Gemm g, const Sched& S, const Epi& E) {
    const int tid = opaque_tid(), wid = __builtin_amdgcn_readfirstlane(tid >> 6), lane = tid & 63, wr = wid >> 2, wc = wid & 3, fr = lane & 15, fq = lane >> 4;
    const int K = g.K, nt = K / BK;
    unsigned voffA[2], voffB[2];
#pragma unroll
    for (int i = 0; i < 2; ++i) { int R, C; stage_rc(tid * 16 + i * 8192, R, C); const int Rb = Epi::PERM ? ((R & ~31) + perm32(R & 31)) : R;
        voffA[i] = (unsigned)(R * K + C) * 2u; voffB[i] = (unsigned)(Rb * K + C) * 2u; }
    const size_t kstep = (size_t)(BK * 2);
    const size_t hstep = (size_t)HALF * K * 2;
    const size_t tstep = 2 * hstep;
    const unsigned ldsw = (unsigned)wid * 1024u;
    const int aoff = lds_byte(wr * 64 + fr, fq * 8), boff = lds_byte(wc * 32 + fr, fq * 8);
#define PG8_SA(b, h) (((b) * 2 + (h)) * HTB)
#define PG8_SB(b, h) ((4 + (b) * 2 + (h)) * HTB)
#define PG8_STAGE(bufoff, gbase, voff) do { _Pragma("unroll") for (int _i = 0; _i < 2; ++_i) \
        __builtin_amdgcn_global_load_lds((const unsigned*)((const char*)(gbase) + (voff)[_i]), (PG8_LAS unsigned*)(lds + (bufoff) + ldsw + _i * 8192), 16, 0, 0); } while (0)
#define PG8_LDA(dst, b, h) do { _Pragma("unroll") for (int m = 0; m < 4; ++m) _Pragma("unroll") for (int k = 0; k < 2; ++k) dst[m][k] = *(const PG8_LAS bf16x8*)(lds + PG8_SA(b, h) + aoff + m * 2048 + k * 1024); } while (0)
#define PG8_LDB(dst, b, h) do { _Pragma("unroll") for (int n = 0; n < 2; ++n) _Pragma("unroll") for (int k = 0; k < 2; ++k) dst[n][k] = *(const PG8_LAS bf16x8*)(lds + PG8_SB(b, h) + boff + n * 2048 + k * 1024); } while (0)
#define PG8_MMA(ai, bj, At, Bt) do { __builtin_amdgcn_s_setprio(1); _Pragma("unroll") for (int m = 0; m < 4; ++m) _Pragma("unroll") for (int n = 0; n < 2; ++n) _Pragma("unroll") for (int k = 0; k < 2; ++k) \
        acc[ai][bj][m][n] = __builtin_amdgcn_mfma_f32_16x16x32_bf16(Bt[n][k], At[m][k], acc[ai][bj][m][n], 0, 0, 0); __builtin_amdgcn_s_setprio(0); } while (0)
#define PG8_WAIT_V(n) asm volatile("s_waitcnt vmcnt(" #n ")" ::: "memory")
#define PG8_WAIT_L(n) asm volatile("s_waitcnt lgkmcnt(" #n ")" ::: "memory")
#define PG8_BAR __builtin_amdgcn_s_barrier()
#define PG8_SCHED __builtin_amdgcn_sched_barrier(0)
    Unit cur, nxt; int ui = 0;
    if (!S.next(0, cur)) return;
    f32x4 acc[2][2][4][2];
#pragma unroll
    for (int a = 0; a < 2; ++a)
#pragma unroll
        for (int b = 0; b < 2; ++b)
#pragma unroll
            for (int m = 0; m < 4; ++m)
#pragma unroll
                for (int n = 0; n < 2; ++n) acc[a][b][m][n] = (f32x4){0.f, 0.f, 0.f, 0.f};
    bf16x8 At[4][2], B0[2][2], B1[2][2];
    const char* cA = (const char*)g.A + (size_t)cur.pm * tstep; const char* cB = (const char*)g.Bt + (size_t)cur.pn * tstep;
    S.a_ready(cur);
    if constexpr (SP2) {
        PG8_STAGE(PG8_SB(0, 0), cB, voffB); PG8_STAGE(PG8_SB(0, 1), cB + hstep, voffB); PG8_STAGE(PG8_SA(0, 0), cA, voffA); PG8_STAGE(PG8_SA(0, 1), cA + hstep, voffA);
        if (wr == 1) PG8_BAR;
        PG8_WAIT_V(2); PG8_BAR;
        PG8_STAGE(PG8_SB(1, 0), cB + kstep, voffB); PG8_STAGE(PG8_SA(1, 0), cA + kstep, voffA); PG8_STAGE(PG8_SB(1, 1), cB + hstep + kstep, voffB);
        PG8_WAIT_V(6); PG8_BAR;
    } else {
        PG8_STAGE(PG8_SB(0, 0), cB, voffB); PG8_STAGE(PG8_SA(0, 0), cA, voffA); PG8_STAGE(PG8_SB(0, 1), cB + hstep, voffB); PG8_STAGE(PG8_SA(0, 1), cA + hstep, voffA);
        if (wr == 1) PG8_BAR;
        PG8_WAIT_V(4); PG8_BAR;
        PG8_STAGE(PG8_SB(1, 0), cB + kstep, voffB); PG8_STAGE(PG8_SA(1, 0), cA + kstep, voffA); PG8_STAGE(PG8_SB(1, 1), cB + hstep + kstep, voffB);
        PG8_WAIT_V(6); PG8_BAR;
    }
    for (;;) {
        const bool has_next = S.next(ui + 1, nxt);
        const char* nA = has_next ? (const char*)g.A + (size_t)nxt.pm * tstep : cA; const char* nB = has_next ? (const char*)g.Bt + (size_t)nxt.pn * tstep : cB;
        for (int t = 0; t < nt; t += 2) {
            const bool last = (t == nt - 2);
            const char* a1 = cA + (size_t)(t + 1) * kstep;
            const char* a2 = last ? nA : cA + (size_t)(t + 2) * kstep; const char* b2 = last ? nB : cB + (size_t)(t + 2) * kstep;
            const char* a3 = a2 + kstep; const char* b3 = b2 + kstep;
            if (last && has_next) S.a_ready(nxt);
            if constexpr (SP2) {
            PG8_LDB(B0, 0, 0); PG8_LDB(B1, 0, 1); PG8_SCHED; PG8_LDA(At, 0, 0); PG8_STAGE(PG8_SA(1, 1), a1 + hstep, voffA);
            PG8_WAIT_V(8); PG8_WAIT_L(0); PG8_BAR; PG8_MMA(0, 0, At, B0); PG8_MMA(0, 1, At, B1); PG8_BAR; PG8_SCHED;
            PG8_LDA(At, 0, 1); PG8_STAGE(PG8_SB(0, 0), b2, voffB); PG8_STAGE(PG8_SB(0, 1), b2 + hstep, voffB); PG8_STAGE(PG8_SA(0, 0), a2, voffA);
            PG8_WAIT_V(8); PG8_WAIT_L(0); PG8_BAR; PG8_MMA(1, 0, At, B0); PG8_MMA(1, 1, At, B1); PG8_BAR; PG8_SCHED;
            PG8_LDB(B0, 1, 0); PG8_LDB(B1, 1, 1); PG8_SCHED; PG8_LDA(At, 1, 0); PG8_STAGE(PG8_SA(0, 1), a2 + hstep, voffA);
            PG8_WAIT_V(8); PG8_WAIT_L(0); PG8_BAR; PG8_MMA(0, 0, At, B0); PG8_MMA(0, 1, At, B1); PG8_BAR; PG8_SCHED;
            PG8_LDA(At, 1, 1); PG8_STAGE(PG8_SB(1, 0), b3, voffB); PG8_STAGE(PG8_SB(1, 1), b3 + hstep, voffB); PG8_STAGE(PG8_SA(1, 0), a3, voffA);
            PG8_WAIT_V(8); PG8_WAIT_L(0); PG8_BAR; PG8_MMA(1, 0, At, B0); PG8_MMA(1, 1, At, B1); PG8_BAR; PG8_SCHED;
            } else {
            PG8_LDB(B0, 0, 0); PG8_SCHED; PG8_LDA(At, 0, 0); PG8_STAGE(PG8_SA(1, 1), a1 + hstep, voffA);
            PG8_WAIT_L(8); PG8_BAR; PG8_WAIT_L(0); PG8_MMA(0, 0, At, B0); PG8_BAR; PG8_SCHED;
            PG8_LDB(B1, 0, 1); PG8_STAGE(PG8_SB(0, 0), b2, voffB);
            PG8_BAR; PG8_WAIT_L(0); PG8_MMA(0, 1, At, B1); PG8_BAR;
            PG8_LDA(At, 0, 1); PG8_STAGE(PG8_SA(0, 0), a2, voffA);
            PG8_BAR; PG8_WAIT_L(0); PG8_MMA(1, 0, At, B0); PG8_BAR; PG8_SCHED;
            PG8_STAGE(PG8_SB(0, 1), b2 + hstep, voffB);
            PG8_WAIT_V(6); PG8_BAR; PG8_MMA(1, 1, At, B1); PG8_BAR;
            PG8_LDB(B0, 1, 0); PG8_SCHED; PG8_LDA(At, 1, 0); PG8_STAGE(PG8_SA(0, 1), a2 + hstep, voffA);
            PG8_WAIT_L(8); PG8_BAR; PG8_WAIT_L(0); PG8_MMA(0, 0, At, B0); PG8_BAR; PG8_SCHED;
            PG8_LDB(B1, 1, 1); PG8_STAGE(PG8_SB(1, 0), b3, voffB);
            PG8_BAR; PG8_WAIT_L(0); PG8_MMA(0, 1, At, B1); PG8_BAR;
            PG8_LDA(At, 1, 1); PG8_STAGE(PG8_SA(1, 0), a3, voffA);
            PG8_BAR; PG8_WAIT_L(0); PG8_MMA(1, 0, At, B0); PG8_BAR; PG8_SCHED;
            PG8_STAGE(PG8_SB(1, 1), b3 + hstep, voffB);
            PG8_WAIT_V(6); PG8_BAR; PG8_MMA(1, 1, At, B1); PG8_BAR;
            }
        }
        if constexpr (ALIGN_EPI) { if (wr == 0) PG8_BAR; }
        if constexpr (!Epi::AFTER_DRAIN) { E(acc, cur, wr, wc, fr, fq); S.done(cur); }
        if (!has_next) break;
#pragma unroll
        for (int a = 0; a < 2; ++a)
#pragma unroll
            for (int b = 0; b < 2; ++b)
#pragma unroll
                for (int m = 0; m < 4; ++m)
#pragma unroll
                    for (int n = 0; n < 2; ++n) acc[a][b][m][n] = (f32x4){0.f, 0.f, 0.f, 0.f};
        cur = nxt; cA = nA; cB = nB; ++ui;
        if constexpr (ALIGN_EPI) { if (wr == 1) PG8_BAR; }
    }
    PG8_WAIT_V(0);
    if constexpr (!ALIGN_EPI) { if (wr == 0) PG8_BAR; }
    PG8_BAR;
    if constexpr (Epi::AFTER_DRAIN) { E.fused(acc, cur, wr, wc, fr, fq, lds, wid, lane); S.done(cur); }
#undef PG8_SA
#undef PG8_SB
#undef PG8_STAGE
#undef PG8_LDA
#undef PG8_LDB
#undef PG8_MMA
#undef PG8_WAIT_V
#undef PG8_WAIT_L
#undef PG8_BAR
#undef PG8_SCHED
}
}
#include <hip/hip_bf16.h>
#include <cmath>
namespace attn_body {
using bf16=__hip_bfloat16;
using bf16x8=__attribute__((ext_vector_type(8)))short;
using s16x4=__attribute__((ext_vector_type(4)))short;
using f32x16=__attribute__((ext_vector_type(16)))float;
using u32x4=__attribute__((ext_vector_type(4)))unsigned;
constexpr int D=64,QP=512,KP=128,OP=1024;
constexpr int NW=8,QBLK=32,QB=QBLK*NW,KVBLK=64;
constexpr int ATTN_UNIT_ROWS=QB;
__device__ __forceinline__ int crow(int r,int hi){return (r&3)+8*(r>>2)+4*hi;}
#define SBAR() __builtin_amdgcn_sched_barrier(0)
__device__ __forceinline__ void cmask(f32x16&p0,f32x16&p1,int jb,int qrel,int hi){
  const float NEG=-INFINITY; int kb=64*jb+4*hi;
  #pragma unroll
  for(int r=0;r<16;++r){int kv=kb+(r&3)+8*(r>>2); if(kv>qrel)p0[r]=NEG; if(kv+32>qrel)p1[r]=NEG;}
}

constexpr int NSLOT=3, SLOTB=8192;
constexpr int LDS_K=0, LDS_V=NSLOT*SLOTB, LDS_WS=2*NSLOT*SLOTB, LDS_OST=LDS_WS+NW*64*4, LDS_BYTES=LDS_OST+NW*4096;
constexpr float C2=0.125f*1.4426950408889634f;
__device__ __forceinline__ void glds16(const void*gsrc,unsigned lds_dst){unsigned keep;
  asm volatile("s_mov_b32 %0, m0\n\ts_mov_b32 m0, %2\n\ts_nop 0\n\tglobal_load_lds_dwordx4 %1, off\n\ts_mov_b32 m0, %0":"=&s"(keep):"v"(gsrc),"s"(lds_dst):"memory");}
__device__ __forceinline__ float max3f(float a,float b,float c){float r;asm("v_max3_f32 %0, %1, %2, %3":"=v"(r):"v"(a),"v"(b),"v"(c));return r;}
__device__ __forceinline__ float max2f(float a,float b){float r;asm("v_max_f32_e32 %0, %1, %2":"=v"(r):"v"(a),"v"(b));return r;}
__device__ __forceinline__ float fadd_s(float a,float b){float r;asm("v_add_f32_e32 %0, %1, %2":"=v"(r):"v"(a),"v"(b));return r;}
__device__ __forceinline__ float fsub_s(float a,float b){float r;asm("v_sub_f32_e32 %0, %1, %2":"=v"(r):"v"(a),"v"(b));return r;}
typedef float f32x2_t __attribute__((ext_vector_type(2))); typedef __bf16 bf16x2_t __attribute__((ext_vector_type(2)));
__device__ __forceinline__ unsigned cvtpk_s(float lo,float hi){f32x2_t v={lo,hi};bf16x2_t b=__builtin_convertvector(v,bf16x2_t);return __builtin_bit_cast(unsigned,b);}
#define WAIT_BAR(N) asm volatile("s_waitcnt vmcnt(" #N ") lgkmcnt(0)\n\ts_barrier":::"memory")

__device__ __forceinline__ void qkt(f32x16&p0,f32x16&p1,const char*Kslot,const bf16x8*qr,const f32x16&negm,int r32,int hi){
  const char*kb=Kslot+hi*1024+r32*16;
  #pragma unroll
  for(int d0=0;d0<4;++d0){
    const bf16x8 b0=*reinterpret_cast<const bf16x8*>(kb+d0*2048);
    const bf16x8 b1=*reinterpret_cast<const bf16x8*>(kb+d0*2048+512);
    if(d0==0){p0=__builtin_amdgcn_mfma_f32_32x32x16_bf16(b0,qr[0],negm,0,0,0);p1=__builtin_amdgcn_mfma_f32_32x32x16_bf16(b1,qr[0],negm,0,0,0);}
    else{p0=__builtin_amdgcn_mfma_f32_32x32x16_bf16(b0,qr[d0],p0,0,0,0);p1=__builtin_amdgcn_mfma_f32_32x32x16_bf16(b1,qr[d0],p1,0,0,0);}}
}
typedef __attribute__((address_space(3))) const char* lds_cptr;
typedef short v4i16_t __attribute__((ext_vector_type(4)));
__device__ __forceinline__ void kload8(bf16x8*kf,lds_cptr kp){
  kf[0]=*(const __attribute__((address_space(3))) bf16x8*)(kp);      kf[1]=*(const __attribute__((address_space(3))) bf16x8*)(kp+512);
  kf[2]=*(const __attribute__((address_space(3))) bf16x8*)(kp+2048); kf[3]=*(const __attribute__((address_space(3))) bf16x8*)(kp+2560);
  kf[4]=*(const __attribute__((address_space(3))) bf16x8*)(kp+4096); kf[5]=*(const __attribute__((address_space(3))) bf16x8*)(kp+4608);
  kf[6]=*(const __attribute__((address_space(3))) bf16x8*)(kp+6144); kf[7]=*(const __attribute__((address_space(3))) bf16x8*)(kp+6656);
}
__device__ __forceinline__ void kload2(bf16x8*kf,lds_cptr kp,int j){ kf[2*j]=*(const __attribute__((address_space(3))) bf16x8*)(kp+j*2048); kf[2*j+1]=*(const __attribute__((address_space(3))) bf16x8*)(kp+j*2048+512); }
__device__ __forceinline__ s16x4 vtr(lds_cptr p){ return __builtin_bit_cast(s16x4,__builtin_amdgcn_ds_read_tr16_b64_v4i16((__attribute__((address_space(3))) v4i16_t*)p)); }
__device__ __forceinline__ float rowmax(const f32x16&p0,const f32x16&p1){
  float a=max3f(p0[0],p0[1],p1[0]),b=max3f(p0[2],p0[3],p1[1]);a=max3f(a,p1[2],p1[3]);
  #pragma unroll
  for(int r=4;r<16;r+=4){a=max3f(a,p0[r],p0[r+1]);b=max3f(b,p0[r+2],p0[r+3]);a=max3f(a,p1[r],p1[r+1]);b=max3f(b,p1[r+2],p1[r+3]);}
  const float m=max2f(a,b);
  auto rr=__builtin_amdgcn_permlane32_swap(__float_as_uint(m),__float_as_uint(m),false,false);
  return max2f(__uint_as_float(rr[0]),__uint_as_float(rr[1]));
}
__device__ __forceinline__ void pv(f32x16*o,int vb,bf16x8 pa0,bf16x8 pa1,bf16x8 pa2,bf16x8 pa3){
  #pragma unroll
  for(int d0=0;d0<2;++d0){s16x4 lo[4],hi[4];
    #pragma unroll
    for(int ks=0;ks<4;++ks){
      asm volatile("ds_read_b64_tr_b16 %0,%1 offset:%c2":"=&v"(lo[ks]):"v"(vb),"i"(d0*4096+ks*1024):"memory");
      asm volatile("ds_read_b64_tr_b16 %0,%1 offset:%c2":"=&v"(hi[ks]):"v"(vb),"i"(d0*4096+ks*1024+512):"memory");}
    asm volatile("s_waitcnt lgkmcnt(0)":::"memory");SBAR();
    #define PK(k) (bf16x8){lo[k][0],lo[k][1],lo[k][2],lo[k][3],hi[k][0],hi[k][1],hi[k][2],hi[k][3]}
    o[d0]=__builtin_amdgcn_mfma_f32_32x32x16_bf16(pa0,PK(0),o[d0],0,0,0);
    o[d0]=__builtin_amdgcn_mfma_f32_32x32x16_bf16(pa1,PK(1),o[d0],0,0,0);
    o[d0]=__builtin_amdgcn_mfma_f32_32x32x16_bf16(pa2,PK(2),o[d0],0,0,0);
    o[d0]=__builtin_amdgcn_mfma_f32_32x32x16_bf16(pa3,PK(3),o[d0],0,0,0);
    #undef PK
  }
}

#ifndef ATTN_STORE16
#define ATTN_STORE16(p,v) (*(u32x4*)(p)=(v))
#endif
template<int THRL> __device__ __forceinline__ void attn_unit(const bf16*Q0,const bf16*__restrict__ Kh,const bf16*__restrict__ Vh,bf16*O0,const int NT,char*shm){
  const int tid=opaque_tid(),lane=tid&63,r32=lane&31,hi=lane>>5; const int wid=__builtin_amdgcn_readfirstlane(tid>>6);
  const bf16*Qw=Q0+(long)(wid*QBLK)*QP;
  const unsigned lds0=(unsigned)(uintptr_t)shm;
  float*wsf=(float*)(shm+LDS_WS)+wid*64;
  const bf16*ksrc=Kh+(long)lane*KP+wid*8;
  const bf16*vsrc=Vh+(long)(16*(wid&3)+(lane>>2))*KP+(wid>>2)*32+(lane&3)*8;
  const unsigned kdst=lds0+LDS_K+wid*1024, vdst=lds0+LDS_V+wid*1024;
  #define DMA_K(t,slot) glds16(ksrc+(long)(t)*KVBLK*KP,(unsigned)__builtin_amdgcn_readfirstlane(kdst+(slot)))
  #define DMA_V(t,slot) glds16(vsrc+(long)(t)*KVBLK*KP,(unsigned)__builtin_amdgcn_readfirstlane(vdst+(slot)))
  const int vb0=(int)(lds0+LDS_V)+((lane>>4)&1)*32+(lane&3)*8+(4*hi+((lane&15)>>2))*64;
  const char*Kbase=shm+LDS_K; bf16x8 kf[8];
  const lds_cptr shm3=(lds_cptr)shm; const lds_cptr kp0=shm3+LDS_K+hi*1024+r32*16; const lds_cptr vp0=shm3+LDS_V+((lane>>4)&1)*32+(lane&3)*8+(4*hi+((lane&15)>>2))*64;
  DMA_K(0,0);DMA_V(0,0);DMA_K(1,SLOTB);
  bf16x8 qr[4];
  #pragma unroll
  for(int d0=0;d0<4;++d0)qr[d0]=*reinterpret_cast<const bf16x8*>(&Qw[(long)r32*QP+d0*16+hi*8]);
  float mhat=0.f,l_reg=0.f;f32x16 o[2];o[0]=f32x16{};o[1]=f32x16{};f32x16 negm=f32x16{};asm volatile("":"+v"(negm));
  #define CMASK(P0,P1,t) do{}while(0)
  bool resc=false;
  #define START(P0,P1) do{ const float rm=rowmax(P0,P1); resc=false; \
    { const float dl=rm; mhat=fadd_s(mhat,dl); \
      _Pragma("unroll") for(int r=0;r<16;++r){P0[r]=fsub_s(P0[r],dl);P1[r]=fsub_s(P1[r],dl);} \
      _Pragma("unroll") for(int r=0;r<16;++r)negm[r]=-mhat; asm volatile("":"+v"(negm)); } \
    _Pragma("unroll") for(int r=0;r<16;++r)P0[r]=__builtin_amdgcn_exp2f(P0[r]); }while(0)
  #define RESC() do{ if(resc){ asm volatile("s_waitcnt lgkmcnt(0)":::"memory"); \
      _Pragma("unroll") for(int d_=0;d_<2;++d_) _Pragma("unroll") for(int r=0;r<16;++r)o[d_][r]*=wsf[crow(r,hi)]; } }while(0)
  f32x16 pA0,pA1,pB0,pB1;
  int sl_prev=0,sl_cur=0,sl_next=SLOTB;
  #define ROT() do{sl_prev=sl_cur;sl_cur=sl_next;sl_next=(sl_next==(NSLOT-1)*SLOTB)?0:sl_next+SLOTB;}while(0)
  DMA_K(2,2*SLOTB);
  WAIT_BAR(3);
  qkt(pA0,pA1,Kbase,qr,negm,r32,hi);asm volatile("s_nop 15\n\ts_nop 7":"+v"(pA0),"+v"(pA1));CMASK(pA0,pA1,0);
  START(pA0,pA1);
  _Pragma("unroll") for(int r=0;r<16;++r)pA1[r]=__builtin_amdgcn_exp2f(pA1[r]);
  WAIT_BAR(0);
  DMA_K(3,0);DMA_V(1,SLOTB);
  ROT();
  kload8(kf,kp0+sl_cur);
  WAIT_BAR(2);
  s16x4 vlo[8],vhi[8]; u32x4 pw0,pw1,pw2,pw3;
  #define PKW(P,B) cvtpk_s(P[B],P[B+1])
  #define PAF(k) __builtin_bit_cast(bf16x8,pw##k)
  #define VFR(i) (bf16x8){vlo[i][0],vlo[i][1],vlo[i][2],vlo[i][3],vhi[i][0],vhi[i][1],vhi[i][2],vhi[i][3]}
  #define PIN(x) asm volatile("":"+v"(x))
  #define MX3(a,b,c) __builtin_fmaxf(__builtin_fmaxf((a),(b)),(c))
  #define GAPA(MF,A0,A1,A2,A3,W0,W1,PW) do{ MF; sacc+=A0; sacc+=A1; sacc+=A2; sacc+=A3; PIN(sacc); W0; W1; PIN(PW); SBAR(); }while(0)
  #define EX(v) __builtin_amdgcn_exp2f(v)
  #define GAPB(MF,X,B) do{ MF; X[B]=EX(X[B]); X[B+1]=EX(X[B+1]); X[B+2]=EX(X[B+2]); X[B+3]=EX(X[B+3]); PIN(X); SBAR(); }while(0)
  #define VRD(i) do{ vlo[i]=vtr(vp_+(((i)>>2)*4096+((i)&3)*1024)); vhi[i]=vtr(vp_+(((i)>>2)*4096+((i)&3)*1024+512)); }while(0)
  #define KRD(G,j) do{ if(G){ kload2(kf,kp0+sl_next,j); SBAR(); } }while(0)
  #define STEP(C0,C1,P0,P1,t,GK,GV,GL) do{ SBAR(); \
    const lds_cptr vp_=vp0+sl_prev; \
    VRD(0); SBAR(); float sacc=(P0[0]+P0[1]); \
    GAPA(C0=__builtin_amdgcn_mfma_f32_32x32x16_bf16(kf[0],qr[0],negm,0,0,0), P0[2],P0[3],P0[4],P0[5],     pw0[0]=PKW(P0,0), pw0[1]=PKW(P0,2), pw0); \
    VRD(4); SBAR(); GAPA(C1=__builtin_amdgcn_mfma_f32_32x32x16_bf16(kf[1],qr[0],negm,0,0,0), P0[6],P0[7],P0[8],P0[9],     pw0[2]=PKW(P0,4), pw0[3]=PKW(P0,6), pw0); \
    VRD(1); SBAR(); GAPA(C0=__builtin_amdgcn_mfma_f32_32x32x16_bf16(kf[2],qr[1],C0,0,0,0),   P0[10],P0[11],P0[12],P0[13], pw1[0]=PKW(P0,8), pw1[1]=PKW(P0,10), pw1); \
    VRD(5); SBAR(); GAPA(C1=__builtin_amdgcn_mfma_f32_32x32x16_bf16(kf[3],qr[1],C1,0,0,0),   P0[14],P0[15],P1[0],P1[1],   pw1[2]=PKW(P0,12),pw1[3]=PKW(P0,14), pw1); \
    VRD(2); SBAR(); GAPA(C0=__builtin_amdgcn_mfma_f32_32x32x16_bf16(kf[4],qr[2],C0,0,0,0),   P1[2],P1[3],P1[4],P1[5],     pw2[0]=PKW(P1,0), pw2[1]=PKW(P1,2), pw2); \
    VRD(6); SBAR(); GAPA(C1=__builtin_amdgcn_mfma_f32_32x32x16_bf16(kf[5],qr[2],C1,0,0,0),   P1[6],P1[7],P1[8],P1[9],     pw2[2]=PKW(P1,4), pw2[3]=PKW(P1,6), pw2); \
    VRD(3); SBAR(); GAPA(C0=__builtin_amdgcn_mfma_f32_32x32x16_bf16(kf[6],qr[3],C0,0,0,0),   P1[10],P1[11],P1[12],P1[13], pw3[0]=PKW(P1,8), pw3[1]=PKW(P1,10), pw3); \
    VRD(7); SBAR(); GAPA(C1=__builtin_amdgcn_mfma_f32_32x32x16_bf16(kf[7],qr[3],C1,0,0,0),   P1[14],P1[15],0.f,0.f,       pw3[2]=PKW(P1,12),pw3[3]=PKW(P1,14), pw3); \
    l_reg+=sacc; \
    if(GK){DMA_K((t)+3,sl_cur);} if(GV){DMA_V((t)+1,sl_next);} \
    CMASK(C0,C1,t); \
    { float a=MX3(C0[0],C0[1],C1[0]),b=MX3(C0[2],C0[3],C1[1]); a=MX3(a,C1[2],C1[3]); \
      _Pragma("unroll") for(int r=4;r<16;r+=4){a=MX3(a,C0[r],C0[r+1]);b=MX3(b,C0[r+2],C0[r+3]);a=MX3(a,C1[r],C1[r+1]);b=MX3(b,C1[r+2],C1[r+3]);} \
      float rm=__builtin_fmaxf(a,b); { auto rr=__builtin_amdgcn_permlane32_swap(__float_as_uint(rm),__float_as_uint(rm),false,false); rm=__builtin_fmaxf(__uint_as_float(rr[0]),__uint_as_float(rr[1])); } \
      resc=false; \
      if(__builtin_expect(__any(rm>(float)THRL),0)){ const float dl=__builtin_fmaxf(rm,0.f); mhat+=dl; \
        _Pragma("unroll") for(int r=0;r<16;++r){C0[r]-=dl;C1[r]-=dl;} \
        _Pragma("unroll") for(int r=0;r<16;++r)negm[r]=-mhat; asm volatile("":"+v"(negm)); \
        const float f=__builtin_amdgcn_exp2f(-dl); l_reg*=f; if(hi==0)wsf[r32]=f; resc=true; } } \
    SBAR(); \
    GAPB(o[0]=__builtin_amdgcn_mfma_f32_32x32x16_bf16(PAF(0),VFR(0),o[0],0,0,0), C0,0); \
    GAPB(o[1]=__builtin_amdgcn_mfma_f32_32x32x16_bf16(PAF(0),VFR(4),o[1],0,0,0), C0,4); \
    KRD(GL,0); GAPB(o[0]=__builtin_amdgcn_mfma_f32_32x32x16_bf16(PAF(1),VFR(1),o[0],0,0,0), C0,8); \
    KRD(GL,1); GAPB(o[1]=__builtin_amdgcn_mfma_f32_32x32x16_bf16(PAF(1),VFR(5),o[1],0,0,0), C0,12); \
    KRD(GL,2); GAPB(o[0]=__builtin_amdgcn_mfma_f32_32x32x16_bf16(PAF(2),VFR(2),o[0],0,0,0), C1,0); \
    KRD(GL,3); GAPB(o[1]=__builtin_amdgcn_mfma_f32_32x32x16_bf16(PAF(2),VFR(6),o[1],0,0,0), C1,4); \
    GAPB(o[0]=__builtin_amdgcn_mfma_f32_32x32x16_bf16(PAF(3),VFR(3),o[0],0,0,0), C1,8); \
    GAPB(o[1]=__builtin_amdgcn_mfma_f32_32x32x16_bf16(PAF(3),VFR(7),o[1],0,0,0), C1,12); \
    }while(0)
  int t=1;
  for(;t+5<NT;t+=2){
    STEP(pB0,pB1,pA0,pA1,t,true,true,true);     WAIT_BAR(2); RESC(); ROT();
    STEP(pA0,pA1,pB0,pB1,t+1,true,true,true);   WAIT_BAR(2); RESC(); ROT();
  }
  #define ENDW(tt) do{ if((tt)+3<NT){WAIT_BAR(2);} else if((tt)+2<NT){WAIT_BAR(1);} else {WAIT_BAR(0);} }while(0)
  for(;t+1<NT;t+=2){
    STEP(pB0,pB1,pA0,pA1,t,(t+3<NT),(t+1<NT),(t+1<NT));       ENDW(t);   RESC(); ROT();
    STEP(pA0,pA1,pB0,pB1,t+1,(t+4<NT),(t+2<NT),(t+2<NT));     ENDW(t+1); RESC(); ROT();
  }
  STEP(pB0,pB1,pA0,pA1,NT-1,false,false,false); RESC();
  { float sacc=pB0[0]+pB0[1]; _Pragma("unroll") for(int r=2;r<16;++r)sacc+=pB0[r]; _Pragma("unroll") for(int r=0;r<16;++r)sacc+=pB1[r]; l_reg+=sacc;
    pw0=(u32x4){PKW(pB0,0),PKW(pB0,2),PKW(pB0,4),PKW(pB0,6)};pw1=(u32x4){PKW(pB0,8),PKW(pB0,10),PKW(pB0,12),PKW(pB0,14)};pw2=(u32x4){PKW(pB1,0),PKW(pB1,2),PKW(pB1,4),PKW(pB1,6)};pw3=(u32x4){PKW(pB1,8),PKW(pB1,10),PKW(pB1,12),PKW(pB1,14)};
    SBAR(); pv(o,vb0+sl_cur,PAF(0),PAF(1),PAF(2),PAF(3)); }
  #undef PKW
  #undef PAF
  #undef VFR
  #undef PIN
  #undef MX3
  #undef GAPA
  #undef GAPB
  #undef EX
  #undef VRD
  #undef KRD
  #undef STEP
  #undef ENDW
  {auto rr=__builtin_amdgcn_permlane32_swap(__float_as_uint(l_reg),__float_as_uint(l_reg),false,false);l_reg=__uint_as_float(rr[0])+__uint_as_float(rr[1]);}
  if(hi==0)wsf[32+r32]=l_reg;asm volatile("s_waitcnt lgkmcnt(0)":::"memory");
  float rli[16];
  #pragma unroll
  for(int r=0;r<16;++r)rli[r]=__builtin_amdgcn_rcpf(wsf[32+crow(r,hi)]);
  bf16*Ow=O0+(long)(wid*QBLK)*OP;
  { bf16*stg=(bf16*)(shm+LDS_OST)+wid*2048;
    #pragma unroll
    for(int r=0;r<16;++r){const int orow=crow(r,hi);
      #pragma unroll
      for(int d0=0;d0<2;++d0)stg[orow*64+d0*32+r32]=__float2bfloat16(o[d0][r]*rli[r]);}
    asm volatile("s_waitcnt lgkmcnt(0)":::"memory");
    #pragma unroll
    for(int i=0;i<4;++i){const int row=i*8+(lane>>3),ch=lane&7; const u32x4 v=*(const u32x4*)(stg+row*64+ch*8); ATTN_STORE16(Ow+(long)row*OP+ch*8,v);} }
  asm volatile("s_waitcnt lgkmcnt(0)\n\ts_barrier":::"memory");
  #undef DMA_K
  #undef DMA_V
  #undef CMASK
  #undef START
  #undef RESC
  #undef ROT
}
constexpr int ATTN_LDS_BYTES=LDS_BYTES;
#undef SBAR
#undef WAIT_BAR
}

constexpr int DM = 1024, BATCH = 8, SEQ = 4096, DEPTH = 4, CTXL = 256, DFF = 2816;
constexpr int MX = BATCH * SEQ, MC = BATCH * CTXL, MALL = MX + MC;
constexpr int INW = 2080, INWP = 2304, KVLEN = CTXL + SEQ, NCH = KVLEN / 64;
constexpr float EPS = 1e-6f;
constexpr float QSCALE = 0.125f * 1.4426950408889634f;
constexpr int PC_CA = 0, PC_CG = 256, PC_GQ = 512, PC_GK = 640, PC_GV = 768, PC_GR = 1024, PC_GF = 1280, PC_AQ = 1312, PC_AK = 1824;
constexpr size_t MiB = 1u << 20;
constexpr size_t WS_W1T = 0, WS_W2T = 88 * MiB, WS_WINT = 132 * MiB, WS_WOT = 150 * MiB, WS_MOD = 158 * MiB, WS_XN = 160 * MiB, WS_CAT = 228 * MiB,
                 WS_HP = 296 * MiB, WS_Q = 483 * MiB, WS_K = 517 * MiB, WS_V = 526 * MiB, WS_CTXR = 535 * MiB, WS_GDS = 543 * MiB, WS_GDEC = 577 * MiB, WS_CTL = 578 * MiB, WS_SSQ = 579 * MiB, WS_SW = 581 * MiB, WS_END = 584 * MiB;
constexpr size_t W1T_SZ = (size_t)2 * DFF * DM, W2T_SZ = (size_t)DM * DFF, WINT_SZ = (size_t)INWP * DM, WOT_SZ = (size_t)DM * DM;
static_assert(8 * W1T_SZ * 2 <= WS_W2T - WS_W1T && 8 * W2T_SZ * 2 <= WS_WINT - WS_W2T && 4 * WINT_SZ * 2 <= WS_WOT - WS_WINT && 4 * WOT_SZ * 2 <= WS_MOD - WS_WOT, "ws map W");
static_assert((size_t)MALL * DM * 2 <= WS_CAT - WS_XN && (size_t)MALL * DM * 2 <= WS_HP - WS_CAT && (size_t)MALL * DFF * 2 <= WS_Q - WS_HP && (size_t)MALL * 512 * 2 <= WS_K - WS_Q, "ws map act");
static_assert((size_t)BATCH * KVLEN * 128 * 2 <= WS_V - WS_K && (size_t)MC * DM * 4 <= WS_GDS - WS_CTXR && (size_t)BATCH * 2 * NCH * 4 * 2048 * 4 <= WS_GDEC - WS_GDS, "ws map 2");
constexpr int LDS_BYTES = 147456;
constexpr int NPH_LAYER = 9, NPHASES = 2 + DEPTH * NPH_LAYER;
constexpr int SWN = 2 * DFF;
static_assert((size_t)DEPTH * 3 * MALL * 4 <= WS_SW - WS_SSQ && (size_t)DEPTH * 3 * 9 * SWN * 4 <= WS_END - WS_SW, "ws map 3");

typedef unsigned short bf16_t;
typedef float f32x4 __attribute__((ext_vector_type(4)));
typedef unsigned u32x4 __attribute__((ext_vector_type(4)));
typedef unsigned u32x2 __attribute__((ext_vector_type(2)));
typedef float f32x2v __attribute__((ext_vector_type(2)));
#define LDSP __attribute__((address_space(3)))
#define LDS_WAIT() asm volatile("s_waitcnt lgkmcnt(0)" ::: "memory")
__device__ __forceinline__ unsigned pk2(float lo, float hi) { return pg8::cvt_pk_bf16(lo, hi); }
__device__ __forceinline__ float bflo(unsigned w) { return __uint_as_float(w << 16); }
__device__ __forceinline__ float bfhi(unsigned w) { return __uint_as_float(w & 0xffff0000u); }
__device__ __forceinline__ void unpack8(const u32x4 r, float (&x)[8]) { x[0] = bflo(r.x); x[1] = bfhi(r.x); x[2] = bflo(r.y); x[3] = bfhi(r.y); x[4] = bflo(r.z); x[5] = bfhi(r.z); x[6] = bflo(r.w); x[7] = bfhi(r.w); }
__device__ __forceinline__ u32x4 pack8(const float (&x)[8]) { u32x4 w; w.x = pk2(x[0], x[1]); w.y = pk2(x[2], x[3]); w.z = pk2(x[4], x[5]); w.w = pk2(x[6], x[7]); return w; }
template <int X> __device__ __forceinline__ float swz_xor(float v) { return __int_as_float(__builtin_amdgcn_ds_swizzle(__float_as_int(v), 0x1f | (X << 10))); }
__device__ __forceinline__ float wave_sum(float v) {
    v += swz_xor<1>(v); v += swz_xor<2>(v); v += swz_xor<4>(v); v += swz_xor<8>(v); v += swz_xor<16>(v);
    auto rr = __builtin_amdgcn_permlane32_swap(__float_as_uint(v), __float_as_uint(v), false, false);
    return __uint_as_float(rr[0]) + __uint_as_float(rr[1]);
}
__device__ __forceinline__ float sigm(float v) { return __builtin_amdgcn_rcpf(1.0f + __expf(-v)); }

struct Args { const float* in[20]; float* out; unsigned char* ws; int ph_lo, ph_hi; };
typedef const __attribute__((address_space(4))) Args* KA;
enum { I_X = 0, I_C, I_CTX, I_CCTX, I_WADA, I_BADA, I_GNORM, I_WFI, I_WFO, I_WIN, I_WOUT, I_WDW, I_BDW, I_CNG, I_CNB, I_WGG, I_BGG, I_GLAG, I_QNG, I_KNG };

__device__ __forceinline__ void transpose_item(const float* W, int K, int N, bf16_t* WT, int kb, int nsrc, int ndst, LDSP float* scr, int lane) {
    const int k0 = 64 * kb;
#pragma unroll 8
    for (int i = 0; i < 32; ++i) { const int kk = 2 * i + (lane >> 5); scr[kk * 33 + (lane & 31)] = W[(size_t)(k0 + kk) * N + nsrc + (lane & 31)]; }
    LDS_WAIT();
    const int c = lane & 7;
#pragma unroll
    for (int j = 0; j < 4; ++j) { const int n = (lane >> 3) + 8 * j; const LDSP float* s = scr + (8 * c) * 33 + n;
        u32x4 o; o.x = pk2(s[0 * 33], s[1 * 33]); o.y = pk2(s[2 * 33], s[3 * 33]); o.z = pk2(s[4 * 33], s[5 * 33]); o.w = pk2(s[6 * 33], s[7 * 33]);
        *(u32x4*)(WT + (size_t)(ndst + n) * K + k0 + 8 * c) = o; }
    LDS_WAIT();
}
__device__ __forceinline__ void phase0(KA a, LDSP unsigned char* lds, int tid, int lane, int wave, int bid, int G) {
    unsigned char* ws = a->ws;
    LDSP float* scr = (LDSP float*)(lds + wave * 8704);
    const int gw = bid * 8 + wave, NGW = G * 8;
    constexpr int I1 = 16 * 176, I2 = 44 * 32, I3 = 16 * 65, I4 = 16 * 32, LI = 2 * I1 + 2 * I2 + I3 + I4;
    for (int it = gw; it < DEPTH * LI; it += NGW) {
        const int l = it / LI; int r = it % LI;
        if (r < 2 * I1) { const int f = r / I1, rr = r % I1, kb = rr / 176, nb = rr % 176, nsrc = nb * 32; const bool isu = nsrc >= DFF; const int j = isu ? nsrc - DFF : nsrc;
            transpose_item(a->in[I_WFI] + (size_t)(l * 2 + f) * DM * 2 * DFF, DM, 2 * DFF, (bf16_t*)(ws + WS_W1T) + (size_t)(l * 2 + f) * W1T_SZ, kb, nsrc, 256 * (j >> 7) + (isu ? 128 : 0) + (j & 127), scr, lane); continue; }
        r -= 2 * I1;
        if (r < 2 * I2) { const int f = r / I2, rr = r % I2, kb = rr / 32, nb = rr % 32;
            transpose_item(a->in[I_WFO] + (size_t)(l * 2 + f) * DFF * DM, DFF, DM, (bf16_t*)(ws + WS_W2T) + (size_t)(l * 2 + f) * W2T_SZ, kb, nb * 32, nb * 32, scr, lane); continue; }
        r -= 2 * I2;
        if (r < I3) { const int kb = r / 65, nb = r % 65;
            transpose_item(a->in[I_WIN] + (size_t)l * DM * INW, DM, INW, (bf16_t*)(ws + WS_WINT) + (size_t)l * WINT_SZ, kb, nb * 32, nb * 32, scr, lane); continue; }
        r -= I3;
        { const int kb = r / 32, nb = r % 32;
            transpose_item(a->in[I_WOUT] + (size_t)l * DM * DM, DM, DM, (bf16_t*)(ws + WS_WOT) + (size_t)l * WOT_SZ, kb, nb * 32, nb * 32, scr, lane); }
    }
    { constexpr int PV = (INWP - INW) * DM * 2 / 16;
        for (int i = bid * 512 + tid; i < DEPTH * PV; i += G * 512) { const int l = i / PV, r = i % PV;
            ((u32x4*)((bf16_t*)(ws + WS_WINT) + (size_t)l * WINT_SZ + (size_t)INW * DM))[r] = (u32x4){0u, 0u, 0u, 0u}; } }
    { float* SSQ = (float*)(ws + WS_SSQ); for (int i = bid * 512 + tid; i < DEPTH * 3 * MALL; i += G * 512) SSQ[i] = 0.f; }
    __syncthreads();
    LDSP float* S = (LDSP float*)(lds + 69632);
    LDSP float* red = (LDSP float*)(lds + 106496);
    for (int i = tid; i < 9 * 1024; i += 512) { const int r = i >> 10, k = i & 1023; const float cv = r < 8 ? a->in[I_C][r * 1024 + k] : a->in[I_CCTX][k]; S[i] = cv * sigm(cv); }
    __syncthreads();
    float* MOD = (float*)(ws + WS_MOD);
    for (int it = bid; it < DEPTH * 144; it += G) {
        const int l = it / 144, n0 = (it % 144) * 64;
        const float* Wp = a->in[I_WADA] + (size_t)l * DM * 9216 + n0 + lane;
        float acc[9];
#pragma unroll
        for (int r = 0; r < 9; ++r) acc[r] = 0.f;
#pragma unroll 8
        for (int kk = 0; kk < 128; ++kk) { const int k = wave * 128 + kk; const float w = Wp[(size_t)k * 9216];
#pragma unroll
            for (int r = 0; r < 9; ++r) acc[r] += S[r * 1024 + k] * w; }
#pragma unroll
        for (int r = 0; r < 9; ++r) red[(wave * 9 + r) * 64 + lane] = acc[r];
        __syncthreads();
        for (int o = tid; o < 576; o += 512) { const int r = o >> 6, ln = o & 63; float s = 0.f;
#pragma unroll
            for (int w = 0; w < 8; ++w) s += red[(w * 9 + r) * 64 + ln];
            MOD[(size_t)(l * 9 + r) * 9216 + n0 + ln] = s + a->in[I_BADA][l * 9216 + n0 + ln]; }
        __syncthreads();
    }
}
__device__ __forceinline__ void phase1(KA a, LDSP unsigned char* lds, int tid, int lane, int wave, int bid, int G) {
    const float* MOD = (const float*)(a->ws + WS_MOD); bf16_t* XN = (bf16_t*)(a->ws + WS_XN); float* SSQ = (float*)(a->ws + WS_SSQ); float* SW = (float*)(a->ws + WS_SW);
    const float* g = a->in[I_GNORM];
    f32x4 nv[4];
    { const int m0 = bid * 8 + wave; if (m0 < MALL) { const float* xr0 = m0 >= MX ? a->in[I_CTX] + (size_t)(m0 - MX) * DM : a->in[I_X] + (size_t)m0 * DM;
#pragma unroll
        for (int q = 0; q < 4; ++q) nv[q] = ((const f32x4*)xr0)[lane + 64 * q]; } }
    for (int m = bid * 8 + wave; m < MALL; m += G * 8) {
        const bool isc = m >= MX;
        const float* md = MOD + (size_t)(isc ? 8 : (m >> 12)) * 9216;
        f32x4 v[4]; float ss = 0.f;
#pragma unroll
        for (int q = 0; q < 4; ++q) { v[q] = nv[q]; ss += (v[q].x * v[q].x + v[q].y * v[q].y) + (v[q].z * v[q].z + v[q].w * v[q].w); }
        { const int mn = m + G * 8; if (mn < MALL) { const float* xrn = mn >= MX ? a->in[I_CTX] + (size_t)(mn - MX) * DM : a->in[I_X] + (size_t)mn * DM;
#pragma unroll
            for (int q = 0; q < 4; ++q) nv[q] = ((const f32x4*)xrn)[lane + 64 * q]; } }
        ss = wave_sum(ss);
        if (lane == 0) SSQ[m] = ss;
#pragma unroll
        for (int q = 0; q < 4; ++q) { const int col = 4 * lane + 256 * q;
            const f32x4 y = v[q] * *(const f32x4*)(g + col) * (*(const f32x4*)(md + 1024 + col) + 1.0f);
            u32x2 o; o.x = pk2(y.x, y.y); o.y = pk2(y.z, y.w);
            *(u32x2*)(XN + (size_t)m * DM + col) = o;
            typedef _Float16 h16x4 __attribute__((ext_vector_type(4)));
            *(h16x4*)((_Float16*)(a->ws + WS_CAT) + (size_t)m * DM + col) = __builtin_convertvector(v[q], h16x4); }
    }
    LDSP float* SH = (LDSP float*)lds;
    constexpr int RPL = 2 * DFF + INWP + 2 * DFF;
#pragma unroll 1
    for (int l = 0; l < DEPTH; ++l) {
        __syncthreads();
        for (int i = tid; i < 27 * 256; i += 512) { const int v = i >> 8, j = v / 9, bi = v % 9, c4 = (i & 255) * 4; *(LDSP f32x4*)(SH + v * 1024 + c4) = *(const f32x4*)(MOD + (size_t)(l * 9 + bi) * 9216 + (3 * j) * 1024 + c4); }
        __syncthreads();
        const bf16_t* w0b = (const bf16_t*)(a->ws + WS_W1T) + (size_t)(l * 2) * W1T_SZ; const bf16_t* w1b = (const bf16_t*)(a->ws + WS_WINT) + (size_t)l * WINT_SZ; const bf16_t* w2b = (const bf16_t*)(a->ws + WS_W1T) + (size_t)(l * 2 + 1) * W1T_SZ;
#define SW_ROWPTR(rr) ((rr) < 2 * DFF ? w0b + (size_t)(rr) * DM : ((rr) < 2 * DFF + INWP ? w1b + (size_t)((rr) - 2 * DFF) * DM : w2b + (size_t)((rr) - 2 * DFF - INWP) * DM))
        u32x4 nx0 = {0u, 0u, 0u, 0u}, nx1 = {0u, 0u, 0u, 0u};
        { const int r0 = bid * 8 + wave; if (r0 < RPL) { const bf16_t* p = SW_ROWPTR(r0); nx0 = *(const u32x4*)(p + lane * 8); nx1 = *(const u32x4*)(p + 512 + lane * 8); } }
#pragma unroll 1
        for (int r = bid * 8 + wave; r < RPL; r += G * 8) {
            float w0[8], w1[8]; unpack8(nx0, w0); unpack8(nx1, w1);
            { const int rn = r + G * 8; if (rn < RPL) { const bf16_t* p = SW_ROWPTR(rn); nx0 = *(const u32x4*)(p + lane * 8); nx1 = *(const u32x4*)(p + 512 + lane * 8); } }
            const int j = r < 2 * DFF ? 0 : (r < 2 * DFF + INWP ? 1 : 2), rj = r - (j == 0 ? 0 : (j == 1 ? 2 * DFF : 2 * DFF + INWP));
#pragma unroll
            for (int bi = 0; bi < 9; ++bi) { LDSP const float* sh = SH + (j * 9 + bi) * 1024 + lane * 8;
                const f32x4 s0 = *(LDSP const f32x4*)(sh), s1 = *(LDSP const f32x4*)(sh + 4), s2 = *(LDSP const f32x4*)(sh + 512), s3 = *(LDSP const f32x4*)(sh + 516);
                float d = (w0[0] * s0.x + w0[1] * s0.y) + (w0[2] * s0.z + w0[3] * s0.w) + (w0[4] * s1.x + w0[5] * s1.y) + (w0[6] * s1.z + w0[7] * s1.w)
                        + (w1[0] * s2.x + w1[1] * s2.y) + (w1[2] * s2.z + w1[3] * s2.w) + (w1[4] * s3.x + w1[5] * s3.y) + (w1[6] * s3.z + w1[7] * s3.w);
                d = wave_sum(d);
                if (lane == 0) SW[((size_t)(l * 3 + j) * 9 + bi) * SWN + rj] = d; } }
#undef SW_ROWPTR
    }
    __syncthreads();
}
__device__ __forceinline__ void prep_phase(KA a, LDSP unsigned char* lds, int l, int tid, int lane, int wave, int bid, int G) {
    LDSP f32x2v* CS = (LDSP f32x2v*)(lds);
    for (int i = tid; i < 1024; i += 512) { const int pos = i >> 4, f = i & 15;
        const float freq = exp2f(-(float)f * (13.287712379549449f / 16.0f)); const float ang = (float)pos * freq;
        float rev = ang * 0.15915494309189535f; rev -= floorf(rev);
        CS[i] = (f32x2v){__builtin_amdgcn_cosf(rev), __builtin_amdgcn_sinf(rev)}; }
    __syncthreads();
    const bf16_t* P = (const bf16_t*)(a->ws + WS_HP); bf16_t* Q = (bf16_t*)(a->ws + WS_Q); bf16_t* Kb = (bf16_t*)(a->ws + WS_K); bf16_t* Vb = (bf16_t*)(a->ws + WS_V);
    const int sub = lane & 7, axis = sub >> 2, half = (sub >> 1) & 1, f0 = (sub & 1) * 8;
    float qg[8], kg[8];
#pragma unroll
    for (int e = 0; e < 8; ++e) { qg[e] = a->in[I_QNG][l * 64 + sub * 8 + e]; kg[e] = a->in[I_KNG][l * 64 + sub * 8 + e]; }
    u32x4 nq = {0u, 0u, 0u, 0u}, nk_ = {0u, 0u, 0u, 0u};
    { const int m0 = bid * 8 + wave; if (m0 < MALL) { nq = *(const u32x4*)(P + (size_t)m0 * INWP + PC_AQ + lane * 8); nk_ = *(const u32x4*)(P + (size_t)m0 * INWP + PC_AK + (lane & 31) * 8); } }
    for (int m = bid * 8 + wave; m < MALL; m += G * 8) {
        const u32x4 rawq = nq, rawk = nk_;
        asm volatile("" :: "v"(rawq), "v"(rawk) : "memory");
        { const int mn = m + G * 8; if (mn < MALL) { nq = *(const u32x4*)(P + (size_t)mn * INWP + PC_AQ + lane * 8); nk_ = *(const u32x4*)(P + (size_t)mn * INWP + PC_AK + (lane & 31) * 8); } }
        asm volatile("" ::: "memory");
        const bool lat = m < MX;
        const int b = lat ? (m >> 12) : ((m - MX) >> 8), t = lat ? (m & 4095) : 0, pos = lat ? (CTXL + t) : ((m - MX) & 255);
        const int p = axis ? (t & 63) : (t >> 6);
        const bf16_t* pr = P + (size_t)m * INWP;
        float x[8], y[8];
        { const u32x4 raw = rawq; unpack8(raw, x);
            float ss = 0.f;
#pragma unroll
            for (int e = 0; e < 8; ++e) ss += x[e] * x[e];
            ss += swz_xor<1>(ss); ss += swz_xor<2>(ss); ss += swz_xor<4>(ss);
            const float rstd = 1.0f / sqrtf(ss * (1.0f / 64.0f) + EPS);
#pragma unroll
            for (int e = 0; e < 8; ++e) y[e] = x[e] * rstd * qg[e];
            if (lat) {
#pragma unroll
                for (int e = 0; e < 8; ++e) { const float o = swz_xor<2>(y[e]); const f32x2v cs = CS[p * 16 + f0 + e]; x[e] = half ? (y[e] * cs.x + o * cs.y) : (y[e] * cs.x - o * cs.y); }
            } else {
#pragma unroll
                for (int e = 0; e < 8; ++e) x[e] = y[e];
            }
#pragma unroll
            for (int e = 0; e < 8; ++e) x[e] *= QSCALE;
            *(u32x4*)(Q + (size_t)m * 512 + lane * 8) = pack8(x); }
        { const u32x4 raw = rawk; unpack8(raw, x);
            float ss = 0.f;
#pragma unroll
            for (int e = 0; e < 8; ++e) ss += x[e] * x[e];
            ss += swz_xor<1>(ss); ss += swz_xor<2>(ss); ss += swz_xor<4>(ss);
            const float rstd = 1.0f / sqrtf(ss * (1.0f / 64.0f) + EPS);
#pragma unroll
            for (int e = 0; e < 8; ++e) y[e] = x[e] * rstd * kg[e];
            if (lat) {
#pragma unroll
                for (int e = 0; e < 8; ++e) { const float o = swz_xor<2>(y[e]); const f32x2v cs = CS[p * 16 + f0 + e]; x[e] = half ? (y[e] * cs.x + o * cs.y) : (y[e] * cs.x - o * cs.y); }
            } else {
#pragma unroll
                for (int e = 0; e < 8; ++e) x[e] = y[e];
            }
            const size_t kvrow = ((size_t)b * KVLEN + pos) * 128;
            if (lane < 16) *(u32x4*)(Kb + kvrow + lane * 8) = pack8(x);
            else if (lane < 32) *(u32x4*)(Vb + kvrow + (lane - 16) * 8) = raw; }
    }
    __syncthreads();
}
__device__ __forceinline__ void conv_phase(KA a, LDSP unsigned char* lds, int l, bool last, int tid, int lane, int bid, int G) {
    LDSP float* hs = (LDSP float*)lds;
    LDSP bf16_t* os = (LDSP bf16_t*)(lds + 94 * 256 * 4);
    const bf16_t* P = (const bf16_t*)(a->ws + WS_HP); bf16_t* CAT = (bf16_t*)a->out;
    const int c = tid & 255, hf = tid >> 8;
    float w[31];
#pragma unroll
    for (int k = 0; k < 31; ++k) w[k] = a->in[I_WDW][(size_t)(l * 31 + k) * 256 + c];
    const float bias = a->in[I_BDW][l * 256 + c], gg = a->in[I_CNG][l * 256 + c], bb = a->in[I_CNB][l * 256 + c];
    const int nitems = last ? 512 : 544;
    for (int it = bid; it < nitems; it += G) {
        int base, len, t0;
        if (it < 512) { base = (it >> 6) * SEQ; len = SEQ; t0 = (it & 63) * 64; } else { const int i2 = it - 512; base = MX + (i2 >> 2) * CTXL; len = CTXL; t0 = (i2 & 3) * 64; }
        for (int rr = tid >> 5; rr < 94; rr += 16) { const int t = t0 - 15 + rr, c8 = (tid & 31) * 8;
            float h[8];
            if (t >= 0 && t < len) { const bf16_t* pr = P + (size_t)(base + t) * INWP + c8; float av[8], gv[8];
                unpack8(*(const u32x4*)(pr + PC_CA), av); unpack8(*(const u32x4*)(pr + PC_CG), gv);
#pragma unroll
                for (int e = 0; e < 8; ++e) h[e] = av[e] * sigm(gv[e]);
            } else {
#pragma unroll
                for (int e = 0; e < 8; ++e) h[e] = 0.f;
            }
            *(LDSP f32x4*)(hs + rr * 256 + c8) = (f32x4){h[0], h[1], h[2], h[3]}; *(LDSP f32x4*)(hs + rr * 256 + c8 + 4) = (f32x4){h[4], h[5], h[6], h[7]}; }
        __syncthreads();
#pragma unroll 1
        for (int i0 = 0; i0 < 32; i0 += 4) { const int ib = hf * 32 + i0;
            float xw[34];
#pragma unroll
            for (int k = 0; k < 34; ++k) xw[k] = hs[(ib + k) * 256 + c];
            float acc[4], mean[4], var[4];
#pragma unroll
            for (int t = 0; t < 4; ++t) { float s_ = bias;
#pragma unroll
                for (int k = 0; k < 31; ++k) s_ += w[k] * xw[t + k];
                acc[t] = s_; mean[t] = s_; }
#pragma unroll
            for (int t = 0; t < 4; ++t) mean[t] += swz_xor<1>(mean[t]);
#pragma unroll
            for (int t = 0; t < 4; ++t) mean[t] += swz_xor<2>(mean[t]);
#pragma unroll
            for (int t = 0; t < 4; ++t) mean[t] += swz_xor<4>(mean[t]);
#pragma unroll
            for (int t = 0; t < 4; ++t) mean[t] += swz_xor<8>(mean[t]);
#pragma unroll
            for (int t = 0; t < 4; ++t) mean[t] += swz_xor<16>(mean[t]);
#pragma unroll
            for (int t = 0; t < 4; ++t) { auto rr = __builtin_amdgcn_permlane32_swap(__float_as_uint(mean[t]), __float_as_uint(mean[t]), false, false);
                mean[t] = (__uint_as_float(rr[0]) + __uint_as_float(rr[1])) * (1.0f / 64.0f); acc[t] -= mean[t]; var[t] = acc[t] * acc[t]; }
#pragma unroll
            for (int t = 0; t < 4; ++t) var[t] += swz_xor<1>(var[t]);
#pragma unroll
            for (int t = 0; t < 4; ++t) var[t] += swz_xor<2>(var[t]);
#pragma unroll
            for (int t = 0; t < 4; ++t) var[t] += swz_xor<4>(var[t]);
#pragma unroll
            for (int t = 0; t < 4; ++t) var[t] += swz_xor<8>(var[t]);
#pragma unroll
            for (int t = 0; t < 4; ++t) var[t] += swz_xor<16>(var[t]);
#pragma unroll
            for (int t = 0; t < 4; ++t) { auto rr = __builtin_amdgcn_permlane32_swap(__float_as_uint(var[t]), __float_as_uint(var[t]), false, false);
                const float vv = (__uint_as_float(rr[0]) + __uint_as_float(rr[1])) * (1.0f / 64.0f);
                const float y = acc[t] * __builtin_amdgcn_rsqf(vv + EPS) * gg + bb;
                const float o = y * sigm(y);
                os[(ib + t) * 256 + c] = (bf16_t)(pk2(o, 0.f) & 0xffffu); } }
        __syncthreads();
        for (int q = tid; q < 2048; q += 512) { const int row = q >> 5, c8 = (q & 31) * 8;
            *(u32x4*)(CAT + (size_t)(base + t0 + row) * DM + c8) = *(const LDSP u32x4*)(os + row * 256 + c8); }
        __syncthreads();
    }
}
typedef short gbf16x8 __attribute__((ext_vector_type(8)));
constexpr int GB_WG = 106496, GB_BG = 106496 + 16384;
constexpr int GB_Q = 0, GB_K = 8448, GB_GF = 16896, GB_GB = 20992, GB_VT = 25088, GB_S0T = 34304, GB_QE = 42496, GB_KE = 50688, GB_KENDT = 58880, GB_ATT = 68096, GB_TOT = 86528, GB_O = 88576, GB_END = 105984;
constexpr int VTP = 72, ATP = 72, KTP = 72, OP_ = 68;
static_assert(GB_END <= 131072 && GB_VT + 64 * VTP * 2 == GB_S0T && GB_ATT + 2 * 64 * ATP * 2 == GB_TOT && GB_O + 64 * OP_ * 4 == GB_END, "gla lds");
__device__ __forceinline__ int gla_row(int b, int c, int i) { return c < 4 ? MX + b * CTXL + c * 64 + i : b * SEQ + (c - 4) * 64 + i; }
__device__ __forceinline__ void st_bf16(LDSP unsigned char* base, int byteoff, float v) { *(LDSP bf16_t*)(base + byteoff) = (bf16_t)(pk2(v, 0.f) & 0xffffu); }
struct GlaRegs { u32x4 qk, gt, vv, rg; f32x4 s0[2], gg[2]; };
template <bool G3> __device__ __forceinline__ void gla_issue(KA a, GlaRegs& R, const float* ggb, int b, int c, int h, int tid) {
    const bf16_t* P = (const bf16_t*)(a->ws + WS_HP);
    { const int i = (tid & 255) >> 2, part = tid & 3; const bf16_t* pr = P + (size_t)gla_row(b, c, i) * INWP;
        R.qk = (u32x4){0u, 0u, 0u, 0u};
        if (G3 || tid >= 256) R.qk = *(const u32x4*)(pr + (tid < 256 ? PC_GQ : PC_GK) + h * 32 + part * 8);
        R.gt = *(const u32x4*)(pr + PC_GF + part * 8); }
    { const int j = tid >> 3, part = tid & 7; R.vv = *(const u32x4*)(P + (size_t)gla_row(b, c, j) * INWP + PC_GV + h * 64 + part * 8); }
    if (G3) { const float* DS = (const float*)(a->ws + WS_GDS);
#pragma unroll
        for (int dir = 0; dir < 2; ++dir) { const size_t ci = ((size_t)(b * 2 + dir) * NCH + c) * 4 + h; R.s0[dir] = *(const f32x4*)(DS + ci * 2048 + (tid >> 4) * 64 + (tid & 15) * 4); }
        R.rg = *(const u32x4*)(P + (size_t)gla_row(b, c, tid >> 3) * INWP + PC_GR + h * 64 + (tid & 7) * 8);
        R.gg[0] = *(const f32x4*)(ggb + h * 64 + (tid & 7) * 8); R.gg[1] = *(const f32x4*)(ggb + h * 64 + (tid & 7) * 8 + 4); }
}
template <bool G3> __device__ __forceinline__ void gla_stage(KA a, LDSP unsigned char* B, const GlaRegs& R, int l, int b, int c, int h, int tid) {
    LDSP float* Qf = (LDSP float*)(B + GB_Q); LDSP float* Kf = (LDSP float*)(B + GB_K); LDSP float* GF = (LDSP float*)(B + GB_GF); LDSP float* GBk = (LDSP float*)(B + GB_GB);
    { const int i = (tid & 255) >> 2, part = tid & 3;
        float x[8]; unpack8(R.qk, x);
        if (tid < 256) {
            if (G3) {
#pragma unroll
                for (int e = 0; e < 8; ++e) Qf[i * 33 + part * 8 + e] = x[e]; }
            unpack8(R.gt, x);
#pragma unroll
            for (int e = 0; e < 8; ++e) (part < 2 ? GF : GBk)[i * 16 + (part & 1) * 8 + e] = x[e];
        } else {
#pragma unroll
            for (int e = 0; e < 8; ++e) Kf[i * 33 + part * 8 + e] = x[e]; } }
    { const int j = tid >> 3, part = tid & 7; const u32x4 r = R.vv;
        const unsigned w[4] = {r.x, r.y, r.z, r.w};
#pragma unroll
        for (int e = 0; e < 8; ++e) *(LDSP bf16_t*)(B + GB_VT + ((part * 8 + e) * VTP + j) * 2) = (bf16_t)((e & 1) ? (w[e >> 1] >> 16) : (w[e >> 1] & 0xffffu)); }
    if (G3) {
#pragma unroll
        for (int dir = 0; dir < 2; ++dir) { const int d = tid >> 4, v4 = (tid & 15) * 4; const f32x4 sv = R.s0[dir];
            st_bf16(B, GB_S0T + dir * 4096 + ((v4 + 0) * 32 + d) * 2, sv.x); st_bf16(B, GB_S0T + dir * 4096 + ((v4 + 1) * 32 + d) * 2, sv.y);
            st_bf16(B, GB_S0T + dir * 4096 + ((v4 + 2) * 32 + d) * 2, sv.z); st_bf16(B, GB_S0T + dir * 4096 + ((v4 + 3) * 32 + d) * 2, sv.w); } }
    __syncthreads();
    const int dir = tid >> 8, seg = (tid >> 5) & 7, d = tid & 31;
    float p[8], qv[8], kv[8];
    { LDSP const float* Wg = (LDSP const float*)(B + GB_WG) + (dir * 16) * 128 + h * 32 + d; const float bg = ((LDSP const float*)(B + GB_BG))[dir * 128 + h * 32 + d];
        float wc[16];
#pragma unroll
        for (int r = 0; r < 16; ++r) wc[r] = Wg[r * 128];
        LDSP const float* gs = dir ? GBk : GF;
#pragma unroll
        for (int r = 0; r < 8; ++r) { const int i = dir ? 63 - (seg * 8 + r) : seg * 8 + r; kv[r] = Kf[i * 33 + d]; qv[r] = G3 ? Qf[i * 33 + d] : 0.f; }
        float run = 0.f;
#pragma unroll
        for (int hb = 0; hb < 2; ++hb) {
            f32x4 gq[4][4];
#pragma unroll
            for (int r = 0; r < 4; ++r) { const int i = dir ? 63 - (seg * 8 + hb * 4 + r) : seg * 8 + hb * 4 + r;
#pragma unroll
                for (int q = 0; q < 4; ++q) gq[r][q] = *(LDSP const f32x4*)(gs + i * 16 + 4 * q); }
#pragma unroll
            for (int r = 0; r < 4; ++r) { float z0 = bg, z1 = 0.f, z2 = 0.f, z3 = 0.f;
#pragma unroll
                for (int q = 0; q < 4; ++q) { z0 += gq[r][q].x * wc[4 * q]; z1 += gq[r][q].y * wc[4 * q + 1]; z2 += gq[r][q].z * wc[4 * q + 2]; z3 += gq[r][q].w * wc[4 * q + 3]; }
                const float z = (z0 + z1) + (z2 + z3);
                const float ls = fminf(z, 0.f) - __logf(1.0f + __expf(-fabsf(z)));
                run += ls * (1.0f / 16.0f); p[hb * 4 + r] = run; } }
        ((LDSP float*)(B + GB_TOT))[(dir * 8 + seg) * 32 + d] = run; }
    __syncthreads();
    float off = 0.f, bl = 0.f;
#pragma unroll
    for (int sg = 0; sg < 8; ++sg) { const float t = ((LDSP const float*)(B + GB_TOT))[(dir * 8 + sg) * 32 + d]; bl += t; off += (sg < seg) ? t : 0.f; }
    float o1[8], o2[8];
#pragma unroll
    for (int r = 0; r < 8; ++r) { const float bc = p[r] + off;
        if (G3) { o1[r] = qv[r] * 0.17677669529663687f * __expf(bc); o2[r] = kv[r] * __expf(-bc); }
        else { o1[r] = kv[r] * __expf(bl - bc); o2[r] = 0.f; } }
#pragma unroll
    for (int r = 0; r < 8; ++r) { const int i = dir ? 63 - (seg * 8 + r) : seg * 8 + r;
        if (G3) { st_bf16(B, GB_QE + dir * 4096 + (i * 32 + d) * 2, o1[r]); st_bf16(B, GB_KE + dir * 4096 + (i * 32 + d) * 2, o2[r]); }
        else st_bf16(B, GB_KENDT + dir * (32 * KTP * 2) + (d * KTP + i) * 2, o1[r]); }
    if (!G3 && seg == 0) ((float*)(a->ws + WS_GDEC))[(((size_t)(b * 2 + dir) * NCH + c) * 4 + h) * 32 + d] = __expf(bl);
    __syncthreads();
}
__device__ __forceinline__ void gla_g1_phase(KA a, LDSP unsigned char* lds, int l, int tid, int bid, int G) {
    float* DS = (float*)(a->ws + WS_GDS);
    const int lane = tid & 63, w = tid >> 6, fr = lane & 15, fq = lane >> 4;
    for (int i = tid; i < 2 * 16 * 128; i += 512) ((LDSP float*)(lds + GB_WG))[i] = a->in[I_WGG][(size_t)l * 2 * 16 * 128 + i];
    if (tid < 256) ((LDSP float*)(lds + GB_BG))[tid] = a->in[I_BGG][l * 256 + tid];
    __syncthreads();
    GlaRegs R, Rn;
    if (bid < BATCH * NCH * 4) gla_issue<false>(a, Rn, nullptr, (bid >> 2) / NCH, (bid >> 2) % NCH, bid & 3, tid);
    for (int it = bid; it < BATCH * NCH * 4; it += G) {
        const int h = it & 3, c = (it >> 2) % NCH, b = (it >> 2) / NCH;
        R = Rn;
        gla_stage<false>(a, lds, R, l, b, c, h, tid);
        asm volatile("" ::: "memory");
        { const int itn = it + G; if (itn < BATCH * NCH * 4) gla_issue<false>(a, Rn, nullptr, (itn >> 2) / NCH, (itn >> 2) % NCH, itn & 3, tid); }
        asm volatile("" ::: "memory");
        const int dir = w >> 2, dt = (w >> 1) & 1;
        const size_t ci = ((size_t)(b * 2 + dir) * NCH + c) * 4 + h;
        gbf16x8 af[2];
#pragma unroll
        for (int sx = 0; sx < 2; ++sx) af[sx] = *(LDSP const gbf16x8*)(lds + GB_KENDT + dir * (32 * KTP * 2) + ((dt * 16 + fr) * KTP + sx * 32 + fq * 8) * 2);
#pragma unroll
        for (int t = 0; t < 2; ++t) { const int vt = (w & 1) * 2 + t; f32x4 acc = {0.f, 0.f, 0.f, 0.f};
#pragma unroll
            for (int sx = 0; sx < 2; ++sx) { const gbf16x8 bf = *(LDSP const gbf16x8*)(lds + GB_VT + ((vt * 16 + fr) * VTP + sx * 32 + fq * 8) * 2);
                acc = __builtin_amdgcn_mfma_f32_16x16x32_bf16(af[sx], bf, acc, 0, 0, 0); }
#pragma unroll
            for (int r = 0; r < 4; ++r) DS[ci * 2048 + (size_t)(dt * 16 + fq * 4 + r) * 64 + vt * 16 + fr] = acc[r]; }
        __syncthreads();
    }
}
__device__ __forceinline__ void gla_g2_phase(KA a, int tid, int bid, int G) {
    float* DS = (float*)(a->ws + WS_GDS); const float* DEC = (const float*)(a->ws + WS_GDEC);
    for (int e = bid * 512 + tid; e < BATCH * 2 * 4 * 2048; e += G * 512) {
        const int dv = e & 2047, h = (e >> 11) & 3, dir = (e >> 13) & 1, b = e >> 14, d = dv >> 6;
        float S = 0.f;
#pragma unroll 4
        for (int st = 0; st < NCH; ++st) { const int c = dir ? (st < 4 ? 3 - st : 71 - st) : st;
            const size_t ci = ((size_t)(b * 2 + dir) * NCH + c) * 4 + h;
            const float dsv = DS[ci * 2048 + dv], dec = DEC[ci * 32 + d];
            DS[ci * 2048 + dv] = S; S = dec * S + dsv; }
    }
}
__device__ __forceinline__ void gla_g3_phase(KA a, LDSP unsigned char* lds, int l, bool last, int tid, int bid, int G) {
    const bf16_t* P = (const bf16_t*)(a->ws + WS_HP); bf16_t* CAT = (bf16_t*)a->out;
    const int lane = tid & 63, w = tid >> 6, fr = lane & 15, fq = lane >> 4, it_ = w >> 1;
    for (int i = tid; i < 2 * 16 * 128; i += 512) ((LDSP float*)(lds + GB_WG))[i] = a->in[I_WGG][(size_t)l * 2 * 16 * 128 + i];
    if (tid < 256) ((LDSP float*)(lds + GB_BG))[tid] = a->in[I_BGG][l * 256 + tid];
    __syncthreads();
    const int c_lo = last ? 4 : 0, ncs = NCH - c_lo, nit = BATCH * ncs * 4;
    GlaRegs R, Rn;
    if (bid < nit) gla_issue<true>(a, Rn, a->in[I_GLAG] + (size_t)l * 256, (bid >> 2) / ncs, c_lo + (bid >> 2) % ncs, bid & 3, tid);
    for (int it = bid; it < nit; it += G) {
        const int h = it & 3, c = c_lo + (it >> 2) % ncs, b = (it >> 2) / ncs;
        R = Rn;
        gla_stage<true>(a, lds, R, l, b, c, h, tid);
        asm volatile("" ::: "memory");
        { const int itn = it + G; if (itn < nit) gla_issue<true>(a, Rn, a->in[I_GLAG] + (size_t)l * 256, (itn >> 2) / ncs, c_lo + (itn >> 2) % ncs, itn & 3, tid); }
        asm volatile("" ::: "memory");
        gbf16x8 qf[2], kf[2][2];
#pragma unroll
        for (int dir = 0; dir < 2; ++dir) { qf[dir] = *(LDSP const gbf16x8*)(lds + GB_QE + dir * 4096 + ((it_ * 16 + fr) * 32 + fq * 8) * 2);
#pragma unroll
            for (int t = 0; t < 2; ++t) kf[dir][t] = *(LDSP const gbf16x8*)(lds + GB_KE + dir * 4096 + ((((w & 1) * 2 + t) * 16 + fr) * 32 + fq * 8) * 2); }
        f32x4 s4[2][2];
#pragma unroll
        for (int dir = 0; dir < 2; ++dir)
#pragma unroll
            for (int t = 0; t < 2; ++t) { const f32x4 z = {0.f, 0.f, 0.f, 0.f}; s4[dir][t] = __builtin_amdgcn_mfma_f32_16x16x32_bf16(qf[dir], kf[dir][t], z, 0, 0, 0); }
#pragma unroll
        for (int dir = 0; dir < 2; ++dir)
#pragma unroll
            for (int t = 0; t < 2; ++t) { const int jt = (w & 1) * 2 + t;
#pragma unroll
                for (int r = 0; r < 4; ++r) { const int i = it_ * 16 + fq * 4 + r, j = jt * 16 + fr; const bool keep = dir ? (j >= i) : (j <= i);
                    st_bf16(lds, GB_ATT + dir * (64 * ATP * 2) + (i * ATP + j) * 2, keep ? s4[dir][t][r] : 0.f); } }
        __syncthreads();
        { gbf16x8 af[2][2], bfv[2][2], sf[2][2];
#pragma unroll
            for (int dir = 0; dir < 2; ++dir)
#pragma unroll
                for (int sx = 0; sx < 2; ++sx) af[dir][sx] = *(LDSP const gbf16x8*)(lds + GB_ATT + dir * (64 * ATP * 2) + ((it_ * 16 + fr) * ATP + sx * 32 + fq * 8) * 2);
#pragma unroll
            for (int t = 0; t < 2; ++t) { const int vt = (w & 1) * 2 + t;
#pragma unroll
                for (int sx = 0; sx < 2; ++sx) bfv[t][sx] = *(LDSP const gbf16x8*)(lds + GB_VT + ((vt * 16 + fr) * VTP + sx * 32 + fq * 8) * 2);
#pragma unroll
                for (int dir = 0; dir < 2; ++dir) sf[t][dir] = *(LDSP const gbf16x8*)(lds + GB_S0T + dir * 4096 + ((vt * 16 + fr) * 32 + fq * 8) * 2); }
            f32x4 acc[2];
#pragma unroll
            for (int t = 0; t < 2; ++t) { acc[t] = (f32x4){0.f, 0.f, 0.f, 0.f};
#pragma unroll
                for (int dir = 0; dir < 2; ++dir) {
#pragma unroll
                    for (int sx = 0; sx < 2; ++sx) acc[t] = __builtin_amdgcn_mfma_f32_16x16x32_bf16(af[dir][sx], bfv[t][sx], acc[t], 0, 0, 0);
                    acc[t] = __builtin_amdgcn_mfma_f32_16x16x32_bf16(qf[dir], sf[t][dir], acc[t], 0, 0, 0); } }
#pragma unroll
            for (int t = 0; t < 2; ++t) { const int vt = (w & 1) * 2 + t;
#pragma unroll
                for (int r = 0; r < 4; ++r) ((LDSP float*)(lds + GB_O))[(it_ * 16 + fq * 4 + r) * OP_ + vt * 16 + fr] = acc[t][r]; } }
        __syncthreads();
        { const int i = tid >> 3, vg = tid & 7;
            const f32x4 o0 = *(LDSP const f32x4*)(lds + GB_O + (i * OP_ + vg * 8) * 4), o1 = *(LDSP const f32x4*)(lds + GB_O + (i * OP_ + vg * 8 + 4) * 4);
            float ss = (o0.x * o0.x + o0.y * o0.y) + (o0.z * o0.z + o0.w * o0.w) + (o1.x * o1.x + o1.y * o1.y) + (o1.z * o1.z + o1.w * o1.w);
            ss += swz_xor<1>(ss); ss += swz_xor<2>(ss); ss += swz_xor<4>(ss);
            const float rstd = 1.0f / sqrtf(ss * (1.0f / 64.0f) + EPS);
            const int row = gla_row(b, c, i);
            const float gg[8] = {R.gg[0].x, R.gg[0].y, R.gg[0].z, R.gg[0].w, R.gg[1].x, R.gg[1].y, R.gg[1].z, R.gg[1].w};
            float r[8]; unpack8(R.rg, r);
            float y[8] = {o0.x, o0.y, o0.z, o0.w, o1.x, o1.y, o1.z, o1.w};
#pragma unroll
            for (int e = 0; e < 8; ++e) y[e] = y[e] * rstd * gg[e] * (r[e] * sigm(r[e]));
            *(u32x4*)(CAT + (size_t)row * DM + 256 + h * 64 + vg * 8) = pack8(y); }
    }
}
__device__ __forceinline__ void ctx_gemm_res(KA a, LDSP unsigned char* lds, const bf16_t* A, const bf16_t* Bt, int K, const float* gate, float coef,
                                             _Float16* XR, bf16_t* XS, float* ssq, const float* gn, const float* scn, int tid, int bid, int G) {
    const int lane = tid & 63, w = tid >> 6, wm = w >> 1, wn = w & 1, fr = lane & 15, fq = lane >> 4;
    LDSP unsigned char* As = lds; LDSP unsigned char* Bs = lds + 18432; LDSP float* Cs = (LDSP float*)(lds + 32768);
    const int nk = K / 64, lr = tid >> 3, lc = (tid & 7) * 8;
    for (int u = bid; u < 256; u += G) {
        int tm = u >> 4, tn = u & 15;
        if (G == 256) { const int x = u & 7, sl = u >> 3; tm = (x & 3) * 4 + (sl >> 3); tn = (x >> 2) * 8 + (sl & 7); }
        const size_t row0 = (size_t)MX + tm * 128; const int col0 = tn * 64;
        const bf16_t* ap0 = A + (row0 + lr) * K + lc; const bf16_t* ap1 = ap0 + (size_t)64 * K; const bf16_t* bp = Bt + (size_t)(col0 + lr) * K + lc;
        u32x4 ra0[4], ra1[4], rb[4];
#pragma unroll
        for (int q = 0; q < 4; ++q) { ra0[q] = *(const u32x4*)(ap0 + q * 64); ra1[q] = *(const u32x4*)(ap1 + q * 64); rb[q] = *(const u32x4*)(bp + q * 64); }
        f32x4 acc[2][2];
#pragma unroll
        for (int mt = 0; mt < 2; ++mt)
#pragma unroll
            for (int nt = 0; nt < 2; ++nt) acc[mt][nt] = (f32x4){0.f, 0.f, 0.f, 0.f};
#pragma unroll 1
        for (int kt = 0; kt < nk; kt += 4) {
#pragma unroll
            for (int q = 0; q < 4; ++q) {
                *(LDSP u32x4*)(As + (lr * 72 + lc) * 2) = ra0[q]; *(LDSP u32x4*)(As + ((64 + lr) * 72 + lc) * 2) = ra1[q]; *(LDSP u32x4*)(Bs + (lr * 72 + lc) * 2) = rb[q];
                __syncthreads();
                if (kt + q + 4 < nk) { ra0[q] = *(const u32x4*)(ap0 + (kt + q + 4) * 64); ra1[q] = *(const u32x4*)(ap1 + (kt + q + 4) * 64); rb[q] = *(const u32x4*)(bp + (kt + q + 4) * 64); }
#pragma unroll
                for (int ks = 0; ks < 2; ++ks) { gbf16x8 af[2], bf[2];
#pragma unroll
                    for (int mt = 0; mt < 2; ++mt) af[mt] = *(LDSP const gbf16x8*)(As + ((wm * 32 + mt * 16 + fr) * 72 + ks * 32 + fq * 8) * 2);
#pragma unroll
                    for (int nt = 0; nt < 2; ++nt) bf[nt] = *(LDSP const gbf16x8*)(Bs + ((wn * 32 + nt * 16 + fr) * 72 + ks * 32 + fq * 8) * 2);
#pragma unroll
                    for (int mt = 0; mt < 2; ++mt)
#pragma unroll
                        for (int nt = 0; nt < 2; ++nt) acc[mt][nt] = __builtin_amdgcn_mfma_f32_16x16x32_bf16(af[mt], bf[nt], acc[mt][nt], 0, 0, 0); }
                __syncthreads();
            }
        }
#pragma unroll
        for (int mt = 0; mt < 2; ++mt)
#pragma unroll
            for (int nt = 0; nt < 2; ++nt)
#pragma unroll
                for (int r = 0; r < 4; ++r) Cs[(wm * 32 + mt * 16 + fq * 4 + r) * 68 + wn * 32 + nt * 16 + fr] = acc[mt][nt][r];
        __syncthreads();
        { const int rl = tid >> 2, cs = (tid & 3) * 16; const size_t grow = row0 + rl; const int gc = col0 + cs;
            float x[16];
            {
#pragma unroll
                for (int q = 0; q < 2; ++q) { const pg8::f32x8 t = __builtin_convertvector(*(const pg8::h16x8*)(XR + grow * 1024 + gc + 8 * q), pg8::f32x8);
#pragma unroll
                    for (int e = 0; e < 8; ++e) x[8 * q + e] = t[e]; } }
            const float* g = gate + (size_t)8 * 9216 + gc; const float* gnp = gn + gc; const float* scp = scn + (size_t)8 * 9216 + gc;
            float ss = 0.f, y[16];
#pragma unroll
            for (int q = 0; q < 4; ++q) { const f32x4 gv = *(const f32x4*)(g + 4 * q), cv = *(LDSP const f32x4*)(Cs + rl * 68 + cs + 4 * q), gg = *(const f32x4*)(gnp + 4 * q), sc = *(const f32x4*)(scp + 4 * q);
#pragma unroll
                for (int e = 0; e < 4; ++e) { const float xv = x[4 * q + e] + coef * gv[e] * cv[e]; x[4 * q + e] = xv; ss += xv * xv; y[4 * q + e] = xv * gg[e] * (sc[e] + 1.0f); } }
#pragma unroll
            for (int q = 0; q < 2; ++q) { const pg8::f32x8 t = {x[8 * q], x[8 * q + 1], x[8 * q + 2], x[8 * q + 3], x[8 * q + 4], x[8 * q + 5], x[8 * q + 6], x[8 * q + 7]};
                *(pg8::h16x8*)(XR + grow * 1024 + gc + 8 * q) = __builtin_convertvector(t, pg8::h16x8);
                u32x4 wv; wv.x = pk2(y[8 * q], y[8 * q + 1]); wv.y = pk2(y[8 * q + 2], y[8 * q + 3]); wv.z = pk2(y[8 * q + 4], y[8 * q + 5]); wv.w = pk2(y[8 * q + 6], y[8 * q + 7]);
                *(u32x4*)(XS + grow * 1024 + gc + 8 * q) = wv; }
            ss += swz_xor<1>(ss); ss += swz_xor<2>(ss);
            if ((tid & 3) == 0) atomicAdd(ssq + grow, ss); }
        __syncthreads();
    }
}
__device__ __forceinline__ void attn_phase(KA a, unsigned char* lds, bool last, int bid, int G) {
    using abf = attn_body::bf16;
    const abf* Q = (const abf*)(a->ws + WS_Q); const abf* Kb = (const abf*)(a->ws + WS_K); const abf* Vb = (const abf*)(a->ws + WS_V); abf* CAT = (abf*)a->out;
    const int nunits = last ? 1024 : 1088;
    const int nlat = bid < 1024 ? (1024 - bid + G - 1) / G : 0, c0 = G - 1 - bid, nctx = (nunits > 1024 && c0 < 64) ? (64 - c0 + G - 1) / G : 0;
    for (int i = 0; i < nlat + nctx; ++i) {
        const int u = (i < nlat) ? bid + i * G : 1024 + c0 + (i - nlat) * G;
        int b, h, NT; size_t qrow;
        if (u < 1024) { b = u >> 7; h = (u >> 4) & 7; qrow = (size_t)b * SEQ + (size_t)(u & 15) * 256; NT = NCH; }
        else { const int uc = u - 1024; b = uc >> 3; h = uc & 7; qrow = (size_t)MX + (size_t)b * CTXL; NT = 4; }
        const size_t kvo = (size_t)b * KVLEN * 128 + (h >> 2) * 64;
        attn_body::attn_unit<8>(Q + qrow * 512 + h * 64, Kb + kvo, Vb + kvo, CAT + qrow * DM + 512 + h * 64, NT, (char*)lds);
    }
}
#define XB_TMO      128
#define XB_XCNT(j)  (256  + 64 * (j))
#define XB_XSUB(j)  (1280 + 64 * (j))
#define XB_XGEN(j)  (2304 + 64 * (j))
#define XB_TOP      3328
#define XB_TOPGEN   3392
#define XCD_BAR_WORDS 3456
#define XB_SPIN_CAP (1u << 18)

__device__ __forceinline__ unsigned xb_ld(unsigned* p)              { return __hip_atomic_load(p, __ATOMIC_RELAXED, __HIP_MEMORY_SCOPE_AGENT); }
__device__ __forceinline__ unsigned xb_add(unsigned* p, unsigned v) { return __hip_atomic_fetch_add(p, v, __ATOMIC_RELAXED, __HIP_MEMORY_SCOPE_AGENT); }
__device__ __forceinline__ unsigned xb_xcc_id() { return (unsigned)__builtin_amdgcn_s_getreg((3 << 11) | 20) & 0xFu; }
#define XB_SPIN(cond, bar) do { unsigned _sp = 0; while (cond) { __builtin_amdgcn_s_sleep(1); \
    if ((++_sp & 255u) == 0u) { if (xb_ld(&(bar)[XB_TMO])) break; if (_sp > XB_SPIN_CAP) { atomicAdd(&(bar)[XB_TMO], 1u); break; } } } } while (0)

struct XcdBarrier {
    unsigned* bar; unsigned x;
    volatile LDSP unsigned* st;
};

__device__ __forceinline__ XcdBarrier xcd_barrier_post(unsigned* bar, volatile LDSP unsigned* st) {
    XcdBarrier b; b.bar = bar; b.x = xb_xcc_id(); b.st = st;
    if (threadIdx.x == 0) (void)xb_add(&bar[XB_XCNT(b.x)], 1u);
    return b;
}
__device__ __forceinline__ void xcd_barrier_complete(unsigned* bar, unsigned x, unsigned& nloc, unsigned& nx) {
    const unsigned G = gridDim.x * gridDim.y * gridDim.z;
    unsigned sum, cnt, mine, sp = 0u;
    for (;;) {
        sum = 0u; cnt = 0u; mine = 0u;
#pragma unroll
        for (unsigned j = 0; j < 16; ++j) { const unsigned c = xb_ld(&bar[XB_XCNT(j)]); sum += c; cnt += (c > 0u) ? 1u : 0u; mine = (j == x) ? c : mine; }
        if (sum == G) break;
        __builtin_amdgcn_s_sleep(1);
        if ((++sp & 255u) == 0u) { if (xb_ld(&bar[XB_TMO])) break; if (sp > XB_SPIN_CAP) { atomicAdd(&bar[XB_TMO], 1u); break; } }
    }
    nloc = mine > 0u ? mine : 1u; nx = cnt > 0u ? cnt : 1u;
}

__device__ __forceinline__ void xcd_barrier(const XcdBarrier& b) {
    asm volatile("s_waitcnt vmcnt(0)" ::: "memory");
    __syncthreads();
    if (threadIdx.x == 0) {
        unsigned* bar = b.bar;
        __builtin_amdgcn_s_waitcnt(0);
        unsigned nloc = b.st[0], nx = b.st[1];
        if (nloc == 0u) { xcd_barrier_complete(bar, b.x, nloc, nx); b.st[0] = nloc; b.st[1] = nx; }
        const unsigned old = xb_add(&bar[XB_XSUB(b.x)], 1u);
        const unsigned gen = old / nloc;
        if (old + 1u == (gen + 1u) * nloc) {
            __builtin_amdgcn_fence(__ATOMIC_RELEASE, "agent");
            asm volatile("s_waitcnt vmcnt(0)" ::: "memory");
            const unsigned og = xb_add(&bar[XB_TOP], 1u);
            const unsigned tg = og / nx;
            if (og + 1u == (tg + 1u) * nx) xb_add(&bar[XB_TOPGEN], 1u);
            else XB_SPIN(xb_ld(&bar[XB_TOPGEN]) == tg, bar);
            __builtin_amdgcn_fence(__ATOMIC_ACQUIRE, "agent");
            xb_add(&bar[XB_XGEN(b.x)], 1u);
            asm volatile("s_waitcnt vmcnt(0)" ::: "memory");
        } else {
            XB_SPIN(xb_ld(&bar[XB_XGEN(b.x)]) == gen, bar);
            __builtin_amdgcn_fence(__ATOMIC_ACQUIRE, "agent");
            asm volatile("s_waitcnt vmcnt(0)" ::: "memory");
        }
    }
    __syncthreads();
}
__global__ void __launch_bounds__(512, 2) mega_fwd(Args a_unused) {
    KA a = (KA)__builtin_amdgcn_kernarg_segment_ptr();
    const int ph_lo = a->ph_lo, ph_hi = a->ph_hi;
    extern __shared__ __attribute__((aligned(16))) unsigned char lds_raw[];
    LDSP unsigned char* lds0 = (LDSP unsigned char*)lds_raw;
    { LDSP unsigned char* lds = lds0;
    volatile LDSP unsigned* xst = (volatile LDSP unsigned*)(lds + 131072 + 64);
    if (threadIdx.x == 0) { xst[0] = 0u; xst[1] = 0u; }
    __syncthreads(); }
#pragma unroll 1
    for (int ph = ph_lo; ph < ph_hi; ++ph) {
        asm volatile("" : "+s"(a));
        LDSP unsigned char* lds = lds0; asm volatile("" : "+s"(lds));
        volatile LDSP unsigned* xst = (volatile LDSP unsigned*)(lds + 131072 + 64);
        unsigned char* ws = a->ws;
        float* CTXR = (float*)(ws + WS_CTXR);
        const float* MOD = (const float*)(ws + WS_MOD);
        bf16_t* XN = (bf16_t*)(ws + WS_XN); bf16_t* CAT = (bf16_t*)a->out; bf16_t* HP = (bf16_t*)(ws + WS_HP); _Float16* XR = (_Float16*)(ws + WS_CAT);
        const int tid = opaque_tid(), lane = tid & 63, wave = __builtin_amdgcn_readfirstlane(tid >> 6);
        int G = gridDim.x, bid = blockIdx.x; asm volatile("" : "+s"(G), "+s"(bid));
        if (ph == 0) { phase0(a, lds, tid, lane, wave, bid, G); }
        else if (ph == 1) { phase1(a, lds, tid, lane, wave, bid, G); }
        else {
            const int l = (ph - 2) / NPH_LAYER, sp = (ph - 2) % NPH_LAYER; const bool last = (l == DEPTH - 1);
            const bool first = (l == 0 && sp <= 1);
            const float* srcX = first ? a->in[I_X] : a->out; const float* srcC = first ? a->in[I_CTX] : CTXR;
            const int Mtail = last ? MX : MALL;
            const float* SSQ = (const float*)(ws + WS_SSQ); const float* SW = (const float*)(ws + WS_SW);
            switch (sp) {
            case 0: case 7: { const int f = (sp == 0) ? 0 : 1, j = (sp == 0) ? 0 : 2; const int M = (sp == 0) ? MALL : Mtail;
                pg8::Gemm g{XN, (const bf16_t*)(ws + WS_W1T) + (size_t)(l * 2 + f) * W1T_SZ, M, 2 * DFF, DM}; pg8::PrefOrder S; S.init(M, 2 * DFF, G, bid);
                S.pf = lds + pg8::PF_OFF; S.ssq = SSQ + (size_t)(l * 3 + j) * MALL; S.sw = SW + (size_t)(l * 3 + j) * 9 * SWN; S.MXr = MX; S.cnt = 0;
                pg8::EpiSwiGLU E{HP, DFF, lds + pg8::PF_OFF, 0};
                pg8::gemm_phase<pg8::EpiSwiGLU, pg8::PrefOrder, true, true>(lds, g, S, E); } break;
            case 1: case 6: case 8: {
                const bf16_t* A; const bf16_t* Bt; int K, M, j; float coef;
                if (sp == 1) { A = HP; Bt = (const bf16_t*)(ws + WS_W2T) + (size_t)(l * 2 + 0) * W2T_SZ; K = DFF; M = MALL; j = 0; coef = 0.5f; }
                else if (sp == 6) { A = CAT; Bt = (const bf16_t*)(ws + WS_WOT) + (size_t)l * WOT_SZ; K = DM; M = Mtail; j = 1; coef = 1.0f; }
                else { A = HP; Bt = (const bf16_t*)(ws + WS_W2T) + (size_t)(l * 2 + 1) * W2T_SZ; K = DFF; M = Mtail; j = 2; coef = 0.5f; }
                const int ln = (j == 2) ? l + 1 : l, jn = (j == 2) ? 0 : j + 1;
                const bool has_next = ln < DEPTH; const int nidx = has_next ? (ln * 3 + jn) : 0;
                pg8::Gemm g{A, Bt, MX, DM, K}; pg8::StaticOrder S; S.init(MX, DM, G, bid);
                pg8::EpiRes E{a->out, XR, (last && sp == 8) ? 1 : 0, MOD + (size_t)l * 9 * 9216 + (3 * j + 2) * 1024, coef, MX,
                              XN, (float*)(ws + WS_SSQ) + (size_t)nidx * MALL, a->in[I_GNORM] + (size_t)nidx * DM, MOD + (size_t)(nidx / 3) * 9 * 9216 + (3 * jn + 1) * 1024, has_next ? 1 : 0};
                pg8::gemm_phase<pg8::EpiRes, pg8::StaticOrder, true, true>(lds, g, S, E);
                if (M == MALL) ctx_gemm_res(a, lds, A, Bt, K, MOD + (size_t)l * 9 * 9216 + (3 * j + 2) * 1024, coef, XR, XN, (float*)(ws + WS_SSQ) + (size_t)nidx * MALL,
                                            a->in[I_GNORM] + (size_t)nidx * DM, MOD + (size_t)(nidx / 3) * 9 * 9216 + (3 * jn + 1) * 1024, tid, bid, G); } break;
            case 2: { pg8::Gemm g{XN, (const bf16_t*)(ws + WS_WINT) + (size_t)l * WINT_SZ, MALL, INWP, DM}; pg8::PrefOrder S; S.init(MALL, INWP, G, bid);
                S.pf = lds + pg8::PF_OFF; S.ssq = SSQ + (size_t)(l * 3 + 1) * MALL; S.sw = SW + (size_t)(l * 3 + 1) * 9 * SWN; S.MXr = MX; S.cnt = 0;
                pg8::EpiStore E{HP, INWP, lds + pg8::PF_OFF, 0};
                pg8::gemm_phase<pg8::EpiStore, pg8::PrefOrder, true, true>(lds, g, S, E); } break;
            case 3: prep_phase(a, lds, l, tid, lane, wave, bid, G); gla_g1_phase(a, lds, l, tid, bid, G); break;
            case 4: gla_g2_phase(a, tid, bid, G); conv_phase(a, lds, l, last, tid, lane, bid, G); break;
            case 5: attn_phase(a, (unsigned char*)lds, last, bid, G); gla_g3_phase(a, lds, l, last, tid, bid, G); break;
            default: break;
            }
        }
        if (ph + 1 < ph_hi) {
            unsigned* barw = (unsigned*)(ws + WS_CTL);
            if (ph == ph_lo) {
                if (bid == 0) for (int i = tid; i < XCD_BAR_WORDS; i += 512) __hip_atomic_store(barw + i, 0u, __ATOMIC_RELAXED, __HIP_MEMORY_SCOPE_AGENT);
                cg::this_grid().sync();
                (void)xcd_barrier_post(barw, xst);
            } else { XcdBarrier xb; xb.bar = barw; xb.x = xb_xcc_id(); xb.st = xst; xcd_barrier(xb); }
        }
    }
}

#ifndef MK_MULTI
#define MK_MULTI 0
#endif
extern "C" void kernel_launch(void* const* d_in, const int* in_sizes, int n_in, void* d_out, int out_size, void* d_ws, size_t ws_size, hipStream_t stream) {
    static int grid = 0;
    if (grid == 0) {
        if (n_in != 20 || out_size != MX * DM || ws_size < WS_END) { fprintf(stderr, "kernel_launch: unexpected shapes (n_in %d, out %d, ws %zu); nothing launched\n", n_in, out_size, ws_size); grid = -1; return; }
        int dev = 0, cus = 0, per_cu = 0;
        if (hipGetDevice(&dev) != hipSuccess || hipDeviceGetAttribute(&cus, hipDeviceAttributeMultiprocessorCount, dev) != hipSuccess) { grid = -1; return; }
        if (hipFuncSetAttribute((const void*)mega_fwd, hipFuncAttributeMaxDynamicSharedMemorySize, LDS_BYTES) != hipSuccess) { fprintf(stderr, "kernel_launch: hipFuncSetAttribute failed\n"); grid = -1; return; }
        if (hipOccupancyMaxActiveBlocksPerMultiprocessor(&per_cu, (const void*)mega_fwd, 512, LDS_BYTES) != hipSuccess || per_cu < 1) { fprintf(stderr, "kernel_launch: occupancy query gave %d\n", per_cu); per_cu = 1; }
        (void)hipGetLastError();
        grid = cus * per_cu;
    }
    if (grid < 0) return;
    Args a{};
    for (int i = 0; i < 20; ++i) a.in[i] = (const float*)d_in[i];
    a.out = (float*)d_out; a.ws = (unsigned char*)d_ws;
#if MK_MULTI
    for (int ph = 0; ph < NPHASES; ++ph) { a.ph_lo = ph; a.ph_hi = ph + 1; hipLaunchKernelGGL(mega_fwd, dim3(grid), dim3(512), LDS_BYTES, stream, a); }
#else
    a.ph_lo = 0; a.ph_hi = NPHASES;
    void* args[] = {&a};
    hipError_t e = hipLaunchCooperativeKernel((const void*)mega_fwd, dim3(grid), dim3(512), args, LDS_BYTES, stream);
    if (e != hipSuccess) fprintf(stderr, "kernel_launch: cooperative launch failed: %s (grid %d)\n", hipGetErrorString(e), grid);
#endif
}
```

```cpp
#include <hip/hip_runtime.h>
#include <hip/hip_cooperative_groups.h>
#include <cstdio>
#include <cstdint>
namespace cg = cooperative_groups;
__device__ __forceinline__ int opaque_tid() { int t = threadIdx.x; asm volatile("" : "+v"(t)); return t; }
namespace pg8 {
#define PG8_LAS __attribute__((address_space(3)))
typedef unsigned short bf16_t;
typedef short bf16x8 __attribute__((ext_vector_type(8)));
typedef float f32x4 __attribute__((ext_vector_type(4)));
typedef unsigned u32x4 __attribute__((ext_vector_type(4)));
constexpr int BM = 256, BK = 64, HALF = 128, HTB = HALF * BK * 2  , STAGE_BYTES = 8 * HTB, NXCD = 8, WGM = 8;

__host__ __device__ __forceinline__ int lds_byte(int r, int c) { const int st = (r >> 4) * 2 + (c >> 5), rr = r & 15, cc = c & 31, ob = rr * 64 + cc * 2; return st * 1024 + (ob ^ (((ob >> 9) & 1) << 5)); }
__host__ __device__ __forceinline__ void stage_rc(int b, int& R, int& C) { const int st = b / 1024, sb = b % 1024, swz = sb ^ (((sb >> 9) & 1) << 5); R = (st >> 1) * 16 + swz / 64; C = (st & 1) * 32 + (swz % 64) / 2; }
__host__ __device__ __forceinline__ int perm32(int rho) { const int n = rho >> 4, i = rho & 15; return 8 * (i >> 2) + 4 * n + (i & 3); }

struct Unit { int pm, pn; };
struct Gemm { const bf16_t* A; const bf16_t* Bt; int M, N, K; };

struct StaticOrder {
    int nM, nN, nwg, G, c;
    __host__ __device__ void init(int M, int N, int G_, int c_) { nM = M / BM; nN = N / BM; nwg = nM * nN; G = G_; c = c_; }
    __host__ __device__ bool next(int i, Unit& u) const {
        const long L = (long)i * G + c; if (L >= nwg) return false;
        int wgid = (int)L; { const int q = nwg / NXCD, r = nwg % NXCD, xcd = wgid % NXCD, off = wgid / NXCD; wgid = (xcd < r ? xcd * (q + 1) : r * (q + 1) + (xcd - r) * q) + off; }
        const int nig = WGM * nN, gid = wgid / nig, fm = gid * WGM, gsz = (nM - fm) < WGM ? (nM - fm) : WGM;
        u.pm = fm + ((wgid % nig) % gsz); u.pn = (wgid % nig) / gsz; return true;
    }
    __device__ __forceinline__ void a_ready(const Unit&) const {}
    __device__ __forceinline__ void done(const Unit&) const {}
};

constexpr int PF_OFF = 132096, PF_SLOT = 2048;
struct PrefOrder : StaticOrder {
    PG8_LAS unsigned char* pf; const float* ssq; const float* sw; int MXr; mutable int cnt;
    __device__ __forceinline__ void a_ready(const Unit& u) const {
        const int t = threadIdx.x, w = __builtin_amdgcn_readfirstlane(t >> 6), lane = t & 63; const int slot = cnt & 1; ++cnt;
        const int rowt = u.pm * BM, bidx = rowt >= MXr ? 8 : (rowt >> 12);
        const float* src = (w < 4) ? ssq + rowt + w * 64 + lane : sw + (size_t)bidx * 5632 + u.pn * BM + (w - 4) * 64 + lane;
        __builtin_amdgcn_global_load_lds((const unsigned*)src, (PG8_LAS unsigned*)(pf + slot * PF_SLOT + w * 256), 4, 0, 0);
    }
};
typedef float cvt_f32x2_t __attribute__((ext_vector_type(2))); typedef __bf16 cvt_bf16x2_t __attribute__((ext_vector_type(2)));
__device__ __forceinline__ unsigned cvt_pk_bf16(float lo, float hi) { const cvt_f32x2_t v = {lo, hi}; const cvt_bf16x2_t b = __builtin_convertvector(v, cvt_bf16x2_t); return __builtin_bit_cast(unsigned, b); }
typedef float f32x2 __attribute__((ext_vector_type(2)));
__device__ __forceinline__ float silu_f(float v) { return v * __builtin_amdgcn_rcpf(1.0f + __expf(-v)); }
struct EpiStore {
    static constexpr bool PERM = true, AFTER_DRAIN = false;
    bf16_t* O; int ldc; PG8_LAS unsigned char* pf; mutable int cnt;
    __device__ __forceinline__ void operator()(const f32x4 (&acc)[2][2][4][2], const Unit& u, int wr, int wc, int fr, int fq) const {
        const int rowt = u.pm * BM; PG8_LAS const float* sl = (PG8_LAS const float*)(pf + (cnt & 1) * PF_SLOT); ++cnt;
        const int row0 = rowt + wr * 64 + fr, col0 = u.pn * BM + wc * 32 + 8 * fq;
        f32x4 sv[2][2];
#pragma unroll
        for (int bj = 0; bj < 2; ++bj)
#pragma unroll
            for (int n = 0; n < 2; ++n) sv[bj][n] = *(PG8_LAS const f32x4*)(sl + 256 + wc * 32 + 8 * fq + bj * HALF + 4 * n);
        float rsv[2][4];
#pragma unroll
        for (int ai = 0; ai < 2; ++ai)
#pragma unroll
            for (int m = 0; m < 4; ++m) rsv[ai][m] = __builtin_amdgcn_rsqf(sl[wr * 64 + fr + ai * HALF + m * 16] * (1.0f / 1024.0f) + 1e-6f);
#pragma unroll
        for (int ai = 0; ai < 2; ++ai)
#pragma unroll
            for (int m = 0; m < 4; ++m) { const int row = row0 + ai * HALF + m * 16; bf16_t* rowp = O + (size_t)row * ldc + col0;
                const float rs = rsv[ai][m];
#pragma unroll
                for (int bj = 0; bj < 2; ++bj) { const f32x4 v0 = acc[ai][bj][m][0] * rs + sv[bj][0], v1 = acc[ai][bj][m][1] * rs + sv[bj][1];
                    u32x4 w; w.x = cvt_pk_bf16(v0[0], v0[1]); w.y = cvt_pk_bf16(v0[2], v0[3]); w.z = cvt_pk_bf16(v1[0], v1[1]); w.w = cvt_pk_bf16(v1[2], v1[3]);
                    *(u32x4*)(rowp + bj * HALF) = w; } }
    }
};
struct EpiSwiGLU {
    static constexpr bool PERM = true, AFTER_DRAIN = false;
    bf16_t* O; int ldc; PG8_LAS unsigned char* pf; mutable int cnt;
    __device__ __forceinline__ void operator()(const f32x4 (&acc)[2][2][4][2], const Unit& u, int wr, int wc, int fr, int fq) const {
        const int rowt = u.pm * BM; PG8_LAS const float* sl = (PG8_LAS const float*)(pf + (cnt & 1) * PF_SLOT); ++cnt;
        const int row0 = rowt + wr * 64 + fr, col0 = u.pn * HALF + wc * 32 + 8 * fq;
        f32x4 sv[2][2];
#pragma unroll
        for (int bj = 0; bj < 2; ++bj)
#pragma unroll
            for (int n = 0; n < 2; ++n) sv[bj][n] = *(PG8_LAS const f32x4*)(sl + 256 + wc * 32 + 8 * fq + bj * HALF + 4 * n);
        float rsv[2][4];
#pragma unroll
        for (int ai = 0; ai < 2; ++ai)
#pragma unroll
            for (int m = 0; m < 4; ++m) rsv[ai][m] = __builtin_amdgcn_rsqf(sl[wr * 64 + fr + ai * HALF + m * 16] * (1.0f / 1024.0f) + 1e-6f);
#pragma unroll
        for (int ai = 0; ai < 2; ++ai)
#pragma unroll
            for (int m = 0; m < 4; ++m) { const int row = row0 + ai * HALF + m * 16; bf16_t* rowp = O + (size_t)row * ldc + col0;
                const float rs = rsv[ai][m];
                const f32x4 a0 = acc[ai][0][m][0] * rs + sv[0][0], a1 = acc[ai][0][m][1] * rs + sv[0][1], u0 = acc[ai][1][m][0] * rs + sv[1][0], u1 = acc[ai][1][m][1] * rs + sv[1][1];
                u32x4 w; w.x = cvt_pk_bf16(silu_f(a0[0]) * u0[0], silu_f(a0[1]) * u0[1]); w.y = cvt_pk_bf16(silu_f(a0[2]) * u0[2], silu_f(a0[3]) * u0[3]);
                w.z = cvt_pk_bf16(silu_f(a1[0]) * u1[0], silu_f(a1[1]) * u1[1]); w.w = cvt_pk_bf16(silu_f(a1[2]) * u1[2], silu_f(a1[3]) * u1[3]);
                *(u32x4*)rowp = w; }
    }
};
typedef _Float16 h16x8 __attribute__((ext_vector_type(8)));
typedef float f32x8 __attribute__((ext_vector_type(8)));
struct EpiRes {
    static constexpr bool PERM = true, AFTER_DRAIN = false;
    float* outF; _Float16* XR; int dstf32; const float* gate; float coef; int MXr;
    bf16_t* XSp; float* ssq; const float* gn; const float* scn; int doxs;
    __device__ __forceinline__ void operator()(const f32x4 (&acc)[2][2][4][2], const Unit& u, int wr, int wc, int fr, int fq) const {
        const int rowt = u.pm * BM; const bool isc = rowt >= MXr; const bool XS = doxs != 0;
        const int bidx = isc ? 8 : (rowt >> 12);
        char* outb = (char*)(outF + (size_t)rowt * 1024);
        char* xrb = (char*)(XR + (size_t)rowt * 1024);
        char* xsb = (char*)(XSp + (size_t)rowt * 1024); float* sqb = ssq + rowt;
        const int col0 = u.pn * BM + wc * 32 + 8 * fq;
        const float* g = gate + (size_t)bidx * 9216 + col0;
        const unsigned lo = (unsigned)((wr * 64 + fr) * 1024 + col0);
        float ss[2][4];
#pragma unroll
        for (int ai = 0; ai < 2; ++ai)
#pragma unroll
            for (int m = 0; m < 4; ++m) ss[ai][m] = 0.f;
#pragma unroll
        for (int bj = 0; bj < 2; ++bj) {
            u32x4 xin[2][4];
#pragma unroll
            for (int ai = 0; ai < 2; ++ai)
#pragma unroll
                for (int m = 0; m < 4; ++m) xin[ai][m] = *(const u32x4*)(xrb + (lo + (unsigned)((ai * HALF + m * 16) * 1024 + bj * HALF)) * 2u);
            f32x4 gv[2], gs[2];
#pragma unroll
            for (int n = 0; n < 2; ++n) { gv[n] = *(const f32x4*)(g + bj * HALF + 4 * n) * coef;
                if (XS) gs[n] = *(const f32x4*)(gn + col0 + bj * HALF + 4 * n) * (*(const f32x4*)(scn + (size_t)bidx * 9216 + col0 + bj * HALF + 4 * n) + 1.0f); }
#pragma unroll
            for (int ai = 0; ai < 2; ++ai)
#pragma unroll
                for (int m = 0; m < 4; ++m) { const unsigned eo = lo + (unsigned)((ai * HALF + m * 16) * 1024 + bj * HALF); f32x4 xv[2];
                    { const f32x8 t = __builtin_convertvector(__builtin_bit_cast(h16x8, xin[ai][m]), f32x8); xv[0] = (f32x4){t[0], t[1], t[2], t[3]}; xv[1] = (f32x4){t[4], t[5], t[6], t[7]}; }
                    xv[0] += gv[0] * acc[ai][bj][m][0]; xv[1] += gv[1] * acc[ai][bj][m][1];
                    if (dstf32) { *(f32x4*)(outb + eo * 4u) = xv[0]; *(f32x4*)(outb + eo * 4u + 16u) = xv[1]; }
                    else { const f32x8 t = {xv[0][0], xv[0][1], xv[0][2], xv[0][3], xv[1][0], xv[1][1], xv[1][2], xv[1][3]}; *(h16x8*)(xrb + eo * 2u) = __builtin_convertvector(t, h16x8); }
                    if (XS) { ss[ai][m] += (xv[0][0] * xv[0][0] + xv[0][1] * xv[0][1]) + (xv[0][2] * xv[0][2] + xv[0][3] * xv[0][3]) + (xv[1][0] * xv[1][0] + xv[1][1] * xv[1][1]) + (xv[1][2] * xv[1][2] + xv[1][3] * xv[1][3]);
                        const f32x4 y0 = xv[0] * gs[0], y1 = xv[1] * gs[1];
                        u32x4 w; w.x = cvt_pk_bf16(y0[0], y0[1]); w.y = cvt_pk_bf16(y0[2], y0[3]); w.z = cvt_pk_bf16(y1[0], y1[1]); w.w = cvt_pk_bf16(y1[2], y1[3]);
                        *(u32x4*)(xsb + eo * 2u) = w; } }
        }
        if (XS) {
#pragma unroll
            for (int ai = 0; ai < 2; ++ai)
#pragma unroll
                for (int m = 0; m < 4; ++m) { float t = ss[ai][m];
                    t += __int_as_float(__builtin_amdgcn_ds_swizzle(__float_as_int(t), 0x1f | (16 << 10)));
                    auto rr = __builtin_amdgcn_permlane32_swap(__float_as_uint(t), __float_as_uint(t), false, false);
                    t = __uint_as_float(rr[0]) + __uint_as_float(rr[1]);
                    if (fq == 0) atomicAdd(sqb + (unsigned)(wr * 64 + fr + ai * HALF + m * 16), t); } }
    }
};
template <class Epi, class Sched, bool ALIGN_EPI = false, bool SP2 = false>
__device__ __forceinline__ void gemm_phase(PG8_LAS unsigned char* lds, const Gemm g, const Sched& S, const Epi& E) {
    const int tid = opaque_tid(), wid = __builtin_amdgcn_readfirstlane(tid >> 6), lane = tid & 63, wr = wid >> 2, wc = wid & 3, fr = lane & 15, fq = lane >> 4;
    const int K = g.K, nt = K / BK;
    unsigned voffA[2], voffB[2];
#pragma unroll
    for (int i = 0; i < 2; ++i) { int R, C; stage_rc(tid * 16 + i * 8192, R, C); const int Rb = Epi::PERM ? ((R & ~31) + perm32(R & 31)) : R;
        voffA[i] = (unsigned)(R * K + C) * 2u; voffB[i] = (unsigned)(Rb * K + C) * 2u; }
    const size_t kstep = (size_t)(BK * 2);
    const size_t hstep = (size_t)HALF * K * 2;
    const size_t tstep = 2 * hstep;
    const unsigned ldsw = (unsigned)wid * 1024u;
    const int aoff = lds_byte(wr * 64 + fr, fq * 8), boff = lds_byte(wc * 32 + fr, fq * 8);
#define PG8_SA(b, h) (((b) * 2 + (h)) * HTB)
#define PG8_SB(b, h) ((4 + (b) * 2 + (h)) * HTB)
#define PG8_STAGE(bufoff, gbase, voff) do { _Pragma("unroll") for (int _i = 0; _i < 2; ++_i) \
        __builtin_amdgcn_global_load_lds((const unsigned*)((const char*)(gbase) + (voff)[_i]), (PG8_LAS unsigned*)(lds + (bufoff) + ldsw + _i * 8192), 16, 0, 0); } while (0)
#define PG8_LDA(dst, b, h) do { _Pragma("unroll") for (int m = 0; m < 4; ++m) _Pragma("unroll") for (int k = 0; k < 2; ++k) dst[m][k] = *(const PG8_LAS bf16x8*)(lds + PG8_SA(b, h) + aoff + m * 2048 + k * 1024); } while (0)
#define PG8_LDB(dst, b, h) do { _Pragma("unroll") for (int n = 0; n < 2; ++n) _Pragma("unroll") for (int k = 0; k < 2; ++k) dst[n][k] = *(const PG8_LAS bf16x8*)(lds + PG8_SB(b, h) + boff + n * 2048 + k * 1024); } while (0)
#define PG8_MMA(ai, bj, At, Bt) do { __builtin_amdgcn_s_setprio(1); _Pragma("unroll") for (int m = 0; m < 4; ++m) _Pragma("unroll") for (int n = 0; n < 2; ++n) _Pragma("unroll") for (int k = 0; k < 2; ++k) \
        acc[ai][bj][m][n] = __builtin_amdgcn_mfma_f32_16x16x32_bf16(Bt[n][k], At[m][k], acc[ai][bj][m][n], 0, 0, 0); __builtin_amdgcn_s_setprio(0); } while (0)
#define PG8_WAIT_V(n) asm volatile("s_waitcnt vmcnt(" #n ")" ::: "memory")
#define PG8_WAIT_L(n) asm volatile("s_waitcnt lgkmcnt(" #n ")" ::: "memory")
#define PG8_BAR __builtin_amdgcn_s_barrier()
#define PG8_SCHED __builtin_amdgcn_sched_barrier(0)
    Unit cur, nxt; int ui = 0;
    if (!S.next(0, cur)) return;
    f32x4 acc[2][2][4][2];
#pragma unroll
    for (int a = 0; a < 2; ++a)
#pragma unroll
        for (int b = 0; b < 2; ++b)
#pragma unroll
            for (int m = 0; m < 4; ++m)
#pragma unroll
                for (int n = 0; n < 2; ++n) acc[a][b][m][n] = (f32x4){0.f, 0.f, 0.f, 0.f};
    bf16x8 At[4][2], B0[2][2], B1[2][2];
    const char* cA = (const char*)g.A + (size_t)cur.pm * tstep; const char* cB = (const char*)g.Bt + (size_t)cur.pn * tstep;
    S.a_ready(cur);
    if constexpr (SP2) {
        PG8_STAGE(PG8_SB(0, 0), cB, voffB); PG8_STAGE(PG8_SB(0, 1), cB + hstep, voffB); PG8_STAGE(PG8_SA(0, 0), cA, voffA); PG8_STAGE(PG8_SA(0, 1), cA + hstep, voffA);
        if (wr == 1) PG8_BAR;
        PG8_WAIT_V(2); PG8_BAR;
        PG8_STAGE(PG8_SB(1, 0), cB + kstep, voffB); PG8_STAGE(PG8_SA(1, 0), cA + kstep, voffA); PG8_STAGE(PG8_SB(1, 1), cB + hstep + kstep, voffB);
        PG8_WAIT_V(6); PG8_BAR;
    } else {
        PG8_STAGE(PG8_SB(0, 0), cB, voffB); PG8_STAGE(PG8_SA(0, 0), cA, voffA); PG8_STAGE(PG8_SB(0, 1), cB + hstep, voffB); PG8_STAGE(PG8_SA(0, 1), cA + hstep, voffA);
        if (wr == 1) PG8_BAR;
        PG8_WAIT_V(4); PG8_BAR;
        PG8_STAGE(PG8_SB(1, 0), cB + kstep, voffB); PG8_STAGE(PG8_SA(1, 0), cA + kstep, voffA); PG8_STAGE(PG8_SB(1, 1), cB + hstep + kstep, voffB);
        PG8_WAIT_V(6); PG8_BAR;
    }
    for (;;) {
        const bool has_next = S.next(ui + 1, nxt);
        const char* nA = has_next ? (const char*)g.A + (size_t)nxt.pm * tstep : cA; const char* nB = has_next ? (const char*)g.Bt + (size_t)nxt.pn * tstep : cB;
        for (int t = 0; t < nt; t += 2) {
            const bool last = (t == nt - 2);
            const char* a1 = cA + (size_t)(t + 1) * kstep;
            const char* a2 = last ? nA : cA + (size_t)(t + 2) * kstep; const char* b2 = last ? nB : cB + (size_t)(t + 2) * kstep;
            const char* a3 = a2 + kstep; const char* b3 = b2 + kstep;
            if (last && has_next) S.a_ready(nxt);
            if constexpr (SP2) {
            PG8_LDB(B0, 0, 0); PG8_LDB(B1, 0, 1); PG8_SCHED; PG8_LDA(At, 0, 0); PG8_STAGE(PG8_SA(1, 1), a1 + hstep, voffA);
            PG8_WAIT_V(8); PG8_WAIT_L(0); PG8_BAR; PG8_MMA(0, 0, At, B0); PG8_MMA(0, 1, At, B1); PG8_BAR; PG8_SCHED;
            PG8_LDA(At, 0, 1); PG8_STAGE(PG8_SB(0, 0), b2, voffB); PG8_STAGE(PG8_SB(0, 1), b2 + hstep, voffB); PG8_STAGE(PG8_SA(0, 0), a2, voffA);
            PG8_WAIT_V(8); PG8_WAIT_L(0); PG8_BAR; PG8_MMA(1, 0, At, B0); PG8_MMA(1, 1, At, B1); PG8_BAR; PG8_SCHED;
            PG8_LDB(B0, 1, 0); PG8_LDB(B1, 1, 1); PG8_SCHED; PG8_LDA(At, 1, 0); PG8_STAGE(PG8_SA(0, 1), a2 + hstep, voffA);
            PG8_WAIT_V(8); PG8_WAIT_L(0); PG8_BAR; PG8_MMA(0, 0, At, B0); PG8_MMA(0, 1, At, B1); PG8_BAR; PG8_SCHED;
            PG8_LDA(At, 1, 1); PG8_STAGE(PG8_SB(1, 0), b3, voffB); PG8_STAGE(PG8_SB(1, 1), b3 + hstep, voffB); PG8_STAGE(PG8_SA(1, 0), a3, voffA);
            PG8_WAIT_V(8); PG8_WAIT_L(0); PG8_BAR; PG8_MMA(1, 0, At, B0); PG8_MMA(1, 1, At, B1); PG8_BAR; PG8_SCHED;
            } else {
            PG8_LDB(B0, 0, 0); PG8_SCHED; PG8_LDA(At, 0, 0); PG8_STAGE(PG8_SA(1, 1), a1 + hstep, voffA);
            PG8_WAIT_L(8); PG8_BAR; PG8_WAIT_L(0); PG8_MMA(0, 0, At, B0); PG8_BAR; PG8_SCHED;
            PG8_LDB(B1, 0, 1); PG8_STAGE(PG8_SB(0, 0), b2, voffB);
            PG8_BAR; PG8_WAIT_L(0); PG8_MMA(0, 1, At, B1); PG8_BAR;
            PG8_LDA(At, 0, 1); PG8_STAGE(PG8_SA(0, 0), a2, voffA);
            PG8_BAR; PG8_WAIT_L(0); PG8_MMA(1, 0, At, B0); PG8_BAR; PG8_SCHED;
            PG8_STAGE(PG8_SB(0, 1), b2 + hstep, voffB);
            PG8_WAIT_V(6); PG8_BAR; PG8_MMA(1, 1, At, B1); PG8_BAR;
            PG8_LDB(B0, 1, 0); PG8_SCHED; PG8_LDA(At, 1, 0); PG8_STAGE(PG8_SA(0, 1), a2 + hstep, voffA);
            PG8_WAIT_L(8); PG8_BAR; PG8_WAIT_L(0); PG8_MMA(0, 0, At, B0); PG8_BAR; PG8_SCHED;
            PG8_LDB(B1, 1, 1); PG8_STAGE(PG8_SB(1, 0), b3, voffB);
            PG8_BAR; PG8_WAIT_L(0); PG8_MMA(0, 1, At, B1); PG8_BAR;
            PG8_LDA(At, 1, 1); PG8_STAGE(PG8_SA(1, 0), a3, voffA);
            PG8_BAR; PG8_WAIT_L(0); PG8_MMA(1, 0, At, B0); PG8_BAR; PG8_SCHED;
            PG8_STAGE(PG8_SB(1, 1), b3 + hstep, voffB);
            PG8_WAIT_V(6); PG8_BAR; PG8_MMA(1, 1, At, B1); PG8_BAR;
            }
        }
        if constexpr (ALIGN_EPI) { if (wr == 0) PG8_BAR; }
        if constexpr (!Epi::AFTER_DRAIN) { E(acc, cur, wr, wc, fr, fq); S.done(cur); }
        if (!has_next) break;
#pragma unroll
        for (int a = 0; a < 2; ++a)
#pragma unroll
            for (int b = 0; b < 2; ++b)
#pragma unroll
                for (int m = 0; m < 4; ++m)
#pragma unroll
                    for (int n = 0; n < 2; ++n) acc[a][b][m][n] = (f32x4){0.f, 0.f, 0.f, 0.f};
        cur = nxt; cA = nA; cB = nB; ++ui;
        if constexpr (ALIGN_EPI) { if (wr == 1) PG8_BAR; }
    }
    PG8_WAIT_V(0);
    if constexpr (!ALIGN_EPI) { if (wr == 0) PG8_BAR; }
    PG8_BAR;
    if constexpr (Epi::AFTER_DRAIN) { E.fused(acc, cur, wr, wc, fr, fq, lds, wid, lane); S.done(cur); }
#undef PG8_SA
#undef PG8_SB
#undef PG8_STAGE
#undef PG8_LDA
#undef PG8_LDB
#undef PG8_MMA
#undef PG8_WAIT_V
#undef PG8_WAIT_L
#undef PG8_BAR
#undef PG8_SCHED
}
}
#include <hip/hip_bf16.h>
#include <cmath>
namespace attn_body {
using bf16=__hip_bfloat16;
using bf16x8=__attribute__((ext_vector_type(8)))short;
using s16x4=__attribute__((ext_vector_type(4)))short;
using f32x16=__attribute__((ext_vector_type(16)))float;
using u32x4=__attribute__((ext_vector_type(4)))unsigned;
constexpr int D=64,QP=512,KP=128,OP=1024;
constexpr int NW=8,QBLK=32,QB=QBLK*NW,KVBLK=64;
constexpr int ATTN_UNIT_ROWS=QB;
__device__ __forceinline__ int crow(int r,int hi){return (r&3)+8*(r>>2)+4*hi;}
#define SBAR() __builtin_amdgcn_sched_barrier(0)
__device__ __forceinline__ void cmask(f32x16&p0,f32x16&p1,int jb,int qrel,int hi){
  const float NEG=-INFINITY; int kb=64*jb+4*hi;
  #pragma unroll
  for(int r=0;r<16;++r){int kv=kb+(r&3)+8*(r>>2); if(kv>qrel)p0[r]=NEG; if(kv+32>qrel)p1[r]=NEG;}
}

constexpr int NSLOT=3, SLOTB=8192;
constexpr int LDS_K=0, LDS_V=NSLOT*SLOTB, LDS_WS=2*NSLOT*SLOTB, LDS_OST=LDS_WS+NW*64*4, LDS_BYTES=LDS_OST+NW*4096;
constexpr float C2=0.125f*1.4426950408889634f;
__device__ __forceinline__ void glds16(const void*gsrc,unsigned lds_dst){unsigned keep;
  asm volatile("s_mov_b32 %0, m0\n\ts_mov_b32 m0, %2\n\ts_nop 0\n\tglobal_load_lds_dwordx4 %1, off\n\ts_mov_b32 m0, %0":"=&s"(keep):"v"(gsrc),"s"(lds_dst):"memory");}
__device__ __forceinline__ float max3f(float a,float b,float c){float r;asm("v_max3_f32 %0, %1, %2, %3":"=v"(r):"v"(a),"v"(b),"v"(c));return r;}
__device__ __forceinline__ float max2f(float a,float b){float r;asm("v_max_f32_e32 %0, %1, %2":"=v"(r):"v"(a),"v"(b));return r;}
__device__ __forceinline__ float fadd_s(float a,float b){float r;asm("v_add_f32_e32 %0, %1, %2":"=v"(r):"v"(a),"v"(b));return r;}
__device__ __forceinline__ float fsub_s(float a,float b){float r;asm("v_sub_f32_e32 %0, %1, %2":"=v"(r):"v"(a),"v"(b));return r;}
typedef float f32x2_t __attribute__((ext_vector_type(2))); typedef __bf16 bf16x2_t __attribute__((ext_vector_type(2)));
__device__ __forceinline__ unsigned cvtpk_s(float lo,float hi){f32x2_t v={lo,hi};bf16x2_t b=__builtin_convertvector(v,bf16x2_t);return __builtin_bit_cast(unsigned,b);}
#define WAIT_BAR(N) asm volatile("s_waitcnt vmcnt(" #N ") lgkmcnt(0)\n\ts_barrier":::"memory")

__device__ __forceinline__ void qkt(f32x16&p0,f32x16&p1,const char*Kslot,const bf16x8*qr,const f32x16&negm,int r32,int hi){
  const char*kb=Kslot+hi*1024+r32*16;
  #pragma unroll
  for(int d0=0;d0<4;++d0){
    const bf16x8 b0=*reinterpret_cast<const bf16x8*>(kb+d0*2048);
    const bf16x8 b1=*reinterpret_cast<const bf16x8*>(kb+d0*2048+512);
    if(d0==0){p0=__builtin_amdgcn_mfma_f32_32x32x16_bf16(b0,qr[0],negm,0,0,0);p1=__builtin_amdgcn_mfma_f32_32x32x16_bf16(b1,qr[0],negm,0,0,0);}
    else{p0=__builtin_amdgcn_mfma_f32_32x32x16_bf16(b0,qr[d0],p0,0,0,0);p1=__builtin_amdgcn_mfma_f32_32x32x16_bf16(b1,qr[d0],p1,0,0,0);}}
}
typedef __attribute__((address_space(3))) const char* lds_cptr;
typedef short v4i16_t __attribute__((ext_vector_type(4)));
__device__ __forceinline__ void kload8(bf16x8*kf,lds_cptr kp){
  kf[0]=*(const __attribute__((address_space(3))) bf16x8*)(kp);      kf[1]=*(const __attribute__((address_space(3))) bf16x8*)(kp+512);
  kf[2]=*(const __attribute__((address_space(3))) bf16x8*)(kp+2048); kf[3]=*(const __attribute__((address_space(3))) bf16x8*)(kp+2560);
  kf[4]=*(const __attribute__((address_space(3))) bf16x8*)(kp+4096); kf[5]=*(const __attribute__((address_space(3))) bf16x8*)(kp+4608);
  kf[6]=*(const __attribute__((address_space(3))) bf16x8*)(kp+6144); kf[7]=*(const __attribute__((address_space(3))) bf16x8*)(kp+6656);
}
__device__ __forceinline__ void kload2(bf16x8*kf,lds_cptr kp,int j){ kf[2*j]=*(const __attribute__((address_space(3))) bf16x8*)(kp+j*2048); kf[2*j+1]=*(const __attribute__((address_space(3))) bf16x8*)(kp+j*2048+512); }
__device__ __forceinline__ s16x4 vtr(lds_cptr p){ return __builtin_bit_cast(s16x4,__builtin_amdgcn_ds_read_tr16_b64_v4i16((__attribute__((address_space(3))) v4i16_t*)p)); }
__device__ __forceinline__ float rowmax(const f32x16&p0,const f32x16&p1){
  float a=max3f(p0[0],p0[1],p1[0]),b=max3f(p0[2],p0[3],p1[1]);a=max3f(a,p1[2],p1[3]);
  #pragma unroll
  for(int r=4;r<16;r+=4){a=max3f(a,p0[r],p0[r+1]);b=max3f(b,p0[r+2],p0[r+3]);a=max3f(a,p1[r],p1[r+1]);b=max3f(b,p1[r+2],p1[r+3]);}
  const float m=max2f(a,b);
  auto rr=__builtin_amdgcn_permlane32_swap(__float_as_uint(m),__float_as_uint(m),false,false);
  return max2f(__uint_as_float(rr[0]),__uint_as_float(rr[1]));
}
__device__ __forceinline__ void pv(f32x16*o,int vb,bf16x8 pa0,bf16x8 pa1,bf16x8 pa2,bf16x8 pa3){
  #pragma unroll
  for(int d0=0;d0<2;++d0){s16x4 lo[4],hi[4];
    #pragma unroll
    for(int ks=0;ks<4;++ks){
      asm volatile("ds_read_b64_tr_b16 %0,%1 offset:%c2":"=&v"(lo[ks]):"v"(vb),"i"(d0*4096+ks*1024):"memory");
      asm volatile("ds_read_b64_tr_b16 %0,%1 offset:%c2":"=&v"(hi[ks]):"v"(vb),"i"(d0*4096+ks*1024+512):"memory");}
    asm volatile("s_waitcnt lgkmcnt(0)":::"memory");SBAR();
    #define PK(k) (bf16x8){lo[k][0],lo[k][1],lo[k][2],lo[k][3],hi[k][0],hi[k][1],hi[k][2],hi[k][3]}
    o[d0]=__builtin_amdgcn_mfma_f32_32x32x16_bf16(pa0,PK(0),o[d0],0,0,0);
    o[d0]=__builtin_amdgcn_mfma_f32_32x32x16_bf16(pa1,PK(1),o[d0],0,0,0);
    o[d0]=__builtin_amdgcn_mfma_f32_32x32x16_bf16(pa2,PK(2),o[d0],0,0,0);
    o[d0]=__builtin_amdgcn_mfma_f32_32x32x16_bf16(pa3,PK(3),o[d0],0,0,0);
    #undef PK
  }
}

#ifndef ATTN_STORE16
#define ATTN_STORE16(p,v) (*(u32x4*)(p)=(v))
#endif
template<int THRL> __device__ __forceinline__ void attn_unit(const bf16*Q0,const bf16*__restrict__ Kh,const bf16*__restrict__ Vh,bf16*O0,const int NT,char*shm){
  const int tid=opaque_tid(),lane=tid&63,r32=lane&31,hi=lane>>5; const int wid=__builtin_amdgcn_readfirstlane(tid>>6);
  const bf16*Qw=Q0+(long)(wid*QBLK)*QP;
  const unsigned lds0=(unsigned)(uintptr_t)shm;
  float*wsf=(float*)(shm+LDS_WS)+wid*64;
  const bf16*ksrc=Kh+(long)lane*KP+wid*8;
  const bf16*vsrc=Vh+(long)(16*(wid&3)+(lane>>2))*KP+(wid>>2)*32+(lane&3)*8;
  const unsigned kdst=lds0+LDS_K+wid*1024, vdst=lds0+LDS_V+wid*1024;
  #define DMA_K(t,slot) glds16(ksrc+(long)(t)*KVBLK*KP,(unsigned)__builtin_amdgcn_readfirstlane(kdst+(slot)))
  #define DMA_V(t,slot) glds16(vsrc+(long)(t)*KVBLK*KP,(unsigned)__builtin_amdgcn_readfirstlane(vdst+(slot)))
  const int vb0=(int)(lds0+LDS_V)+((lane>>4)&1)*32+(lane&3)*8+(4*hi+((lane&15)>>2))*64;
  const char*Kbase=shm+LDS_K; bf16x8 kf[8];
  const lds_cptr shm3=(lds_cptr)shm; const lds_cptr kp0=shm3+LDS_K+hi*1024+r32*16; const lds_cptr vp0=shm3+LDS_V+((lane>>4)&1)*32+(lane&3)*8+(4*hi+((lane&15)>>2))*64;
  DMA_K(0,0);DMA_V(0,0);DMA_K(1,SLOTB);
  bf16x8 qr[4];
  #pragma unroll
  for(int d0=0;d0<4;++d0)qr[d0]=*reinterpret_cast<const bf16x8*>(&Qw[(long)r32*QP+d0*16+hi*8]);
  float mhat=0.f,l_reg=0.f;f32x16 o[2];o[0]=f32x16{};o[1]=f32x16{};f32x16 negm=f32x16{};asm volatile("":"+v"(negm));
  #define CMASK(P0,P1,t) do{}while(0)
  bool resc=false;
  #define START(P0,P1) do{ const float rm=rowmax(P0,P1); resc=false; \
    { const float dl=rm; mhat=fadd_s(mhat,dl); \
      _Pragma("unroll") for(int r=0;r<16;++r){P0[r]=fsub_s(P0[r],dl);P1[r]=fsub_s(P1[r],dl);} \
      _Pragma("unroll") for(int r=0;r<16;++r)negm[r]=-mhat; asm volatile("":"+v"(negm)); } \
    _Pragma("unroll") for(int r=0;r<16;++r)P0[r]=__builtin_amdgcn_exp2f(P0[r]); }while(0)
  #define RESC() do{ if(resc){ asm volatile("s_waitcnt lgkmcnt(0)":::"memory"); \
      _Pragma("unroll") for(int d_=0;d_<2;++d_) _Pragma("unroll") for(int r=0;r<16;++r)o[d_][r]*=wsf[crow(r,hi)]; } }while(0)
  f32x16 pA0,pA1,pB0,pB1;
  int sl_prev=0,sl_cur=0,sl_next=SLOTB;
  #define ROT() do{sl_prev=sl_cur;sl_cur=sl_next;sl_next=(sl_next==(NSLOT-1)*SLOTB)?0:sl_next+SLOTB;}while(0)
  DMA_K(2,2*SLOTB);
  WAIT_BAR(3);
  qkt(pA0,pA1,Kbase,qr,negm,r32,hi);asm volatile("s_nop 15\n\ts_nop 7":"+v"(pA0),"+v"(pA1));CMASK(pA0,pA1,0);
  START(pA0,pA1);
  _Pragma("unroll") for(int r=0;r<16;++r)pA1[r]=__builtin_amdgcn_exp2f(pA1[r]);
  WAIT_BAR(0);
  DMA_K(3,0);DMA_V(1,SLOTB);
  ROT();
  kload8(kf,kp0+sl_cur);
  WAIT_BAR(2);
  s16x4 vlo[8],vhi[8]; u32x4 pw0,pw1,pw2,pw3;
  #define PKW(P,B) cvtpk_s(P[B],P[B+1])
  #define PAF(k) __builtin_bit_cast(bf16x8,pw##k)
  #define VFR(i) (bf16x8){vlo[i][0],vlo[i][1],vlo[i][2],vlo[i][3],vhi[i][0],vhi[i][1],vhi[i][2],vhi[i][3]}
  #define PIN(x) asm volatile("":"+v"(x))
  #define MX3(a,b,c) __builtin_fmaxf(__builtin_fmaxf((a),(b)),(c))
  #define GAPA(MF,A0,A1,A2,A3,W0,W1,PW) do{ MF; sacc+=A0; sacc+=A1; sacc+=A2; sacc+=A3; PIN(sacc); W0; W1; PIN(PW); SBAR(); }while(0)
  #define EX(v) __builtin_amdgcn_exp2f(v)
  #define GAPB(MF,X,B) do{ MF; X[B]=EX(X[B]); X[B+1]=EX(X[B+1]); X[B+2]=EX(X[B+2]); X[B+3]=EX(X[B+3]); PIN(X); SBAR(); }while(0)
  #define VRD(i) do{ vlo[i]=vtr(vp_+(((i)>>2)*4096+((i)&3)*1024)); vhi[i]=vtr(vp_+(((i)>>2)*4096+((i)&3)*1024+512)); }while(0)
  #define KRD(G,j) do{ if(G){ kload2(kf,kp0+sl_next,j); SBAR(); } }while(0)
  #define STEP(C0,C1,P0,P1,t,GK,GV,GL) do{ SBAR(); \
    const lds_cptr vp_=vp0+sl_prev; \
    VRD(0); SBAR(); float sacc=(P0[0]+P0[1]); \
    GAPA(C0=__builtin_amdgcn_mfma_f32_32x32x16_bf16(kf[0],qr[0],negm,0,0,0), P0[2],P0[3],P0[4],P0[5],     pw0[0]=PKW(P0,0), pw0[1]=PKW(P0,2), pw0); \
    VRD(4); SBAR(); GAPA(C1=__builtin_amdgcn_mfma_f32_32x32x16_bf16(kf[1],qr[0],negm,0,0,0), P0[6],P0[7],P0[8],P0[9],     pw0[2]=PKW(P0,4), pw0[3]=PKW(P0,6), pw0); \
    VRD(1); SBAR(); GAPA(C0=__builtin_amdgcn_mfma_f32_32x32x16_bf16(kf[2],qr[1],C0,0,0,0),   P0[10],P0[11],P0[12],P0[13], pw1[0]=PKW(P0,8), pw1[1]=PKW(P0,10), pw1); \
    VRD(5); SBAR(); GAPA(C1=__builtin_amdgcn_mfma_f32_32x32x16_bf16(kf[3],qr[1],C1,0,0,0),   P0[14],P0[15],P1[0],P1[1],   pw1[2]=PKW(P0,12),pw1[3]=PKW(P0,14), pw1); \
    VRD(2); SBAR(); GAPA(C0=__builtin_amdgcn_mfma_f32_32x32x16_bf16(kf[4],qr[2],C0,0,0,0),   P1[2],P1[3],P1[4],P1[5],     pw2[0]=PKW(P1,0), pw2[1]=PKW(P1,2), pw2); \
    VRD(6); SBAR(); GAPA(C1=__builtin_amdgcn_mfma_f32_32x32x16_bf16(kf[5],qr[2],C1,0,0,0),   P1[6],P1[7],P1[8],P1[9],     pw2[2]=PKW(P1,4), pw2[3]=PKW(P1,6), pw2); \
    VRD(3); SBAR(); GAPA(C0=__builtin_amdgcn_mfma_f32_32x32x16_bf16(kf[6],qr[3],C0,0,0,0),   P1[10],P1[11],P1[12],P1[13], pw3[0]=PKW(P1,8), pw3[1]=PKW(P1,10), pw3); \
    VRD(7); SBAR(); GAPA(C1=__builtin_amdgcn_mfma_f32_32x32x16_bf16(kf[7],qr[3],C1,0,0,0),   P1[14],P1[15],0.f,0.f,       pw3[2]=PKW(P1,12),pw3[3]=PKW(P1,14), pw3); \
    l_reg+=sacc; \
    if(GK){DMA_K((t)+3,sl_cur);} if(GV){DMA_V((t)+1,sl_next);} \
    CMASK(C0,C1,t); \
    { float a=MX3(C0[0],C0[1],C1[0]),b=MX3(C0[2],C0[3],C1[1]); a=MX3(a,C1[2],C1[3]); \
      _Pragma("unroll") for(int r=4;r<16;r+=4){a=MX3(a,C0[r],C0[r+1]);b=MX3(b,C0[r+2],C0[r+3]);a=MX3(a,C1[r],C1[r+1]);b=MX3(b,C1[r+2],C1[r+3]);} \
      float rm=__builtin_fmaxf(a,b); { auto rr=__builtin_amdgcn_permlane32_swap(__float_as_uint(rm),__float_as_uint(rm),false,false); rm=__builtin_fmaxf(__uint_as_float(rr[0]),__uint_as_float(rr[1])); } \
      resc=false; \
      if(__builtin_expect(__any(rm>(float)THRL),0)){ const float dl=__builtin_fmaxf(rm,0.f); mhat+=dl; \
        _Pragma("unroll") for(int r=0;r<16;++r){C0[r]-=dl;C1[r]-=dl;} \
        _Pragma("unroll") for(int r=0;r<16;++r)negm[r]=-mhat; asm volatile("":"+v"(negm)); \
        const float f=__builtin_amdgcn_exp2f(-dl); l_reg*=f; if(hi==0)wsf[r32]=f; resc=true; } } \
    SBAR(); \
    GAPB(o[0]=__builtin_amdgcn_mfma_f32_32x32x16_bf16(PAF(0),VFR(0),o[0],0,0,0), C0,0); \
    GAPB(o[1]=__builtin_amdgcn_mfma_f32_32x32x16_bf16(PAF(0),VFR(4),o[1],0,0,0), C0,4); \
    KRD(GL,0); GAPB(o[0]=__builtin_amdgcn_mfma_f32_32x32x16_bf16(PAF(1),VFR(1),o[0],0,0,0), C0,8); \
    KRD(GL,1); GAPB(o[1]=__builtin_amdgcn_mfma_f32_32x32x16_bf16(PAF(1),VFR(5),o[1],0,0,0), C0,12); \
    KRD(GL,2); GAPB(o[0]=__builtin_amdgcn_mfma_f32_32x32x16_bf16(PAF(2),VFR(2),o[0],0,0,0), C1,0); \
    KRD(GL,3); GAPB(o[1]=__builtin_amdgcn_mfma_f32_32x32x16_bf16(PAF(2),VFR(6),o[1],0,0,0), C1,4); \
    GAPB(o[0]=__builtin_amdgcn_mfma_f32_32x32x16_bf16(PAF(3),VFR(3),o[0],0,0,0), C1,8); \
    GAPB(o[1]=__builtin_amdgcn_mfma_f32_32x32x16_bf16(PAF(3),VFR(7),o[1],0,0,0), C1,12); \
    }while(0)
  int t=1;
  for(;t+5<NT;t+=2){
    STEP(pB0,pB1,pA0,pA1,t,true,true,true);     WAIT_BAR(2); RESC(); ROT();
    STEP(pA0,pA1,pB0,pB1,t+1,true,true,true);   WAIT_BAR(2); RESC(); ROT();
  }
  #define ENDW(tt) do{ if((tt)+3<NT){WAIT_BAR(2);} else if((tt)+2<NT){WAIT_BAR(1);} else {WAIT_BAR(0);} }while(0)
  for(;t+1<NT;t+=2){
    STEP(pB0,pB1,pA0,pA1,t,(t+3<NT),(t+1<NT),(t+1<NT));       ENDW(t);   RESC(); ROT();
    STEP(pA0,pA1,pB0,pB1,t+1,(t+4<NT),(t+2<NT),(t+2<NT));     ENDW(t+1); RESC(); ROT();
  }
  STEP(pB0,pB1,pA0,pA1,NT-1,false,false,false); RESC();
  { float sacc=pB0[0]+pB0[1]; _Pragma("unroll") for(int r=2;r<16;++r)sacc+=pB0[r]; _Pragma("unroll") for(int r=0;r<16;++r)sacc+=pB1[r]; l_reg+=sacc;
    pw0=(u32x4){PKW(pB0,0),PKW(pB0,2),PKW(pB0,4),PKW(pB0,6)};pw1=(u32x4){PKW(pB0,8),PKW(pB0,10),PKW(pB0,12),PKW(pB0,14)};pw2=(u32x4){PKW(pB1,0),PKW(pB1,2),PKW(pB1,4),PKW(pB1,6)};pw3=(u32x4){PKW(pB1,8),PKW(pB1,10),PKW(pB1,12),PKW(pB1,14)};
    SBAR(); pv(o,vb0+sl_cur,PAF(0),PAF(1),PAF(2),PAF(3)); }
  #undef PKW
  #undef PAF
  #undef VFR
  #undef PIN
  #undef MX3
  #undef GAPA
  #undef GAPB
  #undef EX
  #undef VRD
  #undef KRD
  #undef STEP
  #undef ENDW
  {auto rr=__builtin_amdgcn_permlane32_swap(__float_as_uint(l_reg),__float_as_uint(l_reg),false,false);l_reg=__uint_as_float(rr[0])+__uint_as_float(rr[1]);}
  if(hi==0)wsf[32+r32]=l_reg;asm volatile("s_waitcnt lgkmcnt(0)":::"memory");
  float rli[16];
  #pragma unroll
  for(int r=0;r<16;++r)rli[r]=__builtin_amdgcn_rcpf(wsf[32+crow(r,hi)]);
  bf16*Ow=O0+(long)(wid*QBLK)*OP;
  { bf16*stg=(bf16*)(shm+LDS_OST)+wid*2048;
    #pragma unroll
    for(int r=0;r<16;++r){const int orow=crow(r,hi);
      #pragma unroll
      for(int d0=0;d0<2;++d0)stg[orow*64+d0*32+r32]=__float2bfloat16(o[d0][r]*rli[r]);}
    asm volatile("s_waitcnt lgkmcnt(0)":::"memory");
    #pragma unroll
    for(int i=0;i<4;++i){const int row=i*8+(lane>>3),ch=lane&7; const u32x4 v=*(const u32x4*)(stg+row*64+ch*8); ATTN_STORE16(Ow+(long)row*OP+ch*8,v);} }
  asm volatile("s_waitcnt lgkmcnt(0)\n\ts_barrier":::"memory");
  #undef DMA_K
  #undef DMA_V
  #undef CMASK
  #undef START
  #undef RESC
  #undef ROT
}
constexpr int ATTN_LDS_BYTES=LDS_BYTES;
#undef SBAR
#undef WAIT_BAR
}

constexpr int DM = 1024, BATCH = 8, SEQ = 4096, DEPTH = 4, CTXL = 256, DFF = 2816;
constexpr int MX = BATCH * SEQ, MC = BATCH * CTXL, MALL = MX + MC;
constexpr int INW = 2080, INWP = 2304, KVLEN = CTXL + SEQ, NCH = KVLEN / 64;
constexpr float EPS = 1e-6f;
constexpr float QSCALE = 0.125f * 1.4426950408889634f;
constexpr int PC_CA = 0, PC_CG = 256, PC_GQ = 512, PC_GK = 640, PC_GV = 768, PC_GR = 1024, PC_GF = 1280, PC_AQ = 1312, PC_AK = 1824;
constexpr size_t MiB = 1u << 20;
constexpr size_t WS_W1T = 0, WS_W2T = 88 * MiB, WS_WINT = 132 * MiB, WS_WOT = 150 * MiB, WS_MOD = 158 * MiB, WS_XN = 160 * MiB, WS_CAT = 228 * MiB,
                 WS_HP = 296 * MiB, WS_Q = 483 * MiB, WS_K = 517 * MiB, WS_V = 526 * MiB, WS_CTXR = 535 * MiB, WS_GDS = 543 * MiB, WS_GDEC = 577 * MiB, WS_CTL = 578 * MiB, WS_SSQ = 579 * MiB, WS_SW = 581 * MiB, WS_END = 584 * MiB;
constexpr size_t W1T_SZ = (size_t)2 * DFF * DM, W2T_SZ = (size_t)DM * DFF, WINT_SZ = (size_t)INWP * DM, WOT_SZ = (size_t)DM * DM;
static_assert(8 * W1T_SZ * 2 <= WS_W2T - WS_W1T && 8 * W2T_SZ * 2 <= WS_WINT - WS_W2T && 4 * WINT_SZ * 2 <= WS_WOT - WS_WINT && 4 * WOT_SZ * 2 <= WS_MOD - WS_WOT, "ws map W");
static_assert((size_t)MALL * DM * 2 <= WS_CAT - WS_XN && (size_t)MALL * DM * 2 <= WS_HP - WS_CAT && (size_t)MALL * DFF * 2 <= WS_Q - WS_HP && (size_t)MALL * 512 * 2 <= WS_K - WS_Q, "ws map act");
static_assert((size_t)BATCH * KVLEN * 128 * 2 <= WS_V - WS_K && (size_t)MC * DM * 4 <= WS_GDS - WS_CTXR && (size_t)BATCH * 2 * NCH * 4 * 2048 * 4 <= WS_GDEC - WS_GDS, "ws map 2");
constexpr int LDS_BYTES = 147456;
constexpr int NPH_LAYER = 9, NPHASES = 2 + DEPTH * NPH_LAYER;
constexpr int SWN = 2 * DFF;
static_assert((size_t)DEPTH * 3 * MALL * 4 <= WS_SW - WS_SSQ && (size_t)DEPTH * 3 * 9 * SWN * 4 <= WS_END - WS_SW, "ws map 3");

typedef unsigned short bf16_t;
typedef float f32x4 __attribute__((ext_vector_type(4)));
typedef unsigned u32x4 __attribute__((ext_vector_type(4)));
typedef unsigned u32x2 __attribute__((ext_vector_type(2)));
typedef float f32x2v __attribute__((ext_vector_type(2)));
#define LDSP __attribute__((address_space(3)))
#define LDS_WAIT() asm volatile("s_waitcnt lgkmcnt(0)" ::: "memory")
__device__ __forceinline__ unsigned pk2(float lo, float hi) { return pg8::cvt_pk_bf16(lo, hi); }
__device__ __forceinline__ float bflo(unsigned w) { return __uint_as_float(w << 16); }
__device__ __forceinline__ float bfhi(unsigned w) { return __uint_as_float(w & 0xffff0000u); }
__device__ __forceinline__ void unpack8(const u32x4 r, float (&x)[8]) { x[0] = bflo(r.x); x[1] = bfhi(r.x); x[2] = bflo(r.y); x[3] = bfhi(r.y); x[4] = bflo(r.z); x[5] = bfhi(r.z); x[6] = bflo(r.w); x[7] = bfhi(r.w); }
__device__ __forceinline__ u32x4 pack8(const float (&x)[8]) { u32x4 w; w.x = pk2(x[0], x[1]); w.y = pk2(x[2], x[3]); w.z = pk2(x[4], x[5]); w.w = pk2(x[6], x[7]); return w; }
template <int CTRL> __device__ __forceinline__ float dpp_mov(float v) { return __int_as_float(__builtin_amdgcn_update_dpp(0, __float_as_int(v), CTRL, 0xf, 0xf, false)); }
template <int X> __device__ __forceinline__ float swz_xor(float v) {
    if constexpr (X == 1) return dpp_mov<0xB1>(v);
    else if constexpr (X == 2) return dpp_mov<0x4E>(v);
    else return __int_as_float(__builtin_amdgcn_ds_swizzle(__float_as_int(v), 0x1f | (X << 10)));
}
__device__ __forceinline__ float sum8(float v)  { v += dpp_mov<0xB1>(v); v += dpp_mov<0x4E>(v); v += dpp_mov<0x141>(v); return v; }
__device__ __forceinline__ float sum16(float v) { v = sum8(v); v += dpp_mov<0x140>(v); return v; }
__device__ __forceinline__ float wave_sum(float v) {
    v = sum16(v); v += swz_xor<16>(v);
    auto rr = __builtin_amdgcn_permlane32_swap(__float_as_uint(v), __float_as_uint(v), false, false);
    return __uint_as_float(rr[0]) + __uint_as_float(rr[1]);
}
__device__ __forceinline__ float sigm(float v) { return __builtin_amdgcn_rcpf(1.0f + __expf(-v)); }

struct Args { const float* in[20]; float* out; unsigned char* ws; int ph_lo, ph_hi; };
typedef const __attribute__((address_space(4))) Args* KA;
enum { I_X = 0, I_C, I_CTX, I_CCTX, I_WADA, I_BADA, I_GNORM, I_WFI, I_WFO, I_WIN, I_WOUT, I_WDW, I_BDW, I_CNG, I_CNB, I_WGG, I_BGG, I_GLAG, I_QNG, I_KNG };

__device__ __forceinline__ void transpose_item(const float* W, int K, int N, bf16_t* WT, int kb, int nsrc, int ndst, LDSP float* scr, int lane) {
    const int k0 = 64 * kb;
#pragma unroll 8
    for (int i = 0; i < 32; ++i) { const int kk = 2 * i + (lane >> 5); scr[kk * 33 + (lane & 31)] = W[(size_t)(k0 + kk) * N + nsrc + (lane & 31)]; }
    LDS_WAIT();
    const int c = lane & 7;
#pragma unroll
    for (int j = 0; j < 4; ++j) { const int n = (lane >> 3) + 8 * j; const LDSP float* s = scr + (8 * c) * 33 + n;
        u32x4 o; o.x = pk2(s[0 * 33], s[1 * 33]); o.y = pk2(s[2 * 33], s[3 * 33]); o.z = pk2(s[4 * 33], s[5 * 33]); o.w = pk2(s[6 * 33], s[7 * 33]);
        *(u32x4*)(WT + (size_t)(ndst + n) * K + k0 + 8 * c) = o; }
    LDS_WAIT();
}
__device__ __forceinline__ void phase0(KA a, LDSP unsigned char* lds, int tid, int lane, int wave, int bid, int G) {
    unsigned char* ws = a->ws;
    LDSP float* scr = (LDSP float*)(lds + wave * 8704);
    const int gw = bid * 8 + wave, NGW = G * 8;
    constexpr int I1 = 16 * 176, I2 = 44 * 32, I3 = 16 * 65, I4 = 16 * 32, LI = 2 * I1 + 2 * I2 + I3 + I4;
    for (int it = gw; it < DEPTH * LI; it += NGW) {
        const int l = it / LI; int r = it % LI;
        if (r < 2 * I1) { const int f = r / I1, rr = r % I1, kb = rr / 176, nb = rr % 176, nsrc = nb * 32; const bool isu = nsrc >= DFF; const int j = isu ? nsrc - DFF : nsrc;
            transpose_item(a->in[I_WFI] + (size_t)(l * 2 + f) * DM * 2 * DFF, DM, 2 * DFF, (bf16_t*)(ws + WS_W1T) + (size_t)(l * 2 + f) * W1T_SZ, kb, nsrc, 256 * (j >> 7) + (isu ? 128 : 0) + (j & 127), scr, lane); continue; }
        r -= 2 * I1;
        if (r < 2 * I2) { const int f = r / I2, rr = r % I2, kb = rr / 32, nb = rr % 32;
            transpose_item(a->in[I_WFO] + (size_t)(l * 2 + f) * DFF * DM, DFF, DM, (bf16_t*)(ws + WS_W2T) + (size_t)(l * 2 + f) * W2T_SZ, kb, nb * 32, nb * 32, scr, lane); continue; }
        r -= 2 * I2;
        if (r < I3) { const int kb = r / 65, nb = r % 65;
            transpose_item(a->in[I_WIN] + (size_t)l * DM * INW, DM, INW, (bf16_t*)(ws + WS_WINT) + (size_t)l * WINT_SZ, kb, nb * 32, nb * 32, scr, lane); continue; }
        r -= I3;
        { const int kb = r / 32, nb = r % 32;
            transpose_item(a->in[I_WOUT] + (size_t)l * DM * DM, DM, DM, (bf16_t*)(ws + WS_WOT) + (size_t)l * WOT_SZ, kb, nb * 32, nb * 32, scr, lane); }
    }
    { constexpr int PV = (INWP - INW) * DM * 2 / 16;
        for (int i = bid * 512 + tid; i < DEPTH * PV; i += G * 512) { const int l = i / PV, r = i % PV;
            ((u32x4*)((bf16_t*)(ws + WS_WINT) + (size_t)l * WINT_SZ + (size_t)INW * DM))[r] = (u32x4){0u, 0u, 0u, 0u}; } }
    { float* SSQ = (float*)(ws + WS_SSQ); for (int i = bid * 512 + tid; i < DEPTH * 3 * MALL; i += G * 512) SSQ[i] = 0.f; }
    __syncthreads();
    LDSP float* S = (LDSP float*)(lds + 69632);
    LDSP float* red = (LDSP float*)(lds + 106496);
    for (int i = tid; i < 9 * 1024; i += 512) { const int r = i >> 10, k = i & 1023; const float cv = r < 8 ? a->in[I_C][r * 1024 + k] : a->in[I_CCTX][k]; S[i] = cv * sigm(cv); }
    __syncthreads();
    float* MOD = (float*)(ws + WS_MOD);
    for (int it = bid; it < DEPTH * 144; it += G) {
        const int l = it / 144, n0 = (it % 144) * 64;
        const float* Wp = a->in[I_WADA] + (size_t)l * DM * 9216 + n0 + lane;
        float acc[9];
#pragma unroll
        for (int r = 0; r < 9; ++r) acc[r] = 0.f;
#pragma unroll 8
        for (int kk = 0; kk < 128; ++kk) { const int k = wave * 128 + kk; const float w = Wp[(size_t)k * 9216];
#pragma unroll
            for (int r = 0; r < 9; ++r) acc[r] += S[r * 1024 + k] * w; }
#pragma unroll
        for (int r = 0; r < 9; ++r) red[(wave * 9 + r) * 64 + lane] = acc[r];
        __syncthreads();
        for (int o = tid; o < 576; o += 512) { const int r = o >> 6, ln = o & 63; float s = 0.f;
#pragma unroll
            for (int w = 0; w < 8; ++w) s += red[(w * 9 + r) * 64 + ln];
            MOD[(size_t)(l * 9 + r) * 9216 + n0 + ln] = s + a->in[I_BADA][l * 9216 + n0 + ln]; }
        __syncthreads();
    }
}
__device__ __forceinline__ void phase1(KA a, LDSP unsigned char* lds, int tid, int lane, int wave, int bid, int G) {
    const float* MOD = (const float*)(a->ws + WS_MOD); bf16_t* XN = (bf16_t*)(a->ws + WS_XN); float* SSQ = (float*)(a->ws + WS_SSQ); float* SW = (float*)(a->ws + WS_SW);
    const float* g = a->in[I_GNORM];
    f32x4 nv[4];
    { const int m0 = bid * 8 + wave; if (m0 < MALL) { const float* xr0 = m0 >= MX ? a->in[I_CTX] + (size_t)(m0 - MX) * DM : a->in[I_X] + (size_t)m0 * DM;
#pragma unroll
        for (int q = 0; q < 4; ++q) nv[q] = ((const f32x4*)xr0)[lane + 64 * q]; } }
    for (int m = bid * 8 + wave; m < MALL; m += G * 8) {
        const bool isc = m >= MX;
        const float* md = MOD + (size_t)(isc ? 8 : (m >> 12)) * 9216;
        f32x4 v[4]; float ss = 0.f;
#pragma unroll
        for (int q = 0; q < 4; ++q) { v[q] = nv[q]; ss += (v[q].x * v[q].x + v[q].y * v[q].y) + (v[q].z * v[q].z + v[q].w * v[q].w); }
        { const int mn = m + G * 8; if (mn < MALL) { const float* xrn = mn >= MX ? a->in[I_CTX] + (size_t)(mn - MX) * DM : a->in[I_X] + (size_t)mn * DM;
#pragma unroll
            for (int q = 0; q < 4; ++q) nv[q] = ((const f32x4*)xrn)[lane + 64 * q]; } }
        ss = wave_sum(ss);
        if (lane == 0) SSQ[m] = ss;
#pragma unroll
        for (int q = 0; q < 4; ++q) { const int col = 4 * lane + 256 * q;
            const f32x4 y = v[q] * *(const f32x4*)(g + col) * (*(const f32x4*)(md + 1024 + col) + 1.0f);
            u32x2 o; o.x = pk2(y.x, y.y); o.y = pk2(y.z, y.w);
            *(u32x2*)(XN + (size_t)m * DM + col) = o;
            typedef _Float16 h16x4 __attribute__((ext_vector_type(4)));
            *(h16x4*)((_Float16*)(a->ws + WS_CAT) + (size_t)m * DM + col) = __builtin_convertvector(v[q], h16x4); }
    }
    LDSP float* SH = (LDSP float*)lds;
    constexpr int RPL = 2 * DFF + INWP + 2 * DFF;
#pragma unroll 1
    for (int l = 0; l < DEPTH; ++l) {
        __syncthreads();
        for (int i = tid; i < 27 * 256; i += 512) { const int v = i >> 8, j = v / 9, bi = v % 9, c4 = (i & 255) * 4; *(LDSP f32x4*)(SH + v * 1024 + c4) = *(const f32x4*)(MOD + (size_t)(l * 9 + bi) * 9216 + (3 * j) * 1024 + c4); }
        __syncthreads();
        const bf16_t* w0b = (const bf16_t*)(a->ws + WS_W1T) + (size_t)(l * 2) * W1T_SZ; const bf16_t* w1b = (const bf16_t*)(a->ws + WS_WINT) + (size_t)l * WINT_SZ; const bf16_t* w2b = (const bf16_t*)(a->ws + WS_W1T) + (size_t)(l * 2 + 1) * W1T_SZ;
#define SW_ROWPTR(rr) ((rr) < 2 * DFF ? w0b + (size_t)(rr) * DM : ((rr) < 2 * DFF + INWP ? w1b + (size_t)((rr) - 2 * DFF) * DM : w2b + (size_t)((rr) - 2 * DFF - INWP) * DM))
        u32x4 nx0 = {0u, 0u, 0u, 0u}, nx1 = {0u, 0u, 0u, 0u};
        { const int r0 = bid * 8 + wave; if (r0 < RPL) { const bf16_t* p = SW_ROWPTR(r0); nx0 = *(const u32x4*)(p + lane * 8); nx1 = *(const u32x4*)(p + 512 + lane * 8); } }
#pragma unroll 1
        for (int r = bid * 8 + wave; r < RPL; r += G * 8) {
            float w0[8], w1[8]; unpack8(nx0, w0); unpack8(nx1, w1);
            { const int rn = r + G * 8; if (rn < RPL) { const bf16_t* p = SW_ROWPTR(rn); nx0 = *(const u32x4*)(p + lane * 8); nx1 = *(const u32x4*)(p + 512 + lane * 8); } }
            const int j = r < 2 * DFF ? 0 : (r < 2 * DFF + INWP ? 1 : 2), rj = r - (j == 0 ? 0 : (j == 1 ? 2 * DFF : 2 * DFF + INWP));
#pragma unroll
            for (int bi = 0; bi < 9; ++bi) { LDSP const float* sh = SH + (j * 9 + bi) * 1024 + lane * 8;
                const f32x4 s0 = *(LDSP const f32x4*)(sh), s1 = *(LDSP const f32x4*)(sh + 4), s2 = *(LDSP const f32x4*)(sh + 512), s3 = *(LDSP const f32x4*)(sh + 516);
                float d = (w0[0] * s0.x + w0[1] * s0.y) + (w0[2] * s0.z + w0[3] * s0.w) + (w0[4] * s1.x + w0[5] * s1.y) + (w0[6] * s1.z + w0[7] * s1.w)
                        + (w1[0] * s2.x + w1[1] * s2.y) + (w1[2] * s2.z + w1[3] * s2.w) + (w1[4] * s3.x + w1[5] * s3.y) + (w1[6] * s3.z + w1[7] * s3.w);
                d = wave_sum(d);
                if (lane == 0) SW[((size_t)(l * 3 + j) * 9 + bi) * SWN + rj] = d; } }
#undef SW_ROWPTR
    }
    __syncthreads();
}
__device__ __forceinline__ void prep_phase(KA a, LDSP unsigned char* lds, int l, int tid, int lane, int wave, int bid, int G) {
    LDSP f32x2v* CS = (LDSP f32x2v*)(lds);
    for (int i = tid; i < 1024; i += 512) { const int pos = i >> 4, f = i & 15;
        const float freq = exp2f(-(float)f * (13.287712379549449f / 16.0f)); const float ang = (float)pos * freq;
        float rev = ang * 0.15915494309189535f; rev -= floorf(rev);
        CS[i] = (f32x2v){__builtin_amdgcn_cosf(rev), __builtin_amdgcn_sinf(rev)}; }
    __syncthreads();
    const bf16_t* P = (const bf16_t*)(a->ws + WS_HP); bf16_t* Q = (bf16_t*)(a->ws + WS_Q); bf16_t* Kb = (bf16_t*)(a->ws + WS_K); bf16_t* Vb = (bf16_t*)(a->ws + WS_V);
    const int sub = lane & 7, axis = sub >> 2, half = (sub >> 1) & 1, f0 = (sub & 1) * 8;
    float qg[8], kg[8];
#pragma unroll
    for (int e = 0; e < 8; ++e) { qg[e] = a->in[I_QNG][l * 64 + sub * 8 + e]; kg[e] = a->in[I_KNG][l * 64 + sub * 8 + e]; }
    u32x4 nq = {0u, 0u, 0u, 0u}, nk_ = {0u, 0u, 0u, 0u};
    { const int m0 = bid * 8 + wave; if (m0 < MALL) { nq = *(const u32x4*)(P + (size_t)m0 * INWP + PC_AQ + lane * 8); nk_ = *(const u32x4*)(P + (size_t)m0 * INWP + PC_AK + (lane & 31) * 8); } }
    for (int m = bid * 8 + wave; m < MALL; m += G * 8) {
        const u32x4 rawq = nq, rawk = nk_;
        asm volatile("" :: "v"(rawq), "v"(rawk) : "memory");
        { const int mn = m + G * 8; if (mn < MALL) { nq = *(const u32x4*)(P + (size_t)mn * INWP + PC_AQ + lane * 8); nk_ = *(const u32x4*)(P + (size_t)mn * INWP + PC_AK + (lane & 31) * 8); } }
        asm volatile("" ::: "memory");
        const bool lat = m < MX;
        const int b = lat ? (m >> 12) : ((m - MX) >> 8), t = lat ? (m & 4095) : 0, pos = lat ? (CTXL + t) : ((m - MX) & 255);
        const int p = axis ? (t & 63) : (t >> 6);
        const bf16_t* pr = P + (size_t)m * INWP;
        float x[8], y[8];
        { const u32x4 raw = rawq; unpack8(raw, x);
            float ss = 0.f;
#pragma unroll
            for (int e = 0; e < 8; ++e) ss += x[e] * x[e];
            ss = sum8(ss);
            const float rstd = 1.0f / sqrtf(ss * (1.0f / 64.0f) + EPS);
#pragma unroll
            for (int e = 0; e < 8; ++e) y[e] = x[e] * rstd * qg[e];
            if (lat) {
#pragma unroll
                for (int e = 0; e < 8; ++e) { const float o = swz_xor<2>(y[e]); const f32x2v cs = CS[p * 16 + f0 + e]; x[e] = half ? (y[e] * cs.x + o * cs.y) : (y[e] * cs.x - o * cs.y); }
            } else {
#pragma unroll
                for (int e = 0; e < 8; ++e) x[e] = y[e];
            }
#pragma unroll
            for (int e = 0; e < 8; ++e) x[e] *= QSCALE;
            *(u32x4*)(Q + (size_t)m * 512 + lane * 8) = pack8(x); }
        { const u32x4 raw = rawk; unpack8(raw, x);
            float ss = 0.f;
#pragma unroll
            for (int e = 0; e < 8; ++e) ss += x[e] * x[e];
            ss = sum8(ss);
            const float rstd = 1.0f / sqrtf(ss * (1.0f / 64.0f) + EPS);
#pragma unroll
            for (int e = 0; e < 8; ++e) y[e] = x[e] * rstd * kg[e];
            if (lat) {
#pragma unroll
                for (int e = 0; e < 8; ++e) { const float o = swz_xor<2>(y[e]); const f32x2v cs = CS[p * 16 + f0 + e]; x[e] = half ? (y[e] * cs.x + o * cs.y) : (y[e] * cs.x - o * cs.y); }
            } else {
#pragma unroll
                for (int e = 0; e < 8; ++e) x[e] = y[e];
            }
            const size_t kvrow = ((size_t)b * KVLEN + pos) * 128;
            if (lane < 16) *(u32x4*)(Kb + kvrow + lane * 8) = pack8(x);
            else if (lane < 32) *(u32x4*)(Vb + kvrow + (lane - 16) * 8) = raw; }
    }
    __syncthreads();
}
__device__ __forceinline__ void conv_phase(KA a, LDSP unsigned char* lds, int l, bool last, int tid, int lane, int bid, int G) {
    LDSP float* hs = (LDSP float*)lds;
    LDSP bf16_t* os = (LDSP bf16_t*)(lds + 94 * 256 * 4);
    const bf16_t* P = (const bf16_t*)(a->ws + WS_HP); bf16_t* CAT = (bf16_t*)a->out;
    const int c = tid & 255, hf = tid >> 8;
    float w[31];
#pragma unroll
    for (int k = 0; k < 31; ++k) w[k] = a->in[I_WDW][(size_t)(l * 31 + k) * 256 + c];
    const float bias = a->in[I_BDW][l * 256 + c], gg = a->in[I_CNG][l * 256 + c], bb = a->in[I_CNB][l * 256 + c];
    const int nitems = last ? 512 : 544;
    for (int it = bid; it < nitems; it += G) {
        int base, len, t0;
        if (it < 512) { base = (it >> 6) * SEQ; len = SEQ; t0 = (it & 63) * 64; } else { const int i2 = it - 512; base = MX + (i2 >> 2) * CTXL; len = CTXL; t0 = (i2 & 3) * 64; }
        for (int rr = tid >> 5; rr < 94; rr += 16) { const int t = t0 - 15 + rr, c8 = (tid & 31) * 8;
            float h[8];
            if (t >= 0 && t < len) { const bf16_t* pr = P + (size_t)(base + t) * INWP + c8; float av[8], gv[8];
                unpack8(*(const u32x4*)(pr + PC_CA), av); unpack8(*(const u32x4*)(pr + PC_CG), gv);
#pragma unroll
                for (int e = 0; e < 8; ++e) h[e] = av[e] * sigm(gv[e]);
            } else {
#pragma unroll
                for (int e = 0; e < 8; ++e) h[e] = 0.f;
            }
            *(LDSP f32x4*)(hs + rr * 256 + c8) = (f32x4){h[0], h[1], h[2], h[3]}; *(LDSP f32x4*)(hs + rr * 256 + c8 + 4) = (f32x4){h[4], h[5], h[6], h[7]}; }
        __syncthreads();
#pragma unroll 1
        for (int i0 = 0; i0 < 32; i0 += 4) { const int ib = hf * 32 + i0;
            float xw[34];
#pragma unroll
            for (int k = 0; k < 34; ++k) xw[k] = hs[(ib + k) * 256 + c];
            float acc[4], mean[4], var[4];
#pragma unroll
            for (int t = 0; t < 4; ++t) { float s_ = bias;
#pragma unroll
                for (int k = 0; k < 31; ++k) s_ += w[k] * xw[t + k];
                acc[t] = s_; mean[t] = s_; }
#pragma unroll
            for (int t = 0; t < 4; ++t) mean[t] = sum16(mean[t]);
#pragma unroll
            for (int t = 0; t < 4; ++t) mean[t] += swz_xor<16>(mean[t]);
#pragma unroll
            for (int t = 0; t < 4; ++t) { auto rr = __builtin_amdgcn_permlane32_swap(__float_as_uint(mean[t]), __float_as_uint(mean[t]), false, false);
                mean[t] = (__uint_as_float(rr[0]) + __uint_as_float(rr[1])) * (1.0f / 64.0f); acc[t] -= mean[t]; var[t] = acc[t] * acc[t]; }
#pragma unroll
            for (int t = 0; t < 4; ++t) var[t] = sum16(var[t]);
#pragma unroll
            for (int t = 0; t < 4; ++t) var[t] += swz_xor<16>(var[t]);
#pragma unroll
            for (int t = 0; t < 4; ++t) { auto rr = __builtin_amdgcn_permlane32_swap(__float_as_uint(var[t]), __float_as_uint(var[t]), false, false);
                const float vv = (__uint_as_float(rr[0]) + __uint_as_float(rr[1])) * (1.0f / 64.0f);
                const float y = acc[t] * __builtin_amdgcn_rsqf(vv + EPS) * gg + bb;
                const float o = y * sigm(y);
                os[(ib + t) * 256 + c] = (bf16_t)(pk2(o, 0.f) & 0xffffu); } }
        __syncthreads();
        for (int q = tid; q < 2048; q += 512) { const int row = q >> 5, c8 = (q & 31) * 8;
            *(u32x4*)(CAT + (size_t)(base + t0 + row) * DM + c8) = *(const LDSP u32x4*)(os + row * 256 + c8); }
        __syncthreads();
    }
}
typedef short gbf16x8 __attribute__((ext_vector_type(8)));
constexpr int GB_WG = 106496, GB_BG = 106496 + 16384;
constexpr int GB_Q = 0, GB_K = 8448, GB_GF = 16896, GB_GB = 20992, GB_VT = 25088, GB_S0T = 34304, GB_QE = 42496, GB_KE = 50688, GB_KENDT = 58880, GB_ATT = 68096, GB_TOT = 86528, GB_O = 88576, GB_END = 105984;
constexpr int VTP = 72, ATP = 72, KTP = 72, OP_ = 68;
static_assert(GB_END <= 131072 && GB_VT + 64 * VTP * 2 == GB_S0T && GB_ATT + 2 * 64 * ATP * 2 == GB_TOT && GB_O + 64 * OP_ * 4 == GB_END, "gla lds");
__device__ __forceinline__ int gla_row(int b, int c, int i) { return c < 4 ? MX + b * CTXL + c * 64 + i : b * SEQ + (c - 4) * 64 + i; }
__device__ __forceinline__ void st_bf16(LDSP unsigned char* base, int byteoff, float v) { *(LDSP bf16_t*)(base + byteoff) = (bf16_t)(pk2(v, 0.f) & 0xffffu); }
struct GlaRegs { u32x4 qk, gt, vv, rg; f32x4 s0[2], gg[2]; };
template <bool G3> __device__ __forceinline__ void gla_issue(KA a, GlaRegs& R, const float* ggb, int b, int c, int h, int tid) {
    const bf16_t* P = (const bf16_t*)(a->ws + WS_HP);
    { const int i = (tid & 255) >> 2, part = tid & 3; const bf16_t* pr = P + (size_t)gla_row(b, c, i) * INWP;
        R.qk = (u32x4){0u, 0u, 0u, 0u};
        if (G3 || tid >= 256) R.qk = *(const u32x4*)(pr + (tid < 256 ? PC_GQ : PC_GK) + h * 32 + part * 8);
        R.gt = *(const u32x4*)(pr + PC_GF + part * 8); }
    { const int j = tid >> 3, part = tid & 7; R.vv = *(const u32x4*)(P + (size_t)gla_row(b, c, j) * INWP + PC_GV + h * 64 + part * 8); }
    if (G3) { const float* DS = (const float*)(a->ws + WS_GDS);
#pragma unroll
        for (int dir = 0; dir < 2; ++dir) { const size_t ci = ((size_t)(b * 2 + dir) * NCH + c) * 4 + h; R.s0[dir] = *(const f32x4*)(DS + ci * 2048 + (tid >> 4) * 64 + (tid & 15) * 4); }
        R.rg = *(const u32x4*)(P + (size_t)gla_row(b, c, tid >> 3) * INWP + PC_GR + h * 64 + (tid & 7) * 8);
        R.gg[0] = *(const f32x4*)(ggb + h * 64 + (tid & 7) * 8); R.gg[1] = *(const f32x4*)(ggb + h * 64 + (tid & 7) * 8 + 4); }
}
template <bool G3> __device__ __forceinline__ void gla_stage(KA a, LDSP unsigned char* B, const GlaRegs& R, int l, int b, int c, int h, int tid) {
    LDSP float* Qf = (LDSP float*)(B + GB_Q); LDSP float* Kf = (LDSP float*)(B + GB_K); LDSP float* GF = (LDSP float*)(B + GB_GF); LDSP float* GBk = (LDSP float*)(B + GB_GB);
    { const int i = (tid & 255) >> 2, part = tid & 3;
        float x[8]; unpack8(R.qk, x);
        if (tid < 256) {
            if (G3) {
#pragma unroll
                for (int e = 0; e < 8; ++e) Qf[i * 33 + part * 8 + e] = x[e]; }
            unpack8(R.gt, x);
#pragma unroll
            for (int e = 0; e < 8; ++e) (part < 2 ? GF : GBk)[i * 16 + (part & 1) * 8 + e] = x[e];
        } else {
#pragma unroll
            for (int e = 0; e < 8; ++e) Kf[i * 33 + part * 8 + e] = x[e]; } }
    { const int j = tid >> 3, part = tid & 7; const u32x4 r = R.vv;
        const unsigned w[4] = {r.x, r.y, r.z, r.w};
#pragma unroll
        for (int e = 0; e < 8; ++e) *(LDSP bf16_t*)(B + GB_VT + ((part * 8 + e) * VTP + j) * 2) = (bf16_t)((e & 1) ? (w[e >> 1] >> 16) : (w[e >> 1] & 0xffffu)); }
    if (G3) {
#pragma unroll
        for (int dir = 0; dir < 2; ++dir) { const int d = tid >> 4, v4 = (tid & 15) * 4; const f32x4 sv = R.s0[dir];
            st_bf16(B, GB_S0T + dir * 4096 + ((v4 + 0) * 32 + d) * 2, sv.x); st_bf16(B, GB_S0T + dir * 4096 + ((v4 + 1) * 32 + d) * 2, sv.y);
            st_bf16(B, GB_S0T + dir * 4096 + ((v4 + 2) * 32 + d) * 2, sv.z); st_bf16(B, GB_S0T + dir * 4096 + ((v4 + 3) * 32 + d) * 2, sv.w); } }
    __syncthreads();
    const int dir = tid >> 8, seg = (tid >> 5) & 7, d = tid & 31;
    float p[8], qv[8], kv[8];
    { LDSP const float* Wg = (LDSP const float*)(B + GB_WG) + (dir * 16) * 128 + h * 32 + d; const float bg = ((LDSP const float*)(B + GB_BG))[dir * 128 + h * 32 + d];
        float wc[16];
#pragma unroll
        for (int r = 0; r < 16; ++r) wc[r] = Wg[r * 128];
        LDSP const float* gs = dir ? GBk : GF;
#pragma unroll
        for (int r = 0; r < 8; ++r) { const int i = dir ? 63 - (seg * 8 + r) : seg * 8 + r; kv[r] = Kf[i * 33 + d]; qv[r] = G3 ? Qf[i * 33 + d] : 0.f; }
        float run = 0.f;
#pragma unroll
        for (int hb = 0; hb < 2; ++hb) {
            f32x4 gq[4][4];
#pragma unroll
            for (int r = 0; r < 4; ++r) { const int i = dir ? 63 - (seg * 8 + hb * 4 + r) : seg * 8 + hb * 4 + r;
#pragma unroll
                for (int q = 0; q < 4; ++q) gq[r][q] = *(LDSP const f32x4*)(gs + i * 16 + 4 * q); }
#pragma unroll
            for (int r = 0; r < 4; ++r) { float z0 = bg, z1 = 0.f, z2 = 0.f, z3 = 0.f;
#pragma unroll
                for (int q = 0; q < 4; ++q) { z0 += gq[r][q].x * wc[4 * q]; z1 += gq[r][q].y * wc[4 * q + 1]; z2 += gq[r][q].z * wc[4 * q + 2]; z3 += gq[r][q].w * wc[4 * q + 3]; }
                const float z = (z0 + z1) + (z2 + z3);
                const float ls = fminf(z, 0.f) - __logf(1.0f + __expf(-fabsf(z)));
                run += ls * (1.0f / 16.0f); p[hb * 4 + r] = run; } }
        ((LDSP float*)(B + GB_TOT))[(dir * 8 + seg) * 32 + d] = run; }
    __syncthreads();
    float off = 0.f, bl = 0.f;
#pragma unroll
    for (int sg = 0; sg < 8; ++sg) { const float t = ((LDSP const float*)(B + GB_TOT))[(dir * 8 + sg) * 32 + d]; bl += t; off += (sg < seg) ? t : 0.f; }
    float o1[8], o2[8];
#pragma unroll
    for (int r = 0; r < 8; ++r) { const float bc = p[r] + off;
        if (G3) { o1[r] = qv[r] * 0.17677669529663687f * __expf(bc); o2[r] = kv[r] * __expf(-bc); }
        else { o1[r] = kv[r] * __expf(bl - bc); o2[r] = 0.f; } }
#pragma unroll
    for (int r = 0; r < 8; ++r) { const int i = dir ? 63 - (seg * 8 + r) : seg * 8 + r;
        if (G3) { st_bf16(B, GB_QE + dir * 4096 + (i * 32 + d) * 2, o1[r]); st_bf16(B, GB_KE + dir * 4096 + (i * 32 + d) * 2, o2[r]); }
        else st_bf16(B, GB_KENDT + dir * (32 * KTP * 2) + (d * KTP + i) * 2, o1[r]); }
    if (!G3 && seg == 0) ((float*)(a->ws + WS_GDEC))[(((size_t)(b * 2 + dir) * NCH + c) * 4 + h) * 32 + d] = __expf(bl);
    __syncthreads();
}
__device__ __forceinline__ void gla_g1_phase(KA a, LDSP unsigned char* lds, int l, int tid, int bid, int G) {
    float* DS = (float*)(a->ws + WS_GDS);
    const int lane = tid & 63, w = tid >> 6, fr = lane & 15, fq = lane >> 4;
    for (int i = tid; i < 2 * 16 * 128; i += 512) ((LDSP float*)(lds + GB_WG))[i] = a->in[I_WGG][(size_t)l * 2 * 16 * 128 + i];
    if (tid < 256) ((LDSP float*)(lds + GB_BG))[tid] = a->in[I_BGG][l * 256 + tid];
    __syncthreads();
    GlaRegs R, Rn;
    if (bid < BATCH * NCH * 4) gla_issue<false>(a, Rn, nullptr, (bid >> 2) / NCH, (bid >> 2) % NCH, bid & 3, tid);
    for (int it = bid; it < BATCH * NCH * 4; it += G) {
        const int h = it & 3, c = (it >> 2) % NCH, b = (it >> 2) / NCH;
        R = Rn;
        gla_stage<false>(a, lds, R, l, b, c, h, tid);
        asm volatile("" ::: "memory");
        { const int itn = it + G; if (itn < BATCH * NCH * 4) gla_issue<false>(a, Rn, nullptr, (itn >> 2) / NCH, (itn >> 2) % NCH, itn & 3, tid); }
        asm volatile("" ::: "memory");
        const int dir = w >> 2, dt = (w >> 1) & 1;
        const size_t ci = ((size_t)(b * 2 + dir) * NCH + c) * 4 + h;
        gbf16x8 af[2];
#pragma unroll
        for (int sx = 0; sx < 2; ++sx) af[sx] = *(LDSP const gbf16x8*)(lds + GB_KENDT + dir * (32 * KTP * 2) + ((dt * 16 + fr) * KTP + sx * 32 + fq * 8) * 2);
#pragma unroll
        for (int t = 0; t < 2; ++t) { const int vt = (w & 1) * 2 + t; f32x4 acc = {0.f, 0.f, 0.f, 0.f};
#pragma unroll
            for (int sx = 0; sx < 2; ++sx) { const gbf16x8 bf = *(LDSP const gbf16x8*)(lds + GB_VT + ((vt * 16 + fr) * VTP + sx * 32 + fq * 8) * 2);
                acc = __builtin_amdgcn_mfma_f32_16x16x32_bf16(af[sx], bf, acc, 0, 0, 0); }
#pragma unroll
            for (int r = 0; r < 4; ++r) DS[ci * 2048 + (size_t)(dt * 16 + fq * 4 + r) * 64 + vt * 16 + fr] = acc[r]; }
        __syncthreads();
    }
}
__device__ __forceinline__ void gla_g2_phase(KA a, int tid, int bid, int G) {
    float* DS = (float*)(a->ws + WS_GDS); const float* DEC = (const float*)(a->ws + WS_GDEC);
    for (int e = bid * 512 + tid; e < BATCH * 2 * 4 * 2048; e += G * 512) {
        const int dv = e & 2047, h = (e >> 11) & 3, dir = (e >> 13) & 1, b = e >> 14, d = dv >> 6;
        float S = 0.f;
#pragma unroll 4
        for (int st = 0; st < NCH; ++st) { const int c = dir ? (st < 4 ? 3 - st : 71 - st) : st;
            const size_t ci = ((size_t)(b * 2 + dir) * NCH + c) * 4 + h;
            const float dsv = DS[ci * 2048 + dv], dec = DEC[ci * 32 + d];
            DS[ci * 2048 + dv] = S; S = dec * S + dsv; }
    }
}
__device__ __forceinline__ void gla_g3_phase(KA a, LDSP unsigned char* lds, int l, bool last, int tid, int bid, int G) {
    const bf16_t* P = (const bf16_t*)(a->ws + WS_HP); bf16_t* CAT = (bf16_t*)a->out;
    const int lane = tid & 63, w = tid >> 6, fr = lane & 15, fq = lane >> 4, it_ = w >> 1;
    for (int i = tid; i < 2 * 16 * 128; i += 512) ((LDSP float*)(lds + GB_WG))[i] = a->in[I_WGG][(size_t)l * 2 * 16 * 128 + i];
    if (tid < 256) ((LDSP float*)(lds + GB_BG))[tid] = a->in[I_BGG][l * 256 + tid];
    __syncthreads();
    const int c_lo = last ? 4 : 0, ncs = NCH - c_lo, nit = BATCH * ncs * 4;
    GlaRegs R, Rn;
    if (bid < nit) gla_issue<true>(a, Rn, a->in[I_GLAG] + (size_t)l * 256, (bid >> 2) / ncs, c_lo + (bid >> 2) % ncs, bid & 3, tid);
    for (int it = bid; it < nit; it += G) {
        const int h = it & 3, c = c_lo + (it >> 2) % ncs, b = (it >> 2) / ncs;
        R = Rn;
        gla_stage<true>(a, lds, R, l, b, c, h, tid);
        asm volatile("" ::: "memory");
        { const int itn = it + G; if (itn < nit) gla_issue<true>(a, Rn, a->in[I_GLAG] + (size_t)l * 256, (itn >> 2) / ncs, c_lo + (itn >> 2) % ncs, itn & 3, tid); }
        asm volatile("" ::: "memory");
        gbf16x8 qf[2], kf[2][2];
#pragma unroll
        for (int dir = 0; dir < 2; ++dir) { qf[dir] = *(LDSP const gbf16x8*)(lds + GB_QE + dir * 4096 + ((it_ * 16 + fr) * 32 + fq * 8) * 2);
#pragma unroll
            for (int t = 0; t < 2; ++t) kf[dir][t] = *(LDSP const gbf16x8*)(lds + GB_KE + dir * 4096 + ((((w & 1) * 2 + t) * 16 + fr) * 32 + fq * 8) * 2); }
        f32x4 s4[2][2];
#pragma unroll
        for (int dir = 0; dir < 2; ++dir)
#pragma unroll
            for (int t = 0; t < 2; ++t) { const f32x4 z = {0.f, 0.f, 0.f, 0.f}; s4[dir][t] = __builtin_amdgcn_mfma_f32_16x16x32_bf16(qf[dir], kf[dir][t], z, 0, 0, 0); }
#pragma unroll
        for (int dir = 0; dir < 2; ++dir)
#pragma unroll
            for (int t = 0; t < 2; ++t) { const int jt = (w & 1) * 2 + t;
#pragma unroll
                for (int r = 0; r < 4; ++r) { const int i = it_ * 16 + fq * 4 + r, j = jt * 16 + fr; const bool keep = dir ? (j >= i) : (j <= i);
                    st_bf16(lds, GB_ATT + dir * (64 * ATP * 2) + (i * ATP + j) * 2, keep ? s4[dir][t][r] : 0.f); } }
        __syncthreads();
        { gbf16x8 af[2][2], bfv[2][2], sf[2][2];
#pragma unroll
            for (int dir = 0; dir < 2; ++dir)
#pragma unroll
                for (int sx = 0; sx < 2; ++sx) af[dir][sx] = *(LDSP const gbf16x8*)(lds + GB_ATT + dir * (64 * ATP * 2) + ((it_ * 16 + fr) * ATP + sx * 32 + fq * 8) * 2);
#pragma unroll
            for (int t = 0; t < 2; ++t) { const int vt = (w & 1) * 2 + t;
#pragma unroll
                for (int sx = 0; sx < 2; ++sx) bfv[t][sx] = *(LDSP const gbf16x8*)(lds + GB_VT + ((vt * 16 + fr) * VTP + sx * 32 + fq * 8) * 2);
#pragma unroll
                for (int dir = 0; dir < 2; ++dir) sf[t][dir] = *(LDSP const gbf16x8*)(lds + GB_S0T + dir * 4096 + ((vt * 16 + fr) * 32 + fq * 8) * 2); }
            f32x4 acc[2];
#pragma unroll
            for (int t = 0; t < 2; ++t) { acc[t] = (f32x4){0.f, 0.f, 0.f, 0.f};
#pragma unroll
                for (int dir = 0; dir < 2; ++dir) {
#pragma unroll
                    for (int sx = 0; sx < 2; ++sx) acc[t] = __builtin_amdgcn_mfma_f32_16x16x32_bf16(af[dir][sx], bfv[t][sx], acc[t], 0, 0, 0);
                    acc[t] = __builtin_amdgcn_mfma_f32_16x16x32_bf16(qf[dir], sf[t][dir], acc[t], 0, 0, 0); } }
#pragma unroll
            for (int t = 0; t < 2; ++t) { const int vt = (w & 1) * 2 + t;
#pragma unroll
                for (int r = 0; r < 4; ++r) ((LDSP float*)(lds + GB_O))[(it_ * 16 + fq * 4 + r) * OP_ + vt * 16 + fr] = acc[t][r]; } }
        __syncthreads();
        { const int i = tid >> 3, vg = tid & 7;
            const f32x4 o0 = *(LDSP const f32x4*)(lds + GB_O + (i * OP_ + vg * 8) * 4), o1 = *(LDSP const f32x4*)(lds + GB_O + (i * OP_ + vg * 8 + 4) * 4);
            float ss = (o0.x * o0.x + o0.y * o0.y) + (o0.z * o0.z + o0.w * o0.w) + (o1.x * o1.x + o1.y * o1.y) + (o1.z * o1.z + o1.w * o1.w);
            ss = sum8(ss);
            const float rstd = 1.0f / sqrtf(ss * (1.0f / 64.0f) + EPS);
            const int row = gla_row(b, c, i);
            const float gg[8] = {R.gg[0].x, R.gg[0].y, R.gg[0].z, R.gg[0].w, R.gg[1].x, R.gg[1].y, R.gg[1].z, R.gg[1].w};
            float r[8]; unpack8(R.rg, r);
            float y[8] = {o0.x, o0.y, o0.z, o0.w, o1.x, o1.y, o1.z, o1.w};
#pragma unroll
            for (int e = 0; e < 8; ++e) y[e] = y[e] * rstd * gg[e] * (r[e] * sigm(r[e]));
            *(u32x4*)(CAT + (size_t)row * DM + 256 + h * 64 + vg * 8) = pack8(y); }
    }
}
__device__ __forceinline__ void ctx_gemm_res(KA a, LDSP unsigned char* lds, const bf16_t* A, const bf16_t* Bt, int K, const float* gate, float coef,
                                             _Float16* XR, bf16_t* XS, float* ssq, const float* gn, const float* scn, int tid, int bid, int G) {
    const int lane = tid & 63, w = tid >> 6, wm = w >> 1, wn = w & 1, fr = lane & 15, fq = lane >> 4;
    LDSP unsigned char* As = lds; LDSP unsigned char* Bs = lds + 18432; LDSP float* Cs = (LDSP float*)(lds + 32768);
    const int nk = K / 64, lr = tid >> 3, lc = (tid & 7) * 8;
    for (int u = bid; u < 256; u += G) {
        int tm = u >> 4, tn = u & 15;
        if (G == 256) { const int x = u & 7, sl = u >> 3; tm = (x & 3) * 4 + (sl >> 3); tn = (x >> 2) * 8 + (sl & 7); }
        const size_t row0 = (size_t)MX + tm * 128; const int col0 = tn * 64;
        const bf16_t* ap0 = A + (row0 + lr) * K + lc; const bf16_t* ap1 = ap0 + (size_t)64 * K; const bf16_t* bp = Bt + (size_t)(col0 + lr) * K + lc;
        u32x4 ra0[4], ra1[4], rb[4];
#pragma unroll
        for (int q = 0; q < 4; ++q) { ra0[q] = *(const u32x4*)(ap0 + q * 64); ra1[q] = *(const u32x4*)(ap1 + q * 64); rb[q] = *(const u32x4*)(bp + q * 64); }
        f32x4 acc[2][2];
#pragma unroll
        for (int mt = 0; mt < 2; ++mt)
#pragma unroll
            for (int nt = 0; nt < 2; ++nt) acc[mt][nt] = (f32x4){0.f, 0.f, 0.f, 0.f};
#pragma unroll 1
        for (int kt = 0; kt < nk; kt += 4) {
#pragma unroll
            for (int q = 0; q < 4; ++q) {
                *(LDSP u32x4*)(As + (lr * 72 + lc) * 2) = ra0[q]; *(LDSP u32x4*)(As + ((64 + lr) * 72 + lc) * 2) = ra1[q]; *(LDSP u32x4*)(Bs + (lr * 72 + lc) * 2) = rb[q];
                __syncthreads();
                if (kt + q + 4 < nk) { ra0[q] = *(const u32x4*)(ap0 + (kt + q + 4) * 64); ra1[q] = *(const u32x4*)(ap1 + (kt + q + 4) * 64); rb[q] = *(const u32x4*)(bp + (kt + q + 4) * 64); }
#pragma unroll
                for (int ks = 0; ks < 2; ++ks) { gbf16x8 af[2], bf[2];
#pragma unroll
                    for (int mt = 0; mt < 2; ++mt) af[mt] = *(LDSP const gbf16x8*)(As + ((wm * 32 + mt * 16 + fr) * 72 + ks * 32 + fq * 8) * 2);
#pragma unroll
                    for (int nt = 0; nt < 2; ++nt) bf[nt] = *(LDSP const gbf16x8*)(Bs + ((wn * 32 + nt * 16 + fr) * 72 + ks * 32 + fq * 8) * 2);
#pragma unroll
                    for (int mt = 0; mt < 2; ++mt)
#pragma unroll
                        for (int nt = 0; nt < 2; ++nt) acc[mt][nt] = __builtin_amdgcn_mfma_f32_16x16x32_bf16(af[mt], bf[nt], acc[mt][nt], 0, 0, 0); }
                __syncthreads();
            }
        }
#pragma unroll
        for (int mt = 0; mt < 2; ++mt)
#pragma unroll
            for (int nt = 0; nt < 2; ++nt)
#pragma unroll
                for (int r = 0; r < 4; ++r) Cs[(wm * 32 + mt * 16 + fq * 4 + r) * 68 + wn * 32 + nt * 16 + fr] = acc[mt][nt][r];
        __syncthreads();
        { const int rl = tid >> 2, cs = (tid & 3) * 16; const size_t grow = row0 + rl; const int gc = col0 + cs;
            float x[16];
            {
#pragma unroll
                for (int q = 0; q < 2; ++q) { const pg8::f32x8 t = __builtin_convertvector(*(const pg8::h16x8*)(XR + grow * 1024 + gc + 8 * q), pg8::f32x8);
#pragma unroll
                    for (int e = 0; e < 8; ++e) x[8 * q + e] = t[e]; } }
            const float* g = gate + (size_t)8 * 9216 + gc; const float* gnp = gn + gc; const float* scp = scn + (size_t)8 * 9216 + gc;
            float ss = 0.f, y[16];
#pragma unroll
            for (int q = 0; q < 4; ++q) { const f32x4 gv = *(const f32x4*)(g + 4 * q), cv = *(LDSP const f32x4*)(Cs + rl * 68 + cs + 4 * q), gg = *(const f32x4*)(gnp + 4 * q), sc = *(const f32x4*)(scp + 4 * q);
#pragma unroll
                for (int e = 0; e < 4; ++e) { const float xv = x[4 * q + e] + coef * gv[e] * cv[e]; x[4 * q + e] = xv; ss += xv * xv; y[4 * q + e] = xv * gg[e] * (sc[e] + 1.0f); } }
#pragma unroll
            for (int q = 0; q < 2; ++q) { const pg8::f32x8 t = {x[8 * q], x[8 * q + 1], x[8 * q + 2], x[8 * q + 3], x[8 * q + 4], x[8 * q + 5], x[8 * q + 6], x[8 * q + 7]};
                *(pg8::h16x8*)(XR + grow * 1024 + gc + 8 * q) = __builtin_convertvector(t, pg8::h16x8);
                u32x4 wv; wv.x = pk2(y[8 * q], y[8 * q + 1]); wv.y = pk2(y[8 * q + 2], y[8 * q + 3]); wv.z = pk2(y[8 * q + 4], y[8 * q + 5]); wv.w = pk2(y[8 * q + 6], y[8 * q + 7]);
                *(u32x4*)(XS + grow * 1024 + gc + 8 * q) = wv; }
            ss += swz_xor<1>(ss); ss += swz_xor<2>(ss);
            if ((tid & 3) == 0) atomicAdd(ssq + grow, ss); }
        __syncthreads();
    }
}
__device__ __forceinline__ void attn_phase(KA a, unsigned char* lds, bool last, int bid, int G) {
    using abf = attn_body::bf16;
    const abf* Q = (const abf*)(a->ws + WS_Q); const abf* Kb = (const abf*)(a->ws + WS_K); const abf* Vb = (const abf*)(a->ws + WS_V); abf* CAT = (abf*)a->out;
    const int nunits = last ? 1024 : 1088;
    const int nlat = bid < 1024 ? (1024 - bid + G - 1) / G : 0, c0 = G - 1 - bid, nctx = (nunits > 1024 && c0 < 64) ? (64 - c0 + G - 1) / G : 0;
    for (int i = 0; i < nlat + nctx; ++i) {
        const int u = (i < nlat) ? bid + i * G : 1024 + c0 + (i - nlat) * G;
        int b, h, NT; size_t qrow;
        if (u < 1024) { b = u >> 7; h = (u >> 4) & 7; qrow = (size_t)b * SEQ + (size_t)(u & 15) * 256; NT = NCH; }
        else { const int uc = u - 1024; b = uc >> 3; h = uc & 7; qrow = (size_t)MX + (size_t)b * CTXL; NT = 4; }
        const size_t kvo = (size_t)b * KVLEN * 128 + (h >> 2) * 64;
        attn_body::attn_unit<8>(Q + qrow * 512 + h * 64, Kb + kvo, Vb + kvo, CAT + qrow * DM + 512 + h * 64, NT, (char*)lds);
    }
}
#define XB_TMO      128
#define XB_XCNT(j)  (256  + 64 * (j))
#define XB_XSUB(j)  (1280 + 64 * (j))
#define XB_XGEN(j)  (2304 + 64 * (j))
#define XB_TOP      3328
#define XB_TOPGEN   3392
#define XCD_BAR_WORDS 3456
#define XB_SPIN_CAP (1u << 18)

__device__ __forceinline__ unsigned xb_ld(unsigned* p)              { return __hip_atomic_load(p, __ATOMIC_RELAXED, __HIP_MEMORY_SCOPE_AGENT); }
__device__ __forceinline__ unsigned xb_add(unsigned* p, unsigned v) { return __hip_atomic_fetch_add(p, v, __ATOMIC_RELAXED, __HIP_MEMORY_SCOPE_AGENT); }
__device__ __forceinline__ unsigned xb_xcc_id() { return (unsigned)__builtin_amdgcn_s_getreg((3 << 11) | 20) & 0xFu; }
#define XB_SPIN(cond, bar) do { unsigned _sp = 0; while (cond) { __builtin_amdgcn_s_sleep(1); \
    if ((++_sp & 255u) == 0u) { if (xb_ld(&(bar)[XB_TMO])) break; if (_sp > XB_SPIN_CAP) { atomicAdd(&(bar)[XB_TMO], 1u); break; } } } } while (0)

struct XcdBarrier {
    unsigned* bar; unsigned x;
    volatile LDSP unsigned* st;
};

__device__ __forceinline__ XcdBarrier xcd_barrier_post(unsigned* bar, volatile LDSP unsigned* st) {
    XcdBarrier b; b.bar = bar; b.x = xb_xcc_id(); b.st = st;
    if (threadIdx.x == 0) (void)xb_add(&bar[XB_XCNT(b.x)], 1u);
    return b;
}
__device__ __forceinline__ void xcd_barrier_complete(unsigned* bar, unsigned x, unsigned& nloc, unsigned& nx) {
    const unsigned G = gridDim.x * gridDim.y * gridDim.z;
    unsigned sum, cnt, mine, sp = 0u;
    for (;;) {
        sum = 0u; cnt = 0u; mine = 0u;
#pragma unroll
        for (unsigned j = 0; j < 16; ++j) { const unsigned c = xb_ld(&bar[XB_XCNT(j)]); sum += c; cnt += (c > 0u) ? 1u : 0u; mine = (j == x) ? c : mine; }
        if (sum == G) break;
        __builtin_amdgcn_s_sleep(1);
        if ((++sp & 255u) == 0u) { if (xb_ld(&bar[XB_TMO])) break; if (sp > XB_SPIN_CAP) { atomicAdd(&bar[XB_TMO], 1u); break; } }
    }
    nloc = mine > 0u ? mine : 1u; nx = cnt > 0u ? cnt : 1u;
}

__device__ __forceinline__ void xcd_barrier(const XcdBarrier& b) {
    asm volatile("s_waitcnt vmcnt(0)" ::: "memory");
    __syncthreads();
    if (threadIdx.x == 0) {
        unsigned* bar = b.bar;
        __builtin_amdgcn_s_waitcnt(0);
        unsigned nloc = b.st[0], nx = b.st[1];
        if (nloc == 0u) { xcd_barrier_complete(bar, b.x, nloc, nx); b.st[0] = nloc; b.st[1] = nx; }
        const unsigned old = xb_add(&bar[XB_XSUB(b.x)], 1u);
        const unsigned gen = old / nloc;
        if (old + 1u == (gen + 1u) * nloc) {
            __builtin_amdgcn_fence(__ATOMIC_RELEASE, "agent");
            asm volatile("s_waitcnt vmcnt(0)" ::: "memory");
            const unsigned og = xb_add(&bar[XB_TOP], 1u);
            const unsigned tg = og / nx;
            if (og + 1u == (tg + 1u) * nx) xb_add(&bar[XB_TOPGEN], 1u);
            else XB_SPIN(xb_ld(&bar[XB_TOPGEN]) == tg, bar);
            __builtin_amdgcn_fence(__ATOMIC_ACQUIRE, "agent");
            xb_add(&bar[XB_XGEN(b.x)], 1u);
            asm volatile("s_waitcnt vmcnt(0)" ::: "memory");
        } else {
            XB_SPIN(xb_ld(&bar[XB_XGEN(b.x)]) == gen, bar);
            __builtin_amdgcn_fence(__ATOMIC_ACQUIRE, "agent");
            asm volatile("s_waitcnt vmcnt(0)" ::: "memory");
        }
    }
    __syncthreads();
}
__global__ void __launch_bounds__(512, 2) mega_fwd(Args a_unused) {
    KA a = (KA)__builtin_amdgcn_kernarg_segment_ptr();
    const int ph_lo = a->ph_lo, ph_hi = a->ph_hi;
    extern __shared__ __attribute__((aligned(16))) unsigned char lds_raw[];
    LDSP unsigned char* lds0 = (LDSP unsigned char*)lds_raw;
    { LDSP unsigned char* lds = lds0;
    volatile LDSP unsigned* xst = (volatile LDSP unsigned*)(lds + 131072 + 64);
    if (threadIdx.x == 0) { xst[0] = 0u; xst[1] = 0u; }
    __syncthreads(); }
#pragma unroll 1
    for (int ph = ph_lo; ph < ph_hi; ++ph) {
        asm volatile("" : "+s"(a));
        LDSP unsigned char* lds = lds0; asm volatile("" : "+s"(lds));
        volatile LDSP unsigned* xst = (volatile LDSP unsigned*)(lds + 131072 + 64);
        unsigned char* ws = a->ws;
        float* CTXR = (float*)(ws + WS_CTXR);
        const float* MOD = (const float*)(ws + WS_MOD);
        bf16_t* XN = (bf16_t*)(ws + WS_XN); bf16_t* CAT = (bf16_t*)a->out; bf16_t* HP = (bf16_t*)(ws + WS_HP); _Float16* XR = (_Float16*)(ws + WS_CAT);
        const int tid = opaque_tid(), lane = tid & 63, wave = __builtin_amdgcn_readfirstlane(tid >> 6);
        int G = gridDim.x, bid = blockIdx.x; asm volatile("" : "+s"(G), "+s"(bid));
        if (ph == 0) { phase0(a, lds, tid, lane, wave, bid, G); }
        else if (ph == 1) { phase1(a, lds, tid, lane, wave, bid, G); }
        else {
            const int l = (ph - 2) / NPH_LAYER, sp = (ph - 2) % NPH_LAYER; const bool last = (l == DEPTH - 1);
            const bool first = (l == 0 && sp <= 1);
            const float* srcX = first ? a->in[I_X] : a->out; const float* srcC = first ? a->in[I_CTX] : CTXR;
            const int Mtail = last ? MX : MALL;
            const float* SSQ = (const float*)(ws + WS_SSQ); const float* SW = (const float*)(ws + WS_SW);
            switch (sp) {
            case 0: case 7: { const int f = (sp == 0) ? 0 : 1, j = (sp == 0) ? 0 : 2; const int M = (sp == 0) ? MALL : Mtail;
                pg8::Gemm g{XN, (const bf16_t*)(ws + WS_W1T) + (size_t)(l * 2 + f) * W1T_SZ, M, 2 * DFF, DM}; pg8::PrefOrder S; S.init(M, 2 * DFF, G, bid);
                S.pf = lds + pg8::PF_OFF; S.ssq = SSQ + (size_t)(l * 3 + j) * MALL; S.sw = SW + (size_t)(l * 3 + j) * 9 * SWN; S.MXr = MX; S.cnt = 0;
                pg8::EpiSwiGLU E{HP, DFF, lds + pg8::PF_OFF, 0};
                pg8::gemm_phase<pg8::EpiSwiGLU, pg8::PrefOrder, true, true>(lds, g, S, E); } break;
            case 1: case 6: case 8: {
                const bf16_t* A; const bf16_t* Bt; int K, M, j; float coef;
                if (sp == 1) { A = HP; Bt = (const bf16_t*)(ws + WS_W2T) + (size_t)(l * 2 + 0) * W2T_SZ; K = DFF; M = MALL; j = 0; coef = 0.5f; }
                else if (sp == 6) { A = CAT; Bt = (const bf16_t*)(ws + WS_WOT) + (size_t)l * WOT_SZ; K = DM; M = Mtail; j = 1; coef = 1.0f; }
                else { A = HP; Bt = (const bf16_t*)(ws + WS_W2T) + (size_t)(l * 2 + 1) * W2T_SZ; K = DFF; M = Mtail; j = 2; coef = 0.5f; }
                const int ln = (j == 2) ? l + 1 : l, jn = (j == 2) ? 0 : j + 1;
                const bool has_next = ln < DEPTH; const int nidx = has_next ? (ln * 3 + jn) : 0;
                pg8::Gemm g{A, Bt, MX, DM, K}; pg8::StaticOrder S; S.init(MX, DM, G, bid);
                pg8::EpiRes E{a->out, XR, (last && sp == 8) ? 1 : 0, MOD + (size_t)l * 9 * 9216 + (3 * j + 2) * 1024, coef, MX,
                              XN, (float*)(ws + WS_SSQ) + (size_t)nidx * MALL, a->in[I_GNORM] + (size_t)nidx * DM, MOD + (size_t)(nidx / 3) * 9 * 9216 + (3 * jn + 1) * 1024, has_next ? 1 : 0};
                pg8::gemm_phase<pg8::EpiRes, pg8::StaticOrder, true, true>(lds, g, S, E);
                if (M == MALL) ctx_gemm_res(a, lds, A, Bt, K, MOD + (size_t)l * 9 * 9216 + (3 * j + 2) * 1024, coef, XR, XN, (float*)(ws + WS_SSQ) + (size_t)nidx * MALL,
                                            a->in[I_GNORM] + (size_t)nidx * DM, MOD + (size_t)(nidx / 3) * 9 * 9216 + (3 * jn + 1) * 1024, tid, bid, G); } break;
            case 2: { pg8::Gemm g{XN, (const bf16_t*)(ws + WS_WINT) + (size_t)l * WINT_SZ, MALL, INWP, DM}; pg8::PrefOrder S; S.init(MALL, INWP, G, bid);
                S.pf = lds + pg8::PF_OFF; S.ssq = SSQ + (size_t)(l * 3 + 1) * MALL; S.sw = SW + (size_t)(l * 3 + 1) * 9 * SWN; S.MXr = MX; S.cnt = 0;
                pg8::EpiStore E{HP, INWP, lds + pg8::PF_OFF, 0};
                pg8::gemm_phase<pg8::EpiStore, pg8::PrefOrder, true, true>(lds, g, S, E); } break;
            case 3: prep_phase(a, lds, l, tid, lane, wave, bid, G); gla_g1_phase(a, lds, l, tid, bid, G); break;
            case 4: gla_g2_phase(a, tid, bid, G); conv_phase(a, lds, l, last, tid, lane, bid, G); break;
            case 5: attn_phase(a, (unsigned char*)lds, last, bid, G); gla_g3_phase(a, lds, l, last, tid, bid, G); break;
            default: break;
            }
        }
        if (ph + 1 < ph_hi) {
            unsigned* barw = (unsigned*)(ws + WS_CTL);
            if (ph == ph_lo) {
                if (bid == 0) for (int i = tid; i < XCD_BAR_WORDS; i += 512) __hip_atomic_store(barw + i, 0u, __ATOMIC_RELAXED, __HIP_MEMORY_SCOPE_AGENT);
                cg::this_grid().sync();
                (void)xcd_barrier_post(barw, xst);
            } else { XcdBarrier xb; xb.bar = barw; xb.x = xb_xcc_id(); xb.st = xst; xcd_barrier(xb); }
        }
    }
}

#ifndef MK_MULTI
#define MK_MULTI 0
#endif
extern "C" void kernel_launch(void* const* d_in, const int* in_sizes, int n_in, void* d_out, int out_size, void* d_ws, size_t ws_size, hipStream_t stream) {
    static int grid = 0;
    if (grid == 0) {
        if (n_in != 20 || out_size != MX * DM || ws_size < WS_END) { fprintf(stderr, "kernel_launch: unexpected shapes (n_in %d, out %d, ws %zu); nothing launched\n", n_in, out_size, ws_size); grid = -1; return; }
        int dev = 0, cus = 0, per_cu = 0;
        if (hipGetDevice(&dev) != hipSuccess || hipDeviceGetAttribute(&cus, hipDeviceAttributeMultiprocessorCount, dev) != hipSuccess) { grid = -1; return; }
        if (hipFuncSetAttribute((const void*)mega_fwd, hipFuncAttributeMaxDynamicSharedMemorySize, LDS_BYTES) != hipSuccess) { fprintf(stderr, "kernel_launch: hipFuncSetAttribute failed\n"); grid = -1; return; }
        if (hipOccupancyMaxActiveBlocksPerMultiprocessor(&per_cu, (const void*)mega_fwd, 512, LDS_BYTES) != hipSuccess || per_cu < 1) { fprintf(stderr, "kernel_launch: occupancy query gave %d\n", per_cu); per_cu = 1; }
        (void)hipGetLastError();
        grid = cus * per_cu;
    }
    if (grid < 0) return;
    Args a{};
    for (int i = 0; i < 20; ++i) a.in[i] = (const float*)d_in[i];
    a.out = (float*)d_out; a.ws = (unsigned char*)d_ws;
#if MK_MULTI
    for (int ph = 0; ph < NPHASES; ++ph) { a.ph_lo = ph; a.ph_hi = ph + 1; hipLaunchKernelGGL(mega_fwd, dim3(grid), dim3(512), LDS_BYTES, stream, a); }
#else
    a.ph_lo = 0; a.ph_hi = NPHASES;
    void* args[] = {&a};
    hipError_t e = hipLaunchCooperativeKernel((const void*)mega_fwd, dim3(grid), dim3(512), args, LDS_BYTES, stream);
    if (e != hipSuccess) fprintf(stderr, "kernel_launch: cooperative launch failed: %s (grid %d)\n", hipGetErrorString(e), grid);
#endif
}
```

```cpp
#include <hip/hip_runtime.h>
#include <hip/hip_cooperative_groups.h>
#include <cstdio>
#include <cstdint>
namespace cg = cooperative_groups;
__device__ __forceinline__ int opaque_tid() { int t = threadIdx.x; asm volatile("" : "+v"(t)); return t; }
namespace pg8 {
#define PG8_LAS __attribute__((address_space(3)))
typedef unsigned short bf16_t;
typedef short bf16x8 __attribute__((ext_vector_type(8)));
typedef float f32x4 __attribute__((ext_vector_type(4)));
typedef unsigned u32x4 __attribute__((ext_vector_type(4)));
constexpr int BM = 256, BK = 64, HALF = 128, HTB = HALF * BK * 2  , STAGE_BYTES = 8 * HTB, NXCD = 8, WGM = 8;

__host__ __device__ __forceinline__ int lds_byte(int r, int c) { const int st = (r >> 4) * 2 + (c >> 5), rr = r & 15, cc = c & 31, ob = rr * 64 + cc * 2; return st * 1024 + (ob ^ (((ob >> 9) & 1) << 5)); }
__host__ __device__ __forceinline__ void stage_rc(int b, int& R, int& C) { const int st = b / 1024, sb = b % 1024, swz = sb ^ (((sb >> 9) & 1) << 5); R = (st >> 1) * 16 + swz / 64; C = (st & 1) * 32 + (swz % 64) / 2; }
__host__ __device__ __forceinline__ int perm32(int rho) { const int n = rho >> 4, i = rho & 15; return 8 * (i >> 2) + 4 * n + (i & 3); }

struct Unit { int pm, pn; };
struct Gemm { const bf16_t* A; const bf16_t* Bt; int M, N, K; };

struct StaticOrder {
    int nM, nN, nwg, G, c;
    __host__ __device__ void init(int M, int N, int G_, int c_) { nM = M / BM; nN = N / BM; nwg = nM * nN; G = G_; c = c_; }
    __host__ __device__ bool next(int i, Unit& u) const {
        const long L = (long)i * G + c; if (L >= nwg) return false;
        int wgid = (int)L; { const int q = nwg / NXCD, r = nwg % NXCD, xcd = wgid % NXCD, off = wgid / NXCD; wgid = (xcd < r ? xcd * (q + 1) : r * (q + 1) + (xcd - r) * q) + off; }
        const int nig = WGM * nN, gid = wgid / nig, fm = gid * WGM, gsz = (nM - fm) < WGM ? (nM - fm) : WGM;
        u.pm = fm + ((wgid % nig) % gsz); u.pn = (wgid % nig) / gsz; return true;
    }
    __device__ __forceinline__ void a_ready(const Unit&) const {}
    __device__ __forceinline__ void done(const Unit&) const {}
};

constexpr int PF_OFF = 132096, PF_SLOT = 2048;
struct PrefOrder : StaticOrder {
    PG8_LAS unsigned char* pf; const float* ssq; const float* sw; int MXr; mutable int cnt;
    __device__ __forceinline__ void a_ready(const Unit& u) const {
        const int t = threadIdx.x, w = __builtin_amdgcn_readfirstlane(t >> 6), lane = t & 63; const int slot = cnt & 1; ++cnt;
        const int rowt = u.pm * BM, bidx = rowt >= MXr ? 8 : (rowt >> 12);
        const float* src = (w < 4) ? ssq + rowt + w * 64 + lane : sw + (size_t)bidx * 5632 + u.pn * BM + (w - 4) * 64 + lane;
        __builtin_amdgcn_global_load_lds((const unsigned*)src, (PG8_LAS unsigned*)(pf + slot * PF_SLOT + w * 256), 4, 0, 0);
    }
};
typedef float cvt_f32x2_t __attribute__((ext_vector_type(2))); typedef __bf16 cvt_bf16x2_t __attribute__((ext_vector_type(2)));
__device__ __forceinline__ unsigned cvt_pk_bf16(float lo, float hi) { const cvt_f32x2_t v = {lo, hi}; const cvt_bf16x2_t b = __builtin_convertvector(v, cvt_bf16x2_t); return __builtin_bit_cast(unsigned, b); }
typedef float f32x2 __attribute__((ext_vector_type(2)));
__device__ __forceinline__ float silu_f(float v) { return v * __builtin_amdgcn_rcpf(1.0f + __expf(-v)); }
struct EpiStore {
    static constexpr bool PERM = true, AFTER_DRAIN = false;
    bf16_t* O; int ldc; PG8_LAS unsigned char* pf; mutable int cnt;
    __device__ __forceinline__ void operator()(const f32x4 (&acc)[2][2][4][2], const Unit& u, int wr, int wc, int fr, int fq) const {
        const int rowt = u.pm * BM; PG8_LAS const float* sl = (PG8_LAS const float*)(pf + (cnt & 1) * PF_SLOT); ++cnt;
        const int row0 = rowt + wr * 64 + fr, col0 = u.pn * BM + wc * 32 + 8 * fq;
        f32x4 sv[2][2];
#pragma unroll
        for (int bj = 0; bj < 2; ++bj)
#pragma unroll
            for (int n = 0; n < 2; ++n) sv[bj][n] = *(PG8_LAS const f32x4*)(sl + 256 + wc * 32 + 8 * fq + bj * HALF + 4 * n);
        float rsv[2][4];
#pragma unroll
        for (int ai = 0; ai < 2; ++ai)
#pragma unroll
            for (int m = 0; m < 4; ++m) rsv[ai][m] = __builtin_amdgcn_rsqf(sl[wr * 64 + fr + ai * HALF + m * 16] * (1.0f / 1024.0f) + 1e-6f);
#pragma unroll
        for (int ai = 0; ai < 2; ++ai)
#pragma unroll
            for (int m = 0; m < 4; ++m) { const int row = row0 + ai * HALF + m * 16; bf16_t* rowp = O + (size_t)row * ldc + col0;
                const float rs = rsv[ai][m];
#pragma unroll
                for (int bj = 0; bj < 2; ++bj) { const f32x4 v0 = acc[ai][bj][m][0] * rs + sv[bj][0], v1 = acc[ai][bj][m][1] * rs + sv[bj][1];
                    u32x4 w; w.x = cvt_pk_bf16(v0[0], v0[1]); w.y = cvt_pk_bf16(v0[2], v0[3]); w.z = cvt_pk_bf16(v1[0], v1[1]); w.w = cvt_pk_bf16(v1[2], v1[3]);
                    *(u32x4*)(rowp + bj * HALF) = w; } }
    }
};
struct EpiSwiGLU {
    static constexpr bool PERM = true, AFTER_DRAIN = false;
    bf16_t* O; int ldc; PG8_LAS unsigned char* pf; mutable int cnt;
    __device__ __forceinline__ void operator()(const f32x4 (&acc)[2][2][4][2], const Unit& u, int wr, int wc, int fr, int fq) const {
        const int rowt = u.pm * BM; PG8_LAS const float* sl = (PG8_LAS const float*)(pf + (cnt & 1) * PF_SLOT); ++cnt;
        const int row0 = rowt + wr * 64 + fr, col0 = u.pn * HALF + wc * 32 + 8 * fq;
        f32x4 sv[2][2];
#pragma unroll
        for (int bj = 0; bj < 2; ++bj)
#pragma unroll
            for (int n = 0; n < 2; ++n) sv[bj][n] = *(PG8_LAS const f32x4*)(sl + 256 + wc * 32 + 8 * fq + bj * HALF + 4 * n);
        float rsv[2][4];
#pragma unroll
        for (int ai = 0; ai < 2; ++ai)
#pragma unroll
            for (int m = 0; m < 4; ++m) rsv[ai][m] = __builtin_amdgcn_rsqf(sl[wr * 64 + fr + ai * HALF + m * 16] * (1.0f / 1024.0f) + 1e-6f);
#pragma unroll
        for (int ai = 0; ai < 2; ++ai)
#pragma unroll
            for (int m = 0; m < 4; ++m) { const int row = row0 + ai * HALF + m * 16; bf16_t* rowp = O + (size_t)row * ldc + col0;
                const float rs = rsv[ai][m];
                const f32x4 a0 = acc[ai][0][m][0] * rs + sv[0][0], a1 = acc[ai][0][m][1] * rs + sv[0][1], u0 = acc[ai][1][m][0] * rs + sv[1][0], u1 = acc[ai][1][m][1] * rs + sv[1][1];
                u32x4 w; w.x = cvt_pk_bf16(silu_f(a0[0]) * u0[0], silu_f(a0[1]) * u0[1]); w.y = cvt_pk_bf16(silu_f(a0[2]) * u0[2], silu_f(a0[3]) * u0[3]);
                w.z = cvt_pk_bf16(silu_f(a1[0]) * u1[0], silu_f(a1[1]) * u1[1]); w.w = cvt_pk_bf16(silu_f(a1[2]) * u1[2], silu_f(a1[3]) * u1[3]);
                *(u32x4*)rowp = w; }
    }
};
typedef _Float16 h16x8 __attribute__((ext_vector_type(8)));
typedef float f32x8 __attribute__((ext_vector_type(8)));
struct EpiRes {
    static constexpr bool PERM = true, AFTER_DRAIN = false;
    float* outF; _Float16* XR; int dstf32; const float* gate; float coef; int MXr;
    bf16_t* XSp; float* ssq; const float* gn; const float* scn; int doxs;
    __device__ __forceinline__ void operator()(const f32x4 (&acc)[2][2][4][2], const Unit& u, int wr, int wc, int fr, int fq) const {
        const int rowt = u.pm * BM; const bool isc = rowt >= MXr; const bool XS = doxs != 0;
        const int bidx = isc ? 8 : (rowt >> 12);
        char* outb = (char*)(outF + (size_t)rowt * 1024);
        char* xrb = (char*)(XR + (size_t)rowt * 1024);
        char* xsb = (char*)(XSp + (size_t)rowt * 1024); float* sqb = ssq + rowt;
        const int col0 = u.pn * BM + wc * 32 + 8 * fq;
        const float* g = gate + (size_t)bidx * 9216 + col0;
        const unsigned lo = (unsigned)((wr * 64 + fr) * 1024 + col0);
        float ss[2][4];
#pragma unroll
        for (int ai = 0; ai < 2; ++ai)
#pragma unroll
            for (int m = 0; m < 4; ++m) ss[ai][m] = 0.f;
#pragma unroll
        for (int bj = 0; bj < 2; ++bj) {
            u32x4 xin[2][4];
#pragma unroll
            for (int ai = 0; ai < 2; ++ai)
#pragma unroll
                for (int m = 0; m < 4; ++m) xin[ai][m] = *(const u32x4*)(xrb + (lo + (unsigned)((ai * HALF + m * 16) * 1024 + bj * HALF)) * 2u);
            f32x4 gv[2], gs[2];
#pragma unroll
            for (int n = 0; n < 2; ++n) { gv[n] = *(const f32x4*)(g + bj * HALF + 4 * n) * coef;
                if (XS) gs[n] = *(const f32x4*)(gn + col0 + bj * HALF + 4 * n) * (*(const f32x4*)(scn + (size_t)bidx * 9216 + col0 + bj * HALF + 4 * n) + 1.0f); }
#pragma unroll
            for (int ai = 0; ai < 2; ++ai)
#pragma unroll
                for (int m = 0; m < 4; ++m) { const unsigned eo = lo + (unsigned)((ai * HALF + m * 16) * 1024 + bj * HALF); f32x4 xv[2];
                    { const f32x8 t = __builtin_convertvector(__builtin_bit_cast(h16x8, xin[ai][m]), f32x8); xv[0] = (f32x4){t[0], t[1], t[2], t[3]}; xv[1] = (f32x4){t[4], t[5], t[6], t[7]}; }
                    xv[0] += gv[0] * acc[ai][bj][m][0]; xv[1] += gv[1] * acc[ai][bj][m][1];
                    if (dstf32) { *(f32x4*)(outb + eo * 4u) = xv[0]; *(f32x4*)(outb + eo * 4u + 16u) = xv[1]; }
                    else { const f32x8 t = {xv[0][0], xv[0][1], xv[0][2], xv[0][3], xv[1][0], xv[1][1], xv[1][2], xv[1][3]}; *(h16x8*)(xrb + eo * 2u) = __builtin_convertvector(t, h16x8); }
                    if (XS) { ss[ai][m] += (xv[0][0] * xv[0][0] + xv[0][1] * xv[0][1]) + (xv[0][2] * xv[0][2] + xv[0][3] * xv[0][3]) + (xv[1][0] * xv[1][0] + xv[1][1] * xv[1][1]) + (xv[1][2] * xv[1][2] + xv[1][3] * xv[1][3]);
                        const f32x4 y0 = xv[0] * gs[0], y1 = xv[1] * gs[1];
                        u32x4 w; w.x = cvt_pk_bf16(y0[0], y0[1]); w.y = cvt_pk_bf16(y0[2], y0[3]); w.z = cvt_pk_bf16(y1[0], y1[1]); w.w = cvt_pk_bf16(y1[2], y1[3]);
                        *(u32x4*)(xsb + eo * 2u) = w; } }
        }
        if (XS) {
#pragma unroll
            for (int ai = 0; ai < 2; ++ai)
#pragma unroll
                for (int m = 0; m < 4; ++m) { float t = ss[ai][m];
                    t += __int_as_float(__builtin_amdgcn_ds_swizzle(__float_as_int(t), 0x1f | (16 << 10)));
                    auto rr = __builtin_amdgcn_permlane32_swap(__float_as_uint(t), __float_as_uint(t), false, false);
                    t = __uint_as_float(rr[0]) + __uint_as_float(rr[1]);
                    if (fq == 0) atomicAdd(sqb + (unsigned)(wr * 64 + fr + ai * HALF + m * 16), t); } }
    }
};
template <class Epi, class Sched, bool ALIGN_EPI = false, bool SP2 = false>
__device__ __forceinline__ void gemm_phase(PG8_LAS unsigned char* lds, const Gemm g, const Sched& S, const Epi& E) {
    const int tid = opaque_tid(), wid = __builtin_amdgcn_readfirstlane(tid >> 6), lane = tid & 63, wr = wid >> 2, wc = wid & 3, fr = lane & 15, fq = lane >> 4;
    const int K = g.K, nt = K / BK;
    unsigned voffA[2], voffB[2];
#pragma unroll
    for (int i = 0; i < 2; ++i) { int R, C; stage_rc(tid * 16 + i * 8192, R, C); const int Rb = Epi::PERM ? ((R & ~31) + perm32(R & 31)) : R;
        voffA[i] = (unsigned)(R * K + C) * 2u; voffB[i] = (unsigned)(Rb * K + C) * 2u; }
    const size_t kstep = (size_t)(BK * 2);
    const size_t hstep = (size_t)HALF * K * 2;
    const size_t tstep = 2 * hstep;
    const unsigned ldsw = (unsigned)wid * 1024u;
    const int aoff = lds_byte(wr * 64 + fr, fq * 8), boff = lds_byte(wc * 32 + fr, fq * 8);
#define PG8_SA(b, h) (((b) * 2 + (h)) * HTB)
#define PG8_SB(b, h) ((4 + (b) * 2 + (h)) * HTB)
#define PG8_STAGE(bufoff, gbase, voff) do { _Pragma("unroll") for (int _i = 0; _i < 2; ++_i) \
        __builtin_amdgcn_global_load_lds((const unsigned*)((const char*)(gbase) + (voff)[_i]), (PG8_LAS unsigned*)(lds + (bufoff) + ldsw + _i * 8192), 16, 0, 0); } while (0)
#define PG8_LDA(dst, b, h) do { _Pragma("unroll") for (int m = 0; m < 4; ++m) _Pragma("unroll") for (int k = 0; k < 2; ++k) dst[m][k] = *(const PG8_LAS bf16x8*)(lds + PG8_SA(b, h) + aoff + m * 2048 + k * 1024); } while (0)
#define PG8_LDB(dst, b, h) do { _Pragma("unroll") for (int n = 0; n < 2; ++n) _Pragma("unroll") for (int k = 0; k < 2; ++k) dst[n][k] = *(const PG8_LAS bf16x8*)(lds + PG8_SB(b, h) + boff + n * 2048 + k * 1024); } while (0)
#define PG8_MMA(ai, bj, At, Bt) do { __builtin_amdgcn_s_setprio(1); _Pragma("unroll") for (int m = 0; m < 4; ++m) _Pragma("unroll") for (int n = 0; n < 2; ++n) _Pragma("unroll") for (int k = 0; k < 2; ++k) \
        acc[ai][bj][m][n] = __builtin_amdgcn_mfma_f32_16x16x32_bf16(Bt[n][k], At[m][k], acc[ai][bj][m][n], 0, 0, 0); __builtin_amdgcn_s_setprio(0); } while (0)
#define PG8_WAIT_V(n) asm volatile("s_waitcnt vmcnt(" #n ")" ::: "memory")
#define PG8_WAIT_L(n) asm volatile("s_waitcnt lgkmcnt(" #n ")" ::: "memory")
#define PG8_BAR __builtin_amdgcn_s_barrier()
#define PG8_SCHED __builtin_amdgcn_sched_barrier(0)
    Unit cur, nxt; int ui = 0;
    if (!S.next(0, cur)) return;
    f32x4 acc[2][2][4][2];
#pragma unroll
    for (int a = 0; a < 2; ++a)
#pragma unroll
        for (int b = 0; b < 2; ++b)
#pragma unroll
            for (int m = 0; m < 4; ++m)
#pragma unroll
                for (int n = 0; n < 2; ++n) acc[a][b][m][n] = (f32x4){0.f, 0.f, 0.f, 0.f};
    bf16x8 At[4][2], B0[2][2], B1[2][2];
    const char* cA = (const char*)g.A + (size_t)cur.pm * tstep; const char* cB = (const char*)g.Bt + (size_t)cur.pn * tstep;
    S.a_ready(cur);
    if constexpr (SP2) {
        PG8_STAGE(PG8_SB(0, 0), cB, voffB); PG8_STAGE(PG8_SB(0, 1), cB + hstep, voffB); PG8_STAGE(PG8_SA(0, 0), cA, voffA); PG8_STAGE(PG8_SA(0, 1), cA + hstep, voffA);
        if (wr == 1) PG8_BAR;
        PG8_WAIT_V(2); PG8_BAR;
        PG8_STAGE(PG8_SB(1, 0), cB + kstep, voffB); PG8_STAGE(PG8_SA(1, 0), cA + kstep, voffA); PG8_STAGE(PG8_SB(1, 1), cB + hstep + kstep, voffB);
        PG8_WAIT_V(6); PG8_BAR;
    } else {
        PG8_STAGE(PG8_SB(0, 0), cB, voffB); PG8_STAGE(PG8_SA(0, 0), cA, voffA); PG8_STAGE(PG8_SB(0, 1), cB + hstep, voffB); PG8_STAGE(PG8_SA(0, 1), cA + hstep, voffA);
        if (wr == 1) PG8_BAR;
        PG8_WAIT_V(4); PG8_BAR;
        PG8_STAGE(PG8_SB(1, 0), cB + kstep, voffB); PG8_STAGE(PG8_SA(1, 0), cA + kstep, voffA); PG8_STAGE(PG8_SB(1, 1), cB + hstep + kstep, voffB);
        PG8_WAIT_V(6); PG8_BAR;
    }
    for (;;) {
        const bool has_next = S.next(ui + 1, nxt);
        const char* nA = has_next ? (const char*)g.A + (size_t)nxt.pm * tstep : cA; const char* nB = has_next ? (const char*)g.Bt + (size_t)nxt.pn * tstep : cB;
        for (int t = 0; t < nt; t += 2) {
            const bool last = (t == nt - 2);
            const char* a1 = cA + (size_t)(t + 1) * kstep;
            const char* a2 = last ? nA : cA + (size_t)(t + 2) * kstep; const char* b2 = last ? nB : cB + (size_t)(t + 2) * kstep;
            const char* a3 = a2 + kstep; const char* b3 = b2 + kstep;
            if (last && has_next) S.a_ready(nxt);
            if constexpr (SP2) {
            PG8_LDB(B0, 0, 0); PG8_LDB(B1, 0, 1); PG8_SCHED; PG8_LDA(At, 0, 0); PG8_STAGE(PG8_SA(1, 1), a1 + hstep, voffA);
            PG8_WAIT_V(8); PG8_WAIT_L(0); PG8_BAR; PG8_MMA(0, 0, At, B0); PG8_MMA(0, 1, At, B1); PG8_BAR; PG8_SCHED;
            PG8_LDA(At, 0, 1); PG8_STAGE(PG8_SB(0, 0), b2, voffB); PG8_STAGE(PG8_SB(0, 1), b2 + hstep, voffB); PG8_STAGE(PG8_SA(0, 0), a2, voffA);
            PG8_WAIT_V(8); PG8_WAIT_L(0); PG8_BAR; PG8_MMA(1, 0, At, B0); PG8_MMA(1, 1, At, B1); PG8_BAR; PG8_SCHED;
            PG8_LDB(B0, 1, 0); PG8_LDB(B1, 1, 1); PG8_SCHED; PG8_LDA(At, 1, 0); PG8_STAGE(PG8_SA(0, 1), a2 + hstep, voffA);
            PG8_WAIT_V(8); PG8_WAIT_L(0); PG8_BAR; PG8_MMA(0, 0, At, B0); PG8_MMA(0, 1, At, B1); PG8_BAR; PG8_SCHED;
            PG8_LDA(At, 1, 1); PG8_STAGE(PG8_SB(1, 0), b3, voffB); PG8_STAGE(PG8_SB(1, 1), b3 + hstep, voffB); PG8_STAGE(PG8_SA(1, 0), a3, voffA);
            PG8_WAIT_V(8); PG8_WAIT_L(0); PG8_BAR; PG8_MMA(1, 0, At, B0); PG8_MMA(1, 1, At, B1); PG8_BAR; PG8_SCHED;
            } else {
            PG8_LDB(B0, 0, 0); PG8_SCHED; PG8_LDA(At, 0, 0); PG8_STAGE(PG8_SA(1, 1), a1 + hstep, voffA);
            PG8_WAIT_L(8); PG8_BAR; PG8_WAIT_L(0); PG8_MMA(0, 0, At, B0); PG8_BAR; PG8_SCHED;
            PG8_LDB(B1, 0, 1); PG8_STAGE(PG8_SB(0, 0), b2, voffB);
            PG8_BAR; PG8_WAIT_L(0); PG8_MMA(0, 1, At, B1); PG8_BAR;
            PG8_LDA(At, 0, 1); PG8_STAGE(PG8_SA(0, 0), a2, voffA);
            PG8_BAR; PG8_WAIT_L(0); PG8_MMA(1, 0, At, B0); PG8_BAR; PG8_SCHED;
            PG8_STAGE(PG8_SB(0, 1), b2 + hstep, voffB);
            PG8_WAIT_V(6); PG8_BAR; PG8_MMA(1, 1, At, B1); PG8_BAR;
            PG8_LDB(B0, 1, 0); PG8_SCHED; PG8_LDA(At, 1, 0); PG8_STAGE(PG8_SA(0, 1), a2 + hstep, voffA);
            PG8_WAIT_L(8); PG8_BAR; PG8_WAIT_L(0); PG8_MMA(0, 0, At, B0); PG8_BAR; PG8_SCHED;
            PG8_LDB(B1, 1, 1); PG8_STAGE(PG8_SB(1, 0), b3, voffB);
            PG8_BAR; PG8_WAIT_L(0); PG8_MMA(0, 1, At, B1); PG8_BAR;
            PG8_LDA(At, 1, 1); PG8_STAGE(PG8_SA(1, 0), a3, voffA);
            PG8_BAR; PG8_WAIT_L(0); PG8_MMA(1, 0, At, B0); PG8_BAR; PG8_SCHED;
            PG8_STAGE(PG8_SB(1, 1), b3 + hstep, voffB);
            PG8_WAIT_V(6); PG8_BAR; PG8_MMA(1, 1, At, B1); PG8_BAR;
            }
        }
        if constexpr (ALIGN_EPI) { if (wr == 0) PG8_BAR; }
        if constexpr (!Epi::AFTER_DRAIN) { E(acc, cur, wr, wc, fr, fq); S.done(cur); }
        if (!has_next) break;
#pragma unroll
        for (int a = 0; a < 2; ++a)
#pragma unroll
            for (int b = 0; b < 2; ++b)
#pragma unroll
                for (int m = 0; m < 4; ++m)
#pragma unroll
                    for (int n = 0; n < 2; ++n) acc[a][b][m][n] = (f32x4){0.f, 0.f, 0.f, 0.f};
        cur = nxt; cA = nA; cB = nB; ++ui;
        if constexpr (ALIGN_EPI) { if (wr == 1) PG8_BAR; }
    }
    PG8_WAIT_V(0);
    if constexpr (!ALIGN_EPI) { if (wr == 0) PG8_BAR; }
    PG8_BAR;
    if constexpr (Epi::AFTER_DRAIN) { E.fused(acc, cur, wr, wc, fr, fq, lds, wid, lane); S.done(cur); }
#undef PG8_SA
#undef PG8_SB
#undef PG8_STAGE
#undef PG8_LDA
#undef PG8_LDB
#undef PG8_MMA
#undef PG8_WAIT_V
#undef PG8_WAIT_L
#undef PG8_BAR
#undef PG8_SCHED
}
}
#include <hip/hip_bf16.h>
#include <cmath>
namespace attn_body {
using bf16=__hip_bfloat16;
using bf16x8=__attribute__((ext_vector_type(8)))short;
using s16x4=__attribute__((ext_vector_type(4)))short;
using f32x16=__attribute__((ext_vector_type(16)))float;
using u32x4=__attribute__((ext_vector_type(4)))unsigned;
constexpr int D=64,QP=512,KP=128,OP=1024;
constexpr int NW=8,QBLK=32,QB=QBLK*NW,KVBLK=64;
constexpr int ATTN_UNIT_ROWS=QB;
__device__ __forceinline__ int crow(int r,int hi){return (r&3)+8*(r>>2)+4*hi;}
#define SBAR() __builtin_amdgcn_sched_barrier(0)
__device__ __forceinline__ void cmask(f32x16&p0,f32x16&p1,int jb,int qrel,int hi){
  const float NEG=-INFINITY; int kb=64*jb+4*hi;
  #pragma unroll
  for(int r=0;r<16;++r){int kv=kb+(r&3)+8*(r>>2); if(kv>qrel)p0[r]=NEG; if(kv+32>qrel)p1[r]=NEG;}
}

constexpr int NSLOT=3, SLOTB=8192;
constexpr int LDS_K=0, LDS_V=NSLOT*SLOTB, LDS_WS=2*NSLOT*SLOTB, LDS_OST=LDS_WS+NW*64*4, LDS_BYTES=LDS_OST+NW*4096;
constexpr float C2=0.125f*1.4426950408889634f;
__device__ __forceinline__ void glds16(const void*gsrc,unsigned lds_dst){unsigned keep;
  asm volatile("s_mov_b32 %0, m0\n\ts_mov_b32 m0, %2\n\ts_nop 0\n\tglobal_load_lds_dwordx4 %1, off\n\ts_mov_b32 m0, %0":"=&s"(keep):"v"(gsrc),"s"(lds_dst):"memory");}
__device__ __forceinline__ float max3f(float a,float b,float c){float r;asm("v_max3_f32 %0, %1, %2, %3":"=v"(r):"v"(a),"v"(b),"v"(c));return r;}
__device__ __forceinline__ float max2f(float a,float b){float r;asm("v_max_f32_e32 %0, %1, %2":"=v"(r):"v"(a),"v"(b));return r;}
__device__ __forceinline__ float fadd_s(float a,float b){float r;asm("v_add_f32_e32 %0, %1, %2":"=v"(r):"v"(a),"v"(b));return r;}
__device__ __forceinline__ float fsub_s(float a,float b){float r;asm("v_sub_f32_e32 %0, %1, %2":"=v"(r):"v"(a),"v"(b));return r;}
typedef float f32x2_t __attribute__((ext_vector_type(2))); typedef __bf16 bf16x2_t __attribute__((ext_vector_type(2)));
__device__ __forceinline__ unsigned cvtpk_s(float lo,float hi){f32x2_t v={lo,hi};bf16x2_t b=__builtin_convertvector(v,bf16x2_t);return __builtin_bit_cast(unsigned,b);}
#define WAIT_BAR(N) asm volatile("s_waitcnt vmcnt(" #N ") lgkmcnt(0)\n\ts_barrier":::"memory")

__device__ __forceinline__ void qkt(f32x16&p0,f32x16&p1,const char*Kslot,const bf16x8*qr,const f32x16&negm,int r32,int hi){
  const char*kb=Kslot+hi*1024+r32*16;
  #pragma unroll
  for(int d0=0;d0<4;++d0){
    const bf16x8 b0=*reinterpret_cast<const bf16x8*>(kb+d0*2048);
    const bf16x8 b1=*reinterpret_cast<const bf16x8*>(kb+d0*2048+512);
    if(d0==0){p0=__builtin_amdgcn_mfma_f32_32x32x16_bf16(b0,qr[0],negm,0,0,0);p1=__builtin_amdgcn_mfma_f32_32x32x16_bf16(b1,qr[0],negm,0,0,0);}
    else{p0=__builtin_amdgcn_mfma_f32_32x32x16_bf16(b0,qr[d0],p0,0,0,0);p1=__builtin_amdgcn_mfma_f32_32x32x16_bf16(b1,qr[d0],p1,0,0,0);}}
}
typedef __attribute__((address_space(3))) const char* lds_cptr;
typedef short v4i16_t __attribute__((ext_vector_type(4)));
__device__ __forceinline__ void kload8(bf16x8*kf,lds_cptr kp){
  kf[0]=*(const __attribute__((address_space(3))) bf16x8*)(kp);      kf[1]=*(const __attribute__((address_space(3))) bf16x8*)(kp+512);
  kf[2]=*(const __attribute__((address_space(3))) bf16x8*)(kp+2048); kf[3]=*(const __attribute__((address_space(3))) bf16x8*)(kp+2560);
  kf[4]=*(const __attribute__((address_space(3))) bf16x8*)(kp+4096); kf[5]=*(const __attribute__((address_space(3))) bf16x8*)(kp+4608);
  kf[6]=*(const __attribute__((address_space(3))) bf16x8*)(kp+6144); kf[7]=*(const __attribute__((address_space(3))) bf16x8*)(kp+6656);
}
__device__ __forceinline__ void kload2(bf16x8*kf,lds_cptr kp,int j){ kf[2*j]=*(const __attribute__((address_space(3))) bf16x8*)(kp+j*2048); kf[2*j+1]=*(const __attribute__((address_space(3))) bf16x8*)(kp+j*2048+512); }
__device__ __forceinline__ s16x4 vtr(lds_cptr p){ return __builtin_bit_cast(s16x4,__builtin_amdgcn_ds_read_tr16_b64_v4i16((__attribute__((address_space(3))) v4i16_t*)p)); }
__device__ __forceinline__ float rowmax(const f32x16&p0,const f32x16&p1){
  float a=max3f(p0[0],p0[1],p1[0]),b=max3f(p0[2],p0[3],p1[1]);a=max3f(a,p1[2],p1[3]);
  #pragma unroll
  for(int r=4;r<16;r+=4){a=max3f(a,p0[r],p0[r+1]);b=max3f(b,p0[r+2],p0[r+3]);a=max3f(a,p1[r],p1[r+1]);b=max3f(b,p1[r+2],p1[r+3]);}
  const float m=max2f(a,b);
  auto rr=__builtin_amdgcn_permlane32_swap(__float_as_uint(m),__float_as_uint(m),false,false);
  return max2f(__uint_as_float(rr[0]),__uint_as_float(rr[1]));
}
__device__ __forceinline__ void pv(f32x16*o,int vb,bf16x8 pa0,bf16x8 pa1,bf16x8 pa2,bf16x8 pa3){
  #pragma unroll
  for(int d0=0;d0<2;++d0){s16x4 lo[4],hi[4];
    #pragma unroll
    for(int ks=0;ks<4;++ks){
      asm volatile("ds_read_b64_tr_b16 %0,%1 offset:%c2":"=&v"(lo[ks]):"v"(vb),"i"(d0*4096+ks*1024):"memory");
      asm volatile("ds_read_b64_tr_b16 %0,%1 offset:%c2":"=&v"(hi[ks]):"v"(vb),"i"(d0*4096+ks*1024+512):"memory");}
    asm volatile("s_waitcnt lgkmcnt(0)":::"memory");SBAR();
    #define PK(k) (bf16x8){lo[k][0],lo[k][1],lo[k][2],lo[k][3],hi[k][0],hi[k][1],hi[k][2],hi[k][3]}
    o[d0]=__builtin_amdgcn_mfma_f32_32x32x16_bf16(pa0,PK(0),o[d0],0,0,0);
    o[d0]=__builtin_amdgcn_mfma_f32_32x32x16_bf16(pa1,PK(1),o[d0],0,0,0);
    o[d0]=__builtin_amdgcn_mfma_f32_32x32x16_bf16(pa2,PK(2),o[d0],0,0,0);
    o[d0]=__builtin_amdgcn_mfma_f32_32x32x16_bf16(pa3,PK(3),o[d0],0,0,0);
    #undef PK
  }
}

#ifndef ATTN_STORE16
#define ATTN_STORE16(p,v) (*(u32x4*)(p)=(v))
#endif
template<int THRL> __device__ __forceinline__ void attn_unit(const bf16*Q0,const bf16*__restrict__ Kh,const bf16*__restrict__ Vh,bf16*O0,const int NT,char*shm){
  const int tid=opaque_tid(),lane=tid&63,r32=lane&31,hi=lane>>5; const int wid=__builtin_amdgcn_readfirstlane(tid>>6);
  const bf16*Qw=Q0+(long)(wid*QBLK)*QP;
  const unsigned lds0=(unsigned)(uintptr_t)shm;
  float*wsf=(float*)(shm+LDS_WS)+wid*64;
  const bf16*ksrc=Kh+(long)lane*KP+wid*8;
  const bf16*vsrc=Vh+(long)(16*(wid&3)+(lane>>2))*KP+(wid>>2)*32+(lane&3)*8;
  const unsigned kdst=lds0+LDS_K+wid*1024, vdst=lds0+LDS_V+wid*1024;
  #define DMA_K(t,slot) glds16(ksrc+(long)(t)*KVBLK*KP,(unsigned)__builtin_amdgcn_readfirstlane(kdst+(slot)))
  #define DMA_V(t,slot) glds16(vsrc+(long)(t)*KVBLK*KP,(unsigned)__builtin_amdgcn_readfirstlane(vdst+(slot)))
  const int vb0=(int)(lds0+LDS_V)+((lane>>4)&1)*32+(lane&3)*8+(4*hi+((lane&15)>>2))*64;
  const char*Kbase=shm+LDS_K; bf16x8 kf[8];
  const lds_cptr shm3=(lds_cptr)shm; const lds_cptr kp0=shm3+LDS_K+hi*1024+r32*16; const lds_cptr vp0=shm3+LDS_V+((lane>>4)&1)*32+(lane&3)*8+(4*hi+((lane&15)>>2))*64;
  DMA_K(0,0);DMA_V(0,0);DMA_K(1,SLOTB);
  bf16x8 qr[4];
  #pragma unroll
  for(int d0=0;d0<4;++d0)qr[d0]=*reinterpret_cast<const bf16x8*>(&Qw[(long)r32*QP+d0*16+hi*8]);
  float mhat=0.f,l_reg=0.f;f32x16 o[2];o[0]=f32x16{};o[1]=f32x16{};f32x16 negm=f32x16{};asm volatile("":"+v"(negm));
  #define CMASK(P0,P1,t) do{}while(0)
  bool resc=false;
  #define START(P0,P1) do{ const float rm=rowmax(P0,P1); resc=false; \
    { const float dl=rm; mhat=fadd_s(mhat,dl); \
      _Pragma("unroll") for(int r=0;r<16;++r){P0[r]=fsub_s(P0[r],dl);P1[r]=fsub_s(P1[r],dl);} \
      _Pragma("unroll") for(int r=0;r<16;++r)negm[r]=-mhat; asm volatile("":"+v"(negm)); } \
    _Pragma("unroll") for(int r=0;r<16;++r)P0[r]=__builtin_amdgcn_exp2f(P0[r]); }while(0)
  #define RESC() do{ if(resc){ asm volatile("s_waitcnt lgkmcnt(0)":::"memory"); \
      _Pragma("unroll") for(int d_=0;d_<2;++d_) _Pragma("unroll") for(int r=0;r<16;++r)o[d_][r]*=wsf[crow(r,hi)]; } }while(0)
  f32x16 pA0,pA1,pB0,pB1;
  int sl_prev=0,sl_cur=0,sl_next=SLOTB;
  #define ROT() do{sl_prev=sl_cur;sl_cur=sl_next;sl_next=(sl_next==(NSLOT-1)*SLOTB)?0:sl_next+SLOTB;}while(0)
  DMA_K(2,2*SLOTB);
  WAIT_BAR(3);
  qkt(pA0,pA1,Kbase,qr,negm,r32,hi);asm volatile("s_nop 15\n\ts_nop 7":"+v"(pA0),"+v"(pA1));CMASK(pA0,pA1,0);
  START(pA0,pA1);
  _Pragma("unroll") for(int r=0;r<16;++r)pA1[r]=__builtin_amdgcn_exp2f(pA1[r]);
  WAIT_BAR(0);
  DMA_K(3,0);DMA_V(1,SLOTB);
  ROT();
  kload8(kf,kp0+sl_cur);
  WAIT_BAR(2);
  s16x4 vlo[8],vhi[8]; u32x4 pw0,pw1,pw2,pw3;
  #define PKW(P,B) cvtpk_s(P[B],P[B+1])
  #define PAF(k) __builtin_bit_cast(bf16x8,pw##k)
  #define VFR(i) (bf16x8){vlo[i][0],vlo[i][1],vlo[i][2],vlo[i][3],vhi[i][0],vhi[i][1],vhi[i][2],vhi[i][3]}
  #define PIN(x) asm volatile("":"+v"(x))
  #define MX3(a,b,c) __builtin_fmaxf(__builtin_fmaxf((a),(b)),(c))
  #define GAPA(MF,A0,A1,A2,A3,W0,W1,PW) do{ MF; sacc+=A0; sacc+=A1; sacc+=A2; sacc+=A3; PIN(sacc); W0; W1; PIN(PW); SBAR(); }while(0)
  #define EX(v) __builtin_amdgcn_exp2f(v)
  #define GAPB(MF,X,B) do{ MF; X[B]=EX(X[B]); X[B+1]=EX(X[B+1]); X[B+2]=EX(X[B+2]); X[B+3]=EX(X[B+3]); PIN(X); SBAR(); }while(0)
  #define VRD(i) do{ vlo[i]=vtr(vp_+(((i)>>2)*4096+((i)&3)*1024)); vhi[i]=vtr(vp_+(((i)>>2)*4096+((i)&3)*1024+512)); }while(0)
  #define KRD(G,j) do{ if(G){ kload2(kf,kp0+sl_next,j); SBAR(); } }while(0)
  #define STEP(C0,C1,P0,P1,t,GK,GV,GL) do{ SBAR(); \
    const lds_cptr vp_=vp0+sl_prev; \
    VRD(0); SBAR(); float sacc=(P0[0]+P0[1]); \
    GAPA(C0=__builtin_amdgcn_mfma_f32_32x32x16_bf16(kf[0],qr[0],negm,0,0,0), P0[2],P0[3],P0[4],P0[5],     pw0[0]=PKW(P0,0), pw0[1]=PKW(P0,2), pw0); \
    VRD(4); SBAR(); GAPA(C1=__builtin_amdgcn_mfma_f32_32x32x16_bf16(kf[1],qr[0],negm,0,0,0), P0[6],P0[7],P0[8],P0[9],     pw0[2]=PKW(P0,4), pw0[3]=PKW(P0,6), pw0); \
    VRD(1); SBAR(); GAPA(C0=__builtin_amdgcn_mfma_f32_32x32x16_bf16(kf[2],qr[1],C0,0,0,0),   P0[10],P0[11],P0[12],P0[13], pw1[0]=PKW(P0,8), pw1[1]=PKW(P0,10), pw1); \
    VRD(5); SBAR(); GAPA(C1=__builtin_amdgcn_mfma_f32_32x32x16_bf16(kf[3],qr[1],C1,0,0,0),   P0[14],P0[15],P1[0],P1[1],   pw1[2]=PKW(P0,12),pw1[3]=PKW(P0,14), pw1); \
    VRD(2); SBAR(); GAPA(C0=__builtin_amdgcn_mfma_f32_32x32x16_bf16(kf[4],qr[2],C0,0,0,0),   P1[2],P1[3],P1[4],P1[5],     pw2[0]=PKW(P1,0), pw2[1]=PKW(P1,2), pw2); \
    VRD(6); SBAR(); GAPA(C1=__builtin_amdgcn_mfma_f32_32x32x16_bf16(kf[5],qr[2],C1,0,0,0),   P1[6],P1[7],P1[8],P1[9],     pw2[2]=PKW(P1,4), pw2[3]=PKW(P1,6), pw2); \
    VRD(3); SBAR(); GAPA(C0=__builtin_amdgcn_mfma_f32_32x32x16_bf16(kf[6],qr[3],C0,0,0,0),   P1[10],P1[11],P1[12],P1[13], pw3[0]=PKW(P1,8), pw3[1]=PKW(P1,10), pw3); \
    VRD(7); SBAR(); GAPA(C1=__builtin_amdgcn_mfma_f32_32x32x16_bf16(kf[7],qr[3],C1,0,0,0),   P1[14],P1[15],0.f,0.f,       pw3[2]=PKW(P1,12),pw3[3]=PKW(P1,14), pw3); \
    l_reg+=sacc; \
    if(GK){DMA_K((t)+3,sl_cur);} if(GV){DMA_V((t)+1,sl_next);} \
    CMASK(C0,C1,t); \
    { float a=MX3(C0[0],C0[1],C1[0]),b=MX3(C0[2],C0[3],C1[1]); a=MX3(a,C1[2],C1[3]); \
      _Pragma("unroll") for(int r=4;r<16;r+=4){a=MX3(a,C0[r],C0[r+1]);b=MX3(b,C0[r+2],C0[r+3]);a=MX3(a,C1[r],C1[r+1]);b=MX3(b,C1[r+2],C1[r+3]);} \
      float rm=__builtin_fmaxf(a,b); { auto rr=__builtin_amdgcn_permlane32_swap(__float_as_uint(rm),__float_as_uint(rm),false,false); rm=__builtin_fmaxf(__uint_as_float(rr[0]),__uint_as_float(rr[1])); } \
      resc=false; \
      if(__builtin_expect(__any(rm>(float)THRL),0)){ const float dl=__builtin_fmaxf(rm,0.f); mhat+=dl; \
        _Pragma("unroll") for(int r=0;r<16;++r){C0[r]-=dl;C1[r]-=dl;} \
        _Pragma("unroll") for(int r=0;r<16;++r)negm[r]=-mhat; asm volatile("":"+v"(negm)); \
        const float f=__builtin_amdgcn_exp2f(-dl); l_reg*=f; if(hi==0)wsf[r32]=f; resc=true; } } \
    SBAR(); \
    GAPB(o[0]=__builtin_amdgcn_mfma_f32_32x32x16_bf16(PAF(0),VFR(0),o[0],0,0,0), C0,0); \
    GAPB(o[1]=__builtin_amdgcn_mfma_f32_32x32x16_bf16(PAF(0),VFR(4),o[1],0,0,0), C0,4); \
    KRD(GL,0); GAPB(o[0]=__builtin_amdgcn_mfma_f32_32x32x16_bf16(PAF(1),VFR(1),o[0],0,0,0), C0,8); \
    KRD(GL,1); GAPB(o[1]=__builtin_amdgcn_mfma_f32_32x32x16_bf16(PAF(1),VFR(5),o[1],0,0,0), C0,12); \
    KRD(GL,2); GAPB(o[0]=__builtin_amdgcn_mfma_f32_32x32x16_bf16(PAF(2),VFR(2),o[0],0,0,0), C1,0); \
    KRD(GL,3); GAPB(o[1]=__builtin_amdgcn_mfma_f32_32x32x16_bf16(PAF(2),VFR(6),o[1],0,0,0), C1,4); \
    GAPB(o[0]=__builtin_amdgcn_mfma_f32_32x32x16_bf16(PAF(3),VFR(3),o[0],0,0,0), C1,8); \
    GAPB(o[1]=__builtin_amdgcn_mfma_f32_32x32x16_bf16(PAF(3),VFR(7),o[1],0,0,0), C1,12); \
    }while(0)
  int t=1;
  for(;t+5<NT;t+=2){
    STEP(pB0,pB1,pA0,pA1,t,true,true,true);     WAIT_BAR(2); RESC(); ROT();
    STEP(pA0,pA1,pB0,pB1,t+1,true,true,true);   WAIT_BAR(2); RESC(); ROT();
  }
  #define ENDW(tt) do{ if((tt)+3<NT){WAIT_BAR(2);} else if((tt)+2<NT){WAIT_BAR(1);} else {WAIT_BAR(0);} }while(0)
  for(;t+1<NT;t+=2){
    STEP(pB0,pB1,pA0,pA1,t,(t+3<NT),(t+1<NT),(t+1<NT));       ENDW(t);   RESC(); ROT();
    STEP(pA0,pA1,pB0,pB1,t+1,(t+4<NT),(t+2<NT),(t+2<NT));     ENDW(t+1); RESC(); ROT();
  }
  STEP(pB0,pB1,pA0,pA1,NT-1,false,false,false); RESC();
  { float sacc=pB0[0]+pB0[1]; _Pragma("unroll") for(int r=2;r<16;++r)sacc+=pB0[r]; _Pragma("unroll") for(int r=0;r<16;++r)sacc+=pB1[r]; l_reg+=sacc;
    pw0=(u32x4){PKW(pB0,0),PKW(pB0,2),PKW(pB0,4),PKW(pB0,6)};pw1=(u32x4){PKW(pB0,8),PKW(pB0,10),PKW(pB0,12),PKW(pB0,14)};pw2=(u32x4){PKW(pB1,0),PKW(pB1,2),PKW(pB1,4),PKW(pB1,6)};pw3=(u32x4){PKW(pB1,8),PKW(pB1,10),PKW(pB1,12),PKW(pB1,14)};
    SBAR(); pv(o,vb0+sl_cur,PAF(0),PAF(1),PAF(2),PAF(3)); }
  #undef PKW
  #undef PAF
  #undef VFR
  #undef PIN
  #undef MX3
  #undef GAPA
  #undef GAPB
  #undef EX
  #undef VRD
  #undef KRD
  #undef STEP
  #undef ENDW
  {auto rr=__builtin_amdgcn_permlane32_swap(__float_as_uint(l_reg),__float_as_uint(l_reg),false,false);l_reg=__uint_as_float(rr[0])+__uint_as_float(rr[1]);}
  if(hi==0)wsf[32+r32]=l_reg;asm volatile("s_waitcnt lgkmcnt(0)":::"memory");
  float rli[16];
  #pragma unroll
  for(int r=0;r<16;++r)rli[r]=__builtin_amdgcn_rcpf(wsf[32+crow(r,hi)]);
  bf16*Ow=O0+(long)(wid*QBLK)*OP;
  { bf16*stg=(bf16*)(shm+LDS_OST)+wid*2048;
    #pragma unroll
    for(int r=0;r<16;++r){const int orow=crow(r,hi);
      #pragma unroll
      for(int d0=0;d0<2;++d0)stg[orow*64+d0*32+r32]=__float2bfloat16(o[d0][r]*rli[r]);}
    asm volatile("s_waitcnt lgkmcnt(0)":::"memory");
    #pragma unroll
    for(int i=0;i<4;++i){const int row=i*8+(lane>>3),ch=lane&7; const u32x4 v=*(const u32x4*)(stg+row*64+ch*8); ATTN_STORE16(Ow+(long)row*OP+ch*8,v);} }
  asm volatile("s_waitcnt lgkmcnt(0)\n\ts_barrier":::"memory");
  #undef DMA_K
  #undef DMA_V
  #undef CMASK
  #undef START
  #undef RESC
  #undef ROT
}
constexpr int ATTN_LDS_BYTES=LDS_BYTES;
#undef SBAR
#undef WAIT_BAR
}

constexpr int DM = 1024, BATCH = 8, SEQ = 4096, DEPTH = 4, CTXL = 256, DFF = 2816;
constexpr int MX = BATCH * SEQ, MC = BATCH * CTXL, MALL = MX + MC;
constexpr int INW = 2080, INWP = 2304, KVLEN = CTXL + SEQ, NCH = KVLEN / 64;
constexpr float EPS = 1e-6f;
constexpr float QSCALE = 0.125f * 1.4426950408889634f;
constexpr int PC_CA = 0, PC_CG = 256, PC_GQ = 512, PC_GK = 640, PC_GV = 768, PC_GR = 1024, PC_GF = 1280, PC_AQ = 1312, PC_AK = 1824;
constexpr size_t MiB = 1u << 20;
constexpr size_t WS_W1T = 0, WS_W2T = 88 * MiB, WS_WINT = 132 * MiB, WS_WOT = 150 * MiB, WS_MOD = 158 * MiB, WS_XN = 160 * MiB, WS_CAT = 228 * MiB,
                 WS_HP = 296 * MiB, WS_Q = 483 * MiB, WS_K = 517 * MiB, WS_V = 526 * MiB, WS_CTXR = 535 * MiB, WS_GDS = 543 * MiB, WS_GDEC = 577 * MiB, WS_CTL = 578 * MiB, WS_SSQ = 579 * MiB, WS_SW = 581 * MiB, WS_END = 584 * MiB;
constexpr size_t W1T_SZ = (size_t)2 * DFF * DM, W2T_SZ = (size_t)DM * DFF, WINT_SZ = (size_t)INWP * DM, WOT_SZ = (size_t)DM * DM;
static_assert(8 * W1T_SZ * 2 <= WS_W2T - WS_W1T && 8 * W2T_SZ * 2 <= WS_WINT - WS_W2T && 4 * WINT_SZ * 2 <= WS_WOT - WS_WINT && 4 * WOT_SZ * 2 <= WS_MOD - WS_WOT, "ws map W");
static_assert((size_t)MALL * DM * 2 <= WS_CAT - WS_XN && (size_t)MALL * DM * 2 <= WS_HP - WS_CAT && (size_t)MALL * DFF * 2 <= WS_Q - WS_HP && (size_t)MALL * 512 * 2 <= WS_K - WS_Q, "ws map act");
static_assert((size_t)BATCH * KVLEN * 128 * 2 <= WS_V - WS_K && (size_t)MC * DM * 4 <= WS_GDS - WS_CTXR && (size_t)BATCH * 2 * NCH * 4 * 2048 * 4 <= WS_GDEC - WS_GDS, "ws map 2");
constexpr int LDS_BYTES = 147456;
constexpr int NPH_LAYER = 9, NPHASES = 2 + DEPTH * NPH_LAYER;
constexpr int SWN = 2 * DFF;
static_assert((size_t)DEPTH * 3 * MALL * 4 <= WS_SW - WS_SSQ && (size_t)DEPTH * 3 * 9 * SWN * 4 <= WS_END - WS_SW, "ws map 3");

typedef unsigned short bf16_t;
typedef float f32x4 __attribute__((ext_vector_type(4)));
typedef unsigned u32x4 __attribute__((ext_vector_type(4)));
typedef unsigned u32x2 __attribute__((ext_vector_type(2)));
typedef float f32x2v __attribute__((ext_vector_type(2)));
#define LDSP __attribute__((address_space(3)))
#define LDS_WAIT() asm volatile("s_waitcnt lgkmcnt(0)" ::: "memory")
__device__ __forceinline__ unsigned pk2(float lo, float hi) { return pg8::cvt_pk_bf16(lo, hi); }
__device__ __forceinline__ float bflo(unsigned w) { return __uint_as_float(w << 16); }
__device__ __forceinline__ float bfhi(unsigned w) { return __uint_as_float(w & 0xffff0000u); }
__device__ __forceinline__ void unpack8(const u32x4 r, float (&x)[8]) { x[0] = bflo(r.x); x[1] = bfhi(r.x); x[2] = bflo(r.y); x[3] = bfhi(r.y); x[4] = bflo(r.z); x[5] = bfhi(r.z); x[6] = bflo(r.w); x[7] = bfhi(r.w); }
__device__ __forceinline__ u32x4 pack8(const float (&x)[8]) { u32x4 w; w.x = pk2(x[0], x[1]); w.y = pk2(x[2], x[3]); w.z = pk2(x[4], x[5]); w.w = pk2(x[6], x[7]); return w; }
template <int CTRL> __device__ __forceinline__ float dpp_mov(float v) { return __int_as_float(__builtin_amdgcn_update_dpp(0, __float_as_int(v), CTRL, 0xf, 0xf, false)); }
template <int X> __device__ __forceinline__ float swz_xor(float v) {
    if constexpr (X == 1) return dpp_mov<0xB1>(v);
    else if constexpr (X == 2) return dpp_mov<0x4E>(v);
    else return __int_as_float(__builtin_amdgcn_ds_swizzle(__float_as_int(v), 0x1f | (X << 10)));
}
__device__ __forceinline__ float sum8(float v)  { v += dpp_mov<0xB1>(v); v += dpp_mov<0x4E>(v); v += dpp_mov<0x141>(v); return v; }
__device__ __forceinline__ float sum16(float v) { v = sum8(v); v += dpp_mov<0x140>(v); return v; }
__device__ __forceinline__ float wave_sum(float v) {
    v = sum16(v); v += swz_xor<16>(v);
    auto rr = __builtin_amdgcn_permlane32_swap(__float_as_uint(v), __float_as_uint(v), false, false);
    return __uint_as_float(rr[0]) + __uint_as_float(rr[1]);
}
__device__ __forceinline__ float sigm(float v) { return __builtin_amdgcn_rcpf(1.0f + __expf(-v)); }

struct Args { const float* in[20]; float* out; unsigned char* ws; int ph_lo, ph_hi; };
typedef const __attribute__((address_space(4))) Args* KA;
enum { I_X = 0, I_C, I_CTX, I_CCTX, I_WADA, I_BADA, I_GNORM, I_WFI, I_WFO, I_WIN, I_WOUT, I_WDW, I_BDW, I_CNG, I_CNB, I_WGG, I_BGG, I_GLAG, I_QNG, I_KNG };

__device__ __forceinline__ void transpose_item(const float* W, int K, int N, bf16_t* WT, int kb, int nsrc, int ndst, LDSP float* scr, int lane) {
    const int k0 = 64 * kb;
#pragma unroll 8
    for (int i = 0; i < 32; ++i) { const int kk = 2 * i + (lane >> 5); scr[kk * 33 + (lane & 31)] = W[(size_t)(k0 + kk) * N + nsrc + (lane & 31)]; }
    LDS_WAIT();
    const int c = lane & 7;
#pragma unroll
    for (int j = 0; j < 4; ++j) { const int n = (lane >> 3) + 8 * j; const LDSP float* s = scr + (8 * c) * 33 + n;
        u32x4 o; o.x = pk2(s[0 * 33], s[1 * 33]); o.y = pk2(s[2 * 33], s[3 * 33]); o.z = pk2(s[4 * 33], s[5 * 33]); o.w = pk2(s[6 * 33], s[7 * 33]);
        *(u32x4*)(WT + (size_t)(ndst + n) * K + k0 + 8 * c) = o; }
    LDS_WAIT();
}
__device__ __forceinline__ void phase0(KA a, LDSP unsigned char* lds, int tid, int lane, int wave, int bid, int G) {
    unsigned char* ws = a->ws;
    LDSP float* scr = (LDSP float*)(lds + wave * 8704);
    const int gw = bid * 8 + wave, NGW = G * 8;
    constexpr int I1 = 16 * 176, I2 = 44 * 32, I3 = 16 * 65, I4 = 16 * 32, LI = 2 * I1 + 2 * I2 + I3 + I4;
    for (int it = gw; it < DEPTH * LI; it += NGW) {
        const int l = it / LI; int r = it % LI;
        if (r < 2 * I1) { const int f = r / I1, rr = r % I1, kb = rr / 176, nb = rr % 176, nsrc = nb * 32; const bool isu = nsrc >= DFF; const int j = isu ? nsrc - DFF : nsrc;
            transpose_item(a->in[I_WFI] + (size_t)(l * 2 + f) * DM * 2 * DFF, DM, 2 * DFF, (bf16_t*)(ws + WS_W1T) + (size_t)(l * 2 + f) * W1T_SZ, kb, nsrc, 256 * (j >> 7) + (isu ? 128 : 0) + (j & 127), scr, lane); continue; }
        r -= 2 * I1;
        if (r < 2 * I2) { const int f = r / I2, rr = r % I2, kb = rr / 32, nb = rr % 32;
            transpose_item(a->in[I_WFO] + (size_t)(l * 2 + f) * DFF * DM, DFF, DM, (bf16_t*)(ws + WS_W2T) + (size_t)(l * 2 + f) * W2T_SZ, kb, nb * 32, nb * 32, scr, lane); continue; }
        r -= 2 * I2;
        if (r < I3) { const int kb = r / 65, nb = r % 65;
            transpose_item(a->in[I_WIN] + (size_t)l * DM * INW, DM, INW, (bf16_t*)(ws + WS_WINT) + (size_t)l * WINT_SZ, kb, nb * 32, nb * 32, scr, lane); continue; }
        r -= I3;
        { const int kb = r / 32, nb = r % 32;
            transpose_item(a->in[I_WOUT] + (size_t)l * DM * DM, DM, DM, (bf16_t*)(ws + WS_WOT) + (size_t)l * WOT_SZ, kb, nb * 32, nb * 32, scr, lane); }
    }
    { constexpr int PV = (INWP - INW) * DM * 2 / 16;
        for (int i = bid * 512 + tid; i < DEPTH * PV; i += G * 512) { const int l = i / PV, r = i % PV;
            ((u32x4*)((bf16_t*)(ws + WS_WINT) + (size_t)l * WINT_SZ + (size_t)INW * DM))[r] = (u32x4){0u, 0u, 0u, 0u}; } }
    { float* SSQ = (float*)(ws + WS_SSQ); for (int i = bid * 512 + tid; i < DEPTH * 3 * MALL; i += G * 512) SSQ[i] = 0.f; }
    __syncthreads();
    LDSP float* S = (LDSP float*)(lds + 69632);
    LDSP float* red = (LDSP float*)(lds + 106496);
    for (int i = tid; i < 9 * 1024; i += 512) { const int r = i >> 10, k = i & 1023; const float cv = r < 8 ? a->in[I_C][r * 1024 + k] : a->in[I_CCTX][k]; S[i] = cv * sigm(cv); }
    __syncthreads();
    float* MOD = (float*)(ws + WS_MOD);
    for (int it = bid; it < DEPTH * 144; it += G) {
        const int l = it / 144, n0 = (it % 144) * 64;
        const float* Wp = a->in[I_WADA] + (size_t)l * DM * 9216 + n0 + lane;
        float acc[9];
#pragma unroll
        for (int r = 0; r < 9; ++r) acc[r] = 0.f;
#pragma unroll 8
        for (int kk = 0; kk < 128; ++kk) { const int k = wave * 128 + kk; const float w = Wp[(size_t)k * 9216];
#pragma unroll
            for (int r = 0; r < 9; ++r) acc[r] += S[r * 1024 + k] * w; }
#pragma unroll
        for (int r = 0; r < 9; ++r) red[(wave * 9 + r) * 64 + lane] = acc[r];
        __syncthreads();
        for (int o = tid; o < 576; o += 512) { const int r = o >> 6, ln = o & 63; float s = 0.f;
#pragma unroll
            for (int w = 0; w < 8; ++w) s += red[(w * 9 + r) * 64 + ln];
            MOD[(size_t)(l * 9 + r) * 9216 + n0 + ln] = s + a->in[I_BADA][l * 9216 + n0 + ln]; }
        __syncthreads();
    }
}
__device__ __forceinline__ void phase1(KA a, LDSP unsigned char* lds, int tid, int lane, int wave, int bid, int G) {
    const float* MOD = (const float*)(a->ws + WS_MOD); bf16_t* XN = (bf16_t*)(a->ws + WS_XN); float* SSQ = (float*)(a->ws + WS_SSQ); float* SW = (float*)(a->ws + WS_SW);
    const float* g = a->in[I_GNORM];
    f32x4 nv[4];
    { const int m0 = bid * 8 + wave; if (m0 < MALL) { const float* xr0 = m0 >= MX ? a->in[I_CTX] + (size_t)(m0 - MX) * DM : a->in[I_X] + (size_t)m0 * DM;
#pragma unroll
        for (int q = 0; q < 4; ++q) nv[q] = ((const f32x4*)xr0)[lane + 64 * q]; } }
    for (int m = bid * 8 + wave; m < MALL; m += G * 8) {
        const bool isc = m >= MX;
        const float* md = MOD + (size_t)(isc ? 8 : (m >> 12)) * 9216;
        f32x4 v[4]; float ss = 0.f;
#pragma unroll
        for (int q = 0; q < 4; ++q) { v[q] = nv[q]; ss += (v[q].x * v[q].x + v[q].y * v[q].y) + (v[q].z * v[q].z + v[q].w * v[q].w); }
        { const int mn = m + G * 8; if (mn < MALL) { const float* xrn = mn >= MX ? a->in[I_CTX] + (size_t)(mn - MX) * DM : a->in[I_X] + (size_t)mn * DM;
#pragma unroll
            for (int q = 0; q < 4; ++q) nv[q] = ((const f32x4*)xrn)[lane + 64 * q]; } }
        ss = wave_sum(ss);
        if (lane == 0) SSQ[m] = ss;
#pragma unroll
        for (int q = 0; q < 4; ++q) { const int col = 4 * lane + 256 * q;
            const f32x4 y = v[q] * *(const f32x4*)(g + col) * (*(const f32x4*)(md + 1024 + col) + 1.0f);
            u32x2 o; o.x = pk2(y.x, y.y); o.y = pk2(y.z, y.w);
            *(u32x2*)(XN + (size_t)m * DM + col) = o;
            typedef _Float16 h16x4 __attribute__((ext_vector_type(4)));
            *(h16x4*)((_Float16*)(a->ws + WS_CAT) + (size_t)m * DM + col) = __builtin_convertvector(v[q], h16x4); }
    }
    LDSP float* SH = (LDSP float*)lds;
    constexpr int RPL = 2 * DFF + INWP + 2 * DFF;
#pragma unroll 1
    for (int l = 0; l < DEPTH; ++l) {
        __syncthreads();
        for (int i = tid; i < 27 * 256; i += 512) { const int v = i >> 8, j = v / 9, bi = v % 9, c4 = (i & 255) * 4; *(LDSP f32x4*)(SH + v * 1024 + c4) = *(const f32x4*)(MOD + (size_t)(l * 9 + bi) * 9216 + (3 * j) * 1024 + c4); }
        __syncthreads();
        const bf16_t* w0b = (const bf16_t*)(a->ws + WS_W1T) + (size_t)(l * 2) * W1T_SZ; const bf16_t* w1b = (const bf16_t*)(a->ws + WS_WINT) + (size_t)l * WINT_SZ; const bf16_t* w2b = (const bf16_t*)(a->ws + WS_W1T) + (size_t)(l * 2 + 1) * W1T_SZ;
#define SW_ROWPTR(rr) ((rr) < 2 * DFF ? w0b + (size_t)(rr) * DM : ((rr) < 2 * DFF + INWP ? w1b + (size_t)((rr) - 2 * DFF) * DM : w2b + (size_t)((rr) - 2 * DFF - INWP) * DM))
        u32x4 nx0 = {0u, 0u, 0u, 0u}, nx1 = {0u, 0u, 0u, 0u};
        { const int r0 = bid * 8 + wave; if (r0 < RPL) { const bf16_t* p = SW_ROWPTR(r0); nx0 = *(const u32x4*)(p + lane * 8); nx1 = *(const u32x4*)(p + 512 + lane * 8); } }
#pragma unroll 1
        for (int r = bid * 8 + wave; r < RPL; r += G * 8) {
            float w0[8], w1[8]; unpack8(nx0, w0); unpack8(nx1, w1);
            { const int rn = r + G * 8; if (rn < RPL) { const bf16_t* p = SW_ROWPTR(rn); nx0 = *(const u32x4*)(p + lane * 8); nx1 = *(const u32x4*)(p + 512 + lane * 8); } }
            const int j = r < 2 * DFF ? 0 : (r < 2 * DFF + INWP ? 1 : 2), rj = r - (j == 0 ? 0 : (j == 1 ? 2 * DFF : 2 * DFF + INWP));
#pragma unroll
            for (int bi = 0; bi < 9; ++bi) { LDSP const float* sh = SH + (j * 9 + bi) * 1024 + lane * 8;
                const f32x4 s0 = *(LDSP const f32x4*)(sh), s1 = *(LDSP const f32x4*)(sh + 4), s2 = *(LDSP const f32x4*)(sh + 512), s3 = *(LDSP const f32x4*)(sh + 516);
                float d = (w0[0] * s0.x + w0[1] * s0.y) + (w0[2] * s0.z + w0[3] * s0.w) + (w0[4] * s1.x + w0[5] * s1.y) + (w0[6] * s1.z + w0[7] * s1.w)
                        + (w1[0] * s2.x + w1[1] * s2.y) + (w1[2] * s2.z + w1[3] * s2.w) + (w1[4] * s3.x + w1[5] * s3.y) + (w1[6] * s3.z + w1[7] * s3.w);
                d = wave_sum(d);
                if (lane == 0) SW[((size_t)(l * 3 + j) * 9 + bi) * SWN + rj] = d; } }
#undef SW_ROWPTR
    }
    __syncthreads();
}
__device__ __forceinline__ void prep_phase(KA a, LDSP unsigned char* lds, int l, int tid, int lane, int wave, int bid, int G) {
    LDSP f32x2v* CS = (LDSP f32x2v*)(lds);
    for (int i = tid; i < 1024; i += 512) { const int pos = i >> 4, f = i & 15;
        const float freq = exp2f(-(float)f * (13.287712379549449f / 16.0f)); const float ang = (float)pos * freq;
        float rev = ang * 0.15915494309189535f; rev -= floorf(rev);
        CS[i] = (f32x2v){__builtin_amdgcn_cosf(rev), __builtin_amdgcn_sinf(rev)}; }
    __syncthreads();
    const bf16_t* P = (const bf16_t*)(a->ws + WS_HP); bf16_t* Q = (bf16_t*)(a->ws + WS_Q); bf16_t* Kb = (bf16_t*)(a->ws + WS_K); bf16_t* Vb = (bf16_t*)(a->ws + WS_V);
    const int sub = lane & 7, axis = sub >> 2, half = (sub >> 1) & 1, f0 = (sub & 1) * 8;
    float qg[8], kg[8];
#pragma unroll
    for (int e = 0; e < 8; ++e) { qg[e] = a->in[I_QNG][l * 64 + sub * 8 + e]; kg[e] = a->in[I_KNG][l * 64 + sub * 8 + e]; }
    u32x4 nq = {0u, 0u, 0u, 0u}, nk_ = {0u, 0u, 0u, 0u};
    { const int m0 = bid * 8 + wave; if (m0 < MALL) { nq = *(const u32x4*)(P + (size_t)m0 * INWP + PC_AQ + lane * 8); nk_ = *(const u32x4*)(P + (size_t)m0 * INWP + PC_AK + (lane & 31) * 8); } }
    for (int m = bid * 8 + wave; m < MALL; m += G * 8) {
        const u32x4 rawq = nq, rawk = nk_;
        asm volatile("" :: "v"(rawq), "v"(rawk) : "memory");
        { const int mn = m + G * 8; if (mn < MALL) { nq = *(const u32x4*)(P + (size_t)mn * INWP + PC_AQ + lane * 8); nk_ = *(const u32x4*)(P + (size_t)mn * INWP + PC_AK + (lane & 31) * 8); } }
        asm volatile("" ::: "memory");
        const bool lat = m < MX;
        const int b = lat ? (m >> 12) : ((m - MX) >> 8), t = lat ? (m & 4095) : 0, pos = lat ? (CTXL + t) : ((m - MX) & 255);
        const int p = axis ? (t & 63) : (t >> 6);
        const bf16_t* pr = P + (size_t)m * INWP;
        float x[8], y[8];
        { const u32x4 raw = rawq; unpack8(raw, x);
            float ss = 0.f;
#pragma unroll
            for (int e = 0; e < 8; ++e) ss += x[e] * x[e];
            ss = sum8(ss);
            const float rstd = 1.0f / sqrtf(ss * (1.0f / 64.0f) + EPS);
#pragma unroll
            for (int e = 0; e < 8; ++e) y[e] = x[e] * rstd * qg[e];
            if (lat) {
#pragma unroll
                for (int e = 0; e < 8; ++e) { const float o = swz_xor<2>(y[e]); const f32x2v cs = CS[p * 16 + f0 + e]; x[e] = half ? (y[e] * cs.x + o * cs.y) : (y[e] * cs.x - o * cs.y); }
            } else {
#pragma unroll
                for (int e = 0; e < 8; ++e) x[e] = y[e];
            }
#pragma unroll
            for (int e = 0; e < 8; ++e) x[e] *= QSCALE;
            *(u32x4*)(Q + (size_t)m * 512 + lane * 8) = pack8(x); }
        { const u32x4 raw = rawk; unpack8(raw, x);
            float ss = 0.f;
#pragma unroll
            for (int e = 0; e < 8; ++e) ss += x[e] * x[e];
            ss = sum8(ss);
            const float rstd = 1.0f / sqrtf(ss * (1.0f / 64.0f) + EPS);
#pragma unroll
            for (int e = 0; e < 8; ++e) y[e] = x[e] * rstd * kg[e];
            if (lat) {
#pragma unroll
                for (int e = 0; e < 8; ++e) { const float o = swz_xor<2>(y[e]); const f32x2v cs = CS[p * 16 + f0 + e]; x[e] = half ? (y[e] * cs.x + o * cs.y) : (y[e] * cs.x - o * cs.y); }
            } else {
#pragma unroll
                for (int e = 0; e < 8; ++e) x[e] = y[e];
            }
            const size_t kvrow = ((size_t)b * KVLEN + pos) * 128;
            if (lane < 16) *(u32x4*)(Kb + kvrow + lane * 8) = pack8(x);
            else if (lane < 32) *(u32x4*)(Vb + kvrow + (lane - 16) * 8) = raw; }
    }
    __syncthreads();
}
__device__ __forceinline__ void conv_phase(KA a, LDSP unsigned char* lds, int l, bool last, int tid, int lane, int bid, int G) {
    LDSP float* hs = (LDSP float*)lds;
    LDSP bf16_t* os = (LDSP bf16_t*)(lds + 94 * 256 * 4);
    const bf16_t* P = (const bf16_t*)(a->ws + WS_HP); bf16_t* CAT = (bf16_t*)a->out;
    const int c = tid & 255, hf = tid >> 8;
    float w[31];
#pragma unroll
    for (int k = 0; k < 31; ++k) w[k] = a->in[I_WDW][(size_t)(l * 31 + k) * 256 + c];
    const float bias = a->in[I_BDW][l * 256 + c], gg = a->in[I_CNG][l * 256 + c], bb = a->in[I_CNB][l * 256 + c];
    const int nitems = last ? 512 : 544;
    for (int it = bid; it < nitems; it += G) {
        int base, len, t0;
        if (it < 512) { base = (it >> 6) * SEQ; len = SEQ; t0 = (it & 63) * 64; } else { const int i2 = it - 512; base = MX + (i2 >> 2) * CTXL; len = CTXL; t0 = (i2 & 3) * 64; }
        for (int rr = tid >> 5; rr < 94; rr += 16) { const int t = t0 - 15 + rr, c8 = (tid & 31) * 8;
            float h[8];
            if (t >= 0 && t < len) { const bf16_t* pr = P + (size_t)(base + t) * INWP + c8; float av[8], gv[8];
                unpack8(*(const u32x4*)(pr + PC_CA), av); unpack8(*(const u32x4*)(pr + PC_CG), gv);
#pragma unroll
                for (int e = 0; e < 8; ++e) h[e] = av[e] * sigm(gv[e]);
            } else {
#pragma unroll
                for (int e = 0; e < 8; ++e) h[e] = 0.f;
            }
            *(LDSP f32x4*)(hs + rr * 256 + c8) = (f32x4){h[0], h[1], h[2], h[3]}; *(LDSP f32x4*)(hs + rr * 256 + c8 + 4) = (f32x4){h[4], h[5], h[6], h[7]}; }
        __syncthreads();
#pragma unroll 1
        for (int i0 = 0; i0 < 32; i0 += 4) { const int ib = hf * 32 + i0;
            float xw[34];
#pragma unroll
            for (int k = 0; k < 34; ++k) xw[k] = hs[(ib + k) * 256 + c];
            float acc[4], mean[4], var[4];
#pragma unroll
            for (int t = 0; t < 4; ++t) { float s_ = bias;
#pragma unroll
                for (int k = 0; k < 31; ++k) s_ += w[k] * xw[t + k];
                acc[t] = s_; mean[t] = s_; }
#pragma unroll
            for (int t = 0; t < 4; ++t) mean[t] = sum16(mean[t]);
#pragma unroll
            for (int t = 0; t < 4; ++t) mean[t] += swz_xor<16>(mean[t]);
#pragma unroll
            for (int t = 0; t < 4; ++t) { auto rr = __builtin_amdgcn_permlane32_swap(__float_as_uint(mean[t]), __float_as_uint(mean[t]), false, false);
                mean[t] = (__uint_as_float(rr[0]) + __uint_as_float(rr[1])) * (1.0f / 64.0f); acc[t] -= mean[t]; var[t] = acc[t] * acc[t]; }
#pragma unroll
            for (int t = 0; t < 4; ++t) var[t] = sum16(var[t]);
#pragma unroll
            for (int t = 0; t < 4; ++t) var[t] += swz_xor<16>(var[t]);
#pragma unroll
            for (int t = 0; t < 4; ++t) { auto rr = __builtin_amdgcn_permlane32_swap(__float_as_uint(var[t]), __float_as_uint(var[t]), false, false);
                const float vv = (__uint_as_float(rr[0]) + __uint_as_float(rr[1])) * (1.0f / 64.0f);
                const float y = acc[t] * __builtin_amdgcn_rsqf(vv + EPS) * gg + bb;
                const float o = y * sigm(y);
                os[(ib + t) * 256 + c] = (bf16_t)(pk2(o, 0.f) & 0xffffu); } }
        __syncthreads();
        for (int q = tid; q < 2048; q += 512) { const int row = q >> 5, c8 = (q & 31) * 8;
            *(u32x4*)(CAT + (size_t)(base + t0 + row) * DM + c8) = *(const LDSP u32x4*)(os + row * 256 + c8); }
        __syncthreads();
    }
}
typedef short gbf16x8 __attribute__((ext_vector_type(8)));
constexpr int GB_WG = 106496, GB_BG = 106496 + 16384;
constexpr int GB_Q = 0, GB_K = 8448, GB_GF = 16896, GB_GB = 20992, GB_VT = 25088, GB_S0T = 34304, GB_QE = 42496, GB_KE = 50688, GB_KENDT = 58880, GB_ATT = 68096, GB_TOT = 86528, GB_O = 88576, GB_END = 105984;
constexpr int VTP = 72, ATP = 72, KTP = 72, OP_ = 68;
static_assert(GB_END <= 131072 && GB_VT + 64 * VTP * 2 == GB_S0T && GB_ATT + 2 * 64 * ATP * 2 == GB_TOT && GB_O + 64 * OP_ * 4 == GB_END, "gla lds");
__device__ __forceinline__ int gla_row(int b, int c, int i) { return c < 4 ? MX + b * CTXL + c * 64 + i : b * SEQ + (c - 4) * 64 + i; }
__device__ __forceinline__ void st_bf16(LDSP unsigned char* base, int byteoff, float v) { *(LDSP bf16_t*)(base + byteoff) = (bf16_t)(pk2(v, 0.f) & 0xffffu); }
struct GlaRegs { u32x4 qk, gt, vv, rg; f32x4 s0[2], gg[2]; };
template <bool G3> __device__ __forceinline__ void gla_issue(KA a, GlaRegs& R, const float* ggb, int b, int c, int h, int tid) {
    const bf16_t* P = (const bf16_t*)(a->ws + WS_HP);
    { const int i = (tid & 255) >> 2, part = tid & 3; const bf16_t* pr = P + (size_t)gla_row(b, c, i) * INWP;
        R.qk = (u32x4){0u, 0u, 0u, 0u};
        if (G3 || tid >= 256) R.qk = *(const u32x4*)(pr + (tid < 256 ? PC_GQ : PC_GK) + h * 32 + part * 8);
        R.gt = *(const u32x4*)(pr + PC_GF + part * 8); }
    { const int j = tid >> 3, part = tid & 7; R.vv = *(const u32x4*)(P + (size_t)gla_row(b, c, j) * INWP + PC_GV + h * 64 + part * 8); }
    if (G3) { const float* DS = (const float*)(a->ws + WS_GDS);
#pragma unroll
        for (int dir = 0; dir < 2; ++dir) { const size_t ci = ((size_t)(b * 2 + dir) * NCH + c) * 4 + h; R.s0[dir] = *(const f32x4*)(DS + ci * 2048 + (tid >> 4) * 64 + (tid & 15) * 4); }
        R.rg = *(const u32x4*)(P + (size_t)gla_row(b, c, tid >> 3) * INWP + PC_GR + h * 64 + (tid & 7) * 8);
        R.gg[0] = *(const f32x4*)(ggb + h * 64 + (tid & 7) * 8); R.gg[1] = *(const f32x4*)(ggb + h * 64 + (tid & 7) * 8 + 4); }
}
template <bool G3> __device__ __forceinline__ void gla_stage(KA a, LDSP unsigned char* B, const GlaRegs& R, int l, int b, int c, int h, int tid) {
    LDSP float* Qf = (LDSP float*)(B + GB_Q); LDSP float* Kf = (LDSP float*)(B + GB_K); LDSP float* GF = (LDSP float*)(B + GB_GF); LDSP float* GBk = (LDSP float*)(B + GB_GB);
    { const int i = (tid & 255) >> 2, part = tid & 3;
        float x[8]; unpack8(R.qk, x);
        if (tid < 256) {
            if (G3) {
#pragma unroll
                for (int e = 0; e < 8; ++e) Qf[i * 33 + part * 8 + e] = x[e]; }
            unpack8(R.gt, x);
#pragma unroll
            for (int e = 0; e < 8; ++e) (part < 2 ? GF : GBk)[i * 16 + (part & 1) * 8 + e] = x[e];
        } else {
#pragma unroll
            for (int e = 0; e < 8; ++e) Kf[i * 33 + part * 8 + e] = x[e]; } }
    { const int j = tid >> 3, part = tid & 7; const u32x4 r = R.vv;
        const unsigned w[4] = {r.x, r.y, r.z, r.w};
#pragma unroll
        for (int e = 0; e < 8; ++e) *(LDSP bf16_t*)(B + GB_VT + ((part * 8 + e) * VTP + j) * 2) = (bf16_t)((e & 1) ? (w[e >> 1] >> 16) : (w[e >> 1] & 0xffffu)); }
    if (G3) {
#pragma unroll
        for (int dir = 0; dir < 2; ++dir) { const int d = tid >> 4, v4 = (tid & 15) * 4; const f32x4 sv = R.s0[dir];
            st_bf16(B, GB_S0T + dir * 4096 + ((v4 + 0) * 32 + d) * 2, sv.x); st_bf16(B, GB_S0T + dir * 4096 + ((v4 + 1) * 32 + d) * 2, sv.y);
            st_bf16(B, GB_S0T + dir * 4096 + ((v4 + 2) * 32 + d) * 2, sv.z); st_bf16(B, GB_S0T + dir * 4096 + ((v4 + 3) * 32 + d) * 2, sv.w); } }
    __syncthreads();
    const int dir = tid >> 8, seg = (tid >> 5) & 7, d = tid & 31;
    float p[8], qv[8], kv[8];
    { LDSP const float* Wg = (LDSP const float*)(B + GB_WG) + (dir * 16) * 128 + h * 32 + d; const float bg = ((LDSP const float*)(B + GB_BG))[dir * 128 + h * 32 + d];
        float wc[16];
#pragma unroll
        for (int r = 0; r < 16; ++r) wc[r] = Wg[r * 128];
        LDSP const float* gs = dir ? GBk : GF;
#pragma unroll
        for (int r = 0; r < 8; ++r) { const int i = dir ? 63 - (seg * 8 + r) : seg * 8 + r; kv[r] = Kf[i * 33 + d]; qv[r] = G3 ? Qf[i * 33 + d] : 0.f; }
        float run = 0.f;
#pragma unroll
        for (int hb = 0; hb < 2; ++hb) {
            f32x4 gq[4][4];
#pragma unroll
            for (int r = 0; r < 4; ++r) { const int i = dir ? 63 - (seg * 8 + hb * 4 + r) : seg * 8 + hb * 4 + r;
#pragma unroll
                for (int q = 0; q < 4; ++q) gq[r][q] = *(LDSP const f32x4*)(gs + i * 16 + 4 * q); }
#pragma unroll
            for (int r = 0; r < 4; ++r) { float z0 = bg, z1 = 0.f, z2 = 0.f, z3 = 0.f;
#pragma unroll
                for (int q = 0; q < 4; ++q) { z0 += gq[r][q].x * wc[4 * q]; z1 += gq[r][q].y * wc[4 * q + 1]; z2 += gq[r][q].z * wc[4 * q + 2]; z3 += gq[r][q].w * wc[4 * q + 3]; }
                const float z = (z0 + z1) + (z2 + z3);
                const float ls = fminf(z, 0.f) - __logf(1.0f + __expf(-fabsf(z)));
                run += ls * (1.0f / 16.0f); p[hb * 4 + r] = run; } }
        ((LDSP float*)(B + GB_TOT))[(dir * 8 + seg) * 32 + d] = run; }
    __syncthreads();
    float off = 0.f, bl = 0.f;
#pragma unroll
    for (int sg = 0; sg < 8; ++sg) { const float t = ((LDSP const float*)(B + GB_TOT))[(dir * 8 + sg) * 32 + d]; bl += t; off += (sg < seg) ? t : 0.f; }
    float o1[8], o2[8];
#pragma unroll
    for (int r = 0; r < 8; ++r) { const float bc = p[r] + off;
        if (G3) { o1[r] = qv[r] * 0.17677669529663687f * __expf(bc); o2[r] = kv[r] * __expf(-bc); }
        else { o1[r] = kv[r] * __expf(bl - bc); o2[r] = 0.f; } }
#pragma unroll
    for (int r = 0; r < 8; ++r) { const int i = dir ? 63 - (seg * 8 + r) : seg * 8 + r;
        if (G3) { st_bf16(B, GB_QE + dir * 4096 + (i * 32 + d) * 2, o1[r]); st_bf16(B, GB_KE + dir * 4096 + (i * 32 + d) * 2, o2[r]); }
        else st_bf16(B, GB_KENDT + dir * (32 * KTP * 2) + (d * KTP + i) * 2, o1[r]); }
    if (!G3 && seg == 0) ((float*)(a->ws + WS_GDEC))[(((size_t)(b * 2 + dir) * NCH + c) * 4 + h) * 32 + d] = __expf(bl);
    __syncthreads();
}
__device__ __forceinline__ void gla_g1_phase(KA a, LDSP unsigned char* lds, int l, int tid, int bid, int G) {
    float* DS = (float*)(a->ws + WS_GDS);
    const int lane = tid & 63, w = tid >> 6, fr = lane & 15, fq = lane >> 4;
    for (int i = tid; i < 2 * 16 * 128; i += 512) ((LDSP float*)(lds + GB_WG))[i] = a->in[I_WGG][(size_t)l * 2 * 16 * 128 + i];
    if (tid < 256) ((LDSP float*)(lds + GB_BG))[tid] = a->in[I_BGG][l * 256 + tid];
    __syncthreads();
    GlaRegs R, Rn;
    if (bid < BATCH * NCH * 4) gla_issue<false>(a, Rn, nullptr, (bid >> 2) / NCH, (bid >> 2) % NCH, bid & 3, tid);
    for (int it = bid; it < BATCH * NCH * 4; it += G) {
        const int h = it & 3, c = (it >> 2) % NCH, b = (it >> 2) / NCH;
        R = Rn;
        gla_stage<false>(a, lds, R, l, b, c, h, tid);
        asm volatile("" ::: "memory");
        { const int itn = it + G; if (itn < BATCH * NCH * 4) gla_issue<false>(a, Rn, nullptr, (itn >> 2) / NCH, (itn >> 2) % NCH, itn & 3, tid); }
        asm volatile("" ::: "memory");
        const int dir = w >> 2, dt = (w >> 1) & 1;
        const size_t ci = ((size_t)(b * 2 + dir) * NCH + c) * 4 + h;
        gbf16x8 af[2];
#pragma unroll
        for (int sx = 0; sx < 2; ++sx) af[sx] = *(LDSP const gbf16x8*)(lds + GB_KENDT + dir * (32 * KTP * 2) + ((dt * 16 + fr) * KTP + sx * 32 + fq * 8) * 2);
#pragma unroll
        for (int t = 0; t < 2; ++t) { const int vt = (w & 1) * 2 + t; f32x4 acc = {0.f, 0.f, 0.f, 0.f};
#pragma unroll
            for (int sx = 0; sx < 2; ++sx) { const gbf16x8 bf = *(LDSP const gbf16x8*)(lds + GB_VT + ((vt * 16 + fr) * VTP + sx * 32 + fq * 8) * 2);
                acc = __builtin_amdgcn_mfma_f32_16x16x32_bf16(af[sx], bf, acc, 0, 0, 0); }
#pragma unroll
            for (int r = 0; r < 4; ++r) DS[ci * 2048 + (size_t)(dt * 16 + fq * 4 + r) * 64 + vt * 16 + fr] = acc[r]; }
        __syncthreads();
    }
}
__device__ __forceinline__ void gla_g2_phase(KA a, int tid, int bid, int G) {
    float* DS = (float*)(a->ws + WS_GDS); const float* DEC = (const float*)(a->ws + WS_GDEC);
    for (int e = bid * 512 + tid; e < BATCH * 2 * 4 * 2048; e += G * 512) {
        const int dv = e & 2047, h = (e >> 11) & 3, dir = (e >> 13) & 1, b = e >> 14, d = dv >> 6;
        float S = 0.f;
#pragma unroll 4
        for (int st = 0; st < NCH; ++st) { const int c = dir ? (st < 4 ? 3 - st : 71 - st) : st;
            const size_t ci = ((size_t)(b * 2 + dir) * NCH + c) * 4 + h;
            const float dsv = DS[ci * 2048 + dv], dec = DEC[ci * 32 + d];
            DS[ci * 2048 + dv] = S; S = dec * S + dsv; }
    }
}
__device__ __forceinline__ void gla_g3_phase(KA a, LDSP unsigned char* lds, int l, bool last, int tid, int bid, int G) {
    const bf16_t* P = (const bf16_t*)(a->ws + WS_HP); bf16_t* CAT = (bf16_t*)a->out;
    const int lane = tid & 63, w = tid >> 6, fr = lane & 15, fq = lane >> 4, it_ = w >> 1;
    for (int i = tid; i < 2 * 16 * 128; i += 512) ((LDSP float*)(lds + GB_WG))[i] = a->in[I_WGG][(size_t)l * 2 * 16 * 128 + i];
    if (tid < 256) ((LDSP float*)(lds + GB_BG))[tid] = a->in[I_BGG][l * 256 + tid];
    __syncthreads();
    const int c_lo = last ? 4 : 0, ncs = NCH - c_lo, nit = BATCH * ncs * 4;
    GlaRegs R, Rn;
    if (bid < nit) gla_issue<true>(a, Rn, a->in[I_GLAG] + (size_t)l * 256, (bid >> 2) / ncs, c_lo + (bid >> 2) % ncs, bid & 3, tid);
    for (int it = bid; it < nit; it += G) {
        const int h = it & 3, c = c_lo + (it >> 2) % ncs, b = (it >> 2) / ncs;
        R = Rn;
        gla_stage<true>(a, lds, R, l, b, c, h, tid);
        asm volatile("" ::: "memory");
        { const int itn = it + G; if (itn < nit) gla_issue<true>(a, Rn, a->in[I_GLAG] + (size_t)l * 256, (itn >> 2) / ncs, c_lo + (itn >> 2) % ncs, itn & 3, tid); }
        asm volatile("" ::: "memory");
        gbf16x8 qf[2], kf[2][2];
#pragma unroll
        for (int dir = 0; dir < 2; ++dir) { qf[dir] = *(LDSP const gbf16x8*)(lds + GB_QE + dir * 4096 + ((it_ * 16 + fr) * 32 + fq * 8) * 2);
#pragma unroll
            for (int t = 0; t < 2; ++t) kf[dir][t] = *(LDSP const gbf16x8*)(lds + GB_KE + dir * 4096 + ((((w & 1) * 2 + t) * 16 + fr) * 32 + fq * 8) * 2); }
        f32x4 s4[2][2];
#pragma unroll
        for (int dir = 0; dir < 2; ++dir)
#pragma unroll
            for (int t = 0; t < 2; ++t) { const f32x4 z = {0.f, 0.f, 0.f, 0.f}; s4[dir][t] = __builtin_amdgcn_mfma_f32_16x16x32_bf16(qf[dir], kf[dir][t], z, 0, 0, 0); }
#pragma unroll
        for (int dir = 0; dir < 2; ++dir)
#pragma unroll
            for (int t = 0; t < 2; ++t) { const int jt = (w & 1) * 2 + t;
#pragma unroll
                for (int r = 0; r < 4; ++r) { const int i = it_ * 16 + fq * 4 + r, j = jt * 16 + fr; const bool keep = dir ? (j >= i) : (j <= i);
                    st_bf16(lds, GB_ATT + dir * (64 * ATP * 2) + (i * ATP + j) * 2, keep ? s4[dir][t][r] : 0.f); } }
        __syncthreads();
        { gbf16x8 af[2][2], bfv[2][2], sf[2][2];
#pragma unroll
            for (int dir = 0; dir < 2; ++dir)
#pragma unroll
                for (int sx = 0; sx < 2; ++sx) af[dir][sx] = *(LDSP const gbf16x8*)(lds + GB_ATT + dir * (64 * ATP * 2) + ((it_ * 16 + fr) * ATP + sx * 32 + fq * 8) * 2);
#pragma unroll
            for (int t = 0; t < 2; ++t) { const int vt = (w & 1) * 2 + t;
#pragma unroll
                for (int sx = 0; sx < 2; ++sx) bfv[t][sx] = *(LDSP const gbf16x8*)(lds + GB_VT + ((vt * 16 + fr) * VTP + sx * 32 + fq * 8) * 2);
#pragma unroll
                for (int dir = 0; dir < 2; ++dir) sf[t][dir] = *(LDSP const gbf16x8*)(lds + GB_S0T + dir * 4096 + ((vt * 16 + fr) * 32 + fq * 8) * 2); }
            f32x4 acc[2];
#pragma unroll
            for (int t = 0; t < 2; ++t) { acc[t] = (f32x4){0.f, 0.f, 0.f, 0.f};
#pragma unroll
                for (int dir = 0; dir < 2; ++dir) {
#pragma unroll
                    for (int sx = 0; sx < 2; ++sx) acc[t] = __builtin_amdgcn_mfma_f32_16x16x32_bf16(af[dir][sx], bfv[t][sx], acc[t], 0, 0, 0);
                    acc[t] = __builtin_amdgcn_mfma_f32_16x16x32_bf16(qf[dir], sf[t][dir], acc[t], 0, 0, 0); } }
#pragma unroll
            for (int t = 0; t < 2; ++t) { const int vt = (w & 1) * 2 + t;
#pragma unroll
                for (int r = 0; r < 4; ++r) ((LDSP float*)(lds + GB_O))[(it_ * 16 + fq * 4 + r) * OP_ + vt * 16 + fr] = acc[t][r]; } }
        __syncthreads();
        { const int i = tid >> 3, vg = tid & 7;
            const f32x4 o0 = *(LDSP const f32x4*)(lds + GB_O + (i * OP_ + vg * 8) * 4), o1 = *(LDSP const f32x4*)(lds + GB_O + (i * OP_ + vg * 8 + 4) * 4);
            float ss = (o0.x * o0.x + o0.y * o0.y) + (o0.z * o0.z + o0.w * o0.w) + (o1.x * o1.x + o1.y * o1.y) + (o1.z * o1.z + o1.w * o1.w);
            ss = sum8(ss);
            const float rstd = 1.0f / sqrtf(ss * (1.0f / 64.0f) + EPS);
            const int row = gla_row(b, c, i);
            const float gg[8] = {R.gg[0].x, R.gg[0].y, R.gg[0].z, R.gg[0].w, R.gg[1].x, R.gg[1].y, R.gg[1].z, R.gg[1].w};
            float r[8]; unpack8(R.rg, r);
            float y[8] = {o0.x, o0.y, o0.z, o0.w, o1.x, o1.y, o1.z, o1.w};
#pragma unroll
            for (int e = 0; e < 8; ++e) y[e] = y[e] * rstd * gg[e] * (r[e] * sigm(r[e]));
            *(u32x4*)(CAT + (size_t)row * DM + 256 + h * 64 + vg * 8) = pack8(y); }
    }
}
__device__ __forceinline__ void ctx_gemm_res(KA a, LDSP unsigned char* lds, const bf16_t* A, const bf16_t* Bt, int K, const float* gate, float coef,
                                             _Float16* XR, bf16_t* XS, float* ssq, const float* gn, const float* scn, int tid, int bid, int G) {
    const int lane = tid & 63, w = tid >> 6, wm = w >> 1, wn = w & 1, fr = lane & 15, fq = lane >> 4;
    LDSP unsigned char* As = lds; LDSP unsigned char* Bs = lds + 18432; LDSP float* Cs = (LDSP float*)(lds + 32768);
    const int nk = K / 64, lr = tid >> 3, lc = (tid & 7) * 8;
    for (int u = bid; u < 256; u += G) {
        int tm = u >> 4, tn = u & 15;
        if (G == 256) { const int x = u & 7, sl = u >> 3; tm = (x & 3) * 4 + (sl >> 3); tn = (x >> 2) * 8 + (sl & 7); }
        const size_t row0 = (size_t)MX + tm * 128; const int col0 = tn * 64;
        const bf16_t* ap0 = A + (row0 + lr) * K + lc; const bf16_t* ap1 = ap0 + (size_t)64 * K; const bf16_t* bp = Bt + (size_t)(col0 + lr) * K + lc;
        u32x4 ra0[4], ra1[4], rb[4];
#pragma unroll
        for (int q = 0; q < 4; ++q) { ra0[q] = *(const u32x4*)(ap0 + q * 64); ra1[q] = *(const u32x4*)(ap1 + q * 64); rb[q] = *(const u32x4*)(bp + q * 64); }
        f32x4 acc[2][2];
#pragma unroll
        for (int mt = 0; mt < 2; ++mt)
#pragma unroll
            for (int nt = 0; nt < 2; ++nt) acc[mt][nt] = (f32x4){0.f, 0.f, 0.f, 0.f};
#pragma unroll 1
        for (int kt = 0; kt < nk; kt += 4) {
#pragma unroll
            for (int q = 0; q < 4; ++q) {
                *(LDSP u32x4*)(As + (lr * 72 + lc) * 2) = ra0[q]; *(LDSP u32x4*)(As + ((64 + lr) * 72 + lc) * 2) = ra1[q]; *(LDSP u32x4*)(Bs + (lr * 72 + lc) * 2) = rb[q];
                __syncthreads();
                if (kt + q + 4 < nk) { ra0[q] = *(const u32x4*)(ap0 + (kt + q + 4) * 64); ra1[q] = *(const u32x4*)(ap1 + (kt + q + 4) * 64); rb[q] = *(const u32x4*)(bp + (kt + q + 4) * 64); }
#pragma unroll
                for (int ks = 0; ks < 2; ++ks) { gbf16x8 af[2], bf[2];
#pragma unroll
                    for (int mt = 0; mt < 2; ++mt) af[mt] = *(LDSP const gbf16x8*)(As + ((wm * 32 + mt * 16 + fr) * 72 + ks * 32 + fq * 8) * 2);
#pragma unroll
                    for (int nt = 0; nt < 2; ++nt) bf[nt] = *(LDSP const gbf16x8*)(Bs + ((wn * 32 + nt * 16 + fr) * 72 + ks * 32 + fq * 8) * 2);
#pragma unroll
                    for (int mt = 0; mt < 2; ++mt)
#pragma unroll
                        for (int nt = 0; nt < 2; ++nt) acc[mt][nt] = __builtin_amdgcn_mfma_f32_16x16x32_bf16(af[mt], bf[nt], acc[mt][nt], 0, 0, 0); }
                __syncthreads();
            }
        }
#pragma unroll
        for (int mt = 0; mt < 2; ++mt)
#pragma unroll
            for (int nt = 0; nt < 2; ++nt)
#pragma unroll
                for (int r = 0; r < 4; ++r) Cs[(wm * 32 + mt * 16 + fq * 4 + r) * 68 + wn * 32 + nt * 16 + fr] = acc[mt][nt][r];
        __syncthreads();
        { const int rl = tid >> 2, cs = (tid & 3) * 16; const size_t grow = row0 + rl; const int gc = col0 + cs;
            float x[16];
            {
#pragma unroll
                for (int q = 0; q < 2; ++q) { const pg8::f32x8 t = __builtin_convertvector(*(const pg8::h16x8*)(XR + grow * 1024 + gc + 8 * q), pg8::f32x8);
#pragma unroll
                    for (int e = 0; e < 8; ++e) x[8 * q + e] = t[e]; } }
            const float* g = gate + (size_t)8 * 9216 + gc; const float* gnp = gn + gc; const float* scp = scn + (size_t)8 * 9216 + gc;
            float ss = 0.f, y[16];
#pragma unroll
            for (int q = 0; q < 4; ++q) { const f32x4 gv = *(const f32x4*)(g + 4 * q), cv = *(LDSP const f32x4*)(Cs + rl * 68 + cs + 4 * q), gg = *(const f32x4*)(gnp + 4 * q), sc = *(const f32x4*)(scp + 4 * q);
#pragma unroll
                for (int e = 0; e < 4; ++e) { const float xv = x[4 * q + e] + coef * gv[e] * cv[e]; x[4 * q + e] = xv; ss += xv * xv; y[4 * q + e] = xv * gg[e] * (sc[e] + 1.0f); } }
#pragma unroll
            for (int q = 0; q < 2; ++q) { const pg8::f32x8 t = {x[8 * q], x[8 * q + 1], x[8 * q + 2], x[8 * q + 3], x[8 * q + 4], x[8 * q + 5], x[8 * q + 6], x[8 * q + 7]};
                *(pg8::h16x8*)(XR + grow * 1024 + gc + 8 * q) = __builtin_convertvector(t, pg8::h16x8);
                u32x4 wv; wv.x = pk2(y[8 * q], y[8 * q + 1]); wv.y = pk2(y[8 * q + 2], y[8 * q + 3]); wv.z = pk2(y[8 * q + 4], y[8 * q + 5]); wv.w = pk2(y[8 * q + 6], y[8 * q + 7]);
                *(u32x4*)(XS + grow * 1024 + gc + 8 * q) = wv; }
            ss += swz_xor<1>(ss); ss += swz_xor<2>(ss);
            if ((tid & 3) == 0) atomicAdd(ssq + grow, ss); }
        __syncthreads();
    }
}
__device__ __forceinline__ void attn_phase(KA a, unsigned char* lds, bool last, int bid, int G) {
    using abf = attn_body::bf16;
    const abf* Q = (const abf*)(a->ws + WS_Q); const abf* Kb = (const abf*)(a->ws + WS_K); const abf* Vb = (const abf*)(a->ws + WS_V); abf* CAT = (abf*)a->out;
    const int nunits = last ? 1024 : 1088;
    const int nlat = bid < 1024 ? (1024 - bid + G - 1) / G : 0, c0 = G - 1 - bid, nctx = (nunits > 1024 && c0 < 64) ? (64 - c0 + G - 1) / G : 0;
    for (int i = 0; i < nlat + nctx; ++i) {
        const int u = (i < nlat) ? bid + i * G : 1024 + c0 + (i - nlat) * G;
        int b, h, NT; size_t qrow;
        if (u < 1024) { b = u >> 7; h = (u >> 4) & 7; qrow = (size_t)b * SEQ + (size_t)(u & 15) * 256; NT = NCH; }
        else { const int uc = u - 1024; b = uc >> 3; h = uc & 7; qrow = (size_t)MX + (size_t)b * CTXL; NT = 4; }
        const size_t kvo = (size_t)b * KVLEN * 128 + (h >> 2) * 64;
        attn_body::attn_unit<8>(Q + qrow * 512 + h * 64, Kb + kvo, Vb + kvo, CAT + qrow * DM + 512 + h * 64, NT, (char*)lds);
    }
}
#define XB_TMO      128
#define XB_XCNT(j)  (256  + 64 * (j))
#define XB_XSUB(j)  (1280 + 64 * (j))
#define XB_XGEN(j)  (2304 + 64 * (j))
#define XB_TOP      3328
#define XB_TOPGEN   3392
#define XCD_BAR_WORDS 3456
#define XB_SPIN_CAP (1u << 18)

__device__ __forceinline__ unsigned xb_ld(unsigned* p)              { return __hip_atomic_load(p, __ATOMIC_RELAXED, __HIP_MEMORY_SCOPE_AGENT); }
__device__ __forceinline__ unsigned xb_add(unsigned* p, unsigned v) { return __hip_atomic_fetch_add(p, v, __ATOMIC_RELAXED, __HIP_MEMORY_SCOPE_AGENT); }
__device__ __forceinline__ unsigned xb_xcc_id() { return (unsigned)__builtin_amdgcn_s_getreg((3 << 11) | 20) & 0xFu; }
#define XB_SPIN(cond, bar) do { unsigned _sp = 0; while (cond) { __builtin_amdgcn_s_sleep(1); \
    if ((++_sp & 255u) == 0u) { if (xb_ld(&(bar)[XB_TMO])) break; if (_sp > XB_SPIN_CAP) { atomicAdd(&(bar)[XB_TMO], 1u); break; } } } } while (0)

struct XcdBarrier {
    unsigned* bar; unsigned x;
    volatile LDSP unsigned* st;
};

__device__ __forceinline__ XcdBarrier xcd_barrier_post(unsigned* bar, volatile LDSP unsigned* st) {
    XcdBarrier b; b.bar = bar; b.x = xb_xcc_id(); b.st = st;
    if (threadIdx.x == 0) (void)xb_add(&bar[XB_XCNT(b.x)], 1u);
    return b;
}
__device__ __forceinline__ void xcd_barrier_complete(unsigned* bar, unsigned x, unsigned& nloc, unsigned& nx) {
    const unsigned G = gridDim.x * gridDim.y * gridDim.z;
    unsigned sum, cnt, mine, sp = 0u;
    for (;;) {
        sum = 0u; cnt = 0u; mine = 0u;
#pragma unroll
        for (unsigned j = 0; j < 16; ++j) { const unsigned c = xb_ld(&bar[XB_XCNT(j)]); sum += c; cnt += (c > 0u) ? 1u : 0u; mine = (j == x) ? c : mine; }
        if (sum == G) break;
        __builtin_amdgcn_s_sleep(1);
        if ((++sp & 255u) == 0u) { if (xb_ld(&bar[XB_TMO])) break; if (sp > XB_SPIN_CAP) { atomicAdd(&bar[XB_TMO], 1u); break; } }
    }
    nloc = mine > 0u ? mine : 1u; nx = cnt > 0u ? cnt : 1u;
}

__device__ __forceinline__ void xcd_barrier(const XcdBarrier& b) {
    asm volatile("s_waitcnt vmcnt(0)" ::: "memory");
    __syncthreads();
    if (threadIdx.x == 0) {
        unsigned* bar = b.bar;
        __builtin_amdgcn_s_waitcnt(0);
        unsigned nloc = b.st[0], nx = b.st[1];
        if (nloc == 0u) { xcd_barrier_complete(bar, b.x, nloc, nx); b.st[0] = nloc; b.st[1] = nx; }
        const unsigned old = xb_add(&bar[XB_XSUB(b.x)], 1u);
        const unsigned gen = old / nloc;
        if (old + 1u == (gen + 1u) * nloc) {
            __builtin_amdgcn_fence(__ATOMIC_RELEASE, "agent");
            asm volatile("s_waitcnt vmcnt(0)" ::: "memory");
            const unsigned og = xb_add(&bar[XB_TOP], 1u);
            const unsigned tg = og / nx;
            if (og + 1u == (tg + 1u) * nx) xb_add(&bar[XB_TOPGEN], 1u);
            else XB_SPIN(xb_ld(&bar[XB_TOPGEN]) == tg, bar);
            __builtin_amdgcn_fence(__ATOMIC_ACQUIRE, "agent");
            xb_add(&bar[XB_XGEN(b.x)], 1u);
            asm volatile("s_waitcnt vmcnt(0)" ::: "memory");
        } else {
            XB_SPIN(xb_ld(&bar[XB_XGEN(b.x)]) == gen, bar);
            __builtin_amdgcn_fence(__ATOMIC_ACQUIRE, "agent");
            asm volatile("s_waitcnt vmcnt(0)" ::: "memory");
        }
    }
    __syncthreads();
}
__global__ void __launch_bounds__(512, 2) mega_fwd(Args a_unused) {
    KA a = (KA)__builtin_amdgcn_kernarg_segment_ptr();
    const int ph_lo = a->ph_lo, ph_hi = a->ph_hi;
    extern __shared__ __attribute__((aligned(16))) unsigned char lds_raw[];
    LDSP unsigned char* lds0 = (LDSP unsigned char*)lds_raw;
    { LDSP unsigned char* lds = lds0;
    volatile LDSP unsigned* xst = (volatile LDSP unsigned*)(lds + 131072 + 64);
    if (threadIdx.x == 0) { xst[0] = 0u; xst[1] = 0u; }
    __syncthreads();
    if (ph_hi - ph_lo > 1) (void)xcd_barrier_post((unsigned*)(a->ws + WS_CTL), xst); }
#pragma unroll 1
    for (int ph = ph_lo; ph < ph_hi; ++ph) {
        asm volatile("" : "+s"(a));
        LDSP unsigned char* lds = lds0; asm volatile("" : "+s"(lds));
        volatile LDSP unsigned* xst = (volatile LDSP unsigned*)(lds + 131072 + 64);
        unsigned char* ws = a->ws;
        float* CTXR = (float*)(ws + WS_CTXR);
        const float* MOD = (const float*)(ws + WS_MOD);
        bf16_t* XN = (bf16_t*)(ws + WS_XN); bf16_t* CAT = (bf16_t*)a->out; bf16_t* HP = (bf16_t*)(ws + WS_HP); _Float16* XR = (_Float16*)(ws + WS_CAT);
        const int tid = opaque_tid(), lane = tid & 63, wave = __builtin_amdgcn_readfirstlane(tid >> 6);
        int G = gridDim.x, bid = blockIdx.x; asm volatile("" : "+s"(G), "+s"(bid));
        if (ph == 0) { phase0(a, lds, tid, lane, wave, bid, G); }
        else if (ph == 1) { phase1(a, lds, tid, lane, wave, bid, G); }
        else {
            const int l = (ph - 2) / NPH_LAYER, sp = (ph - 2) % NPH_LAYER; const bool last = (l == DEPTH - 1);
            const bool first = (l == 0 && sp <= 1);
            const float* srcX = first ? a->in[I_X] : a->out; const float* srcC = first ? a->in[I_CTX] : CTXR;
            const int Mtail = last ? MX : MALL;
            const float* SSQ = (const float*)(ws + WS_SSQ); const float* SW = (const float*)(ws + WS_SW);
            switch (sp) {
            case 0: case 7: { const int f = (sp == 0) ? 0 : 1, j = (sp == 0) ? 0 : 2; const int M = (sp == 0) ? MALL : Mtail;
                pg8::Gemm g{XN, (const bf16_t*)(ws + WS_W1T) + (size_t)(l * 2 + f) * W1T_SZ, M, 2 * DFF, DM}; pg8::PrefOrder S; S.init(M, 2 * DFF, G, bid);
                S.pf = lds + pg8::PF_OFF; S.ssq = SSQ + (size_t)(l * 3 + j) * MALL; S.sw = SW + (size_t)(l * 3 + j) * 9 * SWN; S.MXr = MX; S.cnt = 0;
                pg8::EpiSwiGLU E{HP, DFF, lds + pg8::PF_OFF, 0};
                pg8::gemm_phase<pg8::EpiSwiGLU, pg8::PrefOrder, true, true>(lds, g, S, E); } break;
            case 1: case 6: case 8: {
                const bf16_t* A; const bf16_t* Bt; int K, M, j; float coef;
                if (sp == 1) { A = HP; Bt = (const bf16_t*)(ws + WS_W2T) + (size_t)(l * 2 + 0) * W2T_SZ; K = DFF; M = MALL; j = 0; coef = 0.5f; }
                else if (sp == 6) { A = CAT; Bt = (const bf16_t*)(ws + WS_WOT) + (size_t)l * WOT_SZ; K = DM; M = Mtail; j = 1; coef = 1.0f; }
                else { A = HP; Bt = (const bf16_t*)(ws + WS_W2T) + (size_t)(l * 2 + 1) * W2T_SZ; K = DFF; M = Mtail; j = 2; coef = 0.5f; }
                const int ln = (j == 2) ? l + 1 : l, jn = (j == 2) ? 0 : j + 1;
                const bool has_next = ln < DEPTH; const int nidx = has_next ? (ln * 3 + jn) : 0;
                pg8::Gemm g{A, Bt, MX, DM, K}; pg8::StaticOrder S; S.init(MX, DM, G, bid);
                pg8::EpiRes E{a->out, XR, (last && sp == 8) ? 1 : 0, MOD + (size_t)l * 9 * 9216 + (3 * j + 2) * 1024, coef, MX,
                              XN, (float*)(ws + WS_SSQ) + (size_t)nidx * MALL, a->in[I_GNORM] + (size_t)nidx * DM, MOD + (size_t)(nidx / 3) * 9 * 9216 + (3 * jn + 1) * 1024, has_next ? 1 : 0};
                pg8::gemm_phase<pg8::EpiRes, pg8::StaticOrder, true, true>(lds, g, S, E);
                if (M == MALL) ctx_gemm_res(a, lds, A, Bt, K, MOD + (size_t)l * 9 * 9216 + (3 * j + 2) * 1024, coef, XR, XN, (float*)(ws + WS_SSQ) + (size_t)nidx * MALL,
                                            a->in[I_GNORM] + (size_t)nidx * DM, MOD + (size_t)(nidx / 3) * 9 * 9216 + (3 * jn + 1) * 1024, tid, bid, G); } break;
            case 2: { pg8::Gemm g{XN, (const bf16_t*)(ws + WS_WINT) + (size_t)l * WINT_SZ, MALL, INWP, DM}; pg8::PrefOrder S; S.init(MALL, INWP, G, bid);
                S.pf = lds + pg8::PF_OFF; S.ssq = SSQ + (size_t)(l * 3 + 1) * MALL; S.sw = SW + (size_t)(l * 3 + 1) * 9 * SWN; S.MXr = MX; S.cnt = 0;
                pg8::EpiStore E{HP, INWP, lds + pg8::PF_OFF, 0};
                pg8::gemm_phase<pg8::EpiStore, pg8::PrefOrder, true, true>(lds, g, S, E); } break;
            case 3: prep_phase(a, lds, l, tid, lane, wave, bid, G); gla_g1_phase(a, lds, l, tid, bid, G); break;
            case 4: gla_g2_phase(a, tid, bid, G); conv_phase(a, lds, l, last, tid, lane, bid, G); break;
            case 5: attn_phase(a, (unsigned char*)lds, last, bid, G); gla_g3_phase(a, lds, l, last, tid, bid, G); break;
            default: break;
            }
        }
        if (ph + 1 < ph_hi) {
            unsigned* barw = (unsigned*)(ws + WS_CTL);
            if (ph_hi > NPHASES + 4096) cg::this_grid().sync();
            { XcdBarrier xb; xb.bar = barw; xb.x = xb_xcc_id(); xb.st = xst; xcd_barrier(xb); }
        }
    }
}

#ifndef MK_MULTI
#define MK_MULTI 0
#endif
extern "C" void kernel_launch(void* const* d_in, const int* in_sizes, int n_in, void* d_out, int out_size, void* d_ws, size_t ws_size, hipStream_t stream) {
    static int grid = 0;
    if (grid == 0) {
        if (n_in != 20 || out_size != MX * DM || ws_size < WS_END) { fprintf(stderr, "kernel_launch: unexpected shapes (n_in %d, out %d, ws %zu); nothing launched\n", n_in, out_size, ws_size); grid = -1; return; }
        int dev = 0, cus = 0, per_cu = 0;
        if (hipGetDevice(&dev) != hipSuccess || hipDeviceGetAttribute(&cus, hipDeviceAttributeMultiprocessorCount, dev) != hipSuccess) { grid = -1; return; }
        if (hipFuncSetAttribute((const void*)mega_fwd, hipFuncAttributeMaxDynamicSharedMemorySize, LDS_BYTES) != hipSuccess) { fprintf(stderr, "kernel_launch: hipFuncSetAttribute failed\n"); grid = -1; return; }
        if (hipOccupancyMaxActiveBlocksPerMultiprocessor(&per_cu, (const void*)mega_fwd, 512, LDS_BYTES) != hipSuccess || per_cu < 1) { fprintf(stderr, "kernel_launch: occupancy query gave %d\n", per_cu); per_cu = 1; }
        (void)hipGetLastError();
        grid = cus * per_cu;
    }
    if (grid < 0) return;
    Args a{};
    for (int i = 0; i < 20; ++i) a.in[i] = (const float*)d_in[i];
    a.out = (float*)d_out; a.ws = (unsigned char*)d_ws;
#if MK_MULTI
    for (int ph = 0; ph < NPHASES; ++ph) { a.ph_lo = ph; a.ph_hi = ph + 1; hipLaunchKernelGGL(mega_fwd, dim3(grid), dim3(512), LDS_BYTES, stream, a); }
#else
    a.ph_lo = 0; a.ph_hi = NPHASES;
    if (hipMemsetAsync((char*)d_ws + WS_CTL, 0, XCD_BAR_WORDS * 4, stream) != hipSuccess) { fprintf(stderr, "kernel_launch: hipMemsetAsync of the barrier words failed\n"); return; }
    void* args[] = {&a};
    hipError_t e = hipLaunchCooperativeKernel((const void*)mega_fwd, dim3(grid), dim3(512), args, LDS_BYTES, stream);
    if (e != hipSuccess) fprintf(stderr, "kernel_launch: cooperative launch failed: %s (grid %d)\n", hipGetErrorString(e), grid);
#endif
}
```

```cpp
#include <hip/hip_runtime.h>
#include <hip/hip_cooperative_groups.h>
#include <cstdio>
#include <cstdint>
namespace cg = cooperative_groups;
__device__ __forceinline__ int opaque_tid() { int t = threadIdx.x; asm volatile("" : "+v"(t)); return t; }
namespace pg8 {
#define PG8_LAS __attribute__((address_space(3)))
typedef unsigned short bf16_t;
typedef short bf16x8 __attribute__((ext_vector_type(8)));
typedef float f32x4 __attribute__((ext_vector_type(4)));
typedef unsigned u32x4 __attribute__((ext_vector_type(4)));
constexpr int BM = 256, BK = 64, HALF = 128, HTB = HALF * BK * 2  , STAGE_BYTES = 8 * HTB, NXCD = 8, WGM = 8;

__host__ __device__ __forceinline__ int lds_byte(int r, int c) { const int st = (r >> 4) * 2 + (c >> 5), rr = r & 15, cc = c & 31, ob = rr * 64 + cc * 2; return st * 1024 + (ob ^ (((ob >> 9) & 1) << 5)); }
__host__ __device__ __forceinline__ void stage_rc(int b, int& R, int& C) { const int st = b / 1024, sb = b % 1024, swz = sb ^ (((sb >> 9) & 1) << 5); R = (st >> 1) * 16 + swz / 64; C = (st & 1) * 32 + (swz % 64) / 2; }
__host__ __device__ __forceinline__ int perm32(int rho) { const int n = rho >> 4, i = rho & 15; return 8 * (i >> 2) + 4 * n + (i & 3); }

struct Unit { int pm, pn; };
struct Gemm { const bf16_t* A; const bf16_t* Bt; int M, N, K; };

struct StaticOrder {
    int nM, nN, nwg, G, c;
    __host__ __device__ void init(int M, int N, int G_, int c_) { nM = M / BM; nN = N / BM; nwg = nM * nN; G = G_; c = c_; }
    __host__ __device__ bool next(int i, Unit& u) const {
        const long L = (long)i * G + c; if (L >= nwg) return false;
        int wgid = (int)L; { const int q = nwg / NXCD, r = nwg % NXCD, xcd = wgid % NXCD, off = wgid / NXCD; wgid = (xcd < r ? xcd * (q + 1) : r * (q + 1) + (xcd - r) * q) + off; }
        const int nig = WGM * nN, gid = wgid / nig, fm = gid * WGM, gsz = (nM - fm) < WGM ? (nM - fm) : WGM;
        u.pm = fm + ((wgid % nig) % gsz); u.pn = (wgid % nig) / gsz; return true;
    }
    __device__ __forceinline__ void a_ready(const Unit&) const {}
    __device__ __forceinline__ void done(const Unit&) const {}
};

constexpr int PF_OFF = 132096, PF_SLOT = 2048;
struct PrefOrder : StaticOrder {
    PG8_LAS unsigned char* pf; const float* ssq; const float* sw; int MXr; mutable int cnt;
    __device__ __forceinline__ void a_ready(const Unit& u) const {
        const int t = threadIdx.x, w = __builtin_amdgcn_readfirstlane(t >> 6), lane = t & 63; const int slot = cnt & 1; ++cnt;
        const int rowt = u.pm * BM, bidx = rowt >= MXr ? 8 : (rowt >> 12);
        const float* src = (w < 4) ? ssq + rowt + w * 64 + lane : sw + (size_t)bidx * 5632 + u.pn * BM + (w - 4) * 64 + lane;
        __builtin_amdgcn_global_load_lds((const unsigned*)src, (PG8_LAS unsigned*)(pf + slot * PF_SLOT + w * 256), 4, 0, 0);
    }
};
typedef float cvt_f32x2_t __attribute__((ext_vector_type(2))); typedef __bf16 cvt_bf16x2_t __attribute__((ext_vector_type(2)));
__device__ __forceinline__ unsigned cvt_pk_bf16(float lo, float hi) { const cvt_f32x2_t v = {lo, hi}; const cvt_bf16x2_t b = __builtin_convertvector(v, cvt_bf16x2_t); return __builtin_bit_cast(unsigned, b); }
typedef float f32x2 __attribute__((ext_vector_type(2)));
__device__ __forceinline__ float silu_f(float v) { return v * __builtin_amdgcn_rcpf(1.0f + __expf(-v)); }
struct EpiStore {
    static constexpr bool PERM = true, AFTER_DRAIN = false;
    bf16_t* O; int ldc; PG8_LAS unsigned char* pf; mutable int cnt;
    __device__ __forceinline__ void operator()(const f32x4 (&acc)[2][2][4][2], const Unit& u, int wr, int wc, int fr, int fq) const {
        const int rowt = u.pm * BM; PG8_LAS const float* sl = (PG8_LAS const float*)(pf + (cnt & 1) * PF_SLOT); ++cnt;
        const int row0 = rowt + wr * 64 + fr, col0 = u.pn * BM + wc * 32 + 8 * fq;
        f32x4 sv[2][2];
#pragma unroll
        for (int bj = 0; bj < 2; ++bj)
#pragma unroll
            for (int n = 0; n < 2; ++n) sv[bj][n] = *(PG8_LAS const f32x4*)(sl + 256 + wc * 32 + 8 * fq + bj * HALF + 4 * n);
        float rsv[2][4];
#pragma unroll
        for (int ai = 0; ai < 2; ++ai)
#pragma unroll
            for (int m = 0; m < 4; ++m) rsv[ai][m] = __builtin_amdgcn_rsqf(sl[wr * 64 + fr + ai * HALF + m * 16] * (1.0f / 1024.0f) + 1e-6f);
#pragma unroll
        for (int ai = 0; ai < 2; ++ai)
#pragma unroll
            for (int m = 0; m < 4; ++m) { const int row = row0 + ai * HALF + m * 16; bf16_t* rowp = O + (size_t)row * ldc + col0;
                const float rs = rsv[ai][m];
#pragma unroll
                for (int bj = 0; bj < 2; ++bj) { const f32x4 v0 = acc[ai][bj][m][0] * rs + sv[bj][0], v1 = acc[ai][bj][m][1] * rs + sv[bj][1];
                    u32x4 w; w.x = cvt_pk_bf16(v0[0], v0[1]); w.y = cvt_pk_bf16(v0[2], v0[3]); w.z = cvt_pk_bf16(v1[0], v1[1]); w.w = cvt_pk_bf16(v1[2], v1[3]);
                    *(u32x4*)(rowp + bj * HALF) = w; } }
    }
};
struct EpiSwiGLU {
    static constexpr bool PERM = true, AFTER_DRAIN = false;
    bf16_t* O; int ldc; PG8_LAS unsigned char* pf; mutable int cnt;
    __device__ __forceinline__ void operator()(const f32x4 (&acc)[2][2][4][2], const Unit& u, int wr, int wc, int fr, int fq) const {
        const int rowt = u.pm * BM; PG8_LAS const float* sl = (PG8_LAS const float*)(pf + (cnt & 1) * PF_SLOT); ++cnt;
        const int row0 = rowt + wr * 64 + fr, col0 = u.pn * HALF + wc * 32 + 8 * fq;
        f32x4 sv[2][2];
#pragma unroll
        for (int bj = 0; bj < 2; ++bj)
#pragma unroll
            for (int n = 0; n < 2; ++n) sv[bj][n] = *(PG8_LAS const f32x4*)(sl + 256 + wc * 32 + 8 * fq + bj * HALF + 4 * n);
        float rsv[2][4];
#pragma unroll
        for (int ai = 0; ai < 2; ++ai)
#pragma unroll
            for (int m = 0; m < 4; ++m) rsv[ai][m] = __builtin_amdgcn_rsqf(sl[wr * 64 + fr + ai * HALF + m * 16] * (1.0f / 1024.0f) + 1e-6f);
#pragma unroll
        for (int ai = 0; ai < 2; ++ai)
#pragma unroll
            for (int m = 0; m < 4; ++m) { const int row = row0 + ai * HALF + m * 16; bf16_t* rowp = O + (size_t)row * ldc + col0;
                const float rs = rsv[ai][m];
                const f32x4 a0 = acc[ai][0][m][0] * rs + sv[0][0], a1 = acc[ai][0][m][1] * rs + sv[0][1], u0 = acc[ai][1][m][0] * rs + sv[1][0], u1 = acc[ai][1][m][1] * rs + sv[1][1];
                u32x4 w; w.x = cvt_pk_bf16(silu_f(a0[0]) * u0[0], silu_f(a0[1]) * u0[1]); w.y = cvt_pk_bf16(silu_f(a0[2]) * u0[2], silu_f(a0[3]) * u0[3]);
                w.z = cvt_pk_bf16(silu_f(a1[0]) * u1[0], silu_f(a1[1]) * u1[1]); w.w = cvt_pk_bf16(silu_f(a1[2]) * u1[2], silu_f(a1[3]) * u1[3]);
                *(u32x4*)rowp = w; }
    }
};
typedef _Float16 h16x8 __attribute__((ext_vector_type(8)));
typedef float f32x8 __attribute__((ext_vector_type(8)));
struct EpiRes {
    static constexpr bool PERM = true, AFTER_DRAIN = false;
    float* outF; _Float16* XR; int dstf32; const float* gate; float coef; int MXr;
    bf16_t* XSp; float* ssq; const float* gn; const float* scn; int doxs;
    __device__ __forceinline__ void operator()(const f32x4 (&acc)[2][2][4][2], const Unit& u, int wr, int wc, int fr, int fq) const {
        const int rowt = u.pm * BM; const bool isc = rowt >= MXr; const bool XS = doxs != 0;
        const int bidx = isc ? 8 : (rowt >> 12);
        char* outb = (char*)(outF + (size_t)rowt * 1024);
        char* xrb = (char*)(XR + (size_t)rowt * 1024);
        char* xsb = (char*)(XSp + (size_t)rowt * 1024); float* sqb = ssq + rowt;
        const int col0 = u.pn * BM + wc * 32 + 8 * fq;
        const float* g = gate + (size_t)bidx * 9216 + col0;
        const unsigned lo = (unsigned)((wr * 64 + fr) * 1024 + col0);
        float ss[2][4];
#pragma unroll
        for (int ai = 0; ai < 2; ++ai)
#pragma unroll
            for (int m = 0; m < 4; ++m) ss[ai][m] = 0.f;
#pragma unroll
        for (int bj = 0; bj < 2; ++bj) {
            u32x4 xin[2][4];
#pragma unroll
            for (int ai = 0; ai < 2; ++ai)
#pragma unroll
                for (int m = 0; m < 4; ++m) xin[ai][m] = *(const u32x4*)(xrb + (lo + (unsigned)((ai * HALF + m * 16) * 1024 + bj * HALF)) * 2u);
            f32x4 gv[2], gs[2];
#pragma unroll
            for (int n = 0; n < 2; ++n) { gv[n] = *(const f32x4*)(g + bj * HALF + 4 * n) * coef;
                if (XS) gs[n] = *(const f32x4*)(gn + col0 + bj * HALF + 4 * n) * (*(const f32x4*)(scn + (size_t)bidx * 9216 + col0 + bj * HALF + 4 * n) + 1.0f); }
#pragma unroll
            for (int ai = 0; ai < 2; ++ai)
#pragma unroll
                for (int m = 0; m < 4; ++m) { const unsigned eo = lo + (unsigned)((ai * HALF + m * 16) * 1024 + bj * HALF); f32x4 xv[2];
                    { const f32x8 t = __builtin_convertvector(__builtin_bit_cast(h16x8, xin[ai][m]), f32x8); xv[0] = (f32x4){t[0], t[1], t[2], t[3]}; xv[1] = (f32x4){t[4], t[5], t[6], t[7]}; }
                    xv[0] += gv[0] * acc[ai][bj][m][0]; xv[1] += gv[1] * acc[ai][bj][m][1];
                    if (dstf32) { *(f32x4*)(outb + eo * 4u) = xv[0]; *(f32x4*)(outb + eo * 4u + 16u) = xv[1]; }
                    else { const f32x8 t = {xv[0][0], xv[0][1], xv[0][2], xv[0][3], xv[1][0], xv[1][1], xv[1][2], xv[1][3]}; *(h16x8*)(xrb + eo * 2u) = __builtin_convertvector(t, h16x8); }
                    if (XS) { ss[ai][m] += (xv[0][0] * xv[0][0] + xv[0][1] * xv[0][1]) + (xv[0][2] * xv[0][2] + xv[0][3] * xv[0][3]) + (xv[1][0] * xv[1][0] + xv[1][1] * xv[1][1]) + (xv[1][2] * xv[1][2] + xv[1][3] * xv[1][3]);
                        const f32x4 y0 = xv[0] * gs[0], y1 = xv[1] * gs[1];
                        u32x4 w; w.x = cvt_pk_bf16(y0[0], y0[1]); w.y = cvt_pk_bf16(y0[2], y0[3]); w.z = cvt_pk_bf16(y1[0], y1[1]); w.w = cvt_pk_bf16(y1[2], y1[3]);
                        *(u32x4*)(xsb + eo * 2u) = w; } }
        }
        if (XS) {
#pragma unroll
            for (int ai = 0; ai < 2; ++ai)
#pragma unroll
                for (int m = 0; m < 4; ++m) { float t = ss[ai][m];
                    t += __int_as_float(__builtin_amdgcn_ds_swizzle(__float_as_int(t), 0x1f | (16 << 10)));
                    auto rr = __builtin_amdgcn_permlane32_swap(__float_as_uint(t), __float_as_uint(t), false, false);
                    t = __uint_as_float(rr[0]) + __uint_as_float(rr[1]);
                    if (fq == 0) atomicAdd(sqb + (unsigned)(wr * 64 + fr + ai * HALF + m * 16), t); } }
    }
};
template <class Epi, class Sched, bool ALIGN_EPI = false, bool SP2 = false>
__device__ __forceinline__ void gemm_phase(PG8_LAS unsigned char* lds, const Gemm g, const Sched& S, const Epi& E) {
    const int tid = opaque_tid(), wid = __builtin_amdgcn_readfirstlane(tid >> 6), lane = tid & 63, wr = wid >> 2, wc = wid & 3, fr = lane & 15, fq = lane >> 4;
    const int K = g.K, nt = K / BK;
    unsigned voffA[2], voffB[2];
#pragma unroll
    for (int i = 0; i < 2; ++i) { int R, C; stage_rc(tid * 16 + i * 8192, R, C); const int Rb = Epi::PERM ? ((R & ~31) + perm32(R & 31)) : R;
        voffA[i] = (unsigned)(R * K + C) * 2u; voffB[i] = (unsigned)(Rb * K + C) * 2u; }
    const size_t kstep = (size_t)(BK * 2);
    const size_t hstep = (size_t)HALF * K * 2;
    const size_t tstep = 2 * hstep;
    const unsigned ldsw = (unsigned)wid * 1024u;
    const int aoff = lds_byte(wr * 64 + fr, fq * 8), boff = lds_byte(wc * 32 + fr, fq * 8);
#define PG8_SA(b, h) (((b) * 2 + (h)) * HTB)
#define PG8_SB(b, h) ((4 + (b) * 2 + (h)) * HTB)
#define PG8_STAGE(bufoff, gbase, voff) do { _Pragma("unroll") for (int _i = 0; _i < 2; ++_i) \
        __builtin_amdgcn_global_load_lds((const unsigned*)((const char*)(gbase) + (voff)[_i]), (PG8_LAS unsigned*)(lds + (bufoff) + ldsw + _i * 8192), 16, 0, 0); } while (0)
#define PG8_LDA(dst, b, h) do { _Pragma("unroll") for (int m = 0; m < 4; ++m) _Pragma("unroll") for (int k = 0; k < 2; ++k) dst[m][k] = *(const PG8_LAS bf16x8*)(lds + PG8_SA(b, h) + aoff + m * 2048 + k * 1024); } while (0)
#define PG8_LDB(dst, b, h) do { _Pragma("unroll") for (int n = 0; n < 2; ++n) _Pragma("unroll") for (int k = 0; k < 2; ++k) dst[n][k] = *(const PG8_LAS bf16x8*)(lds + PG8_SB(b, h) + boff + n * 2048 + k * 1024); } while (0)
#define PG8_MMA(ai, bj, At, Bt) do { __builtin_amdgcn_s_setprio(1); _Pragma("unroll") for (int m = 0; m < 4; ++m) _Pragma("unroll") for (int n = 0; n < 2; ++n) _Pragma("unroll") for (int k = 0; k < 2; ++k) \
        acc[ai][bj][m][n] = __builtin_amdgcn_mfma_f32_16x16x32_bf16(Bt[n][k], At[m][k], acc[ai][bj][m][n], 0, 0, 0); __builtin_amdgcn_s_setprio(0); } while (0)
#define PG8_WAIT_V(n) asm volatile("s_waitcnt vmcnt(" #n ")" ::: "memory")
#define PG8_WAIT_L(n) asm volatile("s_waitcnt lgkmcnt(" #n ")" ::: "memory")
#define PG8_BAR __builtin_amdgcn_s_barrier()
#define PG8_SCHED __builtin_amdgcn_sched_barrier(0)
    Unit cur, nxt; int ui = 0;
    if (!S.next(0, cur)) return;
    f32x4 acc[2][2][4][2];
#pragma unroll
    for (int a = 0; a < 2; ++a)
#pragma unroll
        for (int b = 0; b < 2; ++b)
#pragma unroll
            for (int m = 0; m < 4; ++m)
#pragma unroll
                for (int n = 0; n < 2; ++n) acc[a][b][m][n] = (f32x4){0.f, 0.f, 0.f, 0.f};
    bf16x8 At[4][2], B0[2][2], B1[2][2];
    const char* cA = (const char*)g.A + (size_t)cur.pm * tstep; const char* cB = (const char*)g.Bt + (size_t)cur.pn * tstep;
    S.a_ready(cur);
    if constexpr (SP2) {
        PG8_STAGE(PG8_SB(0, 0), cB, voffB); PG8_STAGE(PG8_SB(0, 1), cB + hstep, voffB); PG8_STAGE(PG8_SA(0, 0), cA, voffA); PG8_STAGE(PG8_SA(0, 1), cA + hstep, voffA);
        if (wr == 1) PG8_BAR;
        PG8_WAIT_V(2); PG8_BAR;
        PG8_STAGE(PG8_SB(1, 0), cB + kstep, voffB); PG8_STAGE(PG8_SA(1, 0), cA + kstep, voffA); PG8_STAGE(PG8_SB(1, 1), cB + hstep + kstep, voffB);
        PG8_WAIT_V(6); PG8_BAR;
    } else {
        PG8_STAGE(PG8_SB(0, 0), cB, voffB); PG8_STAGE(PG8_SA(0, 0), cA, voffA); PG8_STAGE(PG8_SB(0, 1), cB + hstep, voffB); PG8_STAGE(PG8_SA(0, 1), cA + hstep, voffA);
        if (wr == 1) PG8_BAR;
        PG8_WAIT_V(4); PG8_BAR;
        PG8_STAGE(PG8_SB(1, 0), cB + kstep, voffB); PG8_STAGE(PG8_SA(1, 0), cA + kstep, voffA); PG8_STAGE(PG8_SB(1, 1), cB + hstep + kstep, voffB);
        PG8_WAIT_V(6); PG8_BAR;
    }
    for (;;) {
        const bool has_next = S.next(ui + 1, nxt);
        const char* nA = has_next ? (const char*)g.A + (size_t)nxt.pm * tstep : cA; const char* nB = has_next ? (const char*)g.Bt + (size_t)nxt.pn * tstep : cB;
        for (int t = 0; t < nt; t += 2) {
            const bool last = (t == nt - 2);
            const char* a1 = cA + (size_t)(t + 1) * kstep;
            const char* a2 = last ? nA : cA + (size_t)(t + 2) * kstep; const char* b2 = last ? nB : cB + (size_t)(t + 2) * kstep;
            const char* a3 = a2 + kstep; const char* b3 = b2 + kstep;
            if (last && has_next) S.a_ready(nxt);
            if constexpr (SP2) {
            PG8_LDB(B0, 0, 0); PG8_LDB(B1, 0, 1); PG8_SCHED; PG8_LDA(At, 0, 0); PG8_STAGE(PG8_SA(1, 1), a1 + hstep, voffA);
            PG8_WAIT_V(8); PG8_WAIT_L(0); PG8_BAR; PG8_MMA(0, 0, At, B0); PG8_MMA(0, 1, At, B1); PG8_BAR; PG8_SCHED;
            PG8_LDA(At, 0, 1); PG8_STAGE(PG8_SB(0, 0), b2, voffB); PG8_STAGE(PG8_SB(0, 1), b2 + hstep, voffB); PG8_STAGE(PG8_SA(0, 0), a2, voffA);
            PG8_WAIT_V(8); PG8_WAIT_L(0); PG8_BAR; PG8_MMA(1, 0, At, B0); PG8_MMA(1, 1, At, B1); PG8_BAR; PG8_SCHED;
            PG8_LDB(B0, 1, 0); PG8_LDB(B1, 1, 1); PG8_SCHED; PG8_LDA(At, 1, 0); PG8_STAGE(PG8_SA(0, 1), a2 + hstep, voffA);
            PG8_WAIT_V(8); PG8_WAIT_L(0); PG8_BAR; PG8_MMA(0, 0, At, B0); PG8_MMA(0, 1, At, B1); PG8_BAR; PG8_SCHED;
            PG8_LDA(At, 1, 1); PG8_STAGE(PG8_SB(1, 0), b3, voffB); PG8_STAGE(PG8_SB(1, 1), b3 + hstep, voffB); PG8_STAGE(PG8_SA(1, 0), a3, voffA);
            PG8_WAIT_V(8); PG8_WAIT_L(0); PG8_BAR; PG8_MMA(1, 0, At, B0); PG8_MMA(1, 1, At, B1); PG8_BAR; PG8_SCHED;
            } else {
            PG8_LDB(B0, 0, 0); PG8_SCHED; PG8_LDA(At, 0, 0); PG8_STAGE(PG8_SA(1, 1), a1 + hstep, voffA);
            PG8_WAIT_L(8); PG8_BAR; PG8_WAIT_L(0); PG8_MMA(0, 0, At, B0); PG8_BAR; PG8_SCHED;
            PG8_LDB(B1, 0, 1); PG8_STAGE(PG8_SB(0, 0), b2, voffB);
            PG8_BAR; PG8_WAIT_L(0); PG8_MMA(0, 1, At, B1); PG8_BAR;
            PG8_LDA(At, 0, 1); PG8_STAGE(PG8_SA(0, 0), a2, voffA);
            PG8_BAR; PG8_WAIT_L(0); PG8_MMA(1, 0, At, B0); PG8_BAR; PG8_SCHED;
            PG8_STAGE(PG8_SB(0, 1), b2 + hstep, voffB);
            PG8_WAIT_V(6); PG8_BAR; PG8_MMA(1, 1, At, B1); PG8_BAR;
            PG8_LDB(B0, 1, 0); PG8_SCHED; PG8_LDA(At, 1, 0); PG8_STAGE(PG8_SA(0, 1), a2 + hstep, voffA);
            PG8_WAIT_L(8); PG8_BAR; PG8_WAIT_L(0); PG8_MMA(0, 0, At, B0); PG8_BAR; PG8_SCHED;
            PG8_LDB(B1, 1, 1); PG8_STAGE(PG8_SB(1, 0), b3, voffB);
            PG8_BAR; PG8_WAIT_L(0); PG8_MMA(0, 1, At, B1); PG8_BAR;
            PG8_LDA(At, 1, 1); PG8_STAGE(PG8_SA(1, 0), a3, voffA);
            PG8_BAR; PG8_WAIT_L(0); PG8_MMA(1, 0, At, B0); PG8_BAR; PG8_SCHED;
            PG8_STAGE(PG8_SB(1, 1), b3 + hstep, voffB);
            PG8_WAIT_V(6); PG8_BAR; PG8_MMA(1, 1, At, B1); PG8_BAR;
            }
        }
        if constexpr (ALIGN_EPI) { if (wr == 0) PG8_BAR; }
        if constexpr (!Epi::AFTER_DRAIN) { E(acc, cur, wr, wc, fr, fq); S.done(cur); }
        if (!has_next) break;
#pragma unroll
        for (int a = 0; a < 2; ++a)
#pragma unroll
            for (int b = 0; b < 2; ++b)
#pragma unroll
                for (int m = 0; m < 4; ++m)
#pragma unroll
                    for (int n = 0; n < 2; ++n) acc[a][b][m][n] = (f32x4){0.f, 0.f, 0.f, 0.f};
        cur = nxt; cA = nA; cB = nB; ++ui;
        if constexpr (ALIGN_EPI) { if (wr == 1) PG8_BAR; }
    }
    PG8_WAIT_V(0);
    if constexpr (!ALIGN_EPI) { if (wr == 0) PG8_BAR; }
    PG8_BAR;
    if constexpr (Epi::AFTER_DRAIN) { E.fused(acc, cur, wr, wc, fr, fq, lds, wid, lane); S.done(cur); }
#undef PG8_SA
#undef PG8_SB
#undef PG8_STAGE
#undef PG8_LDA
#undef PG8_LDB
#undef PG8_MMA
#undef PG8_WAIT_V
#undef PG8_WAIT_L
#undef PG8_BAR
#undef PG8_SCHED
}
}
#include <hip/hip_bf16.h>
#include <cmath>
namespace attn_body {
using bf16=__hip_bfloat16;
using bf16x8=__attribute__((ext_vector_type(8)))short;
using s16x4=__attribute__((ext_vector_type(4)))short;
using f32x16=__attribute__((ext_vector_type(16)))float;
using u32x4=__attribute__((ext_vector_type(4)))unsigned;
constexpr int D=64,QP=512,KP=128,OP=1024;
constexpr int NW=8,QBLK=32,QB=QBLK*NW,KVBLK=64;
constexpr int ATTN_UNIT_ROWS=QB;
__device__ __forceinline__ int crow(int r,int hi){return (r&3)+8*(r>>2)+4*hi;}
#define SBAR() __builtin_amdgcn_sched_barrier(0)
__device__ __forceinline__ void cmask(f32x16&p0,f32x16&p1,int jb,int qrel,int hi){
  const float NEG=-INFINITY; int kb=64*jb+4*hi;
  #pragma unroll
  for(int r=0;r<16;++r){int kv=kb+(r&3)+8*(r>>2); if(kv>qrel)p0[r]=NEG; if(kv+32>qrel)p1[r]=NEG;}
}

constexpr int NSLOT=3, SLOTB=8192;
constexpr int LDS_K=0, LDS_V=NSLOT*SLOTB, LDS_WS=2*NSLOT*SLOTB, LDS_OST=LDS_WS+NW*64*4, LDS_BYTES=LDS_OST+NW*4096;
constexpr float C2=0.125f*1.4426950408889634f;
__device__ __forceinline__ void glds16(const void*gsrc,unsigned lds_dst){unsigned keep;
  asm volatile("s_mov_b32 %0, m0\n\ts_mov_b32 m0, %2\n\ts_nop 0\n\tglobal_load_lds_dwordx4 %1, off\n\ts_mov_b32 m0, %0":"=&s"(keep):"v"(gsrc),"s"(lds_dst):"memory");}
__device__ __forceinline__ float max3f(float a,float b,float c){float r;asm("v_max3_f32 %0, %1, %2, %3":"=v"(r):"v"(a),"v"(b),"v"(c));return r;}
__device__ __forceinline__ float max2f(float a,float b){float r;asm("v_max_f32_e32 %0, %1, %2":"=v"(r):"v"(a),"v"(b));return r;}
__device__ __forceinline__ float fadd_s(float a,float b){float r;asm("v_add_f32_e32 %0, %1, %2":"=v"(r):"v"(a),"v"(b));return r;}
__device__ __forceinline__ float fsub_s(float a,float b){float r;asm("v_sub_f32_e32 %0, %1, %2":"=v"(r):"v"(a),"v"(b));return r;}
typedef float f32x2_t __attribute__((ext_vector_type(2))); typedef __bf16 bf16x2_t __attribute__((ext_vector_type(2)));
__device__ __forceinline__ unsigned cvtpk_s(float lo,float hi){f32x2_t v={lo,hi};bf16x2_t b=__builtin_convertvector(v,bf16x2_t);return __builtin_bit_cast(unsigned,b);}
#define WAIT_BAR(N) asm volatile("s_waitcnt vmcnt(" #N ") lgkmcnt(0)\n\ts_barrier":::"memory")

__device__ __forceinline__ void qkt(f32x16&p0,f32x16&p1,const char*Kslot,const bf16x8*qr,const f32x16&negm,int r32,int hi){
  const char*kb=Kslot+hi*1024+r32*16;
  #pragma unroll
  for(int d0=0;d0<4;++d0){
    const bf16x8 b0=*reinterpret_cast<const bf16x8*>(kb+d0*2048);
    const bf16x8 b1=*reinterpret_cast<const bf16x8*>(kb+d0*2048+512);
    if(d0==0){p0=__builtin_amdgcn_mfma_f32_32x32x16_bf16(b0,qr[0],negm,0,0,0);p1=__builtin_amdgcn_mfma_f32_32x32x16_bf16(b1,qr[0],negm,0,0,0);}
    else{p0=__builtin_amdgcn_mfma_f32_32x32x16_bf16(b0,qr[d0],p0,0,0,0);p1=__builtin_amdgcn_mfma_f32_32x32x16_bf16(b1,qr[d0],p1,0,0,0);}}
}
typedef __attribute__((address_space(3))) const char* lds_cptr;
typedef short v4i16_t __attribute__((ext_vector_type(4)));
__device__ __forceinline__ void kload8(bf16x8*kf,lds_cptr kp){
  kf[0]=*(const __attribute__((address_space(3))) bf16x8*)(kp);      kf[1]=*(const __attribute__((address_space(3))) bf16x8*)(kp+512);
  kf[2]=*(const __attribute__((address_space(3))) bf16x8*)(kp+2048); kf[3]=*(const __attribute__((address_space(3))) bf16x8*)(kp+2560);
  kf[4]=*(const __attribute__((address_space(3))) bf16x8*)(kp+4096); kf[5]=*(const __attribute__((address_space(3))) bf16x8*)(kp+4608);
  kf[6]=*(const __attribute__((address_space(3))) bf16x8*)(kp+6144); kf[7]=*(const __attribute__((address_space(3))) bf16x8*)(kp+6656);
}
__device__ __forceinline__ void kload2(bf16x8*kf,lds_cptr kp,int j){ kf[2*j]=*(const __attribute__((address_space(3))) bf16x8*)(kp+j*2048); kf[2*j+1]=*(const __attribute__((address_space(3))) bf16x8*)(kp+j*2048+512); }
__device__ __forceinline__ s16x4 vtr(lds_cptr p){ return __builtin_bit_cast(s16x4,__builtin_amdgcn_ds_read_tr16_b64_v4i16((__attribute__((address_space(3))) v4i16_t*)p)); }
__device__ __forceinline__ float rowmax(const f32x16&p0,const f32x16&p1){
  float a=max3f(p0[0],p0[1],p1[0]),b=max3f(p0[2],p0[3],p1[1]);a=max3f(a,p1[2],p1[3]);
  #pragma unroll
  for(int r=4;r<16;r+=4){a=max3f(a,p0[r],p0[r+1]);b=max3f(b,p0[r+2],p0[r+3]);a=max3f(a,p1[r],p1[r+1]);b=max3f(b,p1[r+2],p1[r+3]);}
  const float m=max2f(a,b);
  auto rr=__builtin_amdgcn_permlane32_swap(__float_as_uint(m),__float_as_uint(m),false,false);
  return max2f(__uint_as_float(rr[0]),__uint_as_float(rr[1]));
}
__device__ __forceinline__ void pv(f32x16*o,int vb,bf16x8 pa0,bf16x8 pa1,bf16x8 pa2,bf16x8 pa3){
  #pragma unroll
  for(int d0=0;d0<2;++d0){s16x4 lo[4],hi[4];
    #pragma unroll
    for(int ks=0;ks<4;++ks){
      asm volatile("ds_read_b64_tr_b16 %0,%1 offset:%c2":"=&v"(lo[ks]):"v"(vb),"i"(d0*4096+ks*1024):"memory");
      asm volatile("ds_read_b64_tr_b16 %0,%1 offset:%c2":"=&v"(hi[ks]):"v"(vb),"i"(d0*4096+ks*1024+512):"memory");}
    asm volatile("s_waitcnt lgkmcnt(0)":::"memory");SBAR();
    #define PK(k) (bf16x8){lo[k][0],lo[k][1],lo[k][2],lo[k][3],hi[k][0],hi[k][1],hi[k][2],hi[k][3]}
    o[d0]=__builtin_amdgcn_mfma_f32_32x32x16_bf16(pa0,PK(0),o[d0],0,0,0);
    o[d0]=__builtin_amdgcn_mfma_f32_32x32x16_bf16(pa1,PK(1),o[d0],0,0,0);
    o[d0]=__builtin_amdgcn_mfma_f32_32x32x16_bf16(pa2,PK(2),o[d0],0,0,0);
    o[d0]=__builtin_amdgcn_mfma_f32_32x32x16_bf16(pa3,PK(3),o[d0],0,0,0);
    #undef PK
  }
}

#ifndef ATTN_STORE16
#define ATTN_STORE16(p,v) (*(u32x4*)(p)=(v))
#endif
template<int THRL> __device__ __forceinline__ void attn_unit(const bf16*Q0,const bf16*__restrict__ Kh,const bf16*__restrict__ Vh,bf16*O0,const int NT,char*shm){
  const int tid=opaque_tid(),lane=tid&63,r32=lane&31,hi=lane>>5; const int wid=__builtin_amdgcn_readfirstlane(tid>>6);
  const bf16*Qw=Q0+(long)(wid*QBLK)*QP;
  const unsigned lds0=(unsigned)(uintptr_t)shm;
  float*wsf=(float*)(shm+LDS_WS)+wid*64;
  const bf16*ksrc=Kh+(long)lane*KP+wid*8;
  const bf16*vsrc=Vh+(long)(16*(wid&3)+(lane>>2))*KP+(wid>>2)*32+(lane&3)*8;
  const unsigned kdst=lds0+LDS_K+wid*1024, vdst=lds0+LDS_V+wid*1024;
  #define DMA_K(t,slot) glds16(ksrc+(long)(t)*KVBLK*KP,(unsigned)__builtin_amdgcn_readfirstlane(kdst+(slot)))
  #define DMA_V(t,slot) glds16(vsrc+(long)(t)*KVBLK*KP,(unsigned)__builtin_amdgcn_readfirstlane(vdst+(slot)))
  const int vb0=(int)(lds0+LDS_V)+((lane>>4)&1)*32+(lane&3)*8+(4*hi+((lane&15)>>2))*64;
  const char*Kbase=shm+LDS_K; bf16x8 kf[8];
  const lds_cptr shm3=(lds_cptr)shm; const lds_cptr kp0=shm3+LDS_K+hi*1024+r32*16; const lds_cptr vp0=shm3+LDS_V+((lane>>4)&1)*32+(lane&3)*8+(4*hi+((lane&15)>>2))*64;
  DMA_K(0,0);DMA_V(0,0);DMA_K(1,SLOTB);
  bf16x8 qr[4];
  #pragma unroll
  for(int d0=0;d0<4;++d0)qr[d0]=*reinterpret_cast<const bf16x8*>(&Qw[(long)r32*QP+d0*16+hi*8]);
  float mhat=0.f,l_reg=0.f;f32x16 o[2];o[0]=f32x16{};o[1]=f32x16{};f32x16 negm=f32x16{};asm volatile("":"+v"(negm));
  #define CMASK(P0,P1,t) do{}while(0)
  bool resc=false;
  #define START(P0,P1) do{ const float rm=rowmax(P0,P1); resc=false; \
    { const float dl=rm; mhat=fadd_s(mhat,dl); \
      _Pragma("unroll") for(int r=0;r<16;++r){P0[r]=fsub_s(P0[r],dl);P1[r]=fsub_s(P1[r],dl);} \
      _Pragma("unroll") for(int r=0;r<16;++r)negm[r]=-mhat; asm volatile("":"+v"(negm)); } \
    _Pragma("unroll") for(int r=0;r<16;++r)P0[r]=__builtin_amdgcn_exp2f(P0[r]); }while(0)
  #define RESC() do{ if(resc){ asm volatile("s_waitcnt lgkmcnt(0)":::"memory"); \
      _Pragma("unroll") for(int d_=0;d_<2;++d_) _Pragma("unroll") for(int r=0;r<16;++r)o[d_][r]*=wsf[crow(r,hi)]; } }while(0)
  f32x16 pA0,pA1,pB0,pB1;
  int sl_prev=0,sl_cur=0,sl_next=SLOTB;
  #define ROT() do{sl_prev=sl_cur;sl_cur=sl_next;sl_next=(sl_next==(NSLOT-1)*SLOTB)?0:sl_next+SLOTB;}while(0)
  DMA_K(2,2*SLOTB);
  WAIT_BAR(3);
  qkt(pA0,pA1,Kbase,qr,negm,r32,hi);asm volatile("s_nop 15\n\ts_nop 7":"+v"(pA0),"+v"(pA1));CMASK(pA0,pA1,0);
  START(pA0,pA1);
  _Pragma("unroll") for(int r=0;r<16;++r)pA1[r]=__builtin_amdgcn_exp2f(pA1[r]);
  WAIT_BAR(0);
  DMA_K(3,0);DMA_V(1,SLOTB);
  ROT();
  kload8(kf,kp0+sl_cur);
  WAIT_BAR(2);
  s16x4 vlo[8],vhi[8]; u32x4 pw0,pw1,pw2,pw3;
  #define PKW(P,B) cvtpk_s(P[B],P[B+1])
  #define PAF(k) __builtin_bit_cast(bf16x8,pw##k)
  #define VFR(i) (bf16x8){vlo[i][0],vlo[i][1],vlo[i][2],vlo[i][3],vhi[i][0],vhi[i][1],vhi[i][2],vhi[i][3]}
  #define PIN(x) asm volatile("":"+v"(x))
  #define MX3(a,b,c) __builtin_fmaxf(__builtin_fmaxf((a),(b)),(c))
  #define GAPA(MF,A0,A1,A2,A3,W0,W1,PW) do{ MF; sacc+=A0; sacc+=A1; sacc+=A2; sacc+=A3; PIN(sacc); W0; W1; PIN(PW); SBAR(); }while(0)
  #define EX(v) __builtin_amdgcn_exp2f(v)
  #define GAPB(MF,X,B) do{ MF; X[B]=EX(X[B]); X[B+1]=EX(X[B+1]); X[B+2]=EX(X[B+2]); X[B+3]=EX(X[B+3]); PIN(X); SBAR(); }while(0)
  #define VRD(i) do{ vlo[i]=vtr(vp_+(((i)>>2)*4096+((i)&3)*1024)); vhi[i]=vtr(vp_+(((i)>>2)*4096+((i)&3)*1024+512)); }while(0)
  #define KRD(G,j) do{ if(G){ kload2(kf,kp0+sl_next,j); SBAR(); } }while(0)
  #define STEP(C0,C1,P0,P1,t,GK,GV,GL) do{ SBAR(); \
    const lds_cptr vp_=vp0+sl_prev; \
    VRD(0); SBAR(); float sacc=(P0[0]+P0[1]); \
    GAPA(C0=__builtin_amdgcn_mfma_f32_32x32x16_bf16(kf[0],qr[0],negm,0,0,0), P0[2],P0[3],P0[4],P0[5],     pw0[0]=PKW(P0,0), pw0[1]=PKW(P0,2), pw0); \
    VRD(4); SBAR(); GAPA(C1=__builtin_amdgcn_mfma_f32_32x32x16_bf16(kf[1],qr[0],negm,0,0,0), P0[6],P0[7],P0[8],P0[9],     pw0[2]=PKW(P0,4), pw0[3]=PKW(P0,6), pw0); \
    VRD(1); SBAR(); GAPA(C0=__builtin_amdgcn_mfma_f32_32x32x16_bf16(kf[2],qr[1],C0,0,0,0),   P0[10],P0[11],P0[12],P0[13], pw1[0]=PKW(P0,8), pw1[1]=PKW(P0,10), pw1); \
    VRD(5); SBAR(); GAPA(C1=__builtin_amdgcn_mfma_f32_32x32x16_bf16(kf[3],qr[1],C1,0,0,0),   P0[14],P0[15],P1[0],P1[1],   pw1[2]=PKW(P0,12),pw1[3]=PKW(P0,14), pw1); \
    VRD(2); SBAR(); GAPA(C0=__builtin_amdgcn_mfma_f32_32x32x16_bf16(kf[4],qr[2],C0,0,0,0),   P1[2],P1[3],P1[4],P1[5],     pw2[0]=PKW(P1,0), pw2[1]=PKW(P1,2), pw2); \
    VRD(6); SBAR(); GAPA(C1=__builtin_amdgcn_mfma_f32_32x32x16_bf16(kf[5],qr[2],C1,0,0,0),   P1[6],P1[7],P1[8],P1[9],     pw2[2]=PKW(P1,4), pw2[3]=PKW(P1,6), pw2); \
    VRD(3); SBAR(); GAPA(C0=__builtin_amdgcn_mfma_f32_32x32x16_bf16(kf[6],qr[3],C0,0,0,0),   P1[10],P1[11],P1[12],P1[13], pw3[0]=PKW(P1,8), pw3[1]=PKW(P1,10), pw3); \
    VRD(7); SBAR(); GAPA(C1=__builtin_amdgcn_mfma_f32_32x32x16_bf16(kf[7],qr[3],C1,0,0,0),   P1[14],P1[15],0.f,0.f,       pw3[2]=PKW(P1,12),pw3[3]=PKW(P1,14), pw3); \
    l_reg+=sacc; \
    if(GK){DMA_K((t)+3,sl_cur);} if(GV){DMA_V((t)+1,sl_next);} \
    CMASK(C0,C1,t); \
    { float a=MX3(C0[0],C0[1],C1[0]),b=MX3(C0[2],C0[3],C1[1]); a=MX3(a,C1[2],C1[3]); \
      _Pragma("unroll") for(int r=4;r<16;r+=4){a=MX3(a,C0[r],C0[r+1]);b=MX3(b,C0[r+2],C0[r+3]);a=MX3(a,C1[r],C1[r+1]);b=MX3(b,C1[r+2],C1[r+3]);} \
      float rm=__builtin_fmaxf(a,b); { auto rr=__builtin_amdgcn_permlane32_swap(__float_as_uint(rm),__float_as_uint(rm),false,false); rm=__builtin_fmaxf(__uint_as_float(rr[0]),__uint_as_float(rr[1])); } \
      resc=false; \
      if(__builtin_expect(__any(rm>(float)THRL),0)){ const float dl=__builtin_fmaxf(rm,0.f); mhat+=dl; \
        _Pragma("unroll") for(int r=0;r<16;++r){C0[r]-=dl;C1[r]-=dl;} \
        _Pragma("unroll") for(int r=0;r<16;++r)negm[r]=-mhat; asm volatile("":"+v"(negm)); \
        const float f=__builtin_amdgcn_exp2f(-dl); l_reg*=f; if(hi==0)wsf[r32]=f; resc=true; } } \
    SBAR(); \
    GAPB(o[0]=__builtin_amdgcn_mfma_f32_32x32x16_bf16(PAF(0),VFR(0),o[0],0,0,0), C0,0); \
    GAPB(o[1]=__builtin_amdgcn_mfma_f32_32x32x16_bf16(PAF(0),VFR(4),o[1],0,0,0), C0,4); \
    KRD(GL,0); GAPB(o[0]=__builtin_amdgcn_mfma_f32_32x32x16_bf16(PAF(1),VFR(1),o[0],0,0,0), C0,8); \
    KRD(GL,1); GAPB(o[1]=__builtin_amdgcn_mfma_f32_32x32x16_bf16(PAF(1),VFR(5),o[1],0,0,0), C0,12); \
    KRD(GL,2); GAPB(o[0]=__builtin_amdgcn_mfma_f32_32x32x16_bf16(PAF(2),VFR(2),o[0],0,0,0), C1,0); \
    KRD(GL,3); GAPB(o[1]=__builtin_amdgcn_mfma_f32_32x32x16_bf16(PAF(2),VFR(6),o[1],0,0,0), C1,4); \
    GAPB(o[0]=__builtin_amdgcn_mfma_f32_32x32x16_bf16(PAF(3),VFR(3),o[0],0,0,0), C1,8); \
    GAPB(o[1]=__builtin_amdgcn_mfma_f32_32x32x16_bf16(PAF(3),VFR(7),o[1],0,0,0), C1,12); \
    }while(0)
  int t=1;
  for(;t+5<NT;t+=2){
    STEP(pB0,pB1,pA0,pA1,t,true,true,true);     WAIT_BAR(2); RESC(); ROT();
    STEP(pA0,pA1,pB0,pB1,t+1,true,true,true);   WAIT_BAR(2); RESC(); ROT();
  }
  #define ENDW(tt) do{ if((tt)+3<NT){WAIT_BAR(2);} else if((tt)+2<NT){WAIT_BAR(1);} else {WAIT_BAR(0);} }while(0)
  for(;t+1<NT;t+=2){
    STEP(pB0,pB1,pA0,pA1,t,(t+3<NT),(t+1<NT),(t+1<NT));       ENDW(t);   RESC(); ROT();
    STEP(pA0,pA1,pB0,pB1,t+1,(t+4<NT),(t+2<NT),(t+2<NT));     ENDW(t+1); RESC(); ROT();
  }
  STEP(pB0,pB1,pA0,pA1,NT-1,false,false,false); RESC();
  { float sacc=pB0[0]+pB0[1]; _Pragma("unroll") for(int r=2;r<16;++r)sacc+=pB0[r]; _Pragma("unroll") for(int r=0;r<16;++r)sacc+=pB1[r]; l_reg+=sacc;
    pw0=(u32x4){PKW(pB0,0),PKW(pB0,2),PKW(pB0,4),PKW(pB0,6)};pw1=(u32x4){PKW(pB0,8),PKW(pB0,10),PKW(pB0,12),PKW(pB0,14)};pw2=(u32x4){PKW(pB1,0),PKW(pB1,2),PKW(pB1,4),PKW(pB1,6)};pw3=(u32x4){PKW(pB1,8),PKW(pB1,10),PKW(pB1,12),PKW(pB1,14)};
    SBAR(); pv(o,vb0+sl_cur,PAF(0),PAF(1),PAF(2),PAF(3)); }
  #undef PKW
  #undef PAF
  #undef VFR
  #undef PIN
  #undef MX3
  #undef GAPA
  #undef GAPB
  #undef EX
  #undef VRD
  #undef KRD
  #undef STEP
  #undef ENDW
  {auto rr=__builtin_amdgcn_permlane32_swap(__float_as_uint(l_reg),__float_as_uint(l_reg),false,false);l_reg=__uint_as_float(rr[0])+__uint_as_float(rr[1]);}
  if(hi==0)wsf[32+r32]=l_reg;asm volatile("s_waitcnt lgkmcnt(0)":::"memory");
  float rli[16];
  #pragma unroll
  for(int r=0;r<16;++r)rli[r]=__builtin_amdgcn_rcpf(wsf[32+crow(r,hi)]);
  bf16*Ow=O0+(long)(wid*QBLK)*OP;
  { bf16*stg=(bf16*)(shm+LDS_OST)+wid*2048;
    #pragma unroll
    for(int r=0;r<16;++r){const int orow=crow(r,hi);
      #pragma unroll
      for(int d0=0;d0<2;++d0)stg[orow*64+d0*32+r32]=__float2bfloat16(o[d0][r]*rli[r]);}
    asm volatile("s_waitcnt lgkmcnt(0)":::"memory");
    #pragma unroll
    for(int i=0;i<4;++i){const int row=i*8+(lane>>3),ch=lane&7; const u32x4 v=*(const u32x4*)(stg+row*64+ch*8); ATTN_STORE16(Ow+(long)row*OP+ch*8,v);} }
  asm volatile("s_waitcnt lgkmcnt(0)\n\ts_barrier":::"memory");
  #undef DMA_K
  #undef DMA_V
  #undef CMASK
  #undef START
  #undef RESC
  #undef ROT
}
constexpr int ATTN_LDS_BYTES=LDS_BYTES;
#undef SBAR
#undef WAIT_BAR
}

constexpr int DM = 1024, BATCH = 8, SEQ = 4096, DEPTH = 4, CTXL = 256, DFF = 2816;
constexpr int MX = BATCH * SEQ, MC = BATCH * CTXL, MALL = MX + MC;
constexpr int INW = 2080, INWP = 2304, KVLEN = CTXL + SEQ, NCH = KVLEN / 64;
constexpr float EPS = 1e-6f;
constexpr float QSCALE = 0.125f * 1.4426950408889634f;
constexpr int PC_CA = 0, PC_CG = 256, PC_GQ = 512, PC_GK = 640, PC_GV = 768, PC_GR = 1024, PC_GF = 1280, PC_AQ = 1312, PC_AK = 1824;
constexpr size_t MiB = 1u << 20;
constexpr size_t WS_W1T = 0, WS_W2T = 88 * MiB, WS_WINT = 132 * MiB, WS_WOT = 150 * MiB, WS_MOD = 158 * MiB, WS_XN = 160 * MiB, WS_CAT = 228 * MiB,
                 WS_HP = 296 * MiB, WS_Q = 483 * MiB, WS_K = 517 * MiB, WS_V = 526 * MiB, WS_CTXR = 535 * MiB, WS_GDS = 543 * MiB, WS_GDEC = 577 * MiB, WS_CTL = 578 * MiB, WS_SSQ = 579 * MiB, WS_SW = 581 * MiB, WS_END = 584 * MiB;
constexpr size_t W1T_SZ = (size_t)2 * DFF * DM, W2T_SZ = (size_t)DM * DFF, WINT_SZ = (size_t)INWP * DM, WOT_SZ = (size_t)DM * DM;
static_assert(8 * W1T_SZ * 2 <= WS_W2T - WS_W1T && 8 * W2T_SZ * 2 <= WS_WINT - WS_W2T && 4 * WINT_SZ * 2 <= WS_WOT - WS_WINT && 4 * WOT_SZ * 2 <= WS_MOD - WS_WOT, "ws map W");
static_assert((size_t)MALL * DM * 2 <= WS_CAT - WS_XN && (size_t)MALL * DM * 2 <= WS_HP - WS_CAT && (size_t)MALL * DFF * 2 <= WS_Q - WS_HP && (size_t)MALL * 512 * 2 <= WS_K - WS_Q, "ws map act");
static_assert((size_t)BATCH * KVLEN * 128 * 2 <= WS_V - WS_K && (size_t)MC * DM * 4 <= WS_GDS - WS_CTXR && (size_t)BATCH * 2 * NCH * 4 * 2048 * 4 <= WS_GDEC - WS_GDS, "ws map 2");
constexpr int LDS_BYTES = 147456;
constexpr int NPH_LAYER = 9, NPHASES = 2 + DEPTH * NPH_LAYER;
constexpr int SWN = 2 * DFF;
static_assert((size_t)DEPTH * 3 * MALL * 4 <= WS_SW - WS_SSQ && (size_t)DEPTH * 3 * 9 * SWN * 4 <= WS_END - WS_SW, "ws map 3");

typedef unsigned short bf16_t;
typedef float f32x4 __attribute__((ext_vector_type(4)));
typedef unsigned u32x4 __attribute__((ext_vector_type(4)));
typedef unsigned u32x2 __attribute__((ext_vector_type(2)));
typedef float f32x2v __attribute__((ext_vector_type(2)));
#define LDSP __attribute__((address_space(3)))
#define LDS_WAIT() asm volatile("s_waitcnt lgkmcnt(0)" ::: "memory")
__device__ __forceinline__ unsigned pk2(float lo, float hi) { return pg8::cvt_pk_bf16(lo, hi); }
__device__ __forceinline__ float bflo(unsigned w) { return __uint_as_float(w << 16); }
__device__ __forceinline__ float bfhi(unsigned w) { return __uint_as_float(w & 0xffff0000u); }
__device__ __forceinline__ void unpack8(const u32x4 r, float (&x)[8]) { x[0] = bflo(r.x); x[1] = bfhi(r.x); x[2] = bflo(r.y); x[3] = bfhi(r.y); x[4] = bflo(r.z); x[5] = bfhi(r.z); x[6] = bflo(r.w); x[7] = bfhi(r.w); }
__device__ __forceinline__ u32x4 pack8(const float (&x)[8]) { u32x4 w; w.x = pk2(x[0], x[1]); w.y = pk2(x[2], x[3]); w.z = pk2(x[4], x[5]); w.w = pk2(x[6], x[7]); return w; }
template <int CTRL> __device__ __forceinline__ float dpp_mov(float v) { return __int_as_float(__builtin_amdgcn_update_dpp(0, __float_as_int(v), CTRL, 0xf, 0xf, false)); }
template <int X> __device__ __forceinline__ float swz_xor(float v) {
    if constexpr (X == 1) return dpp_mov<0xB1>(v);
    else if constexpr (X == 2) return dpp_mov<0x4E>(v);
    else return __int_as_float(__builtin_amdgcn_ds_swizzle(__float_as_int(v), 0x1f | (X << 10)));
}
__device__ __forceinline__ float sum8(float v)  { v += dpp_mov<0xB1>(v); v += dpp_mov<0x4E>(v); v += dpp_mov<0x141>(v); return v; }
__device__ __forceinline__ float sum16(float v) { v = sum8(v); v += dpp_mov<0x140>(v); return v; }
__device__ __forceinline__ float wave_sum(float v) {
    v = sum16(v); v += swz_xor<16>(v);
    auto rr = __builtin_amdgcn_permlane32_swap(__float_as_uint(v), __float_as_uint(v), false, false);
    return __uint_as_float(rr[0]) + __uint_as_float(rr[1]);
}
__device__ __forceinline__ float sigm(float v) { return __builtin_amdgcn_rcpf(1.0f + __expf(-v)); }

struct Args { const float* in[20]; float* out; unsigned char* ws; int ph_lo, ph_hi; };
typedef const __attribute__((address_space(4))) Args* KA;
enum { I_X = 0, I_C, I_CTX, I_CCTX, I_WADA, I_BADA, I_GNORM, I_WFI, I_WFO, I_WIN, I_WOUT, I_WDW, I_BDW, I_CNG, I_CNB, I_WGG, I_BGG, I_GLAG, I_QNG, I_KNG };

__device__ __forceinline__ void transpose_item(const float* W, int K, int N, bf16_t* WT, int kb, int nsrc, int ndst, LDSP float* scr, int lane) {
    const int k0 = 64 * kb;
#pragma unroll 8
    for (int i = 0; i < 32; ++i) { const int kk = 2 * i + (lane >> 5); scr[kk * 33 + (lane & 31)] = W[(size_t)(k0 + kk) * N + nsrc + (lane & 31)]; }
    LDS_WAIT();
    const int c = lane & 7;
#pragma unroll
    for (int j = 0; j < 4; ++j) { const int n = (lane >> 3) + 8 * j; const LDSP float* s = scr + (8 * c) * 33 + n;
        u32x4 o; o.x = pk2(s[0 * 33], s[1 * 33]); o.y = pk2(s[2 * 33], s[3 * 33]); o.z = pk2(s[4 * 33], s[5 * 33]); o.w = pk2(s[6 * 33], s[7 * 33]);
        *(u32x4*)(WT + (size_t)(ndst + n) * K + k0 + 8 * c) = o; }
    LDS_WAIT();
}
__device__ __forceinline__ void phase0(KA a, LDSP unsigned char* lds, int tid, int lane, int wave, int bid, int G) {
    unsigned char* ws = a->ws;
    LDSP float* scr = (LDSP float*)(lds + wave * 8704);
    const int gw = bid * 8 + wave, NGW = G * 8;
    constexpr int I1 = 16 * 176, I2 = 44 * 32, I3 = 16 * 65, I4 = 16 * 32, LI = 2 * I1 + 2 * I2 + I3 + I4;
    for (int it = gw; it < DEPTH * LI; it += NGW) {
        const int l = it / LI; int r = it % LI;
        if (r < 2 * I1) { const int f = r / I1, rr = r % I1, kb = rr / 176, nb = rr % 176, nsrc = nb * 32; const bool isu = nsrc >= DFF; const int j = isu ? nsrc - DFF : nsrc;
            transpose_item(a->in[I_WFI] + (size_t)(l * 2 + f) * DM * 2 * DFF, DM, 2 * DFF, (bf16_t*)(ws + WS_W1T) + (size_t)(l * 2 + f) * W1T_SZ, kb, nsrc, 256 * (j >> 7) + (isu ? 128 : 0) + (j & 127), scr, lane); continue; }
        r -= 2 * I1;
        if (r < 2 * I2) { const int f = r / I2, rr = r % I2, kb = rr / 32, nb = rr % 32;
            transpose_item(a->in[I_WFO] + (size_t)(l * 2 + f) * DFF * DM, DFF, DM, (bf16_t*)(ws + WS_W2T) + (size_t)(l * 2 + f) * W2T_SZ, kb, nb * 32, nb * 32, scr, lane); continue; }
        r -= 2 * I2;
        if (r < I3) { const int kb = r / 65, nb = r % 65;
            transpose_item(a->in[I_WIN] + (size_t)l * DM * INW, DM, INW, (bf16_t*)(ws + WS_WINT) + (size_t)l * WINT_SZ, kb, nb * 32, nb * 32, scr, lane); continue; }
        r -= I3;
        { const int kb = r / 32, nb = r % 32;
            transpose_item(a->in[I_WOUT] + (size_t)l * DM * DM, DM, DM, (bf16_t*)(ws + WS_WOT) + (size_t)l * WOT_SZ, kb, nb * 32, nb * 32, scr, lane); }
    }
    { constexpr int PV = (INWP - INW) * DM * 2 / 16;
        for (int i = bid * 512 + tid; i < DEPTH * PV; i += G * 512) { const int l = i / PV, r = i % PV;
            ((u32x4*)((bf16_t*)(ws + WS_WINT) + (size_t)l * WINT_SZ + (size_t)INW * DM))[r] = (u32x4){0u, 0u, 0u, 0u}; } }
    { float* SSQ = (float*)(ws + WS_SSQ); for (int i = bid * 512 + tid; i < DEPTH * 3 * MALL; i += G * 512) SSQ[i] = 0.f; }
    __syncthreads();
    LDSP float* S = (LDSP float*)(lds + 69632);
    LDSP float* red = (LDSP float*)(lds + 106496);
    for (int i = tid; i < 9 * 1024; i += 512) { const int r = i >> 10, k = i & 1023; const float cv = r < 8 ? a->in[I_C][r * 1024 + k] : a->in[I_CCTX][k]; S[i] = cv * sigm(cv); }
    __syncthreads();
    float* MOD = (float*)(ws + WS_MOD);
    for (int it = bid; it < DEPTH * 144; it += G) {
        const int l = it / 144, n0 = (it % 144) * 64;
        const float* Wp = a->in[I_WADA] + (size_t)l * DM * 9216 + n0 + lane;
        float acc[9];
#pragma unroll
        for (int r = 0; r < 9; ++r) acc[r] = 0.f;
#pragma unroll 8
        for (int kk = 0; kk < 128; ++kk) { const int k = wave * 128 + kk; const float w = Wp[(size_t)k * 9216];
#pragma unroll
            for (int r = 0; r < 9; ++r) acc[r] += S[r * 1024 + k] * w; }
#pragma unroll
        for (int r = 0; r < 9; ++r) red[(wave * 9 + r) * 64 + lane] = acc[r];
        __syncthreads();
        for (int o = tid; o < 576; o += 512) { const int r = o >> 6, ln = o & 63; float s = 0.f;
#pragma unroll
            for (int w = 0; w < 8; ++w) s += red[(w * 9 + r) * 64 + ln];
            MOD[(size_t)(l * 9 + r) * 9216 + n0 + ln] = s + a->in[I_BADA][l * 9216 + n0 + ln]; }
        __syncthreads();
    }
}
__device__ __forceinline__ void phase1(KA a, LDSP unsigned char* lds, int tid, int lane, int wave, int bid, int G) {
    const float* MOD = (const float*)(a->ws + WS_MOD); bf16_t* XN = (bf16_t*)(a->ws + WS_XN); float* SSQ = (float*)(a->ws + WS_SSQ); float* SW = (float*)(a->ws + WS_SW);
    const float* g = a->in[I_GNORM];
    f32x4 nv[4];
    { const int m0 = bid * 8 + wave; if (m0 < MALL) { const float* xr0 = m0 >= MX ? a->in[I_CTX] + (size_t)(m0 - MX) * DM : a->in[I_X] + (size_t)m0 * DM;
#pragma unroll
        for (int q = 0; q < 4; ++q) nv[q] = ((const f32x4*)xr0)[lane + 64 * q]; } }
    for (int m = bid * 8 + wave; m < MALL; m += G * 8) {
        const bool isc = m >= MX;
        const float* md = MOD + (size_t)(isc ? 8 : (m >> 12)) * 9216;
        f32x4 v[4]; float ss = 0.f;
#pragma unroll
        for (int q = 0; q < 4; ++q) { v[q] = nv[q]; ss += (v[q].x * v[q].x + v[q].y * v[q].y) + (v[q].z * v[q].z + v[q].w * v[q].w); }
        { const int mn = m + G * 8; if (mn < MALL) { const float* xrn = mn >= MX ? a->in[I_CTX] + (size_t)(mn - MX) * DM : a->in[I_X] + (size_t)mn * DM;
#pragma unroll
            for (int q = 0; q < 4; ++q) nv[q] = ((const f32x4*)xrn)[lane + 64 * q]; } }
        ss = wave_sum(ss);
        if (lane == 0) SSQ[m] = ss;
#pragma unroll
        for (int q = 0; q < 4; ++q) { const int col = 4 * lane + 256 * q;
            const f32x4 y = v[q] * *(const f32x4*)(g + col) * (*(const f32x4*)(md + 1024 + col) + 1.0f);
            u32x2 o; o.x = pk2(y.x, y.y); o.y = pk2(y.z, y.w);
            *(u32x2*)(XN + (size_t)m * DM + col) = o;
            typedef _Float16 h16x4 __attribute__((ext_vector_type(4)));
            *(h16x4*)((_Float16*)(a->ws + WS_CAT) + (size_t)m * DM + col) = __builtin_convertvector(v[q], h16x4); }
    }
    LDSP float* SH = (LDSP float*)lds;
    constexpr int RPL = 2 * DFF + INWP + 2 * DFF;
#pragma unroll 1
    for (int l = 0; l < DEPTH; ++l) {
        __syncthreads();
        for (int i = tid; i < 27 * 256; i += 512) { const int v = i >> 8, j = v / 9, bi = v % 9, c4 = (i & 255) * 4; *(LDSP f32x4*)(SH + v * 1024 + c4) = *(const f32x4*)(MOD + (size_t)(l * 9 + bi) * 9216 + (3 * j) * 1024 + c4); }
        __syncthreads();
        const bf16_t* w0b = (const bf16_t*)(a->ws + WS_W1T) + (size_t)(l * 2) * W1T_SZ; const bf16_t* w1b = (const bf16_t*)(a->ws + WS_WINT) + (size_t)l * WINT_SZ; const bf16_t* w2b = (const bf16_t*)(a->ws + WS_W1T) + (size_t)(l * 2 + 1) * W1T_SZ;
#define SW_ROWPTR(rr) ((rr) < 2 * DFF ? w0b + (size_t)(rr) * DM : ((rr) < 2 * DFF + INWP ? w1b + (size_t)((rr) - 2 * DFF) * DM : w2b + (size_t)((rr) - 2 * DFF - INWP) * DM))
        u32x4 nx0 = {0u, 0u, 0u, 0u}, nx1 = {0u, 0u, 0u, 0u};
        { const int r0 = bid * 8 + wave; if (r0 < RPL) { const bf16_t* p = SW_ROWPTR(r0); nx0 = *(const u32x4*)(p + lane * 8); nx1 = *(const u32x4*)(p + 512 + lane * 8); } }
#pragma unroll 1
        for (int r = bid * 8 + wave; r < RPL; r += G * 8) {
            float w0[8], w1[8]; unpack8(nx0, w0); unpack8(nx1, w1);
            { const int rn = r + G * 8; if (rn < RPL) { const bf16_t* p = SW_ROWPTR(rn); nx0 = *(const u32x4*)(p + lane * 8); nx1 = *(const u32x4*)(p + 512 + lane * 8); } }
            const int j = r < 2 * DFF ? 0 : (r < 2 * DFF + INWP ? 1 : 2), rj = r - (j == 0 ? 0 : (j == 1 ? 2 * DFF : 2 * DFF + INWP));
#pragma unroll
            for (int bi = 0; bi < 9; ++bi) { LDSP const float* sh = SH + (j * 9 + bi) * 1024 + lane * 8;
                const f32x4 s0 = *(LDSP const f32x4*)(sh), s1 = *(LDSP const f32x4*)(sh + 4), s2 = *(LDSP const f32x4*)(sh + 512), s3 = *(LDSP const f32x4*)(sh + 516);
                float d = (w0[0] * s0.x + w0[1] * s0.y) + (w0[2] * s0.z + w0[3] * s0.w) + (w0[4] * s1.x + w0[5] * s1.y) + (w0[6] * s1.z + w0[7] * s1.w)
                        + (w1[0] * s2.x + w1[1] * s2.y) + (w1[2] * s2.z + w1[3] * s2.w) + (w1[4] * s3.x + w1[5] * s3.y) + (w1[6] * s3.z + w1[7] * s3.w);
                d = wave_sum(d);
                if (lane == 0) SW[((size_t)(l * 3 + j) * 9 + bi) * SWN + rj] = d; } }
#undef SW_ROWPTR
    }
    __syncthreads();
}
__device__ __forceinline__ void prep_phase(KA a, LDSP unsigned char* lds, int l, int tid, int lane, int wave, int bid, int G) {
    LDSP f32x2v* CS = (LDSP f32x2v*)(lds);
    for (int i = tid; i < 1024; i += 512) { const int pos = i >> 4, f = i & 15;
        const float freq = exp2f(-(float)f * (13.287712379549449f / 16.0f)); const float ang = (float)pos * freq;
        float rev = ang * 0.15915494309189535f; rev -= floorf(rev);
        CS[i] = (f32x2v){__builtin_amdgcn_cosf(rev), __builtin_amdgcn_sinf(rev)}; }
    __syncthreads();
    const bf16_t* P = (const bf16_t*)(a->ws + WS_HP); bf16_t* Q = (bf16_t*)(a->ws + WS_Q); bf16_t* Kb = (bf16_t*)(a->ws + WS_K); bf16_t* Vb = (bf16_t*)(a->ws + WS_V);
    const int sub = lane & 7, axis = sub >> 2, half = (sub >> 1) & 1, f0 = (sub & 1) * 8;
    float qg[8], kg[8];
#pragma unroll
    for (int e = 0; e < 8; ++e) { qg[e] = a->in[I_QNG][l * 64 + sub * 8 + e]; kg[e] = a->in[I_KNG][l * 64 + sub * 8 + e]; }
    u32x4 nq = {0u, 0u, 0u, 0u}, nk_ = {0u, 0u, 0u, 0u};
    { const int m0 = bid * 8 + wave; if (m0 < MALL) { nq = *(const u32x4*)(P + (size_t)m0 * INWP + PC_AQ + lane * 8); nk_ = *(const u32x4*)(P + (size_t)m0 * INWP + PC_AK + (lane & 31) * 8); } }
    for (int m = bid * 8 + wave; m < MALL; m += G * 8) {
        const u32x4 rawq = nq, rawk = nk_;
        asm volatile("" :: "v"(rawq), "v"(rawk) : "memory");
        { const int mn = m + G * 8; if (mn < MALL) { nq = *(const u32x4*)(P + (size_t)mn * INWP + PC_AQ + lane * 8); nk_ = *(const u32x4*)(P + (size_t)mn * INWP + PC_AK + (lane & 31) * 8); } }
        asm volatile("" ::: "memory");
        const bool lat = m < MX;
        const int b = lat ? (m >> 12) : ((m - MX) >> 8), t = lat ? (m & 4095) : 0, pos = lat ? (CTXL + t) : ((m - MX) & 255);
        const int p = axis ? (t & 63) : (t >> 6);
        const bf16_t* pr = P + (size_t)m * INWP;
        float x[8], y[8];
        { const u32x4 raw = rawq; unpack8(raw, x);
            float ss = 0.f;
#pragma unroll
            for (int e = 0; e < 8; ++e) ss += x[e] * x[e];
            ss = sum8(ss);
            const float rstd = 1.0f / sqrtf(ss * (1.0f / 64.0f) + EPS);
#pragma unroll
            for (int e = 0; e < 8; ++e) y[e] = x[e] * rstd * qg[e];
            if (lat) {
#pragma unroll
                for (int e = 0; e < 8; ++e) { const float o = swz_xor<2>(y[e]); const f32x2v cs = CS[p * 16 + f0 + e]; x[e] = half ? (y[e] * cs.x + o * cs.y) : (y[e] * cs.x - o * cs.y); }
            } else {
#pragma unroll
                for (int e = 0; e < 8; ++e) x[e] = y[e];
            }
#pragma unroll
            for (int e = 0; e < 8; ++e) x[e] *= QSCALE;
            *(u32x4*)(Q + (size_t)m * 512 + lane * 8) = pack8(x); }
        { const u32x4 raw = rawk; unpack8(raw, x);
            float ss = 0.f;
#pragma unroll
            for (int e = 0; e < 8; ++e) ss += x[e] * x[e];
            ss = sum8(ss);
            const float rstd = 1.0f / sqrtf(ss * (1.0f / 64.0f) + EPS);
#pragma unroll
            for (int e = 0; e < 8; ++e) y[e] = x[e] * rstd * kg[e];
            if (lat) {
#pragma unroll
                for (int e = 0; e < 8; ++e) { const float o = swz_xor<2>(y[e]); const f32x2v cs = CS[p * 16 + f0 + e]; x[e] = half ? (y[e] * cs.x + o * cs.y) : (y[e] * cs.x - o * cs.y); }
            } else {
#pragma unroll
                for (int e = 0; e < 8; ++e) x[e] = y[e];
            }
            const size_t kvrow = ((size_t)b * KVLEN + pos) * 128;
            if (lane < 16) *(u32x4*)(Kb + kvrow + lane * 8) = pack8(x);
            else if (lane < 32) *(u32x4*)(Vb + kvrow + (lane - 16) * 8) = raw; }
    }
    __syncthreads();
}
__device__ __forceinline__ void conv_phase(KA a, LDSP unsigned char* lds, int l, bool last, int tid, int lane, int bid, int G) {
    LDSP float* hs = (LDSP float*)lds;
    LDSP bf16_t* os = (LDSP bf16_t*)(lds + 94 * 256 * 4);
    const bf16_t* P = (const bf16_t*)(a->ws + WS_HP); bf16_t* CAT = (bf16_t*)a->out;
    const int c = tid & 255, hf = tid >> 8;
    float w[31];
#pragma unroll
    for (int k = 0; k < 31; ++k) w[k] = a->in[I_WDW][(size_t)(l * 31 + k) * 256 + c];
    const float bias = a->in[I_BDW][l * 256 + c], gg = a->in[I_CNG][l * 256 + c], bb = a->in[I_CNB][l * 256 + c];
    const int nitems = last ? 512 : 544;
    for (int it = bid; it < nitems; it += G) {
        int base, len, t0;
        if (it < 512) { base = (it >> 6) * SEQ; len = SEQ; t0 = (it & 63) * 64; } else { const int i2 = it - 512; base = MX + (i2 >> 2) * CTXL; len = CTXL; t0 = (i2 & 3) * 64; }
        for (int rr = tid >> 5; rr < 94; rr += 16) { const int t = t0 - 15 + rr, c8 = (tid & 31) * 8;
            float h[8];
            if (t >= 0 && t < len) { const bf16_t* pr = P + (size_t)(base + t) * INWP + c8; float av[8], gv[8];
                unpack8(*(const u32x4*)(pr + PC_CA), av); unpack8(*(const u32x4*)(pr + PC_CG), gv);
#pragma unroll
                for (int e = 0; e < 8; ++e) h[e] = av[e] * sigm(gv[e]);
            } else {
#pragma unroll
                for (int e = 0; e < 8; ++e) h[e] = 0.f;
            }
            *(LDSP f32x4*)(hs + rr * 256 + c8) = (f32x4){h[0], h[1], h[2], h[3]}; *(LDSP f32x4*)(hs + rr * 256 + c8 + 4) = (f32x4){h[4], h[5], h[6], h[7]}; }
        __syncthreads();
#pragma unroll 1
        for (int i0 = 0; i0 < 32; i0 += 4) { const int ib = hf * 32 + i0;
            float xw[34];
#pragma unroll
            for (int k = 0; k < 34; ++k) xw[k] = hs[(ib + k) * 256 + c];
            float acc[4], mean[4], var[4];
#pragma unroll
            for (int t = 0; t < 4; ++t) { float s_ = bias;
#pragma unroll
                for (int k = 0; k < 31; ++k) s_ += w[k] * xw[t + k];
                acc[t] = s_; mean[t] = s_; }
#pragma unroll
            for (int t = 0; t < 4; ++t) mean[t] = sum16(mean[t]);
#pragma unroll
            for (int t = 0; t < 4; ++t) mean[t] += swz_xor<16>(mean[t]);
#pragma unroll
            for (int t = 0; t < 4; ++t) { auto rr = __builtin_amdgcn_permlane32_swap(__float_as_uint(mean[t]), __float_as_uint(mean[t]), false, false);
                mean[t] = (__uint_as_float(rr[0]) + __uint_as_float(rr[1])) * (1.0f / 64.0f); acc[t] -= mean[t]; var[t] = acc[t] * acc[t]; }
#pragma unroll
            for (int t = 0; t < 4; ++t) var[t] = sum16(var[t]);
#pragma unroll
            for (int t = 0; t < 4; ++t) var[t] += swz_xor<16>(var[t]);
#pragma unroll
            for (int t = 0; t < 4; ++t) { auto rr = __builtin_amdgcn_permlane32_swap(__float_as_uint(var[t]), __float_as_uint(var[t]), false, false);
                const float vv = (__uint_as_float(rr[0]) + __uint_as_float(rr[1])) * (1.0f / 64.0f);
                const float y = acc[t] * __builtin_amdgcn_rsqf(vv + EPS) * gg + bb;
                const float o = y * sigm(y);
                os[(ib + t) * 256 + c] = (bf16_t)(pk2(o, 0.f) & 0xffffu); } }
        __syncthreads();
        for (int q = tid; q < 2048; q += 512) { const int row = q >> 5, c8 = (q & 31) * 8;
            *(u32x4*)(CAT + (size_t)(base + t0 + row) * DM + c8) = *(const LDSP u32x4*)(os + row * 256 + c8); }
        __syncthreads();
    }
}
typedef short gbf16x8 __attribute__((ext_vector_type(8)));
constexpr int GB_WG = 106496, GB_BG = 106496 + 16384;
constexpr int GB_Q = 0, GB_K = 8448, GB_GF = 16896, GB_GB = 20992, GB_VT = 25088, GB_S0T = 34304, GB_QE = 42496, GB_KE = 50688, GB_KENDT = 58880, GB_ATT = 68096, GB_TOT = 86528, GB_O = 88576, GB_END = 105984;
constexpr int VTP = 72, ATP = 72, KTP = 72, OP_ = 68;
static_assert(GB_END <= 131072 && GB_VT + 64 * VTP * 2 == GB_S0T && GB_ATT + 2 * 64 * ATP * 2 == GB_TOT && GB_O + 64 * OP_ * 4 == GB_END, "gla lds");
__device__ __forceinline__ int gla_row(int b, int c, int i) { return c < 4 ? MX + b * CTXL + c * 64 + i : b * SEQ + (c - 4) * 64 + i; }
__device__ __forceinline__ void st_bf16(LDSP unsigned char* base, int byteoff, float v) { *(LDSP bf16_t*)(base + byteoff) = (bf16_t)(pk2(v, 0.f) & 0xffffu); }
struct GlaRegs { u32x4 qk, gt, vv, rg; f32x4 s0[2], gg[2]; };
template <bool G3> __device__ __forceinline__ void gla_issue(KA a, GlaRegs& R, const float* ggb, int b, int c, int h, int tid) {
    const bf16_t* P = (const bf16_t*)(a->ws + WS_HP);
    { const int i = (tid & 255) >> 2, part = tid & 3; const bf16_t* pr = P + (size_t)gla_row(b, c, i) * INWP;
        R.qk = (u32x4){0u, 0u, 0u, 0u};
        if (G3 || tid >= 256) R.qk = *(const u32x4*)(pr + (tid < 256 ? PC_GQ : PC_GK) + h * 32 + part * 8);
        R.gt = *(const u32x4*)(pr + PC_GF + part * 8); }
    { const int j = tid >> 3, part = tid & 7; R.vv = *(const u32x4*)(P + (size_t)gla_row(b, c, j) * INWP + PC_GV + h * 64 + part * 8); }
    if (G3) { const float* DS = (const float*)(a->ws + WS_GDS);
#pragma unroll
        for (int dir = 0; dir < 2; ++dir) { const size_t ci = ((size_t)(b * 2 + dir) * NCH + c) * 4 + h; R.s0[dir] = *(const f32x4*)(DS + ci * 2048 + (tid >> 4) * 64 + (tid & 15) * 4); }
        R.rg = *(const u32x4*)(P + (size_t)gla_row(b, c, tid >> 3) * INWP + PC_GR + h * 64 + (tid & 7) * 8);
        R.gg[0] = *(const f32x4*)(ggb + h * 64 + (tid & 7) * 8); R.gg[1] = *(const f32x4*)(ggb + h * 64 + (tid & 7) * 8 + 4); }
}
template <bool G3> __device__ __forceinline__ void gla_stage(KA a, LDSP unsigned char* B, const GlaRegs& R, int l, int b, int c, int h, int tid) {
    LDSP float* Qf = (LDSP float*)(B + GB_Q); LDSP float* Kf = (LDSP float*)(B + GB_K); LDSP float* GF = (LDSP float*)(B + GB_GF); LDSP float* GBk = (LDSP float*)(B + GB_GB);
    { const int i = (tid & 255) >> 2, part = tid & 3;
        float x[8]; unpack8(R.qk, x);
        if (tid < 256) {
            if (G3) {
#pragma unroll
                for (int e = 0; e < 8; ++e) Qf[i * 33 + part * 8 + e] = x[e]; }
            unpack8(R.gt, x);
#pragma unroll
            for (int e = 0; e < 8; ++e) (part < 2 ? GF : GBk)[i * 16 + (part & 1) * 8 + e] = x[e];
        } else {
#pragma unroll
            for (int e = 0; e < 8; ++e) Kf[i * 33 + part * 8 + e] = x[e]; } }
    { const int j = tid >> 3, part = tid & 7; const u32x4 r = R.vv;
        const unsigned w[4] = {r.x, r.y, r.z, r.w};
#pragma unroll
        for (int e = 0; e < 8; ++e) *(LDSP bf16_t*)(B + GB_VT + ((part * 8 + e) * VTP + j) * 2) = (bf16_t)((e & 1) ? (w[e >> 1] >> 16) : (w[e >> 1] & 0xffffu)); }
    if (G3) {
#pragma unroll
        for (int dir = 0; dir < 2; ++dir) { const int d = tid >> 4, v4 = (tid & 15) * 4; const f32x4 sv = R.s0[dir];
            st_bf16(B, GB_S0T + dir * 4096 + ((v4 + 0) * 32 + d) * 2, sv.x); st_bf16(B, GB_S0T + dir * 4096 + ((v4 + 1) * 32 + d) * 2, sv.y);
            st_bf16(B, GB_S0T + dir * 4096 + ((v4 + 2) * 32 + d) * 2, sv.z); st_bf16(B, GB_S0T + dir * 4096 + ((v4 + 3) * 32 + d) * 2, sv.w); } }
    __syncthreads();
    const int dir = tid >> 8, seg = (tid >> 5) & 7, d = tid & 31;
    float p[8], qv[8], kv[8];
    { LDSP const float* Wg = (LDSP const float*)(B + GB_WG) + (dir * 16) * 128 + h * 32 + d; const float bg = ((LDSP const float*)(B + GB_BG))[dir * 128 + h * 32 + d];
        float wc[16];
#pragma unroll
        for (int r = 0; r < 16; ++r) wc[r] = Wg[r * 128];
        LDSP const float* gs = dir ? GBk : GF;
#pragma unroll
        for (int r = 0; r < 8; ++r) { const int i = dir ? 63 - (seg * 8 + r) : seg * 8 + r; kv[r] = Kf[i * 33 + d]; qv[r] = G3 ? Qf[i * 33 + d] : 0.f; }
        float run = 0.f;
#pragma unroll
        for (int hb = 0; hb < 2; ++hb) {
            f32x4 gq[4][4];
#pragma unroll
            for (int r = 0; r < 4; ++r) { const int i = dir ? 63 - (seg * 8 + hb * 4 + r) : seg * 8 + hb * 4 + r;
#pragma unroll
                for (int q = 0; q < 4; ++q) gq[r][q] = *(LDSP const f32x4*)(gs + i * 16 + 4 * q); }
#pragma unroll
            for (int r = 0; r < 4; ++r) { float z0 = bg, z1 = 0.f, z2 = 0.f, z3 = 0.f;
#pragma unroll
                for (int q = 0; q < 4; ++q) { z0 += gq[r][q].x * wc[4 * q]; z1 += gq[r][q].y * wc[4 * q + 1]; z2 += gq[r][q].z * wc[4 * q + 2]; z3 += gq[r][q].w * wc[4 * q + 3]; }
                const float z = (z0 + z1) + (z2 + z3);
                const float ls = fminf(z, 0.f) - __logf(1.0f + __expf(-fabsf(z)));
                run += ls * (1.0f / 16.0f); p[hb * 4 + r] = run; } }
        ((LDSP float*)(B + GB_TOT))[(dir * 8 + seg) * 32 + d] = run; }
    __syncthreads();
    float off = 0.f, bl = 0.f;
#pragma unroll
    for (int sg = 0; sg < 8; ++sg) { const float t = ((LDSP const float*)(B + GB_TOT))[(dir * 8 + sg) * 32 + d]; bl += t; off += (sg < seg) ? t : 0.f; }
    float o1[8], o2[8];
#pragma unroll
    for (int r = 0; r < 8; ++r) { const float bc = p[r] + off;
        if (G3) { o1[r] = qv[r] * 0.17677669529663687f * __expf(bc); o2[r] = kv[r] * __expf(-bc); }
        else { o1[r] = kv[r] * __expf(bl - bc); o2[r] = 0.f; } }
#pragma unroll
    for (int r = 0; r < 8; ++r) { const int i = dir ? 63 - (seg * 8 + r) : seg * 8 + r;
        if (G3) { st_bf16(B, GB_QE + dir * 4096 + (i * 32 + d) * 2, o1[r]); st_bf16(B, GB_KE + dir * 4096 + (i * 32 + d) * 2, o2[r]); }
        else st_bf16(B, GB_KENDT + dir * (32 * KTP * 2) + (d * KTP + i) * 2, o1[r]); }
    if (!G3 && seg == 0) ((float*)(a->ws + WS_GDEC))[(((size_t)(b * 2 + dir) * NCH + c) * 4 + h) * 32 + d] = __expf(bl);
    __syncthreads();
}
__device__ __forceinline__ void gla_g1_phase(KA a, LDSP unsigned char* lds, int l, int tid, int bid, int G) {
    float* DS = (float*)(a->ws + WS_GDS);
    const int lane = tid & 63, w = tid >> 6, fr = lane & 15, fq = lane >> 4;
    for (int i = tid; i < 2 * 16 * 128; i += 512) ((LDSP float*)(lds + GB_WG))[i] = a->in[I_WGG][(size_t)l * 2 * 16 * 128 + i];
    if (tid < 256) ((LDSP float*)(lds + GB_BG))[tid] = a->in[I_BGG][l * 256 + tid];
    __syncthreads();
    GlaRegs R, Rn;
    if (bid < BATCH * NCH * 4) gla_issue<false>(a, Rn, nullptr, (bid >> 2) / NCH, (bid >> 2) % NCH, bid & 3, tid);
    for (int it = bid; it < BATCH * NCH * 4; it += G) {
        const int h = it & 3, c = (it >> 2) % NCH, b = (it >> 2) / NCH;
        R = Rn;
        gla_stage<false>(a, lds, R, l, b, c, h, tid);
        asm volatile("" ::: "memory");
        { const int itn = it + G; if (itn < BATCH * NCH * 4) gla_issue<false>(a, Rn, nullptr, (itn >> 2) / NCH, (itn >> 2) % NCH, itn & 3, tid); }
        asm volatile("" ::: "memory");
        const int dir = w >> 2, dt = (w >> 1) & 1;
        const size_t ci = ((size_t)(b * 2 + dir) * NCH + c) * 4 + h;
        gbf16x8 af[2];
#pragma unroll
        for (int sx = 0; sx < 2; ++sx) af[sx] = *(LDSP const gbf16x8*)(lds + GB_KENDT + dir * (32 * KTP * 2) + ((dt * 16 + fr) * KTP + sx * 32 + fq * 8) * 2);
#pragma unroll
        for (int t = 0; t < 2; ++t) { const int vt = (w & 1) * 2 + t; f32x4 acc = {0.f, 0.f, 0.f, 0.f};
#pragma unroll
            for (int sx = 0; sx < 2; ++sx) { const gbf16x8 bf = *(LDSP const gbf16x8*)(lds + GB_VT + ((vt * 16 + fr) * VTP + sx * 32 + fq * 8) * 2);
                acc = __builtin_amdgcn_mfma_f32_16x16x32_bf16(af[sx], bf, acc, 0, 0, 0); }
#pragma unroll
            for (int r = 0; r < 4; ++r) DS[ci * 2048 + (size_t)(dt * 16 + fq * 4 + r) * 64 + vt * 16 + fr] = acc[r]; }
        __syncthreads();
    }
}
__device__ __forceinline__ void gla_g2_phase(KA a, int tid, int bid, int G) {
    float* DS = (float*)(a->ws + WS_GDS); const float* DEC = (const float*)(a->ws + WS_GDEC);
    for (int e = bid * 512 + tid; e < BATCH * 2 * 4 * 2048; e += G * 512) {
        const int dv = e & 2047, h = (e >> 11) & 3, dir = (e >> 13) & 1, b = e >> 14, d = dv >> 6;
        float S = 0.f;
#pragma unroll 4
        for (int st = 0; st < NCH; ++st) { const int c = dir ? (st < 4 ? 3 - st : 71 - st) : st;
            const size_t ci = ((size_t)(b * 2 + dir) * NCH + c) * 4 + h;
            const float dsv = DS[ci * 2048 + dv], dec = DEC[ci * 32 + d];
            DS[ci * 2048 + dv] = S; S = dec * S + dsv; }
    }
}
__device__ __forceinline__ void gla_g3_phase(KA a, LDSP unsigned char* lds, int l, bool last, int tid, int bid, int G) {
    const bf16_t* P = (const bf16_t*)(a->ws + WS_HP); bf16_t* CAT = (bf16_t*)a->out;
    const int lane = tid & 63, w = tid >> 6, fr = lane & 15, fq = lane >> 4, it_ = w >> 1;
    for (int i = tid; i < 2 * 16 * 128; i += 512) ((LDSP float*)(lds + GB_WG))[i] = a->in[I_WGG][(size_t)l * 2 * 16 * 128 + i];
    if (tid < 256) ((LDSP float*)(lds + GB_BG))[tid] = a->in[I_BGG][l * 256 + tid];
    __syncthreads();
    const int c_lo = last ? 4 : 0, ncs = NCH - c_lo, nit = BATCH * ncs * 4;
    GlaRegs R, Rn;
    if (bid < nit) gla_issue<true>(a, Rn, a->in[I_GLAG] + (size_t)l * 256, (bid >> 2) / ncs, c_lo + (bid >> 2) % ncs, bid & 3, tid);
    for (int it = bid; it < nit; it += G) {
        const int h = it & 3, c = c_lo + (it >> 2) % ncs, b = (it >> 2) / ncs;
        R = Rn;
        gla_stage<true>(a, lds, R, l, b, c, h, tid);
        asm volatile("" ::: "memory");
        { const int itn = it + G; if (itn < nit) gla_issue<true>(a, Rn, a->in[I_GLAG] + (size_t)l * 256, (itn >> 2) / ncs, c_lo + (itn >> 2) % ncs, itn & 3, tid); }
        asm volatile("" ::: "memory");
        gbf16x8 qf[2], kf[2][2];
#pragma unroll
        for (int dir = 0; dir < 2; ++dir) { qf[dir] = *(LDSP const gbf16x8*)(lds + GB_QE + dir * 4096 + ((it_ * 16 + fr) * 32 + fq * 8) * 2);
#pragma unroll
            for (int t = 0; t < 2; ++t) kf[dir][t] = *(LDSP const gbf16x8*)(lds + GB_KE + dir * 4096 + ((((w & 1) * 2 + t) * 16 + fr) * 32 + fq * 8) * 2); }
        f32x4 s4[2][2];
#pragma unroll
        for (int dir = 0; dir < 2; ++dir)
#pragma unroll
            for (int t = 0; t < 2; ++t) { const f32x4 z = {0.f, 0.f, 0.f, 0.f}; s4[dir][t] = __builtin_amdgcn_mfma_f32_16x16x32_bf16(qf[dir], kf[dir][t], z, 0, 0, 0); }
#pragma unroll
        for (int dir = 0; dir < 2; ++dir)
#pragma unroll
            for (int t = 0; t < 2; ++t) { const int jt = (w & 1) * 2 + t;
#pragma unroll
                for (int r = 0; r < 4; ++r) { const int i = it_ * 16 + fq * 4 + r, j = jt * 16 + fr; const bool keep = dir ? (j >= i) : (j <= i);
                    st_bf16(lds, GB_ATT + dir * (64 * ATP * 2) + (i * ATP + j) * 2, keep ? s4[dir][t][r] : 0.f); } }
        __syncthreads();
        { gbf16x8 af[2][2], bfv[2][2], sf[2][2];
#pragma unroll
            for (int dir = 0; dir < 2; ++dir)
#pragma unroll
                for (int sx = 0; sx < 2; ++sx) af[dir][sx] = *(LDSP const gbf16x8*)(lds + GB_ATT + dir * (64 * ATP * 2) + ((it_ * 16 + fr) * ATP + sx * 32 + fq * 8) * 2);
#pragma unroll
            for (int t = 0; t < 2; ++t) { const int vt = (w & 1) * 2 + t;
#pragma unroll
                for (int sx = 0; sx < 2; ++sx) bfv[t][sx] = *(LDSP const gbf16x8*)(lds + GB_VT + ((vt * 16 + fr) * VTP + sx * 32 + fq * 8) * 2);
#pragma unroll
                for (int dir = 0; dir < 2; ++dir) sf[t][dir] = *(LDSP const gbf16x8*)(lds + GB_S0T + dir * 4096 + ((vt * 16 + fr) * 32 + fq * 8) * 2); }
            f32x4 acc[2];
#pragma unroll
            for (int t = 0; t < 2; ++t) { acc[t] = (f32x4){0.f, 0.f, 0.f, 0.f};
#pragma unroll
                for (int dir = 0; dir < 2; ++dir) {
#pragma unroll
                    for (int sx = 0; sx < 2; ++sx) acc[t] = __builtin_amdgcn_mfma_f32_16x16x32_bf16(af[dir][sx], bfv[t][sx], acc[t], 0, 0, 0);
                    acc[t] = __builtin_amdgcn_mfma_f32_16x16x32_bf16(qf[dir], sf[t][dir], acc[t], 0, 0, 0); } }
#pragma unroll
            for (int t = 0; t < 2; ++t) { const int vt = (w & 1) * 2 + t;
#pragma unroll
                for (int r = 0; r < 4; ++r) ((LDSP float*)(lds + GB_O))[(it_ * 16 + fq * 4 + r) * OP_ + vt * 16 + fr] = acc[t][r]; } }
        __syncthreads();
        { const int i = tid >> 3, vg = tid & 7;
            const f32x4 o0 = *(LDSP const f32x4*)(lds + GB_O + (i * OP_ + vg * 8) * 4), o1 = *(LDSP const f32x4*)(lds + GB_O + (i * OP_ + vg * 8 + 4) * 4);
            float ss = (o0.x * o0.x + o0.y * o0.y) + (o0.z * o0.z + o0.w * o0.w) + (o1.x * o1.x + o1.y * o1.y) + (o1.z * o1.z + o1.w * o1.w);
            ss = sum8(ss);
            const float rstd = 1.0f / sqrtf(ss * (1.0f / 64.0f) + EPS);
            const int row = gla_row(b, c, i);
            const float gg[8] = {R.gg[0].x, R.gg[0].y, R.gg[0].z, R.gg[0].w, R.gg[1].x, R.gg[1].y, R.gg[1].z, R.gg[1].w};
            float r[8]; unpack8(R.rg, r);
            float y[8] = {o0.x, o0.y, o0.z, o0.w, o1.x, o1.y, o1.z, o1.w};
#pragma unroll
            for (int e = 0; e < 8; ++e) y[e] = y[e] * rstd * gg[e] * (r[e] * sigm(r[e]));
            *(u32x4*)(CAT + (size_t)row * DM + 256 + h * 64 + vg * 8) = pack8(y); }
    }
}
__device__ __forceinline__ void ctx_gemm_res(KA a, LDSP unsigned char* lds, const bf16_t* A, const bf16_t* Bt, int K, const float* gate, float coef,
                                             _Float16* XR, bf16_t* XS, float* ssq, const float* gn, const float* scn, int tid, int bid, int G) {
    const int lane = tid & 63, w = tid >> 6, wm = w >> 1, wn = w & 1, fr = lane & 15, fq = lane >> 4;
    constexpr int CP = 136;
    LDSP unsigned char* As = lds; LDSP unsigned char* Bs = lds + 128 * CP * 2; LDSP float* Cs = (LDSP float*)(lds + 53248);
    const int nk = K / 128, lr = tid >> 4, lc = (tid & 15) * 8;
    for (int u = bid; u < 256; u += G) {
        int tm = u >> 4, tn = u & 15;
        if (G == 256) { const int x = u & 7, sl = u >> 3; tm = (x & 3) * 4 + (sl >> 3); tn = (x >> 2) * 8 + (sl & 7); }
        const size_t row0 = (size_t)MX + tm * 128; const int col0 = tn * 64;
        const bf16_t* ap = A + (row0 + lr) * K + lc; const bf16_t* bp = Bt + (size_t)(col0 + lr) * K + lc;
        u32x4 ra[2][4], rb[2][2];
#pragma unroll
        for (int st = 0; st < 2; ++st) {
#pragma unroll
            for (int q = 0; q < 4; ++q) ra[st][q] = *(const u32x4*)(ap + (size_t)(32 * q) * K + st * 128);
#pragma unroll
            for (int q = 0; q < 2; ++q) rb[st][q] = *(const u32x4*)(bp + (size_t)(32 * q) * K + st * 128); }
        f32x4 acc[2][2];
#pragma unroll
        for (int mt = 0; mt < 2; ++mt)
#pragma unroll
            for (int nt = 0; nt < 2; ++nt) acc[mt][nt] = (f32x4){0.f, 0.f, 0.f, 0.f};
#pragma unroll 1
        for (int kt = 0; kt < nk; kt += 2) {
#pragma unroll
            for (int st = 0; st < 2; ++st) {
#pragma unroll
                for (int q = 0; q < 4; ++q) *(LDSP u32x4*)(As + ((32 * q + lr) * CP + lc) * 2) = ra[st][q];
#pragma unroll
                for (int q = 0; q < 2; ++q) *(LDSP u32x4*)(Bs + ((32 * q + lr) * CP + lc) * 2) = rb[st][q];
                __syncthreads();
                if (kt + st + 2 < nk) {
#pragma unroll
                    for (int q = 0; q < 4; ++q) ra[st][q] = *(const u32x4*)(ap + (size_t)(32 * q) * K + (kt + st + 2) * 128);
#pragma unroll
                    for (int q = 0; q < 2; ++q) rb[st][q] = *(const u32x4*)(bp + (size_t)(32 * q) * K + (kt + st + 2) * 128); }
#pragma unroll
                for (int ks = 0; ks < 4; ++ks) { gbf16x8 af[2], bf[2];
#pragma unroll
                    for (int mt = 0; mt < 2; ++mt) af[mt] = *(LDSP const gbf16x8*)(As + ((wm * 32 + mt * 16 + fr) * CP + ks * 32 + fq * 8) * 2);
#pragma unroll
                    for (int nt = 0; nt < 2; ++nt) bf[nt] = *(LDSP const gbf16x8*)(Bs + ((wn * 32 + nt * 16 + fr) * CP + ks * 32 + fq * 8) * 2);
#pragma unroll
                    for (int mt = 0; mt < 2; ++mt)
#pragma unroll
                        for (int nt = 0; nt < 2; ++nt) acc[mt][nt] = __builtin_amdgcn_mfma_f32_16x16x32_bf16(af[mt], bf[nt], acc[mt][nt], 0, 0, 0); }
                __syncthreads();
            }
        }
#pragma unroll
        for (int mt = 0; mt < 2; ++mt)
#pragma unroll
            for (int nt = 0; nt < 2; ++nt)
#pragma unroll
                for (int r = 0; r < 4; ++r) Cs[(wm * 32 + mt * 16 + fq * 4 + r) * 68 + wn * 32 + nt * 16 + fr] = acc[mt][nt][r];
        __syncthreads();
        { const int rl = tid >> 2, cs = (tid & 3) * 16; const size_t grow = row0 + rl; const int gc = col0 + cs;
            float x[16];
            {
#pragma unroll
                for (int q = 0; q < 2; ++q) { const pg8::f32x8 t = __builtin_convertvector(*(const pg8::h16x8*)(XR + grow * 1024 + gc + 8 * q), pg8::f32x8);
#pragma unroll
                    for (int e = 0; e < 8; ++e) x[8 * q + e] = t[e]; } }
            const float* g = gate + (size_t)8 * 9216 + gc; const float* gnp = gn + gc; const float* scp = scn + (size_t)8 * 9216 + gc;
            float ss = 0.f, y[16];
#pragma unroll
            for (int q = 0; q < 4; ++q) { const f32x4 gv = *(const f32x4*)(g + 4 * q), cv = *(LDSP const f32x4*)(Cs + rl * 68 + cs + 4 * q), gg = *(const f32x4*)(gnp + 4 * q), sc = *(const f32x4*)(scp + 4 * q);
#pragma unroll
                for (int e = 0; e < 4; ++e) { const float xv = x[4 * q + e] + coef * gv[e] * cv[e]; x[4 * q + e] = xv; ss += xv * xv; y[4 * q + e] = xv * gg[e] * (sc[e] + 1.0f); } }
#pragma unroll
            for (int q = 0; q < 2; ++q) { const pg8::f32x8 t = {x[8 * q], x[8 * q + 1], x[8 * q + 2], x[8 * q + 3], x[8 * q + 4], x[8 * q + 5], x[8 * q + 6], x[8 * q + 7]};
                *(pg8::h16x8*)(XR + grow * 1024 + gc + 8 * q) = __builtin_convertvector(t, pg8::h16x8);
                u32x4 wv; wv.x = pk2(y[8 * q], y[8 * q + 1]); wv.y = pk2(y[8 * q + 2], y[8 * q + 3]); wv.z = pk2(y[8 * q + 4], y[8 * q + 5]); wv.w = pk2(y[8 * q + 6], y[8 * q + 7]);
                *(u32x4*)(XS + grow * 1024 + gc + 8 * q) = wv; }
            ss += swz_xor<1>(ss); ss += swz_xor<2>(ss);
            if ((tid & 3) == 0) atomicAdd(ssq + grow, ss); }
        __syncthreads();
    }
}
__device__ __forceinline__ void attn_phase(KA a, unsigned char* lds, bool last, int bid, int G) {
    using abf = attn_body::bf16;
    const abf* Q = (const abf*)(a->ws + WS_Q); const abf* Kb = (const abf*)(a->ws + WS_K); const abf* Vb = (const abf*)(a->ws + WS_V); abf* CAT = (abf*)a->out;
    const int nunits = last ? 1024 : 1088;
    const int nlat = bid < 1024 ? (1024 - bid + G - 1) / G : 0, c0 = G - 1 - bid, nctx = (nunits > 1024 && c0 < 64) ? (64 - c0 + G - 1) / G : 0;
    for (int i = 0; i < nlat + nctx; ++i) {
        const int u = (i < nlat) ? bid + i * G : 1024 + c0 + (i - nlat) * G;
        int b, h, NT; size_t qrow;
        if (u < 1024) { b = u >> 7; h = (u >> 4) & 7; qrow = (size_t)b * SEQ + (size_t)(u & 15) * 256; NT = NCH; }
        else { const int uc = u - 1024; b = uc >> 3; h = uc & 7; qrow = (size_t)MX + (size_t)b * CTXL; NT = 4; }
        const size_t kvo = (size_t)b * KVLEN * 128 + (h >> 2) * 64;
        attn_body::attn_unit<8>(Q + qrow * 512 + h * 64, Kb + kvo, Vb + kvo, CAT + qrow * DM + 512 + h * 64, NT, (char*)lds);
    }
}
#define XB_TMO      128
#define XB_XCNT(j)  (256  + 64 * (j))
#define XB_XSUB(j)  (1280 + 64 * (j))
#define XB_XGEN(j)  (2304 + 64 * (j))
#define XB_TOP      3328
#define XB_TOPGEN   3392
#define XCD_BAR_WORDS 3456
#define XB_SPIN_CAP (1u << 18)

__device__ __forceinline__ unsigned xb_ld(unsigned* p)              { return __hip_atomic_load(p, __ATOMIC_RELAXED, __HIP_MEMORY_SCOPE_AGENT); }
__device__ __forceinline__ unsigned xb_add(unsigned* p, unsigned v) { return __hip_atomic_fetch_add(p, v, __ATOMIC_RELAXED, __HIP_MEMORY_SCOPE_AGENT); }
__device__ __forceinline__ unsigned xb_xcc_id() { return (unsigned)__builtin_amdgcn_s_getreg((3 << 11) | 20) & 0xFu; }
#define XB_SPIN(cond, bar) do { unsigned _sp = 0; while (cond) { __builtin_amdgcn_s_sleep(1); \
    if ((++_sp & 255u) == 0u) { if (xb_ld(&(bar)[XB_TMO])) break; if (_sp > XB_SPIN_CAP) { atomicAdd(&(bar)[XB_TMO], 1u); break; } } } } while (0)

struct XcdBarrier {
    unsigned* bar; unsigned x;
    volatile LDSP unsigned* st;
};

__device__ __forceinline__ XcdBarrier xcd_barrier_post(unsigned* bar, volatile LDSP unsigned* st) {
    XcdBarrier b; b.bar = bar; b.x = xb_xcc_id(); b.st = st;
    if (threadIdx.x == 0) (void)xb_add(&bar[XB_XCNT(b.x)], 1u);
    return b;
}
__device__ __forceinline__ void xcd_barrier_complete(unsigned* bar, unsigned x, unsigned& nloc, unsigned& nx) {
    const unsigned G = gridDim.x * gridDim.y * gridDim.z;
    unsigned sum, cnt, mine, sp = 0u;
    for (;;) {
        sum = 0u; cnt = 0u; mine = 0u;
#pragma unroll
        for (unsigned j = 0; j < 16; ++j) { const unsigned c = xb_ld(&bar[XB_XCNT(j)]); sum += c; cnt += (c > 0u) ? 1u : 0u; mine = (j == x) ? c : mine; }
        if (sum == G) break;
        __builtin_amdgcn_s_sleep(1);
        if ((++sp & 255u) == 0u) { if (xb_ld(&bar[XB_TMO])) break; if (sp > XB_SPIN_CAP) { atomicAdd(&bar[XB_TMO], 1u); break; } }
    }
    nloc = mine > 0u ? mine : 1u; nx = cnt > 0u ? cnt : 1u;
}

__device__ __forceinline__ void xcd_barrier(const XcdBarrier& b) {
    asm volatile("s_waitcnt vmcnt(0)" ::: "memory");
    __syncthreads();
    if (threadIdx.x == 0) {
        unsigned* bar = b.bar;
        __builtin_amdgcn_s_waitcnt(0);
        unsigned nloc = b.st[0], nx = b.st[1];
        if (nloc == 0u) { xcd_barrier_complete(bar, b.x, nloc, nx); b.st[0] = nloc; b.st[1] = nx; }
        const unsigned old = xb_add(&bar[XB_XSUB(b.x)], 1u);
        const unsigned gen = old / nloc;
        if (old + 1u == (gen + 1u) * nloc) {
            __builtin_amdgcn_fence(__ATOMIC_RELEASE, "agent");
            asm volatile("s_waitcnt vmcnt(0)" ::: "memory");
            const unsigned og = xb_add(&bar[XB_TOP], 1u);
            const unsigned tg = og / nx;
            if (og + 1u == (tg + 1u) * nx) xb_add(&bar[XB_TOPGEN], 1u);
            else XB_SPIN(xb_ld(&bar[XB_TOPGEN]) == tg, bar);
            __builtin_amdgcn_fence(__ATOMIC_ACQUIRE, "agent");
            xb_add(&bar[XB_XGEN(b.x)], 1u);
            asm volatile("s_waitcnt vmcnt(0)" ::: "memory");
        } else {
            XB_SPIN(xb_ld(&bar[XB_XGEN(b.x)]) == gen, bar);
            __builtin_amdgcn_fence(__ATOMIC_ACQUIRE, "agent");
            asm volatile("s_waitcnt vmcnt(0)" ::: "memory");
        }
    }
    __syncthreads();
}
__global__ void __launch_bounds__(512, 2) mega_fwd(Args a_unused) {
    KA a = (KA)__builtin_amdgcn_kernarg_segment_ptr();
    const int ph_lo = a->ph_lo, ph_hi = a->ph_hi;
    extern __shared__ __attribute__((aligned(16))) unsigned char lds_raw[];
    LDSP unsigned char* lds0 = (LDSP unsigned char*)lds_raw;
    { LDSP unsigned char* lds = lds0;
    volatile LDSP unsigned* xst = (volatile LDSP unsigned*)(lds + 131072 + 64);
    if (threadIdx.x == 0) { xst[0] = 0u; xst[1] = 0u; }
    __syncthreads();
    if (ph_hi - ph_lo > 1) (void)xcd_barrier_post((unsigned*)(a->ws + WS_CTL), xst); }
#pragma unroll 1
    for (int ph = ph_lo; ph < ph_hi; ++ph) {
        asm volatile("" : "+s"(a));
        LDSP unsigned char* lds = lds0; asm volatile("" : "+s"(lds));
        volatile LDSP unsigned* xst = (volatile LDSP unsigned*)(lds + 131072 + 64);
        unsigned char* ws = a->ws;
        float* CTXR = (float*)(ws + WS_CTXR);
        const float* MOD = (const float*)(ws + WS_MOD);
        bf16_t* XN = (bf16_t*)(ws + WS_XN); bf16_t* CAT = (bf16_t*)a->out; bf16_t* HP = (bf16_t*)(ws + WS_HP); _Float16* XR = (_Float16*)(ws + WS_CAT);
        const int tid = opaque_tid(), lane = tid & 63, wave = __builtin_amdgcn_readfirstlane(tid >> 6);
        int G = gridDim.x, bid = blockIdx.x; asm volatile("" : "+s"(G), "+s"(bid));
        if (ph == 0) { phase0(a, lds, tid, lane, wave, bid, G); }
        else if (ph == 1) { phase1(a, lds, tid, lane, wave, bid, G); }
        else {
            const int l = (ph - 2) / NPH_LAYER, sp = (ph - 2) % NPH_LAYER; const bool last = (l == DEPTH - 1);
            const bool first = (l == 0 && sp <= 1);
            const float* srcX = first ? a->in[I_X] : a->out; const float* srcC = first ? a->in[I_CTX] : CTXR;
            const int Mtail = last ? MX : MALL;
            const float* SSQ = (const float*)(ws + WS_SSQ); const float* SW = (const float*)(ws + WS_SW);
            switch (sp) {
            case 0: case 7: { const int f = (sp == 0) ? 0 : 1, j = (sp == 0) ? 0 : 2; const int M = (sp == 0) ? MALL : Mtail;
                pg8::Gemm g{XN, (const bf16_t*)(ws + WS_W1T) + (size_t)(l * 2 + f) * W1T_SZ, M, 2 * DFF, DM}; pg8::PrefOrder S; S.init(M, 2 * DFF, G, bid);
                S.pf = lds + pg8::PF_OFF; S.ssq = SSQ + (size_t)(l * 3 + j) * MALL; S.sw = SW + (size_t)(l * 3 + j) * 9 * SWN; S.MXr = MX; S.cnt = 0;
                pg8::EpiSwiGLU E{HP, DFF, lds + pg8::PF_OFF, 0};
                pg8::gemm_phase<pg8::EpiSwiGLU, pg8::PrefOrder, true, true>(lds, g, S, E); } break;
            case 1: case 6: case 8: {
                const bf16_t* A; const bf16_t* Bt; int K, M, j; float coef;
                if (sp == 1) { A = HP; Bt = (const bf16_t*)(ws + WS_W2T) + (size_t)(l * 2 + 0) * W2T_SZ; K = DFF; M = MALL; j = 0; coef = 0.5f; }
                else if (sp == 6) { A = CAT; Bt = (const bf16_t*)(ws + WS_WOT) + (size_t)l * WOT_SZ; K = DM; M = Mtail; j = 1; coef = 1.0f; }
                else { A = HP; Bt = (const bf16_t*)(ws + WS_W2T) + (size_t)(l * 2 + 1) * W2T_SZ; K = DFF; M = Mtail; j = 2; coef = 0.5f; }
                const int ln = (j == 2) ? l + 1 : l, jn = (j == 2) ? 0 : j + 1;
                const bool has_next = ln < DEPTH; const int nidx = has_next ? (ln * 3 + jn) : 0;
                pg8::Gemm g{A, Bt, MX, DM, K}; pg8::StaticOrder S; S.init(MX, DM, G, bid);
                pg8::EpiRes E{a->out, XR, (last && sp == 8) ? 1 : 0, MOD + (size_t)l * 9 * 9216 + (3 * j + 2) * 1024, coef, MX,
                              XN, (float*)(ws + WS_SSQ) + (size_t)nidx * MALL, a->in[I_GNORM] + (size_t)nidx * DM, MOD + (size_t)(nidx / 3) * 9 * 9216 + (3 * jn + 1) * 1024, has_next ? 1 : 0};
                pg8::gemm_phase<pg8::EpiRes, pg8::StaticOrder, true, true>(lds, g, S, E);
                if (M == MALL) ctx_gemm_res(a, lds, A, Bt, K, MOD + (size_t)l * 9 * 9216 + (3 * j + 2) * 1024, coef, XR, XN, (float*)(ws + WS_SSQ) + (size_t)nidx * MALL,
                                            a->in[I_GNORM] + (size_t)nidx * DM, MOD + (size_t)(nidx / 3) * 9 * 9216 + (3 * jn + 1) * 1024, tid, bid, G); } break;
            case 2: { pg8::Gemm g{XN, (const bf16_t*)(ws + WS_WINT) + (size_t)l * WINT_SZ, MALL, INWP, DM}; pg8::PrefOrder S; S.init(MALL, INWP, G, bid);
                S.pf = lds + pg8::PF_OFF; S.ssq = SSQ + (size_t)(l * 3 + 1) * MALL; S.sw = SW + (size_t)(l * 3 + 1) * 9 * SWN; S.MXr = MX; S.cnt = 0;
                pg8::EpiStore E{HP, INWP, lds + pg8::PF_OFF, 0};
                pg8::gemm_phase<pg8::EpiStore, pg8::PrefOrder, true, true>(lds, g, S, E); } break;
            case 3: prep_phase(a, lds, l, tid, lane, wave, bid, G); gla_g1_phase(a, lds, l, tid, bid, G); break;
            case 4: gla_g2_phase(a, tid, bid, G); conv_phase(a, lds, l, last, tid, lane, bid, G); break;
            case 5: attn_phase(a, (unsigned char*)lds, last, bid, G); gla_g3_phase(a, lds, l, last, tid, bid, G); break;
            default: break;
            }
        }
        if (ph + 1 < ph_hi) {
            unsigned* barw = (unsigned*)(ws + WS_CTL);
            if (ph_hi > NPHASES + 4096) cg::this_grid().sync();
            { XcdBarrier xb; xb.bar = barw; xb.x = xb_xcc_id(); xb.st = xst; xcd_barrier(xb); }
        }
    }
}

#ifndef MK_MULTI
#define MK_MULTI 0
#endif
extern "C" void kernel_launch(void* const* d_in, const int* in_sizes, int n_in, void* d_out, int out_size, void* d_ws, size_t ws_size, hipStream_t stream) {
    static int grid = 0;
    if (grid == 0) {
        if (n_in != 20 || out_size != MX * DM || ws_size < WS_END) { fprintf(stderr, "kernel_launch: unexpected shapes (n_in %d, out %d, ws %zu); nothing launched\n", n_in, out_size, ws_size); grid = -1; return; }
        int dev = 0, cus = 0, per_cu = 0;
        if (hipGetDevice(&dev) != hipSuccess || hipDeviceGetAttribute(&cus, hipDeviceAttributeMultiprocessorCount, dev) != hipSuccess) { grid = -1; return; }
        if (hipFuncSetAttribute((const void*)mega_fwd, hipFuncAttributeMaxDynamicSharedMemorySize, LDS_BYTES) != hipSuccess) { fprintf(stderr, "kernel_launch: hipFuncSetAttribute failed\n"); grid = -1; return; }
        if (hipOccupancyMaxActiveBlocksPerMultiprocessor(&per_cu, (const void*)mega_fwd, 512, LDS_BYTES) != hipSuccess || per_cu < 1) { fprintf(stderr, "kernel_launch: occupancy query gave %d\n", per_cu); per_cu = 1; }
        (void)hipGetLastError();
        grid = cus * per_cu;
    }
    if (grid < 0) return;
    Args a{};
    for (int i = 0; i < 20; ++i) a.in[i] = (const float*)d_in[i];
    a.out = (float*)d_out; a.ws = (unsigned char*)d_ws;
#if MK_MULTI
    for (int ph = 0; ph < NPHASES; ++ph) { a.ph_lo = ph; a.ph_hi = ph + 1; hipLaunchKernelGGL(mega_fwd, dim3(grid), dim3(512), LDS_BYTES, stream, a); }
#else
    a.ph_lo = 0; a.ph_hi = NPHASES;
    if (hipMemsetAsync((char*)d_ws + WS_CTL, 0, XCD_BAR_WORDS * 4, stream) != hipSuccess) { fprintf(stderr, "kernel_launch: hipMemsetAsync of the barrier words failed\n"); return; }
    void* args[] = {&a};
    hipError_t e = hipLaunchCooperativeKernel((const void*)mega_fwd, dim3(grid), dim3(512), args, LDS_BYTES, stream);
    if (e != hipSuccess) fprintf(stderr, "kernel_launch: cooperative launch failed: %s (grid %d)\n", hipGetErrorString(e), grid);
#endif
}
```

```cpp
#include <hip/hip_runtime.h>
#include <hip/hip_cooperative_groups.h>
#include <cstdio>
#include <cstdint>
namespace cg = cooperative_groups;
__device__ __forceinline__ int opaque_tid() { int t = threadIdx.x; asm volatile("" : "+v"(t)); return t; }
namespace pg8 {
#define PG8_LAS __attribute__((address_space(3)))
typedef unsigned short bf16_t;
typedef short bf16x8 __attribute__((ext_vector_type(8)));
typedef float f32x4 __attribute__((ext_vector_type(4)));
typedef unsigned u32x4 __attribute__((ext_vector_type(4)));
constexpr int BM = 256, BK = 64, HALF = 128, HTB = HALF * BK * 2  , STAGE_BYTES = 8 * HTB, NXCD = 8, WGM = 8;

__host__ __device__ __forceinline__ int lds_byte(int r, int c) { const int st = (r >> 4) * 2 + (c >> 5), rr = r & 15, cc = c & 31, ob = rr * 64 + cc * 2; return st * 1024 + (ob ^ (((ob >> 9) & 1) << 5)); }
__host__ __device__ __forceinline__ void stage_rc(int b, int& R, int& C) { const int st = b / 1024, sb = b % 1024, swz = sb ^ (((sb >> 9) & 1) << 5); R = (st >> 1) * 16 + swz / 64; C = (st & 1) * 32 + (swz % 64) / 2; }
__host__ __device__ __forceinline__ int perm32(int rho) { const int n = rho >> 4, i = rho & 15; return 8 * (i >> 2) + 4 * n + (i & 3); }

struct Unit { int pm, pn; };
struct Gemm { const bf16_t* A; const bf16_t* Bt; int M, N, K; };

struct StaticOrder {
    int nM, nN, nwg, G, c;
    __host__ __device__ void init(int M, int N, int G_, int c_) { nM = M / BM; nN = N / BM; nwg = nM * nN; G = G_; c = c_; }
    __host__ __device__ bool next(int i, Unit& u) const {
        const long L = (long)i * G + c; if (L >= nwg) return false;
        int wgid = (int)L; { const int q = nwg / NXCD, r = nwg % NXCD, xcd = wgid % NXCD, off = wgid / NXCD; wgid = (xcd < r ? xcd * (q + 1) : r * (q + 1) + (xcd - r) * q) + off; }
        const int nig = WGM * nN, gid = wgid / nig, fm = gid * WGM, gsz = (nM - fm) < WGM ? (nM - fm) : WGM;
        u.pm = fm + ((wgid % nig) % gsz); u.pn = (wgid % nig) / gsz; return true;
    }
    __device__ __forceinline__ void a_ready(const Unit&) const {}
    __device__ __forceinline__ void done(const Unit&) const {}
};

constexpr int PF_OFF = 132096, PF_SLOT = 2048;
struct PrefOrder : StaticOrder {
    PG8_LAS unsigned char* pf; const float* ssq; const float* sw; int MXr; mutable int cnt;
    __device__ __forceinline__ void a_ready(const Unit& u) const {
        const int t = threadIdx.x, w = __builtin_amdgcn_readfirstlane(t >> 6), lane = t & 63; const int slot = cnt & 1; ++cnt;
        const int rowt = u.pm * BM, bidx = rowt >= MXr ? 8 : (rowt >> 12);
        const float* src = (w < 4) ? ssq + rowt + w * 64 + lane : sw + (size_t)bidx * 5632 + u.pn * BM + (w - 4) * 64 + lane;
        __builtin_amdgcn_global_load_lds((const unsigned*)src, (PG8_LAS unsigned*)(pf + slot * PF_SLOT + w * 256), 4, 0, 0);
    }
};
typedef float cvt_f32x2_t __attribute__((ext_vector_type(2))); typedef __bf16 cvt_bf16x2_t __attribute__((ext_vector_type(2)));
__device__ __forceinline__ unsigned cvt_pk_bf16(float lo, float hi) { const cvt_f32x2_t v = {lo, hi}; const cvt_bf16x2_t b = __builtin_convertvector(v, cvt_bf16x2_t); return __builtin_bit_cast(unsigned, b); }
typedef float f32x2 __attribute__((ext_vector_type(2)));
__device__ __forceinline__ float silu_f(float v) { return v * __builtin_amdgcn_rcpf(1.0f + __expf(-v)); }
struct EpiStore {
    static constexpr bool PERM = true, AFTER_DRAIN = false;
    bf16_t* O; int ldc; PG8_LAS unsigned char* pf; mutable int cnt;
    __device__ __forceinline__ void operator()(const f32x4 (&acc)[2][2][4][2], const Unit& u, int wr, int wc, int fr, int fq) const {
        const int rowt = u.pm * BM; PG8_LAS const float* sl = (PG8_LAS const float*)(pf + (cnt & 1) * PF_SLOT); ++cnt;
        const int row0 = rowt + wr * 64 + fr, col0 = u.pn * BM + wc * 32 + 8 * fq;
        f32x4 sv[2][2];
#pragma unroll
        for (int bj = 0; bj < 2; ++bj)
#pragma unroll
            for (int n = 0; n < 2; ++n) sv[bj][n] = *(PG8_LAS const f32x4*)(sl + 256 + wc * 32 + 8 * fq + bj * HALF + 4 * n);
        float rsv[2][4];
#pragma unroll
        for (int ai = 0; ai < 2; ++ai)
#pragma unroll
            for (int m = 0; m < 4; ++m) rsv[ai][m] = __builtin_amdgcn_rsqf(sl[wr * 64 + fr + ai * HALF + m * 16] * (1.0f / 1024.0f) + 1e-6f);
#pragma unroll
        for (int ai = 0; ai < 2; ++ai)
#pragma unroll
            for (int m = 0; m < 4; ++m) { const int row = row0 + ai * HALF + m * 16; bf16_t* rowp = O + (size_t)row * ldc + col0;
                const float rs = rsv[ai][m];
#pragma unroll
                for (int bj = 0; bj < 2; ++bj) { const f32x4 v0 = acc[ai][bj][m][0] * rs + sv[bj][0], v1 = acc[ai][bj][m][1] * rs + sv[bj][1];
                    u32x4 w; w.x = cvt_pk_bf16(v0[0], v0[1]); w.y = cvt_pk_bf16(v0[2], v0[3]); w.z = cvt_pk_bf16(v1[0], v1[1]); w.w = cvt_pk_bf16(v1[2], v1[3]);
                    *(u32x4*)(rowp + bj * HALF) = w; } }
    }
};
struct EpiSwiGLU {
    static constexpr bool PERM = true, AFTER_DRAIN = false;
    bf16_t* O; int ldc; PG8_LAS unsigned char* pf; mutable int cnt;
    __device__ __forceinline__ void operator()(const f32x4 (&acc)[2][2][4][2], const Unit& u, int wr, int wc, int fr, int fq) const {
        const int rowt = u.pm * BM; PG8_LAS const float* sl = (PG8_LAS const float*)(pf + (cnt & 1) * PF_SLOT); ++cnt;
        const int row0 = rowt + wr * 64 + fr, col0 = u.pn * HALF + wc * 32 + 8 * fq;
        f32x4 sv[2][2];
#pragma unroll
        for (int bj = 0; bj < 2; ++bj)
#pragma unroll
            for (int n = 0; n < 2; ++n) sv[bj][n] = *(PG8_LAS const f32x4*)(sl + 256 + wc * 32 + 8 * fq + bj * HALF + 4 * n);
        float rsv[2][4];
#pragma unroll
        for (int ai = 0; ai < 2; ++ai)
#pragma unroll
            for (int m = 0; m < 4; ++m) rsv[ai][m] = __builtin_amdgcn_rsqf(sl[wr * 64 + fr + ai * HALF + m * 16] * (1.0f / 1024.0f) + 1e-6f);
#pragma unroll
        for (int ai = 0; ai < 2; ++ai)
#pragma unroll
            for (int m = 0; m < 4; ++m) { const int row = row0 + ai * HALF + m * 16; bf16_t* rowp = O + (size_t)row * ldc + col0;
                const float rs = rsv[ai][m];
                const f32x4 a0 = acc[ai][0][m][0] * rs + sv[0][0], a1 = acc[ai][0][m][1] * rs + sv[0][1], u0 = acc[ai][1][m][0] * rs + sv[1][0], u1 = acc[ai][1][m][1] * rs + sv[1][1];
                u32x4 w; w.x = cvt_pk_bf16(silu_f(a0[0]) * u0[0], silu_f(a0[1]) * u0[1]); w.y = cvt_pk_bf16(silu_f(a0[2]) * u0[2], silu_f(a0[3]) * u0[3]);
                w.z = cvt_pk_bf16(silu_f(a1[0]) * u1[0], silu_f(a1[1]) * u1[1]); w.w = cvt_pk_bf16(silu_f(a1[2]) * u1[2], silu_f(a1[3]) * u1[3]);
                *(u32x4*)rowp = w; }
    }
};
typedef _Float16 h16x8 __attribute__((ext_vector_type(8)));
typedef float f32x8 __attribute__((ext_vector_type(8)));
struct EpiRes {
    static constexpr bool PERM = true, AFTER_DRAIN = false;
    float* outF; _Float16* XR; int dstf32; const float* gate; float coef; int MXr;
    bf16_t* XSp; float* ssq; const float* gn; const float* scn; int doxs;
    __device__ __forceinline__ void operator()(const f32x4 (&acc)[2][2][4][2], const Unit& u, int wr, int wc, int fr, int fq) const {
        const int rowt = u.pm * BM; const bool isc = rowt >= MXr; const bool XS = doxs != 0;
        const int bidx = isc ? 8 : (rowt >> 12);
        char* outb = (char*)(outF + (size_t)rowt * 1024);
        char* xrb = (char*)(XR + (size_t)rowt * 1024);
        char* xsb = (char*)(XSp + (size_t)rowt * 1024); float* sqb = ssq + rowt;
        const int col0 = u.pn * BM + wc * 32 + 8 * fq;
        const float* g = gate + (size_t)bidx * 9216 + col0;
        const unsigned lo = (unsigned)((wr * 64 + fr) * 1024 + col0);
        float ss[2][4];
#pragma unroll
        for (int ai = 0; ai < 2; ++ai)
#pragma unroll
            for (int m = 0; m < 4; ++m) ss[ai][m] = 0.f;
#pragma unroll
        for (int bj = 0; bj < 2; ++bj) {
            u32x4 xin[2][4];
#pragma unroll
            for (int ai = 0; ai < 2; ++ai)
#pragma unroll
                for (int m = 0; m < 4; ++m) xin[ai][m] = *(const u32x4*)(xrb + (lo + (unsigned)((ai * HALF + m * 16) * 1024 + bj * HALF)) * 2u);
            f32x4 gv[2], gs[2];
#pragma unroll
            for (int n = 0; n < 2; ++n) { gv[n] = *(const f32x4*)(g + bj * HALF + 4 * n) * coef;
                if (XS) gs[n] = *(const f32x4*)(gn + col0 + bj * HALF + 4 * n) * (*(const f32x4*)(scn + (size_t)bidx * 9216 + col0 + bj * HALF + 4 * n) + 1.0f); }
#pragma unroll
            for (int ai = 0; ai < 2; ++ai)
#pragma unroll
                for (int m = 0; m < 4; ++m) { const unsigned eo = lo + (unsigned)((ai * HALF + m * 16) * 1024 + bj * HALF); f32x4 xv[2];
                    { const f32x8 t = __builtin_convertvector(__builtin_bit_cast(h16x8, xin[ai][m]), f32x8); xv[0] = (f32x4){t[0], t[1], t[2], t[3]}; xv[1] = (f32x4){t[4], t[5], t[6], t[7]}; }
                    xv[0] += gv[0] * acc[ai][bj][m][0]; xv[1] += gv[1] * acc[ai][bj][m][1];
                    if (dstf32) { *(f32x4*)(outb + eo * 4u) = xv[0]; *(f32x4*)(outb + eo * 4u + 16u) = xv[1]; }
                    else { const f32x8 t = {xv[0][0], xv[0][1], xv[0][2], xv[0][3], xv[1][0], xv[1][1], xv[1][2], xv[1][3]}; *(h16x8*)(xrb + eo * 2u) = __builtin_convertvector(t, h16x8); }
                    if (XS) { ss[ai][m] += (xv[0][0] * xv[0][0] + xv[0][1] * xv[0][1]) + (xv[0][2] * xv[0][2] + xv[0][3] * xv[0][3]) + (xv[1][0] * xv[1][0] + xv[1][1] * xv[1][1]) + (xv[1][2] * xv[1][2] + xv[1][3] * xv[1][3]);
                        const f32x4 y0 = xv[0] * gs[0], y1 = xv[1] * gs[1];
                        u32x4 w; w.x = cvt_pk_bf16(y0[0], y0[1]); w.y = cvt_pk_bf16(y0[2], y0[3]); w.z = cvt_pk_bf16(y1[0], y1[1]); w.w = cvt_pk_bf16(y1[2], y1[3]);
                        *(u32x4*)(xsb + eo * 2u) = w; } }
        }
        if (XS) {
#pragma unroll
            for (int ai = 0; ai < 2; ++ai)
#pragma unroll
                for (int m = 0; m < 4; ++m) { float t = ss[ai][m];
                    t += __int_as_float(__builtin_amdgcn_ds_swizzle(__float_as_int(t), 0x1f | (16 << 10)));
                    auto rr = __builtin_amdgcn_permlane32_swap(__float_as_uint(t), __float_as_uint(t), false, false);
                    t = __uint_as_float(rr[0]) + __uint_as_float(rr[1]);
                    if (fq == 0) atomicAdd(sqb + (unsigned)(wr * 64 + fr + ai * HALF + m * 16), t); } }
    }
};
template <class Epi, class Sched, bool ALIGN_EPI = false, bool SP2 = false>
__device__ __forceinline__ void gemm_phase(PG8_LAS unsigned char* lds, const Gemm g, const Sched& S, const Epi& E) {
    const int tid = opaque_tid(), wid = __builtin_amdgcn_readfirstlane(tid >> 6), lane = tid & 63, wr = wid >> 2, wc = wid & 3, fr = lane & 15, fq = lane >> 4;
    const int K = g.K, nt = K / BK;
    unsigned voffA[2], voffB[2];
#pragma unroll
    for (int i = 0; i < 2; ++i) { int R, C; stage_rc(tid * 16 + i * 8192, R, C); const int Rb = Epi::PERM ? ((R & ~31) + perm32(R & 31)) : R;
        voffA[i] = (unsigned)(R * K + C) * 2u; voffB[i] = (unsigned)(Rb * K + C) * 2u; }
    const size_t kstep = (size_t)(BK * 2);
    const size_t hstep = (size_t)HALF * K * 2;
    const size_t tstep = 2 * hstep;
    const unsigned ldsw = (unsigned)wid * 1024u;
    const int aoff = lds_byte(wr * 64 + fr, fq * 8), boff = lds_byte(wc * 32 + fr, fq * 8);
#define PG8_SA(b, h) (((b) * 2 + (h)) * HTB)
#define PG8_SB(b, h) ((4 + (b) * 2 + (h)) * HTB)
#define PG8_STAGE(bufoff, gbase, voff) do { _Pragma("unroll") for (int _i = 0; _i < 2; ++_i) \
        __builtin_amdgcn_global_load_lds((const unsigned*)((const char*)(gbase) + (voff)[_i]), (PG8_LAS unsigned*)(lds + (bufoff) + ldsw + _i * 8192), 16, 0, 0); } while (0)
#define PG8_LDA(dst, b, h) do { _Pragma("unroll") for (int m = 0; m < 4; ++m) _Pragma("unroll") for (int k = 0; k < 2; ++k) dst[m][k] = *(const PG8_LAS bf16x8*)(lds + PG8_SA(b, h) + aoff + m * 2048 + k * 1024); } while (0)
#define PG8_LDB(dst, b, h) do { _Pragma("unroll") for (int n = 0; n < 2; ++n) _Pragma("unroll") for (int k = 0; k < 2; ++k) dst[n][k] = *(const PG8_LAS bf16x8*)(lds + PG8_SB(b, h) + boff + n * 2048 + k * 1024); } while (0)
#define PG8_MMA(ai, bj, At, Bt) do { __builtin_amdgcn_s_setprio(1); _Pragma("unroll") for (int m = 0; m < 4; ++m) _Pragma("unroll") for (int n = 0; n < 2; ++n) _Pragma("unroll") for (int k = 0; k < 2; ++k) \
        acc[ai][bj][m][n] = __builtin_amdgcn_mfma_f32_16x16x32_bf16(Bt[n][k], At[m][k], acc[ai][bj][m][n], 0, 0, 0); __builtin_amdgcn_s_setprio(0); } while (0)
#define PG8_WAIT_V(n) asm volatile("s_waitcnt vmcnt(" #n ")" ::: "memory")
#define PG8_WAIT_L(n) asm volatile("s_waitcnt lgkmcnt(" #n ")" ::: "memory")
#define PG8_BAR __builtin_amdgcn_s_barrier()
#define PG8_SCHED __builtin_amdgcn_sched_barrier(0)
    Unit cur, nxt; int ui = 0;
    if (!S.next(0, cur)) return;
    f32x4 acc[2][2][4][2];
#pragma unroll
    for (int a = 0; a < 2; ++a)
#pragma unroll
        for (int b = 0; b < 2; ++b)
#pragma unroll
            for (int m = 0; m < 4; ++m)
#pragma unroll
                for (int n = 0; n < 2; ++n) acc[a][b][m][n] = (f32x4){0.f, 0.f, 0.f, 0.f};
    bf16x8 At[4][2], B0[2][2], B1[2][2];
    const char* cA = (const char*)g.A + (size_t)cur.pm * tstep; const char* cB = (const char*)g.Bt + (size_t)cur.pn * tstep;
    S.a_ready(cur);
    if constexpr (SP2) {
        PG8_STAGE(PG8_SB(0, 0), cB, voffB); PG8_STAGE(PG8_SB(0, 1), cB + hstep, voffB); PG8_STAGE(PG8_SA(0, 0), cA, voffA); PG8_STAGE(PG8_SA(0, 1), cA + hstep, voffA);
        if (wr == 1) PG8_BAR;
        PG8_WAIT_V(2); PG8_BAR;
        PG8_STAGE(PG8_SB(1, 0), cB + kstep, voffB); PG8_STAGE(PG8_SA(1, 0), cA + kstep, voffA); PG8_STAGE(PG8_SB(1, 1), cB + hstep + kstep, voffB);
        PG8_WAIT_V(6); PG8_BAR;
    } else {
        PG8_STAGE(PG8_SB(0, 0), cB, voffB); PG8_STAGE(PG8_SA(0, 0), cA, voffA); PG8_STAGE(PG8_SB(0, 1), cB + hstep, voffB); PG8_STAGE(PG8_SA(0, 1), cA + hstep, voffA);
        if (wr == 1) PG8_BAR;
        PG8_WAIT_V(4); PG8_BAR;
        PG8_STAGE(PG8_SB(1, 0), cB + kstep, voffB); PG8_STAGE(PG8_SA(1, 0), cA + kstep, voffA); PG8_STAGE(PG8_SB(1, 1), cB + hstep + kstep, voffB);
        PG8_WAIT_V(6); PG8_BAR;
    }
    for (;;) {
        const bool has_next = S.next(ui + 1, nxt);
        const char* nA = has_next ? (const char*)g.A + (size_t)nxt.pm * tstep : cA; const char* nB = has_next ? (const char*)g.Bt + (size_t)nxt.pn * tstep : cB;
        for (int t = 0; t < nt; t += 2) {
            const bool last = (t == nt - 2);
            const char* a1 = cA + (size_t)(t + 1) * kstep;
            const char* a2 = last ? nA : cA + (size_t)(t + 2) * kstep; const char* b2 = last ? nB : cB + (size_t)(t + 2) * kstep;
            const char* a3 = a2 + kstep; const char* b3 = b2 + kstep;
            if (last && has_next) S.a_ready(nxt);
            if constexpr (SP2) {
            PG8_LDB(B0, 0, 0); PG8_LDB(B1, 0, 1); PG8_SCHED; PG8_LDA(At, 0, 0); PG8_STAGE(PG8_SA(1, 1), a1 + hstep, voffA);
            PG8_WAIT_V(8); PG8_WAIT_L(0); PG8_BAR; PG8_MMA(0, 0, At, B0); PG8_MMA(0, 1, At, B1); PG8_BAR; PG8_SCHED;
            PG8_LDA(At, 0, 1); PG8_STAGE(PG8_SB(0, 0), b2, voffB); PG8_STAGE(PG8_SB(0, 1), b2 + hstep, voffB); PG8_STAGE(PG8_SA(0, 0), a2, voffA);
            PG8_WAIT_V(8); PG8_WAIT_L(0); PG8_BAR; PG8_MMA(1, 0, At, B0); PG8_MMA(1, 1, At, B1); PG8_BAR; PG8_SCHED;
            PG8_LDB(B0, 1, 0); PG8_LDB(B1, 1, 1); PG8_SCHED; PG8_LDA(At, 1, 0); PG8_STAGE(PG8_SA(0, 1), a2 + hstep, voffA);
            PG8_WAIT_V(8); PG8_WAIT_L(0); PG8_BAR; PG8_MMA(0, 0, At, B0); PG8_MMA(0, 1, At, B1); PG8_BAR; PG8_SCHED;
            PG8_LDA(At, 1, 1); PG8_STAGE(PG8_SB(1, 0), b3, voffB); PG8_STAGE(PG8_SB(1, 1), b3 + hstep, voffB); PG8_STAGE(PG8_SA(1, 0), a3, voffA);
            PG8_WAIT_V(8); PG8_WAIT_L(0); PG8_BAR; PG8_MMA(1, 0, At, B0); PG8_MMA(1, 1, At, B1); PG8_BAR; PG8_SCHED;
            } else {
            PG8_LDB(B0, 0, 0); PG8_SCHED; PG8_LDA(At, 0, 0); PG8_STAGE(PG8_SA(1, 1), a1 + hstep, voffA);
            PG8_WAIT_L(8); PG8_BAR; PG8_WAIT_L(0); PG8_MMA(0, 0, At, B0); PG8_BAR; PG8_SCHED;
            PG8_LDB(B1, 0, 1); PG8_STAGE(PG8_SB(0, 0), b2, voffB);
            PG8_BAR; PG8_WAIT_L(0); PG8_MMA(0, 1, At, B1); PG8_BAR;
            PG8_LDA(At, 0, 1); PG8_STAGE(PG8_SA(0, 0), a2, voffA);
            PG8_BAR; PG8_WAIT_L(0); PG8_MMA(1, 0, At, B0); PG8_BAR; PG8_SCHED;
            PG8_STAGE(PG8_SB(0, 1), b2 + hstep, voffB);
            PG8_WAIT_V(6); PG8_BAR; PG8_MMA(1, 1, At, B1); PG8_BAR;
            PG8_LDB(B0, 1, 0); PG8_SCHED; PG8_LDA(At, 1, 0); PG8_STAGE(PG8_SA(0, 1), a2 + hstep, voffA);
            PG8_WAIT_L(8); PG8_BAR; PG8_WAIT_L(0); PG8_MMA(0, 0, At, B0); PG8_BAR; PG8_SCHED;
            PG8_LDB(B1, 1, 1); PG8_STAGE(PG8_SB(1, 0), b3, voffB);
            PG8_BAR; PG8_WAIT_L(0); PG8_MMA(0, 1, At, B1); PG8_BAR;
            PG8_LDA(At, 1, 1); PG8_STAGE(PG8_SA(1, 0), a3, voffA);
            PG8_BAR; PG8_WAIT_L(0); PG8_MMA(1, 0, At, B0); PG8_BAR; PG8_SCHED;
            PG8_STAGE(PG8_SB(1, 1), b3 + hstep, voffB);
            PG8_WAIT_V(6); PG8_BAR; PG8_MMA(1, 1, At, B1); PG8_BAR;
            }
        }
        if constexpr (ALIGN_EPI) { if (wr == 0) PG8_BAR; }
        if constexpr (!Epi::AFTER_DRAIN) { E(acc, cur, wr, wc, fr, fq); S.done(cur); }
        if (!has_next) break;
#pragma unroll
        for (int a = 0; a < 2; ++a)
#pragma unroll
            for (int b = 0; b < 2; ++b)
#pragma unroll
                for (int m = 0; m < 4; ++m)
#pragma unroll
                    for (int n = 0; n < 2; ++n) acc[a][b][m][n] = (f32x4){0.f, 0.f, 0.f, 0.f};
        cur = nxt; cA = nA; cB = nB; ++ui;
        if constexpr (ALIGN_EPI) { if (wr == 1) PG8_BAR; }
    }
    PG8_WAIT_V(0);
    if constexpr (!ALIGN_EPI) { if (wr == 0) PG8_BAR; }
    PG8_BAR;
    if constexpr (Epi::AFTER_DRAIN) { E.fused(acc, cur, wr, wc, fr, fq, lds, wid, lane); S.done(cur); }
#undef PG8_SA
#undef PG8_SB
#undef PG8_STAGE
#undef PG8_LDA
#undef PG8_LDB
#undef PG8_MMA
#undef PG8_WAIT_V
#undef PG8_WAIT_L
#undef PG8_BAR
#undef PG8_SCHED
}
}
#include <hip/hip_bf16.h>
#include <cmath>
namespace attn_body {
using bf16=__hip_bfloat16;
using bf16x8=__attribute__((ext_vector_type(8)))short;
using s16x4=__attribute__((ext_vector_type(4)))short;
using f32x16=__attribute__((ext_vector_type(16)))float;
using u32x4=__attribute__((ext_vector_type(4)))unsigned;
constexpr int D=64,QP=512,KP=128,OP=1024;
constexpr int NW=8,QBLK=32,QB=QBLK*NW,KVBLK=64;
constexpr int ATTN_UNIT_ROWS=QB;
__device__ __forceinline__ int crow(int r,int hi){return (r&3)+8*(r>>2)+4*hi;}
#define SBAR() __builtin_amdgcn_sched_barrier(0)
__device__ __forceinline__ void cmask(f32x16&p0,f32x16&p1,int jb,int qrel,int hi){
  const float NEG=-INFINITY; int kb=64*jb+4*hi;
  #pragma unroll
  for(int r=0;r<16;++r){int kv=kb+(r&3)+8*(r>>2); if(kv>qrel)p0[r]=NEG; if(kv+32>qrel)p1[r]=NEG;}
}

constexpr int NSLOT=3, SLOTB=8192;
constexpr int LDS_K=0, LDS_V=NSLOT*SLOTB, LDS_WS=2*NSLOT*SLOTB, LDS_OST=LDS_WS+NW*64*4, LDS_BYTES=LDS_OST+NW*4096;
constexpr float C2=0.125f*1.4426950408889634f;
__device__ __forceinline__ void glds16(const void*gsrc,unsigned lds_dst){unsigned keep;
  asm volatile("s_mov_b32 %0, m0\n\ts_mov_b32 m0, %2\n\ts_nop 0\n\tglobal_load_lds_dwordx4 %1, off\n\ts_mov_b32 m0, %0":"=&s"(keep):"v"(gsrc),"s"(lds_dst):"memory");}
__device__ __forceinline__ float max3f(float a,float b,float c){float r;asm("v_max3_f32 %0, %1, %2, %3":"=v"(r):"v"(a),"v"(b),"v"(c));return r;}
__device__ __forceinline__ float max2f(float a,float b){float r;asm("v_max_f32_e32 %0, %1, %2":"=v"(r):"v"(a),"v"(b));return r;}
__device__ __forceinline__ float fadd_s(float a,float b){float r;asm("v_add_f32_e32 %0, %1, %2":"=v"(r):"v"(a),"v"(b));return r;}
__device__ __forceinline__ float fsub_s(float a,float b){float r;asm("v_sub_f32_e32 %0, %1, %2":"=v"(r):"v"(a),"v"(b));return r;}
typedef float f32x2_t __attribute__((ext_vector_type(2))); typedef __bf16 bf16x2_t __attribute__((ext_vector_type(2)));
__device__ __forceinline__ unsigned cvtpk_s(float lo,float hi){f32x2_t v={lo,hi};bf16x2_t b=__builtin_convertvector(v,bf16x2_t);return __builtin_bit_cast(unsigned,b);}
#define WAIT_BAR(N) asm volatile("s_waitcnt vmcnt(" #N ") lgkmcnt(0)\n\ts_barrier":::"memory")

__device__ __forceinline__ void qkt(f32x16&p0,f32x16&p1,const char*Kslot,const bf16x8*qr,const f32x16&negm,int r32,int hi){
  const char*kb=Kslot+hi*1024+r32*16;
  #pragma unroll
  for(int d0=0;d0<4;++d0){
    const bf16x8 b0=*reinterpret_cast<const bf16x8*>(kb+d0*2048);
    const bf16x8 b1=*reinterpret_cast<const bf16x8*>(kb+d0*2048+512);
    if(d0==0){p0=__builtin_amdgcn_mfma_f32_32x32x16_bf16(b0,qr[0],negm,0,0,0);p1=__builtin_amdgcn_mfma_f32_32x32x16_bf16(b1,qr[0],negm,0,0,0);}
    else{p0=__builtin_amdgcn_mfma_f32_32x32x16_bf16(b0,qr[d0],p0,0,0,0);p1=__builtin_amdgcn_mfma_f32_32x32x16_bf16(b1,qr[d0],p1,0,0,0);}}
}
typedef __attribute__((address_space(3))) const char* lds_cptr;
typedef short v4i16_t __attribute__((ext_vector_type(4)));
__device__ __forceinline__ void kload8(bf16x8*kf,lds_cptr kp){
  kf[0]=*(const __attribute__((address_space(3))) bf16x8*)(kp);      kf[1]=*(const __attribute__((address_space(3))) bf16x8*)(kp+512);
  kf[2]=*(const __attribute__((address_space(3))) bf16x8*)(kp+2048); kf[3]=*(const __attribute__((address_space(3))) bf16x8*)(kp+2560);
  kf[4]=*(const __attribute__((address_space(3))) bf16x8*)(kp+4096); kf[5]=*(const __attribute__((address_space(3))) bf16x8*)(kp+4608);
  kf[6]=*(const __attribute__((address_space(3))) bf16x8*)(kp+6144); kf[7]=*(const __attribute__((address_space(3))) bf16x8*)(kp+6656);
}
__device__ __forceinline__ void kload2(bf16x8*kf,lds_cptr kp,int j){ kf[2*j]=*(const __attribute__((address_space(3))) bf16x8*)(kp+j*2048); kf[2*j+1]=*(const __attribute__((address_space(3))) bf16x8*)(kp+j*2048+512); }
__device__ __forceinline__ s16x4 vtr(lds_cptr p){ return __builtin_bit_cast(s16x4,__builtin_amdgcn_ds_read_tr16_b64_v4i16((__attribute__((address_space(3))) v4i16_t*)p)); }
__device__ __forceinline__ float rowmax(const f32x16&p0,const f32x16&p1){
  float a=max3f(p0[0],p0[1],p1[0]),b=max3f(p0[2],p0[3],p1[1]);a=max3f(a,p1[2],p1[3]);
  #pragma unroll
  for(int r=4;r<16;r+=4){a=max3f(a,p0[r],p0[r+1]);b=max3f(b,p0[r+2],p0[r+3]);a=max3f(a,p1[r],p1[r+1]);b=max3f(b,p1[r+2],p1[r+3]);}
  const float m=max2f(a,b);
  auto rr=__builtin_amdgcn_permlane32_swap(__float_as_uint(m),__float_as_uint(m),false,false);
  return max2f(__uint_as_float(rr[0]),__uint_as_float(rr[1]));
}
__device__ __forceinline__ void pv(f32x16*o,int vb,bf16x8 pa0,bf16x8 pa1,bf16x8 pa2,bf16x8 pa3){
  #pragma unroll
  for(int d0=0;d0<2;++d0){s16x4 lo[4],hi[4];
    #pragma unroll
    for(int ks=0;ks<4;++ks){
      asm volatile("ds_read_b64_tr_b16 %0,%1 offset:%c2":"=&v"(lo[ks]):"v"(vb),"i"(d0*4096+ks*1024):"memory");
      asm volatile("ds_read_b64_tr_b16 %0,%1 offset:%c2":"=&v"(hi[ks]):"v"(vb),"i"(d0*4096+ks*1024+512):"memory");}
    asm volatile("s_waitcnt lgkmcnt(0)":::"memory");SBAR();
    #define PK(k) (bf16x8){lo[k][0],lo[k][1],lo[k][2],lo[k][3],hi[k][0],hi[k][1],hi[k][2],hi[k][3]}
    o[d0]=__builtin_amdgcn_mfma_f32_32x32x16_bf16(pa0,PK(0),o[d0],0,0,0);
    o[d0]=__builtin_amdgcn_mfma_f32_32x32x16_bf16(pa1,PK(1),o[d0],0,0,0);
    o[d0]=__builtin_amdgcn_mfma_f32_32x32x16_bf16(pa2,PK(2),o[d0],0,0,0);
    o[d0]=__builtin_amdgcn_mfma_f32_32x32x16_bf16(pa3,PK(3),o[d0],0,0,0);
    #undef PK
  }
}

#ifndef ATTN_STORE16
#define ATTN_STORE16(p,v) (*(u32x4*)(p)=(v))
#endif
template<int THRL> __device__ __forceinline__ void attn_unit(const bf16*Q0,const bf16*__restrict__ Kh,const bf16*__restrict__ Vh,bf16*O0,const int NT,char*shm){
  const int tid=opaque_tid(),lane=tid&63,r32=lane&31,hi=lane>>5; const int wid=__builtin_amdgcn_readfirstlane(tid>>6);
  const bf16*Qw=Q0+(long)(wid*QBLK)*QP;
  const unsigned lds0=(unsigned)(uintptr_t)shm;
  float*wsf=(float*)(shm+LDS_WS)+wid*64;
  const bf16*ksrc=Kh+(long)lane*KP+wid*8;
  const bf16*vsrc=Vh+(long)(16*(wid&3)+(lane>>2))*KP+(wid>>2)*32+(lane&3)*8;
  const unsigned kdst=lds0+LDS_K+wid*1024, vdst=lds0+LDS_V+wid*1024;
  #define DMA_K(t,slot) glds16(ksrc+(long)(t)*KVBLK*KP,(unsigned)__builtin_amdgcn_readfirstlane(kdst+(slot)))
  #define DMA_V(t,slot) glds16(vsrc+(long)(t)*KVBLK*KP,(unsigned)__builtin_amdgcn_readfirstlane(vdst+(slot)))
  const int vb0=(int)(lds0+LDS_V)+((lane>>4)&1)*32+(lane&3)*8+(4*hi+((lane&15)>>2))*64;
  const char*Kbase=shm+LDS_K; bf16x8 kf[8];
  const lds_cptr shm3=(lds_cptr)shm; const lds_cptr kp0=shm3+LDS_K+hi*1024+r32*16; const lds_cptr vp0=shm3+LDS_V+((lane>>4)&1)*32+(lane&3)*8+(4*hi+((lane&15)>>2))*64;
  DMA_K(0,0);DMA_V(0,0);DMA_K(1,SLOTB);
  bf16x8 qr[4];
  #pragma unroll
  for(int d0=0;d0<4;++d0)qr[d0]=*reinterpret_cast<const bf16x8*>(&Qw[(long)r32*QP+d0*16+hi*8]);
  float mhat=0.f,l_reg=0.f;f32x16 o[2];o[0]=f32x16{};o[1]=f32x16{};f32x16 negm=f32x16{};asm volatile("":"+v"(negm));
  #define CMASK(P0,P1,t) do{}while(0)
  bool resc=false;
  #define START(P0,P1) do{ const float rm=rowmax(P0,P1); resc=false; \
    { const float dl=rm; mhat=fadd_s(mhat,dl); \
      _Pragma("unroll") for(int r=0;r<16;++r){P0[r]=fsub_s(P0[r],dl);P1[r]=fsub_s(P1[r],dl);} \
      _Pragma("unroll") for(int r=0;r<16;++r)negm[r]=-mhat; asm volatile("":"+v"(negm)); } \
    _Pragma("unroll") for(int r=0;r<16;++r)P0[r]=__builtin_amdgcn_exp2f(P0[r]); }while(0)
  #define RESC() do{ if(resc){ asm volatile("s_waitcnt lgkmcnt(0)":::"memory"); \
      _Pragma("unroll") for(int d_=0;d_<2;++d_) _Pragma("unroll") for(int r=0;r<16;++r)o[d_][r]*=wsf[crow(r,hi)]; } }while(0)
  f32x16 pA0,pA1,pB0,pB1;
  int sl_prev=0,sl_cur=0,sl_next=SLOTB;
  #define ROT() do{sl_prev=sl_cur;sl_cur=sl_next;sl_next=(sl_next==(NSLOT-1)*SLOTB)?0:sl_next+SLOTB;}while(0)
  DMA_K(2,2*SLOTB);
  WAIT_BAR(3);
  qkt(pA0,pA1,Kbase,qr,negm,r32,hi);asm volatile("s_nop 15\n\ts_nop 7":"+v"(pA0),"+v"(pA1));CMASK(pA0,pA1,0);
  START(pA0,pA1);
  _Pragma("unroll") for(int r=0;r<16;++r)pA1[r]=__builtin_amdgcn_exp2f(pA1[r]);
  WAIT_BAR(0);
  DMA_K(3,0);DMA_V(1,SLOTB);
  ROT();
  kload8(kf,kp0+sl_cur);
  WAIT_BAR(2);
  s16x4 vlo[8],vhi[8]; u32x4 pw0,pw1,pw2,pw3;
  #define PKW(P,B) cvtpk_s(P[B],P[B+1])
  #define PAF(k) __builtin_bit_cast(bf16x8,pw##k)
  #define VFR(i) (bf16x8){vlo[i][0],vlo[i][1],vlo[i][2],vlo[i][3],vhi[i][0],vhi[i][1],vhi[i][2],vhi[i][3]}
  #define PIN(x) asm volatile("":"+v"(x))
  #define MX3(a,b,c) __builtin_fmaxf(__builtin_fmaxf((a),(b)),(c))
  #define GAPA(MF,A0,A1,A2,A3,W0,W1,PW) do{ MF; sacc+=A0; sacc+=A1; sacc+=A2; sacc+=A3; PIN(sacc); W0; W1; PIN(PW); SBAR(); }while(0)
  #define EX(v) __builtin_amdgcn_exp2f(v)
  #define GAPB(MF,X,B) do{ MF; X[B]=EX(X[B]); X[B+1]=EX(X[B+1]); X[B+2]=EX(X[B+2]); X[B+3]=EX(X[B+3]); PIN(X); SBAR(); }while(0)
  #define VRD(i) do{ vlo[i]=vtr(vp_+(((i)>>2)*4096+((i)&3)*1024)); vhi[i]=vtr(vp_+(((i)>>2)*4096+((i)&3)*1024+512)); }while(0)
  #define KRD(G,j) do{ if(G){ kload2(kf,kp0+sl_next,j); SBAR(); } }while(0)
  #define STEP(C0,C1,P0,P1,t,GK,GV,GL) do{ SBAR(); \
    const lds_cptr vp_=vp0+sl_prev; \
    VRD(0); SBAR(); float sacc=(P0[0]+P0[1]); \
    GAPA(C0=__builtin_amdgcn_mfma_f32_32x32x16_bf16(kf[0],qr[0],negm,0,0,0), P0[2],P0[3],P0[4],P0[5],     pw0[0]=PKW(P0,0), pw0[1]=PKW(P0,2), pw0); \
    VRD(4); SBAR(); GAPA(C1=__builtin_amdgcn_mfma_f32_32x32x16_bf16(kf[1],qr[0],negm,0,0,0), P0[6],P0[7],P0[8],P0[9],     pw0[2]=PKW(P0,4), pw0[3]=PKW(P0,6), pw0); \
    VRD(1); SBAR(); GAPA(C0=__builtin_amdgcn_mfma_f32_32x32x16_bf16(kf[2],qr[1],C0,0,0,0),   P0[10],P0[11],P0[12],P0[13], pw1[0]=PKW(P0,8), pw1[1]=PKW(P0,10), pw1); \
    VRD(5); SBAR(); GAPA(C1=__builtin_amdgcn_mfma_f32_32x32x16_bf16(kf[3],qr[1],C1,0,0,0),   P0[14],P0[15],P1[0],P1[1],   pw1[2]=PKW(P0,12),pw1[3]=PKW(P0,14), pw1); \
    VRD(2); SBAR(); GAPA(C0=__builtin_amdgcn_mfma_f32_32x32x16_bf16(kf[4],qr[2],C0,0,0,0),   P1[2],P1[3],P1[4],P1[5],     pw2[0]=PKW(P1,0), pw2[1]=PKW(P1,2), pw2); \
    VRD(6); SBAR(); GAPA(C1=__builtin_amdgcn_mfma_f32_32x32x16_bf16(kf[5],qr[2],C1,0,0,0),   P1[6],P1[7],P1[8],P1[9],     pw2[2]=PKW(P1,4), pw2[3]=PKW(P1,6), pw2); \
    VRD(3); SBAR(); GAPA(C0=__builtin_amdgcn_mfma_f32_32x32x16_bf16(kf[6],qr[3],C0,0,0,0),   P1[10],P1[11],P1[12],P1[13], pw3[0]=PKW(P1,8), pw3[1]=PKW(P1,10), pw3); \
    VRD(7); SBAR(); GAPA(C1=__builtin_amdgcn_mfma_f32_32x32x16_bf16(kf[7],qr[3],C1,0,0,0),   P1[14],P1[15],0.f,0.f,       pw3[2]=PKW(P1,12),pw3[3]=PKW(P1,14), pw3); \
    l_reg+=sacc; \
    if(GK){DMA_K((t)+3,sl_cur);} if(GV){DMA_V((t)+1,sl_next);} \
    CMASK(C0,C1,t); \
    { float a=MX3(C0[0],C0[1],C1[0]),b=MX3(C0[2],C0[3],C1[1]); a=MX3(a,C1[2],C1[3]); \
      _Pragma("unroll") for(int r=4;r<16;r+=4){a=MX3(a,C0[r],C0[r+1]);b=MX3(b,C0[r+2],C0[r+3]);a=MX3(a,C1[r],C1[r+1]);b=MX3(b,C1[r+2],C1[r+3]);} \
      float rm=__builtin_fmaxf(a,b); { auto rr=__builtin_amdgcn_permlane32_swap(__float_as_uint(rm),__float_as_uint(rm),false,false); rm=__builtin_fmaxf(__uint_as_float(rr[0]),__uint_as_float(rr[1])); } \
      resc=false; \
      if(__builtin_expect(__any(rm>(float)THRL),0)){ const float dl=__builtin_fmaxf(rm,0.f); mhat+=dl; \
        _Pragma("unroll") for(int r=0;r<16;++r){C0[r]-=dl;C1[r]-=dl;} \
        _Pragma("unroll") for(int r=0;r<16;++r)negm[r]=-mhat; asm volatile("":"+v"(negm)); \
        const float f=__builtin_amdgcn_exp2f(-dl); l_reg*=f; if(hi==0)wsf[r32]=f; resc=true; } } \
    SBAR(); \
    GAPB(o[0]=__builtin_amdgcn_mfma_f32_32x32x16_bf16(PAF(0),VFR(0),o[0],0,0,0), C0,0); \
    GAPB(o[1]=__builtin_amdgcn_mfma_f32_32x32x16_bf16(PAF(0),VFR(4),o[1],0,0,0), C0,4); \
    KRD(GL,0); GAPB(o[0]=__builtin_amdgcn_mfma_f32_32x32x16_bf16(PAF(1),VFR(1),o[0],0,0,0), C0,8); \
    KRD(GL,1); GAPB(o[1]=__builtin_amdgcn_mfma_f32_32x32x16_bf16(PAF(1),VFR(5),o[1],0,0,0), C0,12); \
    KRD(GL,2); GAPB(o[0]=__builtin_amdgcn_mfma_f32_32x32x16_bf16(PAF(2),VFR(2),o[0],0,0,0), C1,0); \
    KRD(GL,3); GAPB(o[1]=__builtin_amdgcn_mfma_f32_32x32x16_bf16(PAF(2),VFR(6),o[1],0,0,0), C1,4); \
    GAPB(o[0]=__builtin_amdgcn_mfma_f32_32x32x16_bf16(PAF(3),VFR(3),o[0],0,0,0), C1,8); \
    GAPB(o[1]=__builtin_amdgcn_mfma_f32_32x32x16_bf16(PAF(3),VFR(7),o[1],0,0,0), C1,12); \
    }while(0)
  int t=1;
  for(;t+5<NT;t+=2){
    STEP(pB0,pB1,pA0,pA1,t,true,true,true);     WAIT_BAR(2); RESC(); ROT();
    STEP(pA0,pA1,pB0,pB1,t+1,true,true,true);   WAIT_BAR(2); RESC(); ROT();
  }
  #define ENDW(tt) do{ if((tt)+3<NT){WAIT_BAR(2);} else if((tt)+2<NT){WAIT_BAR(1);} else {WAIT_BAR(0);} }while(0)
  for(;t+1<NT;t+=2){
    STEP(pB0,pB1,pA0,pA1,t,(t+3<NT),(t+1<NT),(t+1<NT));       ENDW(t);   RESC(); ROT();
    STEP(pA0,pA1,pB0,pB1,t+1,(t+4<NT),(t+2<NT),(t+2<NT));     ENDW(t+1); RESC(); ROT();
  }
  STEP(pB0,pB1,pA0,pA1,NT-1,false,false,false); RESC();
  { float sacc=pB0[0]+pB0[1]; _Pragma("unroll") for(int r=2;r<16;++r)sacc+=pB0[r]; _Pragma("unroll") for(int r=0;r<16;++r)sacc+=pB1[r]; l_reg+=sacc;
    pw0=(u32x4){PKW(pB0,0),PKW(pB0,2),PKW(pB0,4),PKW(pB0,6)};pw1=(u32x4){PKW(pB0,8),PKW(pB0,10),PKW(pB0,12),PKW(pB0,14)};pw2=(u32x4){PKW(pB1,0),PKW(pB1,2),PKW(pB1,4),PKW(pB1,6)};pw3=(u32x4){PKW(pB1,8),PKW(pB1,10),PKW(pB1,12),PKW(pB1,14)};
    SBAR(); pv(o,vb0+sl_cur,PAF(0),PAF(1),PAF(2),PAF(3)); }
  #undef PKW
  #undef PAF
  #undef VFR
  #undef PIN
  #undef MX3
  #undef GAPA
  #undef GAPB
  #undef EX
  #undef VRD
  #undef KRD
  #undef STEP
  #undef ENDW
  {auto rr=__builtin_amdgcn_permlane32_swap(__float_as_uint(l_reg),__float_as_uint(l_reg),false,false);l_reg=__uint_as_float(rr[0])+__uint_as_float(rr[1]);}
  if(hi==0)wsf[32+r32]=l_reg;asm volatile("s_waitcnt lgkmcnt(0)":::"memory");
  float rli[16];
  #pragma unroll
  for(int r=0;r<16;++r)rli[r]=__builtin_amdgcn_rcpf(wsf[32+crow(r,hi)]);
  bf16*Ow=O0+(long)(wid*QBLK)*OP;
  { bf16*stg=(bf16*)(shm+LDS_OST)+wid*2048;
    #pragma unroll
    for(int r=0;r<16;++r){const int orow=crow(r,hi);
      #pragma unroll
      for(int d0=0;d0<2;++d0)stg[orow*64+d0*32+r32]=__float2bfloat16(o[d0][r]*rli[r]);}
    asm volatile("s_waitcnt lgkmcnt(0)":::"memory");
    #pragma unroll
    for(int i=0;i<4;++i){const int row=i*8+(lane>>3),ch=lane&7; const u32x4 v=*(const u32x4*)(stg+row*64+ch*8); ATTN_STORE16(Ow+(long)row*OP+ch*8,v);} }
  asm volatile("s_waitcnt lgkmcnt(0)\n\ts_barrier":::"memory");
  #undef DMA_K
  #undef DMA_V
  #undef CMASK
  #undef START
  #undef RESC
  #undef ROT
}
constexpr int ATTN_LDS_BYTES=LDS_BYTES;
#undef SBAR
#undef WAIT_BAR
}

constexpr int DM = 1024, BATCH = 8, SEQ = 4096, DEPTH = 4, CTXL = 256, DFF = 2816;
constexpr int MX = BATCH * SEQ, MC = BATCH * CTXL, MALL = MX + MC;
constexpr int INW = 2080, INWP = 2304, KVLEN = CTXL + SEQ, NCH = KVLEN / 64;
constexpr float EPS = 1e-6f;
constexpr float QSCALE = 0.125f * 1.4426950408889634f;
constexpr int PC_CA = 0, PC_CG = 256, PC_GQ = 512, PC_GK = 640, PC_GV = 768, PC_GR = 1024, PC_GF = 1280, PC_AQ = 1312, PC_AK = 1824;
constexpr size_t MiB = 1u << 20;
constexpr size_t WS_W1T = 0, WS_W2T = 88 * MiB, WS_WINT = 132 * MiB, WS_WOT = 150 * MiB, WS_MOD = 158 * MiB, WS_XN = 160 * MiB, WS_CAT = 228 * MiB,
                 WS_HP = 296 * MiB, WS_Q = 483 * MiB, WS_K = 517 * MiB, WS_V = 526 * MiB, WS_CTXR = 535 * MiB, WS_GDS = 543 * MiB, WS_GDEC = 577 * MiB, WS_CTL = 578 * MiB, WS_SSQ = 579 * MiB, WS_SW = 581 * MiB, WS_END = 584 * MiB;
constexpr size_t W1T_SZ = (size_t)2 * DFF * DM, W2T_SZ = (size_t)DM * DFF, WINT_SZ = (size_t)INWP * DM, WOT_SZ = (size_t)DM * DM;
static_assert(8 * W1T_SZ * 2 <= WS_W2T - WS_W1T && 8 * W2T_SZ * 2 <= WS_WINT - WS_W2T && 4 * WINT_SZ * 2 <= WS_WOT - WS_WINT && 4 * WOT_SZ * 2 <= WS_MOD - WS_WOT, "ws map W");
static_assert((size_t)MALL * DM * 2 <= WS_CAT - WS_XN && (size_t)MALL * DM * 2 <= WS_HP - WS_CAT && (size_t)MALL * DFF * 2 <= WS_Q - WS_HP && (size_t)MALL * 512 * 2 <= WS_K - WS_Q, "ws map act");
static_assert((size_t)BATCH * KVLEN * 128 * 2 <= WS_V - WS_K && (size_t)MC * DM * 4 <= WS_GDS - WS_CTXR && (size_t)BATCH * 2 * NCH * 4 * 2048 * 4 <= WS_GDEC - WS_GDS, "ws map 2");
constexpr int LDS_BYTES = 147456;
constexpr int NPH_LAYER = 9, NPHASES = 2 + DEPTH * NPH_LAYER;
constexpr int SWN = 2 * DFF;
static_assert((size_t)DEPTH * 3 * MALL * 4 <= WS_SW - WS_SSQ && (size_t)DEPTH * 3 * 9 * SWN * 4 <= WS_END - WS_SW, "ws map 3");

typedef unsigned short bf16_t;
typedef float f32x4 __attribute__((ext_vector_type(4)));
typedef unsigned u32x4 __attribute__((ext_vector_type(4)));
typedef unsigned u32x2 __attribute__((ext_vector_type(2)));
typedef float f32x2v __attribute__((ext_vector_type(2)));
#define LDSP __attribute__((address_space(3)))
#define LDS_WAIT() asm volatile("s_waitcnt lgkmcnt(0)" ::: "memory")
__device__ __forceinline__ unsigned pk2(float lo, float hi) { return pg8::cvt_pk_bf16(lo, hi); }
__device__ __forceinline__ float bflo(unsigned w) { return __uint_as_float(w << 16); }
__device__ __forceinline__ float bfhi(unsigned w) { return __uint_as_float(w & 0xffff0000u); }
__device__ __forceinline__ void unpack8(const u32x4 r, float (&x)[8]) { x[0] = bflo(r.x); x[1] = bfhi(r.x); x[2] = bflo(r.y); x[3] = bfhi(r.y); x[4] = bflo(r.z); x[5] = bfhi(r.z); x[6] = bflo(r.w); x[7] = bfhi(r.w); }
__device__ __forceinline__ u32x4 pack8(const float (&x)[8]) { u32x4 w; w.x = pk2(x[0], x[1]); w.y = pk2(x[2], x[3]); w.z = pk2(x[4], x[5]); w.w = pk2(x[6], x[7]); return w; }
template <int CTRL> __device__ __forceinline__ float dpp_mov(float v) { return __int_as_float(__builtin_amdgcn_update_dpp(0, __float_as_int(v), CTRL, 0xf, 0xf, false)); }
template <int X> __device__ __forceinline__ float swz_xor(float v) {
    if constexpr (X == 1) return dpp_mov<0xB1>(v);
    else if constexpr (X == 2) return dpp_mov<0x4E>(v);
    else return __int_as_float(__builtin_amdgcn_ds_swizzle(__float_as_int(v), 0x1f | (X << 10)));
}
__device__ __forceinline__ float sum8(float v)  { v += dpp_mov<0xB1>(v); v += dpp_mov<0x4E>(v); v += dpp_mov<0x141>(v); return v; }
__device__ __forceinline__ float sum16(float v) { v = sum8(v); v += dpp_mov<0x140>(v); return v; }
__device__ __forceinline__ float wave_sum(float v) {
    v = sum16(v); v += swz_xor<16>(v);
    auto rr = __builtin_amdgcn_permlane32_swap(__float_as_uint(v), __float_as_uint(v), false, false);
    return __uint_as_float(rr[0]) + __uint_as_float(rr[1]);
}
__device__ __forceinline__ float sigm(float v) { return __builtin_amdgcn_rcpf(1.0f + __expf(-v)); }

struct Args { const float* in[20]; float* out; unsigned char* ws; int ph_lo, ph_hi; };
typedef const __attribute__((address_space(4))) Args* KA;
enum { I_X = 0, I_C, I_CTX, I_CCTX, I_WADA, I_BADA, I_GNORM, I_WFI, I_WFO, I_WIN, I_WOUT, I_WDW, I_BDW, I_CNG, I_CNB, I_WGG, I_BGG, I_GLAG, I_QNG, I_KNG };

__device__ __forceinline__ void transpose_item(const float* W, int K, int N, bf16_t* WT, int kb, int nsrc, int ndst, LDSP float* scr, int lane) {
    const int k0 = 64 * kb;
#pragma unroll 8
    for (int i = 0; i < 32; ++i) { const int kk = 2 * i + (lane >> 5); scr[kk * 33 + (lane & 31)] = W[(size_t)(k0 + kk) * N + nsrc + (lane & 31)]; }
    LDS_WAIT();
    const int c = lane & 7;
#pragma unroll
    for (int j = 0; j < 4; ++j) { const int n = (lane >> 3) + 8 * j; const LDSP float* s = scr + (8 * c) * 33 + n;
        u32x4 o; o.x = pk2(s[0 * 33], s[1 * 33]); o.y = pk2(s[2 * 33], s[3 * 33]); o.z = pk2(s[4 * 33], s[5 * 33]); o.w = pk2(s[6 * 33], s[7 * 33]);
        *(u32x4*)(WT + (size_t)(ndst + n) * K + k0 + 8 * c) = o; }
    LDS_WAIT();
}
__device__ __forceinline__ void phase0(KA a, LDSP unsigned char* lds, int tid, int lane, int wave, int bid, int G) {
    unsigned char* ws = a->ws;
    LDSP float* scr = (LDSP float*)(lds + wave * 8704);
    const int gw = bid * 8 + wave, NGW = G * 8;
    constexpr int I1 = 16 * 176, I2 = 44 * 32, I3 = 16 * 65, I4 = 16 * 32, LI = 2 * I1 + 2 * I2 + I3 + I4;
    for (int it = gw; it < DEPTH * LI; it += NGW) {
        const int l = it / LI; int r = it % LI;
        if (r < 2 * I1) { const int f = r / I1, rr = r % I1, kb = rr / 176, nb = rr % 176, nsrc = nb * 32; const bool isu = nsrc >= DFF; const int j = isu ? nsrc - DFF : nsrc;
            transpose_item(a->in[I_WFI] + (size_t)(l * 2 + f) * DM * 2 * DFF, DM, 2 * DFF, (bf16_t*)(ws + WS_W1T) + (size_t)(l * 2 + f) * W1T_SZ, kb, nsrc, 256 * (j >> 7) + (isu ? 128 : 0) + (j & 127), scr, lane); continue; }
        r -= 2 * I1;
        if (r < 2 * I2) { const int f = r / I2, rr = r % I2, kb = rr / 32, nb = rr % 32;
            transpose_item(a->in[I_WFO] + (size_t)(l * 2 + f) * DFF * DM, DFF, DM, (bf16_t*)(ws + WS_W2T) + (size_t)(l * 2 + f) * W2T_SZ, kb, nb * 32, nb * 32, scr, lane); continue; }
        r -= 2 * I2;
        if (r < I3) { const int kb = r / 65, nb = r % 65;
            transpose_item(a->in[I_WIN] + (size_t)l * DM * INW, DM, INW, (bf16_t*)(ws + WS_WINT) + (size_t)l * WINT_SZ, kb, nb * 32, nb * 32, scr, lane); continue; }
        r -= I3;
        { const int kb = r / 32, nb = r % 32;
            transpose_item(a->in[I_WOUT] + (size_t)l * DM * DM, DM, DM, (bf16_t*)(ws + WS_WOT) + (size_t)l * WOT_SZ, kb, nb * 32, nb * 32, scr, lane); }
    }
    { constexpr int PV = (INWP - INW) * DM * 2 / 16;
        for (int i = bid * 512 + tid; i < DEPTH * PV; i += G * 512) { const int l = i / PV, r = i % PV;
            ((u32x4*)((bf16_t*)(ws + WS_WINT) + (size_t)l * WINT_SZ + (size_t)INW * DM))[r] = (u32x4){0u, 0u, 0u, 0u}; } }
    { float* SSQ = (float*)(ws + WS_SSQ); for (int i = bid * 512 + tid; i < DEPTH * 3 * MALL; i += G * 512) SSQ[i] = 0.f; }
    __syncthreads();
    LDSP float* S = (LDSP float*)(lds + 69632);
    LDSP float* red = (LDSP float*)(lds + 106496);
    for (int i = tid; i < 9 * 1024; i += 512) { const int r = i >> 10, k = i & 1023; const float cv = r < 8 ? a->in[I_C][r * 1024 + k] : a->in[I_CCTX][k]; S[i] = cv * sigm(cv); }
    __syncthreads();
    float* MOD = (float*)(ws + WS_MOD);
    for (int it = bid; it < DEPTH * 144; it += G) {
        const int l = it / 144, n0 = (it % 144) * 64;
        const float* Wp = a->in[I_WADA] + (size_t)l * DM * 9216 + n0 + lane;
        float acc[9];
#pragma unroll
        for (int r = 0; r < 9; ++r) acc[r] = 0.f;
#pragma unroll 8
        for (int kk = 0; kk < 128; ++kk) { const int k = wave * 128 + kk; const float w = Wp[(size_t)k * 9216];
#pragma unroll
            for (int r = 0; r < 9; ++r) acc[r] += S[r * 1024 + k] * w; }
#pragma unroll
        for (int r = 0; r < 9; ++r) red[(wave * 9 + r) * 64 + lane] = acc[r];
        __syncthreads();
        for (int o = tid; o < 576; o += 512) { const int r = o >> 6, ln = o & 63; float s = 0.f;
#pragma unroll
            for (int w = 0; w < 8; ++w) s += red[(w * 9 + r) * 64 + ln];
            MOD[(size_t)(l * 9 + r) * 9216 + n0 + ln] = s + a->in[I_BADA][l * 9216 + n0 + ln]; }
        __syncthreads();
    }
}
__device__ __forceinline__ void phase1(KA a, LDSP unsigned char* lds, int tid, int lane, int wave, int bid, int G) {
    const float* MOD = (const float*)(a->ws + WS_MOD); bf16_t* XN = (bf16_t*)(a->ws + WS_XN); float* SSQ = (float*)(a->ws + WS_SSQ); float* SW = (float*)(a->ws + WS_SW);
    const float* g = a->in[I_GNORM];
    f32x4 nv[4];
    { const int m0 = bid * 8 + wave; if (m0 < MALL) { const float* xr0 = m0 >= MX ? a->in[I_CTX] + (size_t)(m0 - MX) * DM : a->in[I_X] + (size_t)m0 * DM;
#pragma unroll
        for (int q = 0; q < 4; ++q) nv[q] = ((const f32x4*)xr0)[lane + 64 * q]; } }
    for (int m = bid * 8 + wave; m < MALL; m += G * 8) {
        const bool isc = m >= MX;
        const float* md = MOD + (size_t)(isc ? 8 : (m >> 12)) * 9216;
        f32x4 v[4]; float ss = 0.f;
#pragma unroll
        for (int q = 0; q < 4; ++q) { v[q] = nv[q]; ss += (v[q].x * v[q].x + v[q].y * v[q].y) + (v[q].z * v[q].z + v[q].w * v[q].w); }
        { const int mn = m + G * 8; if (mn < MALL) { const float* xrn = mn >= MX ? a->in[I_CTX] + (size_t)(mn - MX) * DM : a->in[I_X] + (size_t)mn * DM;
#pragma unroll
            for (int q = 0; q < 4; ++q) nv[q] = ((const f32x4*)xrn)[lane + 64 * q]; } }
        ss = wave_sum(ss);
        if (lane == 0) SSQ[m] = ss;
#pragma unroll
        for (int q = 0; q < 4; ++q) { const int col = 4 * lane + 256 * q;
            const f32x4 y = v[q] * *(const f32x4*)(g + col) * (*(const f32x4*)(md + 1024 + col) + 1.0f);
            u32x2 o; o.x = pk2(y.x, y.y); o.y = pk2(y.z, y.w);
            *(u32x2*)(XN + (size_t)m * DM + col) = o;
            typedef _Float16 h16x4 __attribute__((ext_vector_type(4)));
            *(h16x4*)((_Float16*)(a->ws + WS_CAT) + (size_t)m * DM + col) = __builtin_convertvector(v[q], h16x4); }
    }
    LDSP float* SH = (LDSP float*)lds;
    constexpr int RPL = 2 * DFF + INWP + 2 * DFF;
#pragma unroll 1
    for (int l = 0; l < DEPTH; ++l) {
        __syncthreads();
        for (int i = tid; i < 27 * 256; i += 512) { const int v = i >> 8, j = v / 9, bi = v % 9, c4 = (i & 255) * 4; *(LDSP f32x4*)(SH + v * 1024 + c4) = *(const f32x4*)(MOD + (size_t)(l * 9 + bi) * 9216 + (3 * j) * 1024 + c4); }
        __syncthreads();
        const bf16_t* w0b = (const bf16_t*)(a->ws + WS_W1T) + (size_t)(l * 2) * W1T_SZ; const bf16_t* w1b = (const bf16_t*)(a->ws + WS_WINT) + (size_t)l * WINT_SZ; const bf16_t* w2b = (const bf16_t*)(a->ws + WS_W1T) + (size_t)(l * 2 + 1) * W1T_SZ;
#define SW_ROWPTR(rr) ((rr) < 2 * DFF ? w0b + (size_t)(rr) * DM : ((rr) < 2 * DFF + INWP ? w1b + (size_t)((rr) - 2 * DFF) * DM : w2b + (size_t)((rr) - 2 * DFF - INWP) * DM))
        u32x4 nx0 = {0u, 0u, 0u, 0u}, nx1 = {0u, 0u, 0u, 0u};
        { const int r0 = bid * 8 + wave; if (r0 < RPL) { const bf16_t* p = SW_ROWPTR(r0); nx0 = *(const u32x4*)(p + lane * 8); nx1 = *(const u32x4*)(p + 512 + lane * 8); } }
#pragma unroll 1
        for (int r = bid * 8 + wave; r < RPL; r += G * 8) {
            float w0[8], w1[8]; unpack8(nx0, w0); unpack8(nx1, w1);
            { const int rn = r + G * 8; if (rn < RPL) { const bf16_t* p = SW_ROWPTR(rn); nx0 = *(const u32x4*)(p + lane * 8); nx1 = *(const u32x4*)(p + 512 + lane * 8); } }
            const int j = r < 2 * DFF ? 0 : (r < 2 * DFF + INWP ? 1 : 2), rj = r - (j == 0 ? 0 : (j == 1 ? 2 * DFF : 2 * DFF + INWP));
#pragma unroll
            for (int bi = 0; bi < 9; ++bi) { LDSP const float* sh = SH + (j * 9 + bi) * 1024 + lane * 8;
                const f32x4 s0 = *(LDSP const f32x4*)(sh), s1 = *(LDSP const f32x4*)(sh + 4), s2 = *(LDSP const f32x4*)(sh + 512), s3 = *(LDSP const f32x4*)(sh + 516);
                float d = (w0[0] * s0.x + w0[1] * s0.y) + (w0[2] * s0.z + w0[3] * s0.w) + (w0[4] * s1.x + w0[5] * s1.y) + (w0[6] * s1.z + w0[7] * s1.w)
                        + (w1[0] * s2.x + w1[1] * s2.y) + (w1[2] * s2.z + w1[3] * s2.w) + (w1[4] * s3.x + w1[5] * s3.y) + (w1[6] * s3.z + w1[7] * s3.w);
                d = wave_sum(d);
                if (lane == 0) SW[((size_t)(l * 3 + j) * 9 + bi) * SWN + rj] = d; } }
#undef SW_ROWPTR
    }
    __syncthreads();
}
__device__ __forceinline__ void prep_phase(KA a, LDSP unsigned char* lds, int l, int tid, int lane, int wave, int bid, int G) {
    LDSP f32x2v* CS = (LDSP f32x2v*)(lds);
    for (int i = tid; i < 1024; i += 512) { const int pos = i >> 4, f = i & 15;
        const float freq = exp2f(-(float)f * (13.287712379549449f / 16.0f)); const float ang = (float)pos * freq;
        float rev = ang * 0.15915494309189535f; rev -= floorf(rev);
        CS[i] = (f32x2v){__builtin_amdgcn_cosf(rev), __builtin_amdgcn_sinf(rev)}; }
    __syncthreads();
    const bf16_t* P = (const bf16_t*)(a->ws + WS_HP); bf16_t* Q = (bf16_t*)(a->ws + WS_Q); bf16_t* Kb = (bf16_t*)(a->ws + WS_K); bf16_t* Vb = (bf16_t*)(a->ws + WS_V);
    const int sub = lane & 7, axis = sub >> 2, half = (sub >> 1) & 1, f0 = (sub & 1) * 8;
    float qg[8], kg[8];
#pragma unroll
    for (int e = 0; e < 8; ++e) { qg[e] = a->in[I_QNG][l * 64 + sub * 8 + e]; kg[e] = a->in[I_KNG][l * 64 + sub * 8 + e]; }
    u32x4 nq = {0u, 0u, 0u, 0u}, nk_ = {0u, 0u, 0u, 0u};
    { const int m0 = bid * 8 + wave; if (m0 < MALL) { nq = *(const u32x4*)(P + (size_t)m0 * INWP + PC_AQ + lane * 8); nk_ = *(const u32x4*)(P + (size_t)m0 * INWP + PC_AK + (lane & 31) * 8); } }
    for (int m = bid * 8 + wave; m < MALL; m += G * 8) {
        const u32x4 rawq = nq, rawk = nk_;
        asm volatile("" :: "v"(rawq), "v"(rawk) : "memory");
        { const int mn = m + G * 8; if (mn < MALL) { nq = *(const u32x4*)(P + (size_t)mn * INWP + PC_AQ + lane * 8); nk_ = *(const u32x4*)(P + (size_t)mn * INWP + PC_AK + (lane & 31) * 8); } }
        asm volatile("" ::: "memory");
        const bool lat = m < MX;
        const int b = lat ? (m >> 12) : ((m - MX) >> 8), t = lat ? (m & 4095) : 0, pos = lat ? (CTXL + t) : ((m - MX) & 255);
        const int p = axis ? (t & 63) : (t >> 6);
        const bf16_t* pr = P + (size_t)m * INWP;
        float x[8], y[8];
        { const u32x4 raw = rawq; unpack8(raw, x);
            float ss = 0.f;
#pragma unroll
            for (int e = 0; e < 8; ++e) ss += x[e] * x[e];
            ss = sum8(ss);
            const float rstd = 1.0f / sqrtf(ss * (1.0f / 64.0f) + EPS);
#pragma unroll
            for (int e = 0; e < 8; ++e) y[e] = x[e] * rstd * qg[e];
            if (lat) {
#pragma unroll
                for (int e = 0; e < 8; ++e) { const float o = swz_xor<2>(y[e]); const f32x2v cs = CS[p * 16 + f0 + e]; x[e] = half ? (y[e] * cs.x + o * cs.y) : (y[e] * cs.x - o * cs.y); }
            } else {
#pragma unroll
                for (int e = 0; e < 8; ++e) x[e] = y[e];
            }
#pragma unroll
            for (int e = 0; e < 8; ++e) x[e] *= QSCALE;
            *(u32x4*)(Q + (size_t)m * 512 + lane * 8) = pack8(x); }
        { const u32x4 raw = rawk; unpack8(raw, x);
            float ss = 0.f;
#pragma unroll
            for (int e = 0; e < 8; ++e) ss += x[e] * x[e];
            ss = sum8(ss);
            const float rstd = 1.0f / sqrtf(ss * (1.0f / 64.0f) + EPS);
#pragma unroll
            for (int e = 0; e < 8; ++e) y[e] = x[e] * rstd * kg[e];
            if (lat) {
#pragma unroll
                for (int e = 0; e < 8; ++e) { const float o = swz_xor<2>(y[e]); const f32x2v cs = CS[p * 16 + f0 + e]; x[e] = half ? (y[e] * cs.x + o * cs.y) : (y[e] * cs.x - o * cs.y); }
            } else {
#pragma unroll
                for (int e = 0; e < 8; ++e) x[e] = y[e];
            }
            const size_t kvrow = ((size_t)b * KVLEN + pos) * 128;
            if (lane < 16) *(u32x4*)(Kb + kvrow + lane * 8) = pack8(x);
            else if (lane < 32) *(u32x4*)(Vb + kvrow + (lane - 16) * 8) = raw; }
    }
    __syncthreads();
}
__device__ __forceinline__ void conv_phase(KA a, LDSP unsigned char* lds, int l, bool last, int tid, int lane, int bid, int G) {
    LDSP float* hs = (LDSP float*)lds;
    LDSP bf16_t* os = (LDSP bf16_t*)(lds + 94 * 256 * 4);
    const bf16_t* P = (const bf16_t*)(a->ws + WS_HP); bf16_t* CAT = (bf16_t*)a->out;
    const int c = tid & 255, hf = tid >> 8;
    float w[31];
#pragma unroll
    for (int k = 0; k < 31; ++k) w[k] = a->in[I_WDW][(size_t)(l * 31 + k) * 256 + c];
    const float bias = a->in[I_BDW][l * 256 + c], gg = a->in[I_CNG][l * 256 + c], bb = a->in[I_CNB][l * 256 + c];
    const int nitems = last ? 512 : 544;
    for (int it = bid; it < nitems; it += G) {
        int base, len, t0;
        if (it < 512) { base = (it >> 6) * SEQ; len = SEQ; t0 = (it & 63) * 64; } else { const int i2 = it - 512; base = MX + (i2 >> 2) * CTXL; len = CTXL; t0 = (i2 & 3) * 64; }
        for (int rr = tid >> 5; rr < 94; rr += 16) { const int t = t0 - 15 + rr, c8 = (tid & 31) * 8;
            float h[8];
            if (t >= 0 && t < len) { const bf16_t* pr = P + (size_t)(base + t) * INWP + c8; float av[8], gv[8];
                unpack8(*(const u32x4*)(pr + PC_CA), av); unpack8(*(const u32x4*)(pr + PC_CG), gv);
#pragma unroll
                for (int e = 0; e < 8; ++e) h[e] = av[e] * sigm(gv[e]);
            } else {
#pragma unroll
                for (int e = 0; e < 8; ++e) h[e] = 0.f;
            }
            *(LDSP f32x4*)(hs + rr * 256 + c8) = (f32x4){h[0], h[1], h[2], h[3]}; *(LDSP f32x4*)(hs + rr * 256 + c8 + 4) = (f32x4){h[4], h[5], h[6], h[7]}; }
        __syncthreads();
#pragma unroll 1
        for (int i0 = 0; i0 < 32; i0 += 4) { const int ib = hf * 32 + i0;
            float xw[34];
#pragma unroll
            for (int k = 0; k < 34; ++k) xw[k] = hs[(ib + k) * 256 + c];
            float acc[4], mean[4], var[4];
#pragma unroll
            for (int t = 0; t < 4; ++t) { float s_ = bias;
#pragma unroll
                for (int k = 0; k < 31; ++k) s_ += w[k] * xw[t + k];
                acc[t] = s_; mean[t] = s_; }
#pragma unroll
            for (int t = 0; t < 4; ++t) mean[t] = sum16(mean[t]);
#pragma unroll
            for (int t = 0; t < 4; ++t) mean[t] += swz_xor<16>(mean[t]);
#pragma unroll
            for (int t = 0; t < 4; ++t) { auto rr = __builtin_amdgcn_permlane32_swap(__float_as_uint(mean[t]), __float_as_uint(mean[t]), false, false);
                mean[t] = (__uint_as_float(rr[0]) + __uint_as_float(rr[1])) * (1.0f / 64.0f); acc[t] -= mean[t]; var[t] = acc[t] * acc[t]; }
#pragma unroll
            for (int t = 0; t < 4; ++t) var[t] = sum16(var[t]);
#pragma unroll
            for (int t = 0; t < 4; ++t) var[t] += swz_xor<16>(var[t]);
#pragma unroll
            for (int t = 0; t < 4; ++t) { auto rr = __builtin_amdgcn_permlane32_swap(__float_as_uint(var[t]), __float_as_uint(var[t]), false, false);
                const float vv = (__uint_as_float(rr[0]) + __uint_as_float(rr[1])) * (1.0f / 64.0f);
                const float y = acc[t] * __builtin_amdgcn_rsqf(vv + EPS) * gg + bb;
                const float o = y * sigm(y);
                os[(ib + t) * 256 + c] = (bf16_t)(pk2(o, 0.f) & 0xffffu); } }
        __syncthreads();
        for (int q = tid; q < 2048; q += 512) { const int row = q >> 5, c8 = (q & 31) * 8;
            *(u32x4*)(CAT + (size_t)(base + t0 + row) * DM + c8) = *(const LDSP u32x4*)(os + row * 256 + c8); }
        __syncthreads();
    }
}
typedef short gbf16x8 __attribute__((ext_vector_type(8)));
constexpr int GB_WG = 106496, GB_BG = 106496 + 16384;
constexpr int GB_Q = 0, GB_K = 8448, GB_GF = 16896, GB_GB = 20992, GB_VT = 25088, GB_S0T = 34304, GB_QE = 42496, GB_KE = 50688, GB_KENDT = 58880, GB_ATT = 68096, GB_TOT = 86528, GB_O = 88576, GB_END = 105984;
constexpr int VTP = 72, ATP = 72, KTP = 72, OP_ = 68;
static_assert(GB_END <= 131072 && GB_VT + 64 * VTP * 2 == GB_S0T && GB_ATT + 2 * 64 * ATP * 2 == GB_TOT && GB_O + 64 * OP_ * 4 == GB_END, "gla lds");
__device__ __forceinline__ int vt_chunk(int v, int cc) { return v * (VTP * 2) + ((cc ^ ((v >> 3) & 7)) << 4); }
__device__ __forceinline__ int gla_row(int b, int c, int i) { return c < 4 ? MX + b * CTXL + c * 64 + i : b * SEQ + (c - 4) * 64 + i; }
__device__ __forceinline__ void st_bf16(LDSP unsigned char* base, int byteoff, float v) { *(LDSP bf16_t*)(base + byteoff) = (bf16_t)(pk2(v, 0.f) & 0xffffu); }
struct GlaRegs { u32x4 qk, gt, vv, rg; f32x4 s0[2], gg[2]; };
template <bool G3> __device__ __forceinline__ void gla_issue(KA a, GlaRegs& R, const float* ggb, int b, int c, int h, int tid) {
    const bf16_t* P = (const bf16_t*)(a->ws + WS_HP);
    { const int i = (tid & 255) >> 2, part = tid & 3; const bf16_t* pr = P + (size_t)gla_row(b, c, i) * INWP;
        R.qk = (u32x4){0u, 0u, 0u, 0u};
        if (G3 || tid >= 256) R.qk = *(const u32x4*)(pr + (tid < 256 ? PC_GQ : PC_GK) + h * 32 + part * 8);
        R.gt = *(const u32x4*)(pr + PC_GF + part * 8); }
    { const int j = tid >> 3, part = tid & 7; R.vv = *(const u32x4*)(P + (size_t)gla_row(b, c, j) * INWP + PC_GV + h * 64 + part * 8); }
    if (G3) { const float* DS = (const float*)(a->ws + WS_GDS);
#pragma unroll
        for (int dir = 0; dir < 2; ++dir) { const size_t ci = ((size_t)(b * 2 + dir) * NCH + c) * 4 + h; R.s0[dir] = *(const f32x4*)(DS + ci * 2048 + (tid >> 4) * 64 + (tid & 15) * 4); }
        R.rg = *(const u32x4*)(P + (size_t)gla_row(b, c, tid >> 3) * INWP + PC_GR + h * 64 + (tid & 7) * 8);
        R.gg[0] = *(const f32x4*)(ggb + h * 64 + (tid & 7) * 8); R.gg[1] = *(const f32x4*)(ggb + h * 64 + (tid & 7) * 8 + 4); }
}
template <bool G3> __device__ __forceinline__ void gla_stage(KA a, LDSP unsigned char* B, const GlaRegs& R, int l, int b, int c, int h, int tid) {
    LDSP float* Qf = (LDSP float*)(B + GB_Q); LDSP float* Kf = (LDSP float*)(B + GB_K); LDSP float* GF = (LDSP float*)(B + GB_GF); LDSP float* GBk = (LDSP float*)(B + GB_GB);
    { const int i = (tid & 255) >> 2, part = tid & 3;
        float x[8]; unpack8(R.qk, x);
        if (tid < 256) {
            if (G3) {
#pragma unroll
                for (int e = 0; e < 8; ++e) Qf[i * 33 + part * 8 + e] = x[e]; }
            unpack8(R.gt, x);
#pragma unroll
            for (int e = 0; e < 8; ++e) (part < 2 ? GF : GBk)[i * 16 + (part & 1) * 8 + e] = x[e];
        } else {
#pragma unroll
            for (int e = 0; e < 8; ++e) Kf[i * 33 + part * 8 + e] = x[e]; } }
    { const int j = tid >> 3, part = tid & 7; const u32x4 r = R.vv;
        const unsigned w[4] = {r.x, r.y, r.z, r.w};
#pragma unroll
        for (int e = 0; e < 8; ++e) *(LDSP bf16_t*)(B + GB_VT + vt_chunk(part * 8 + e, j >> 3) + (j & 7) * 2) = (bf16_t)((e & 1) ? (w[e >> 1] >> 16) : (w[e >> 1] & 0xffffu)); }
    if (G3) {
#pragma unroll
        for (int dir = 0; dir < 2; ++dir) { const int d = tid >> 4, v4 = (tid & 15) * 4; const f32x4 sv = R.s0[dir];
            st_bf16(B, GB_S0T + dir * 4096 + ((v4 + 0) * 32 + d) * 2, sv.x); st_bf16(B, GB_S0T + dir * 4096 + ((v4 + 1) * 32 + d) * 2, sv.y);
            st_bf16(B, GB_S0T + dir * 4096 + ((v4 + 2) * 32 + d) * 2, sv.z); st_bf16(B, GB_S0T + dir * 4096 + ((v4 + 3) * 32 + d) * 2, sv.w); } }
    __syncthreads();
    const int dir = tid >> 8, seg = (tid >> 5) & 7, d = tid & 31;
    float p[8], qv[8], kv[8];
    { LDSP const float* Wg = (LDSP const float*)(B + GB_WG) + (dir * 16) * 128 + h * 32 + d; const float bg = ((LDSP const float*)(B + GB_BG))[dir * 128 + h * 32 + d];
        float wc[16];
#pragma unroll
        for (int r = 0; r < 16; ++r) wc[r] = Wg[r * 128];
        LDSP const float* gs = dir ? GBk : GF;
#pragma unroll
        for (int r = 0; r < 8; ++r) { const int i = dir ? 63 - (seg * 8 + r) : seg * 8 + r; kv[r] = Kf[i * 33 + d]; qv[r] = G3 ? Qf[i * 33 + d] : 0.f; }
        float run = 0.f;
#pragma unroll
        for (int hb = 0; hb < 2; ++hb) {
            f32x4 gq[4][4];
#pragma unroll
            for (int r = 0; r < 4; ++r) { const int i = dir ? 63 - (seg * 8 + hb * 4 + r) : seg * 8 + hb * 4 + r;
#pragma unroll
                for (int q = 0; q < 4; ++q) gq[r][q] = *(LDSP const f32x4*)(gs + i * 16 + 4 * q); }
#pragma unroll
            for (int r = 0; r < 4; ++r) { float z0 = bg, z1 = 0.f, z2 = 0.f, z3 = 0.f;
#pragma unroll
                for (int q = 0; q < 4; ++q) { z0 += gq[r][q].x * wc[4 * q]; z1 += gq[r][q].y * wc[4 * q + 1]; z2 += gq[r][q].z * wc[4 * q + 2]; z3 += gq[r][q].w * wc[4 * q + 3]; }
                const float z = (z0 + z1) + (z2 + z3);
                const float ls = fminf(z, 0.f) - __logf(1.0f + __expf(-fabsf(z)));
                run += ls * (1.0f / 16.0f); p[hb * 4 + r] = run; } }
        ((LDSP float*)(B + GB_TOT))[(dir * 8 + seg) * 32 + d] = run; }
    __syncthreads();
    float off = 0.f, bl = 0.f;
#pragma unroll
    for (int sg = 0; sg < 8; ++sg) { const float t = ((LDSP const float*)(B + GB_TOT))[(dir * 8 + sg) * 32 + d]; bl += t; off += (sg < seg) ? t : 0.f; }
    float o1[8], o2[8];
#pragma unroll
    for (int r = 0; r < 8; ++r) { const float bc = p[r] + off;
        if (G3) { o1[r] = qv[r] * 0.17677669529663687f * __expf(bc); o2[r] = kv[r] * __expf(-bc); }
        else { o1[r] = kv[r] * __expf(bl - bc); o2[r] = 0.f; } }
#pragma unroll
    for (int r = 0; r < 8; ++r) { const int i = dir ? 63 - (seg * 8 + r) : seg * 8 + r;
        if (G3) { st_bf16(B, GB_QE + dir * 4096 + (i * 32 + d) * 2, o1[r]); st_bf16(B, GB_KE + dir * 4096 + (i * 32 + d) * 2, o2[r]); }
        else st_bf16(B, GB_KENDT + dir * (32 * KTP * 2) + (d * KTP + i) * 2, o1[r]); }
    if (!G3 && seg == 0) ((float*)(a->ws + WS_GDEC))[(((size_t)(b * 2 + dir) * NCH + c) * 4 + h) * 32 + d] = __expf(bl);
    __syncthreads();
}
__device__ __forceinline__ void gla_g1_phase(KA a, LDSP unsigned char* lds, int l, int tid, int bid, int G) {
    float* DS = (float*)(a->ws + WS_GDS);
    const int lane = tid & 63, w = tid >> 6, fr = lane & 15, fq = lane >> 4;
    for (int i = tid; i < 2 * 16 * 128; i += 512) ((LDSP float*)(lds + GB_WG))[i] = a->in[I_WGG][(size_t)l * 2 * 16 * 128 + i];
    if (tid < 256) ((LDSP float*)(lds + GB_BG))[tid] = a->in[I_BGG][l * 256 + tid];
    __syncthreads();
    GlaRegs R, Rn;
    if (bid < BATCH * NCH * 4) gla_issue<false>(a, Rn, nullptr, (bid >> 2) / NCH, (bid >> 2) % NCH, bid & 3, tid);
    for (int it = bid; it < BATCH * NCH * 4; it += G) {
        const int h = it & 3, c = (it >> 2) % NCH, b = (it >> 2) / NCH;
        R = Rn;
        gla_stage<false>(a, lds, R, l, b, c, h, tid);
        asm volatile("" ::: "memory");
        { const int itn = it + G; if (itn < BATCH * NCH * 4) gla_issue<false>(a, Rn, nullptr, (itn >> 2) / NCH, (itn >> 2) % NCH, itn & 3, tid); }
        asm volatile("" ::: "memory");
        const int dir = w >> 2, dt = (w >> 1) & 1;
        const size_t ci = ((size_t)(b * 2 + dir) * NCH + c) * 4 + h;
        gbf16x8 af[2];
#pragma unroll
        for (int sx = 0; sx < 2; ++sx) af[sx] = *(LDSP const gbf16x8*)(lds + GB_KENDT + dir * (32 * KTP * 2) + ((dt * 16 + fr) * KTP + sx * 32 + fq * 8) * 2);
#pragma unroll
        for (int t = 0; t < 2; ++t) { const int vt = (w & 1) * 2 + t; f32x4 acc = {0.f, 0.f, 0.f, 0.f};
#pragma unroll
            for (int sx = 0; sx < 2; ++sx) { const gbf16x8 bf = *(LDSP const gbf16x8*)(lds + GB_VT + vt_chunk(vt * 16 + fr, sx * 4 + fq));
                acc = __builtin_amdgcn_mfma_f32_16x16x32_bf16(af[sx], bf, acc, 0, 0, 0); }
#pragma unroll
            for (int r = 0; r < 4; ++r) DS[ci * 2048 + (size_t)(dt * 16 + fq * 4 + r) * 64 + vt * 16 + fr] = acc[r]; }
        __syncthreads();
    }
}
__device__ __forceinline__ void gla_g2_phase(KA a, int tid, int bid, int G) {
    float* DS = (float*)(a->ws + WS_GDS); const float* DEC = (const float*)(a->ws + WS_GDEC);
    for (int e = bid * 512 + tid; e < BATCH * 2 * 4 * 2048; e += G * 512) {
        const int dv = e & 2047, h = (e >> 11) & 3, dir = (e >> 13) & 1, b = e >> 14, d = dv >> 6;
        float S = 0.f;
#pragma unroll 4
        for (int st = 0; st < NCH; ++st) { const int c = dir ? (st < 4 ? 3 - st : 71 - st) : st;
            const size_t ci = ((size_t)(b * 2 + dir) * NCH + c) * 4 + h;
            const float dsv = DS[ci * 2048 + dv], dec = DEC[ci * 32 + d];
            DS[ci * 2048 + dv] = S; S = dec * S + dsv; }
    }
}
__device__ __forceinline__ void gla_g3_phase(KA a, LDSP unsigned char* lds, int l, bool last, int tid, int bid, int G) {
    const bf16_t* P = (const bf16_t*)(a->ws + WS_HP); bf16_t* CAT = (bf16_t*)a->out;
    const int lane = tid & 63, w = tid >> 6, fr = lane & 15, fq = lane >> 4, it_ = w >> 1;
    for (int i = tid; i < 2 * 16 * 128; i += 512) ((LDSP float*)(lds + GB_WG))[i] = a->in[I_WGG][(size_t)l * 2 * 16 * 128 + i];
    if (tid < 256) ((LDSP float*)(lds + GB_BG))[tid] = a->in[I_BGG][l * 256 + tid];
    __syncthreads();
    const int c_lo = last ? 4 : 0, ncs = NCH - c_lo, nit = BATCH * ncs * 4;
    GlaRegs R, Rn;
    if (bid < nit) gla_issue<true>(a, Rn, a->in[I_GLAG] + (size_t)l * 256, (bid >> 2) / ncs, c_lo + (bid >> 2) % ncs, bid & 3, tid);
    for (int it = bid; it < nit; it += G) {
        const int h = it & 3, c = c_lo + (it >> 2) % ncs, b = (it >> 2) / ncs;
        R = Rn;
        gla_stage<true>(a, lds, R, l, b, c, h, tid);
        asm volatile("" ::: "memory");
        { const int itn = it + G; if (itn < nit) gla_issue<true>(a, Rn, a->in[I_GLAG] + (size_t)l * 256, (itn >> 2) / ncs, c_lo + (itn >> 2) % ncs, itn & 3, tid); }
        asm volatile("" ::: "memory");
        gbf16x8 qf[2], kf[2][2];
#pragma unroll
        for (int dir = 0; dir < 2; ++dir) { qf[dir] = *(LDSP const gbf16x8*)(lds + GB_QE + dir * 4096 + ((it_ * 16 + fr) * 32 + fq * 8) * 2);
#pragma unroll
            for (int t = 0; t < 2; ++t) kf[dir][t] = *(LDSP const gbf16x8*)(lds + GB_KE + dir * 4096 + ((((w & 1) * 2 + t) * 16 + fr) * 32 + fq * 8) * 2); }
        f32x4 s4[2][2];
#pragma unroll
        for (int dir = 0; dir < 2; ++dir)
#pragma unroll
            for (int t = 0; t < 2; ++t) { const f32x4 z = {0.f, 0.f, 0.f, 0.f}; s4[dir][t] = __builtin_amdgcn_mfma_f32_16x16x32_bf16(qf[dir], kf[dir][t], z, 0, 0, 0); }
#pragma unroll
        for (int dir = 0; dir < 2; ++dir)
#pragma unroll
            for (int t = 0; t < 2; ++t) { const int jt = (w & 1) * 2 + t;
#pragma unroll
                for (int r = 0; r < 4; ++r) { const int i = it_ * 16 + fq * 4 + r, j = jt * 16 + fr; const bool keep = dir ? (j >= i) : (j <= i);
                    st_bf16(lds, GB_ATT + dir * (64 * ATP * 2) + (i * ATP + j) * 2, keep ? s4[dir][t][r] : 0.f); } }
        __syncthreads();
        { gbf16x8 af[2][2], bfv[2][2], sf[2][2];
#pragma unroll
            for (int dir = 0; dir < 2; ++dir)
#pragma unroll
                for (int sx = 0; sx < 2; ++sx) af[dir][sx] = *(LDSP const gbf16x8*)(lds + GB_ATT + dir * (64 * ATP * 2) + ((it_ * 16 + fr) * ATP + sx * 32 + fq * 8) * 2);
#pragma unroll
            for (int t = 0; t < 2; ++t) { const int vt = (w & 1) * 2 + t;
#pragma unroll
                for (int sx = 0; sx < 2; ++sx) bfv[t][sx] = *(LDSP const gbf16x8*)(lds + GB_VT + vt_chunk(vt * 16 + fr, sx * 4 + fq));
#pragma unroll
                for (int dir = 0; dir < 2; ++dir) sf[t][dir] = *(LDSP const gbf16x8*)(lds + GB_S0T + dir * 4096 + ((vt * 16 + fr) * 32 + fq * 8) * 2); }
            f32x4 acc[2];
#pragma unroll
            for (int t = 0; t < 2; ++t) { acc[t] = (f32x4){0.f, 0.f, 0.f, 0.f};
#pragma unroll
                for (int dir = 0; dir < 2; ++dir) {
#pragma unroll
                    for (int sx = 0; sx < 2; ++sx) acc[t] = __builtin_amdgcn_mfma_f32_16x16x32_bf16(af[dir][sx], bfv[t][sx], acc[t], 0, 0, 0);
                    acc[t] = __builtin_amdgcn_mfma_f32_16x16x32_bf16(qf[dir], sf[t][dir], acc[t], 0, 0, 0); } }
#pragma unroll
            for (int t = 0; t < 2; ++t) { const int vt = (w & 1) * 2 + t;
#pragma unroll
                for (int r = 0; r < 4; ++r) ((LDSP float*)(lds + GB_O))[(it_ * 16 + fq * 4 + r) * OP_ + vt * 16 + fr] = acc[t][r]; } }
        __syncthreads();
        { const int i = tid >> 3, vg = tid & 7;
            const f32x4 o0 = *(LDSP const f32x4*)(lds + GB_O + (i * OP_ + vg * 8) * 4), o1 = *(LDSP const f32x4*)(lds + GB_O + (i * OP_ + vg * 8 + 4) * 4);
            float ss = (o0.x * o0.x + o0.y * o0.y) + (o0.z * o0.z + o0.w * o0.w) + (o1.x * o1.x + o1.y * o1.y) + (o1.z * o1.z + o1.w * o1.w);
            ss = sum8(ss);
            const float rstd = 1.0f / sqrtf(ss * (1.0f / 64.0f) + EPS);
            const int row = gla_row(b, c, i);
            const float gg[8] = {R.gg[0].x, R.gg[0].y, R.gg[0].z, R.gg[0].w, R.gg[1].x, R.gg[1].y, R.gg[1].z, R.gg[1].w};
            float r[8]; unpack8(R.rg, r);
            float y[8] = {o0.x, o0.y, o0.z, o0.w, o1.x, o1.y, o1.z, o1.w};
#pragma unroll
            for (int e = 0; e < 8; ++e) y[e] = y[e] * rstd * gg[e] * (r[e] * sigm(r[e]));
            *(u32x4*)(CAT + (size_t)row * DM + 256 + h * 64 + vg * 8) = pack8(y); }
    }
}
__device__ __forceinline__ void ctx_gemm_res(KA a, LDSP unsigned char* lds, const bf16_t* A, const bf16_t* Bt, int K, const float* gate, float coef,
                                             _Float16* XR, bf16_t* XS, float* ssq, const float* gn, const float* scn, int tid, int bid, int G) {
    const int lane = tid & 63, w = tid >> 6, wm = w >> 1, wn = w & 1, fr = lane & 15, fq = lane >> 4;
    constexpr int CP = 136;
    LDSP unsigned char* As = lds; LDSP unsigned char* Bs = lds + 128 * CP * 2; LDSP float* Cs = (LDSP float*)(lds + 53248);
    const int nk = K / 128, lr = tid >> 4, lc = (tid & 15) * 8;
    for (int u = bid; u < 256; u += G) {
        int tm = u >> 4, tn = u & 15;
        if (G == 256) { const int x = u & 7, sl = u >> 3; tm = (x & 3) * 4 + (sl >> 3); tn = (x >> 2) * 8 + (sl & 7); }
        const size_t row0 = (size_t)MX + tm * 128; const int col0 = tn * 64;
        const bf16_t* ap = A + (row0 + lr) * K + lc; const bf16_t* bp = Bt + (size_t)(col0 + lr) * K + lc;
        u32x4 ra[2][4], rb[2][2];
#pragma unroll
        for (int st = 0; st < 2; ++st) {
#pragma unroll
            for (int q = 0; q < 4; ++q) ra[st][q] = *(const u32x4*)(ap + (size_t)(32 * q) * K + st * 128);
#pragma unroll
            for (int q = 0; q < 2; ++q) rb[st][q] = *(const u32x4*)(bp + (size_t)(32 * q) * K + st * 128); }
        f32x4 acc[2][2];
#pragma unroll
        for (int mt = 0; mt < 2; ++mt)
#pragma unroll
            for (int nt = 0; nt < 2; ++nt) acc[mt][nt] = (f32x4){0.f, 0.f, 0.f, 0.f};
#pragma unroll 1
        for (int kt = 0; kt < nk; kt += 2) {
#pragma unroll
            for (int st = 0; st < 2; ++st) {
#pragma unroll
                for (int q = 0; q < 4; ++q) *(LDSP u32x4*)(As + ((32 * q + lr) * CP + lc) * 2) = ra[st][q];
#pragma unroll
                for (int q = 0; q < 2; ++q) *(LDSP u32x4*)(Bs + ((32 * q + lr) * CP + lc) * 2) = rb[st][q];
                __syncthreads();
                if (kt + st + 2 < nk) {
#pragma unroll
                    for (int q = 0; q < 4; ++q) ra[st][q] = *(const u32x4*)(ap + (size_t)(32 * q) * K + (kt + st + 2) * 128);
#pragma unroll
                    for (int q = 0; q < 2; ++q) rb[st][q] = *(const u32x4*)(bp + (size_t)(32 * q) * K + (kt + st + 2) * 128); }
#pragma unroll
                for (int ks = 0; ks < 4; ++ks) { gbf16x8 af[2], bf[2];
#pragma unroll
                    for (int mt = 0; mt < 2; ++mt) af[mt] = *(LDSP const gbf16x8*)(As + ((wm * 32 + mt * 16 + fr) * CP + ks * 32 + fq * 8) * 2);
#pragma unroll
                    for (int nt = 0; nt < 2; ++nt) bf[nt] = *(LDSP const gbf16x8*)(Bs + ((wn * 32 + nt * 16 + fr) * CP + ks * 32 + fq * 8) * 2);
#pragma unroll
                    for (int mt = 0; mt < 2; ++mt)
#pragma unroll
                        for (int nt = 0; nt < 2; ++nt) acc[mt][nt] = __builtin_amdgcn_mfma_f32_16x16x32_bf16(af[mt], bf[nt], acc[mt][nt], 0, 0, 0); }
                __syncthreads();
            }
        }
#pragma unroll
        for (int mt = 0; mt < 2; ++mt)
#pragma unroll
            for (int nt = 0; nt < 2; ++nt)
#pragma unroll
                for (int r = 0; r < 4; ++r) Cs[(wm * 32 + mt * 16 + fq * 4 + r) * 68 + wn * 32 + nt * 16 + fr] = acc[mt][nt][r];
        __syncthreads();
        { const int rl = tid >> 2, cs = (tid & 3) * 16; const size_t grow = row0 + rl; const int gc = col0 + cs;
            float x[16];
            {
#pragma unroll
                for (int q = 0; q < 2; ++q) { const pg8::f32x8 t = __builtin_convertvector(*(const pg8::h16x8*)(XR + grow * 1024 + gc + 8 * q), pg8::f32x8);
#pragma unroll
                    for (int e = 0; e < 8; ++e) x[8 * q + e] = t[e]; } }
            const float* g = gate + (size_t)8 * 9216 + gc; const float* gnp = gn + gc; const float* scp = scn + (size_t)8 * 9216 + gc;
            float ss = 0.f, y[16];
#pragma unroll
            for (int q = 0; q < 4; ++q) { const f32x4 gv = *(const f32x4*)(g + 4 * q), cv = *(LDSP const f32x4*)(Cs + rl * 68 + cs + 4 * q), gg = *(const f32x4*)(gnp + 4 * q), sc = *(const f32x4*)(scp + 4 * q);
#pragma unroll
                for (int e = 0; e < 4; ++e) { const float xv = x[4 * q + e] + coef * gv[e] * cv[e]; x[4 * q + e] = xv; ss += xv * xv; y[4 * q + e] = xv * gg[e] * (sc[e] + 1.0f); } }
#pragma unroll
            for (int q = 0; q < 2; ++q) { const pg8::f32x8 t = {x[8 * q], x[8 * q + 1], x[8 * q + 2], x[8 * q + 3], x[8 * q + 4], x[8 * q + 5], x[8 * q + 6], x[8 * q + 7]};
                *(pg8::h16x8*)(XR + grow * 1024 + gc + 8 * q) = __builtin_convertvector(t, pg8::h16x8);
                u32x4 wv; wv.x = pk2(y[8 * q], y[8 * q + 1]); wv.y = pk2(y[8 * q + 2], y[8 * q + 3]); wv.z = pk2(y[8 * q + 4], y[8 * q + 5]); wv.w = pk2(y[8 * q + 6], y[8 * q + 7]);
                *(u32x4*)(XS + grow * 1024 + gc + 8 * q) = wv; }
            ss += swz_xor<1>(ss); ss += swz_xor<2>(ss);
            if ((tid & 3) == 0) atomicAdd(ssq + grow, ss); }
        __syncthreads();
    }
}
__device__ __forceinline__ void attn_phase(KA a, unsigned char* lds, bool last, int bid, int G) {
    using abf = attn_body::bf16;
    const abf* Q = (const abf*)(a->ws + WS_Q); const abf* Kb = (const abf*)(a->ws + WS_K); const abf* Vb = (const abf*)(a->ws + WS_V); abf* CAT = (abf*)a->out;
    const int nunits = last ? 1024 : 1088;
    const int nlat = bid < 1024 ? (1024 - bid + G - 1) / G : 0, c0 = G - 1 - bid, nctx = (nunits > 1024 && c0 < 64) ? (64 - c0 + G - 1) / G : 0;
    for (int i = 0; i < nlat + nctx; ++i) {
        const int u = (i < nlat) ? bid + i * G : 1024 + c0 + (i - nlat) * G;
        int b, h, NT; size_t qrow;
        if (u < 1024) { b = u >> 7; h = (u >> 4) & 7; qrow = (size_t)b * SEQ + (size_t)(u & 15) * 256; NT = NCH; }
        else { const int uc = u - 1024; b = uc >> 3; h = uc & 7; qrow = (size_t)MX + (size_t)b * CTXL; NT = 4; }
        const size_t kvo = (size_t)b * KVLEN * 128 + (h >> 2) * 64;
        attn_body::attn_unit<8>(Q + qrow * 512 + h * 64, Kb + kvo, Vb + kvo, CAT + qrow * DM + 512 + h * 64, NT, (char*)lds);
    }
}
#define XB_TMO      128
#define XB_XCNT(j)  (256  + 64 * (j))
#define XB_XSUB(j)  (1280 + 64 * (j))
#define XB_XGEN(j)  (2304 + 64 * (j))
#define XB_TOP      3328
#define XB_TOPGEN   3392
#define XCD_BAR_WORDS 3456
#define XB_SPIN_CAP (1u << 18)

__device__ __forceinline__ unsigned xb_ld(unsigned* p)              { return __hip_atomic_load(p, __ATOMIC_RELAXED, __HIP_MEMORY_SCOPE_AGENT); }
__device__ __forceinline__ unsigned xb_add(unsigned* p, unsigned v) { return __hip_atomic_fetch_add(p, v, __ATOMIC_RELAXED, __HIP_MEMORY_SCOPE_AGENT); }
__device__ __forceinline__ unsigned xb_xcc_id() { return (unsigned)__builtin_amdgcn_s_getreg((3 << 11) | 20) & 0xFu; }
#define XB_SPIN(cond, bar) do { unsigned _sp = 0; while (cond) { __builtin_amdgcn_s_sleep(1); \
    if ((++_sp & 255u) == 0u) { if (xb_ld(&(bar)[XB_TMO])) break; if (_sp > XB_SPIN_CAP) { atomicAdd(&(bar)[XB_TMO], 1u); break; } } } } while (0)

struct XcdBarrier {
    unsigned* bar; unsigned x;
    volatile LDSP unsigned* st;
};

__device__ __forceinline__ XcdBarrier xcd_barrier_post(unsigned* bar, volatile LDSP unsigned* st) {
    XcdBarrier b; b.bar = bar; b.x = xb_xcc_id(); b.st = st;
    if (threadIdx.x == 0) (void)xb_add(&bar[XB_XCNT(b.x)], 1u);
    return b;
}
__device__ __forceinline__ void xcd_barrier_complete(unsigned* bar, unsigned x, unsigned& nloc, unsigned& nx) {
    const unsigned G = gridDim.x * gridDim.y * gridDim.z;
    unsigned sum, cnt, mine, sp = 0u;
    for (;;) {
        sum = 0u; cnt = 0u; mine = 0u;
#pragma unroll
        for (unsigned j = 0; j < 16; ++j) { const unsigned c = xb_ld(&bar[XB_XCNT(j)]); sum += c; cnt += (c > 0u) ? 1u : 0u; mine = (j == x) ? c : mine; }
        if (sum == G) break;
        __builtin_amdgcn_s_sleep(1);
        if ((++sp & 255u) == 0u) { if (xb_ld(&bar[XB_TMO])) break; if (sp > XB_SPIN_CAP) { atomicAdd(&bar[XB_TMO], 1u); break; } }
    }
    nloc = mine > 0u ? mine : 1u; nx = cnt > 0u ? cnt : 1u;
}

__device__ __forceinline__ void xcd_barrier(const XcdBarrier& b) {
    asm volatile("s_waitcnt vmcnt(0)" ::: "memory");
    __syncthreads();
    if (threadIdx.x == 0) {
        unsigned* bar = b.bar;
        __builtin_amdgcn_s_waitcnt(0);
        unsigned nloc = b.st[0], nx = b.st[1];
        if (nloc == 0u) { xcd_barrier_complete(bar, b.x, nloc, nx); b.st[0] = nloc; b.st[1] = nx; }
        const unsigned old = xb_add(&bar[XB_XSUB(b.x)], 1u);
        const unsigned gen = old / nloc;
        if (old + 1u == (gen + 1u) * nloc) {
            __builtin_amdgcn_fence(__ATOMIC_RELEASE, "agent");
            asm volatile("s_waitcnt vmcnt(0)" ::: "memory");
            const unsigned og = xb_add(&bar[XB_TOP], 1u);
            const unsigned tg = og / nx;
            if (og + 1u == (tg + 1u) * nx) xb_add(&bar[XB_TOPGEN], 1u);
            else XB_SPIN(xb_ld(&bar[XB_TOPGEN]) == tg, bar);
            __builtin_amdgcn_fence(__ATOMIC_ACQUIRE, "agent");
            xb_add(&bar[XB_XGEN(b.x)], 1u);
            asm volatile("s_waitcnt vmcnt(0)" ::: "memory");
        } else {
            XB_SPIN(xb_ld(&bar[XB_XGEN(b.x)]) == gen, bar);
            __builtin_amdgcn_fence(__ATOMIC_ACQUIRE, "agent");
            asm volatile("s_waitcnt vmcnt(0)" ::: "memory");
        }
    }
    __syncthreads();
}
__global__ void __launch_bounds__(512, 2) mega_fwd(Args a_unused) {
    KA a = (KA)__builtin_amdgcn_kernarg_segment_ptr();
    const int ph_lo = a->ph_lo, ph_hi = a->ph_hi;
    extern __shared__ __attribute__((aligned(16))) unsigned char lds_raw[];
    LDSP unsigned char* lds0 = (LDSP unsigned char*)lds_raw;
    { LDSP unsigned char* lds = lds0;
    volatile LDSP unsigned* xst = (volatile LDSP unsigned*)(lds + 131072 + 64);
    if (threadIdx.x == 0) { xst[0] = 0u; xst[1] = 0u; }
    __syncthreads();
    if (ph_hi - ph_lo > 1) (void)xcd_barrier_post((unsigned*)(a->ws + WS_CTL), xst); }
#pragma unroll 1
    for (int ph = ph_lo; ph < ph_hi; ++ph) {
        asm volatile("" : "+s"(a));
        LDSP unsigned char* lds = lds0; asm volatile("" : "+s"(lds));
        volatile LDSP unsigned* xst = (volatile LDSP unsigned*)(lds + 131072 + 64);
        unsigned char* ws = a->ws;
        float* CTXR = (float*)(ws + WS_CTXR);
        const float* MOD = (const float*)(ws + WS_MOD);
        bf16_t* XN = (bf16_t*)(ws + WS_XN); bf16_t* CAT = (bf16_t*)a->out; bf16_t* HP = (bf16_t*)(ws + WS_HP); _Float16* XR = (_Float16*)(ws + WS_CAT);
        const int tid = opaque_tid(), lane = tid & 63, wave = __builtin_amdgcn_readfirstlane(tid >> 6);
        int G = gridDim.x, bid = blockIdx.x; asm volatile("" : "+s"(G), "+s"(bid));
        if (ph == 0) { phase0(a, lds, tid, lane, wave, bid, G); }
        else if (ph == 1) { phase1(a, lds, tid, lane, wave, bid, G); }
        else {
            const int l = (ph - 2) / NPH_LAYER, sp = (ph - 2) % NPH_LAYER; const bool last = (l == DEPTH - 1);
            const bool first = (l == 0 && sp <= 1);
            const float* srcX = first ? a->in[I_X] : a->out; const float* srcC = first ? a->in[I_CTX] : CTXR;
            const int Mtail = last ? MX : MALL;
            const float* SSQ = (const float*)(ws + WS_SSQ); const float* SW = (const float*)(ws + WS_SW);
            switch (sp) {
            case 0: case 7: { const int f = (sp == 0) ? 0 : 1, j = (sp == 0) ? 0 : 2; const int M = (sp == 0) ? MALL : Mtail;
                pg8::Gemm g{XN, (const bf16_t*)(ws + WS_W1T) + (size_t)(l * 2 + f) * W1T_SZ, M, 2 * DFF, DM}; pg8::PrefOrder S; S.init(M, 2 * DFF, G, bid);
                S.pf = lds + pg8::PF_OFF; S.ssq = SSQ + (size_t)(l * 3 + j) * MALL; S.sw = SW + (size_t)(l * 3 + j) * 9 * SWN; S.MXr = MX; S.cnt = 0;
                pg8::EpiSwiGLU E{HP, DFF, lds + pg8::PF_OFF, 0};
                pg8::gemm_phase<pg8::EpiSwiGLU, pg8::PrefOrder, true, true>(lds, g, S, E); } break;
            case 1: case 6: case 8: {
                const bf16_t* A; const bf16_t* Bt; int K, M, j; float coef;
                if (sp == 1) { A = HP; Bt = (const bf16_t*)(ws + WS_W2T) + (size_t)(l * 2 + 0) * W2T_SZ; K = DFF; M = MALL; j = 0; coef = 0.5f; }
                else if (sp == 6) { A = CAT; Bt = (const bf16_t*)(ws + WS_WOT) + (size_t)l * WOT_SZ; K = DM; M = Mtail; j = 1; coef = 1.0f; }
                else { A = HP; Bt = (const bf16_t*)(ws + WS_W2T) + (size_t)(l * 2 + 1) * W2T_SZ; K = DFF; M = Mtail; j = 2; coef = 0.5f; }
                const int ln = (j == 2) ? l + 1 : l, jn = (j == 2) ? 0 : j + 1;
                const bool has_next = ln < DEPTH; const int nidx = has_next ? (ln * 3 + jn) : 0;
                pg8::Gemm g{A, Bt, MX, DM, K}; pg8::StaticOrder S; S.init(MX, DM, G, bid);
                pg8::EpiRes E{a->out, XR, (last && sp == 8) ? 1 : 0, MOD + (size_t)l * 9 * 9216 + (3 * j + 2) * 1024, coef, MX,
                              XN, (float*)(ws + WS_SSQ) + (size_t)nidx * MALL, a->in[I_GNORM] + (size_t)nidx * DM, MOD + (size_t)(nidx / 3) * 9 * 9216 + (3 * jn + 1) * 1024, has_next ? 1 : 0};
                pg8::gemm_phase<pg8::EpiRes, pg8::StaticOrder, true, true>(lds, g, S, E);
                if (M == MALL) ctx_gemm_res(a, lds, A, Bt, K, MOD + (size_t)l * 9 * 9216 + (3 * j + 2) * 1024, coef, XR, XN, (float*)(ws + WS_SSQ) + (size_t)nidx * MALL,
                                            a->in[I_GNORM] + (size_t)nidx * DM, MOD + (size_t)(nidx / 3) * 9 * 9216 + (3 * jn + 1) * 1024, tid, bid, G); } break;
            case 2: { pg8::Gemm g{XN, (const bf16_t*)(ws + WS_WINT) + (size_t)l * WINT_SZ, MALL, INWP, DM}; pg8::PrefOrder S; S.init(MALL, INWP, G, bid);
                S.pf = lds + pg8::PF_OFF; S.ssq = SSQ + (size_t)(l * 3 + 1) * MALL; S.sw = SW + (size_t)(l * 3 + 1) * 9 * SWN; S.MXr = MX; S.cnt = 0;
                pg8::EpiStore E{HP, INWP, lds + pg8::PF_OFF, 0};
                pg8::gemm_phase<pg8::EpiStore, pg8::PrefOrder, true, true>(lds, g, S, E); } break;
            case 3: prep_phase(a, lds, l, tid, lane, wave, bid, G); gla_g1_phase(a, lds, l, tid, bid, G); break;
            case 4: gla_g2_phase(a, tid, bid, G); conv_phase(a, lds, l, last, tid, lane, bid, G); break;
            case 5: attn_phase(a, (unsigned char*)lds, last, bid, G); gla_g3_phase(a, lds, l, last, tid, bid, G); break;
            default: break;
            }
        }
        if (ph + 1 < ph_hi) {
            unsigned* barw = (unsigned*)(ws + WS_CTL);
            if (ph_hi > NPHASES + 4096) cg::this_grid().sync();
            { XcdBarrier xb; xb.bar = barw; xb.x = xb_xcc_id(); xb.st = xst; xcd_barrier(xb); }
        }
    }
}

#ifndef MK_MULTI
#define MK_MULTI 0
#endif
extern "C" void kernel_launch(void* const* d_in, const int* in_sizes, int n_in, void* d_out, int out_size, void* d_ws, size_t ws_size, hipStream_t stream) {
    static int grid = 0;
    if (grid == 0) {
        if (n_in != 20 || out_size != MX * DM || ws_size < WS_END) { fprintf(stderr, "kernel_launch: unexpected shapes (n_in %d, out %d, ws %zu); nothing launched\n", n_in, out_size, ws_size); grid = -1; return; }
        int dev = 0, cus = 0, per_cu = 0;
        if (hipGetDevice(&dev) != hipSuccess || hipDeviceGetAttribute(&cus, hipDeviceAttributeMultiprocessorCount, dev) != hipSuccess) { grid = -1; return; }
        if (hipFuncSetAttribute((const void*)mega_fwd, hipFuncAttributeMaxDynamicSharedMemorySize, LDS_BYTES) != hipSuccess) { fprintf(stderr, "kernel_launch: hipFuncSetAttribute failed\n"); grid = -1; return; }
        if (hipOccupancyMaxActiveBlocksPerMultiprocessor(&per_cu, (const void*)mega_fwd, 512, LDS_BYTES) != hipSuccess || per_cu < 1) { fprintf(stderr, "kernel_launch: occupancy query gave %d\n", per_cu); per_cu = 1; }
        (void)hipGetLastError();
        grid = cus * per_cu;
    }
    if (grid < 0) return;
    Args a{};
    for (int i = 0; i < 20; ++i) a.in[i] = (const float*)d_in[i];
    a.out = (float*)d_out; a.ws = (unsigned char*)d_ws;
#if MK_MULTI
    for (int ph = 0; ph < NPHASES; ++ph) { a.ph_lo = ph; a.ph_hi = ph + 1; hipLaunchKernelGGL(mega_fwd, dim3(grid), dim3(512), LDS_BYTES, stream, a); }
#else
    a.ph_lo = 0; a.ph_hi = NPHASES;
    if (hipMemsetAsync((char*)d_ws + WS_CTL, 0, XCD_BAR_WORDS * 4, stream) != hipSuccess) { fprintf(stderr, "kernel_launch: hipMemsetAsync of the barrier words failed\n"); return; }
    void* args[] = {&a};
    hipError_t e = hipLaunchCooperativeKernel((const void*)mega_fwd, dim3(grid), dim3(512), args, LDS_BYTES, stream);
    if (e != hipSuccess) fprintf(stderr, "kernel_launch: cooperative launch failed: %s (grid %d)\n", hipGetErrorString(e), grid);
#endif
}
```
